# Optimizing an MI355X kernel written in HIP

```python
import math
import jax, jax.numpy as jnp
from jax import lax
import numpy as np

D_MODEL = 1024
BATCH = 8
SEQ = 2048
DEPTH = 2

PLE_DIM = 256
NORM_EPS = 1e-6
N_BRANCHES = 3
BRANCH_WIDTH = D_MODEL // 2

M_HEADS = 4
M_DK = BRANCH_WIDTH // M_HEADS
M_DV = BRANCH_WIDTH // M_HEADS
M_CONV = 4
M_CHUNK = 128
M_FBIAS_LO = 3.0
M_FBIAS_HI = 6.0

A_HEADS = 4
A_DV = BRANCH_WIDTH // A_HEADS
A_DQK = A_DV // 2
Q_BLOCK = 128
ALIBI_SLOPES = tuple(2.0 ** (-8.0 * (h + 1) / A_HEADS) for h in range(A_HEADS))

P_WINDOWS = (2, 4, 8, 16)
P_GROUPS = len(P_WINDOWS)
P_GC = BRANCH_WIDTH // P_GROUPS

D_FF = 2816
N_EXPERTS = 8
TOP_K = 2
D_FF_EXPERT = 3584
N_DENSE = (DEPTH + 1) // 2
N_MOE = DEPTH // 2

IN_SPLITS = (2 * M_HEADS * M_DK,
             M_HEADS * M_DV,
             BRANCH_WIDTH,
             M_HEADS,
             M_HEADS,
             A_HEADS * 2 * A_DQK,
             A_HEADS * 2 * A_DQK,
             A_HEADS * A_DV,
             BRANCH_WIDTH,
             N_BRANCHES * D_MODEL)
IN_WIDTH = sum(IN_SPLITS)

kernel_name = "hybrid_mlstm_diffattn_pool_moe_block"

F32 = jnp.float32


def rms_norm(x, gain):
    xf = x.astype(F32)
    y = xf * lax.rsqrt(jnp.mean(xf * xf, axis=-1, keepdims=True) + NORM_EPS)
    return (y * gain.astype(F32)).astype(x.dtype)


def causal_dwconv(x, w, b):
    C = x.shape[-1]
    y = lax.conv_general_dilated(x, w[:, None, :].astype(x.dtype), window_strides=(1,),
                                 padding=[(w.shape[0] - 1, 0)],
                                 dimension_numbers=('NWC', 'WIO', 'NWC'),
                                 feature_group_count=C)
    return y + b.astype(x.dtype)


def swiglu(h, w_gu, w_down):
    g, u = jnp.split(h @ w_gu, 2, axis=-1)
    return (jax.nn.silu(g) * u) @ w_down


def mlstm_chunkwise(q, k, v, i_pre, f_pre):
    B, H, S, DK = q.shape
    DV = v.shape[-1]
    L = M_CHUNK
    NC = S // L
    logf = jax.nn.log_sigmoid(f_pre)

    def to_chunks(a):
        return jnp.moveaxis(a.reshape(B, H, NC, L, *a.shape[3:]), 2, 0)

    xs = (to_chunks(q), to_chunks(k), to_chunks(v), to_chunks(i_pre), to_chunks(logf))
    causal = jnp.tril(jnp.ones((L, L), dtype=bool))

    def step(carry, xc):
        C, n, m = carry
        qx, kx, vx, ix, fx = xc
        b = jnp.cumsum(fx, axis=-1)
        logD = jnp.where(causal, b[..., :, None] - b[..., None, :] + ix[..., None, :], -jnp.inf)
        inter = b + m[..., None]
        m_t = jnp.maximum(jnp.max(logD, axis=-1), inter)
        Dw = jnp.exp(logD - m_t[..., None])
        w_inter = jnp.exp(inter - m_t)
        s = jnp.einsum('bhtd,bhsd->bhts', qx, kx) * Dw
        num = jnp.einsum('bhts,bhsv->bhtv', s, vx) + w_inter[..., None] * jnp.einsum('bhtd,bhdv->bhtv', qx, C)
        den = jnp.sum(s, axis=-1) + w_inter * jnp.einsum('bhtd,bhd->bht', qx, n)
        h = num / jnp.maximum(jnp.abs(den), jnp.exp(-m_t))[..., None]
        bL = b[..., -1]
        log_w = bL[..., None] - b + ix
        m_new = jnp.maximum(bL + m, jnp.max(log_w, axis=-1))
        decay = jnp.exp(bL + m - m_new)
        w = jnp.exp(log_w - m_new[..., None])
        C_new = decay[..., None, None] * C + jnp.einsum('bhs,bhsd,bhsv->bhdv', w, kx, vx)
        n_new = decay[..., None] * n + jnp.einsum('bhs,bhsd->bhd', w, kx)
        return (C_new, n_new, m_new), h

    init = (jnp.zeros((B, H, DK, DV), F32), jnp.zeros((B, H, DK), F32), jnp.zeros((B, H), F32))
    _, hs = lax.scan(step, init, xs)
    return jnp.moveaxis(hs, 0, 2).reshape(B, H, S, DV)


def mlstm_branch(qk_pre, v_pre, o_pre, i_pre, f_pre, conv_w, conv_b, gate_bias, head_gain):
    B, S, _ = qk_pre.shape
    qk = jax.nn.silu(causal_dwconv(qk_pre, conv_w, conv_b))
    q, k = jnp.split(qk, 2, axis=-1)

    def heads(a, d):
        return a.reshape(B, S, M_HEADS, d).transpose(0, 2, 1, 3).astype(F32)

    q = heads(q, M_DK)
    k = heads(k, M_DK) * (M_DK ** -0.5)
    v = heads(v_pre, M_DV)
    gb = gate_bias.astype(F32)
    ig = (i_pre.astype(F32) + gb[:M_HEADS]).transpose(0, 2, 1)
    fg = (f_pre.astype(F32) + gb[M_HEADS:]).transpose(0, 2, 1)
    h = mlstm_chunkwise(q, k, v, ig, fg).transpose(0, 2, 1, 3)
    h = rms_norm(h, head_gain.reshape(M_HEADS, M_DV)).reshape(B, S, BRANCH_WIDTH)
    h = h * jax.nn.sigmoid(o_pre.astype(F32))
    return h.astype(qk_pre.dtype)


def diff_attention_branch(q_pre, k_pre, v_pre, q_gain, k_gain, lam_params, head_gain, lam_init):
    B, S, _ = q_pre.shape
    dt = q_pre.dtype
    q = rms_norm(q_pre.reshape(B, S, A_HEADS, 2, A_DQK), q_gain).astype(F32) * (A_DQK ** -0.5)
    k = rms_norm(k_pre.reshape(B, S, A_HEADS, 2, A_DQK), k_gain).astype(F32)
    q = q.transpose(0, 2, 3, 1, 4)
    k = k.transpose(0, 2, 3, 1, 4)
    v = v_pre.reshape(B, S, A_HEADS, A_DV).transpose(0, 2, 1, 3).astype(F32)
    lp = lam_params.astype(F32)
    lam = jnp.exp(jnp.dot(lp[0], lp[1])) - jnp.exp(jnp.dot(lp[2], lp[3])) + lam_init
    slopes = jnp.asarray(ALIBI_SLOPES, F32)[:, None, None, None]
    outs = []
    for blk in range(S // Q_BLOCK):
        q0 = blk * Q_BLOCK
        q1 = q0 + Q_BLOCK
        s = jnp.einsum('bhmqd,bhmkd->bhmqk', q[:, :, :, q0:q1], k[:, :, :, :q1])
        dist = (jnp.arange(q0, q1)[:, None] - jnp.arange(q1)[None, :]).astype(F32)
        s = jnp.where(dist >= 0, s - slopes * dist, -jnp.inf)
        a = jax.nn.softmax(s, axis=-1)
        a = a[:, :, 0] - lam * a[:, :, 1]
        outs.append(jnp.einsum('bhqk,bhkd->bhqd', a, v[:, :, :q1]))
    o = jnp.concatenate(outs, axis=2).transpose(0, 2, 1, 3)
    o = rms_norm(o, head_gain.reshape(A_HEADS, A_DV)) * (1.0 - lam_init)
    return o.reshape(B, S, BRANCH_WIDTH).astype(dt)


def pool_branch(u, w_group, scale):
    B, S, _ = u.shape
    uf = u.astype(F32).reshape(B, S, P_GROUPS, P_GC)
    cs = jnp.pad(jnp.cumsum(uf, axis=1), ((0, 0), (1, 0), (0, 0), (0, 0)))
    t = jnp.arange(S)
    outs = []
    for g, w in enumerate(P_WINDOWS):
        lower = jnp.pad(cs[:, :S - w + 1, g], ((0, 0), (w - 1, 0), (0, 0)))
        cnt = jnp.minimum(t + 1, w).astype(F32)[None, :, None]
        outs.append((cs[:, 1:, g] - lower) / cnt)
    pooled = jnp.stack(outs, axis=2) - uf
    y = jnp.einsum('bsgc,gcd->bsgd', pooled, w_group.astype(F32)).reshape(B, S, BRANCH_WIDTH)
    return (y * scale.astype(F32)).astype(u.dtype)


def moe_swiglu(h, w_router, b_router, w_gu, w_down):
    logits = h.astype(F32) @ w_router.astype(F32) + b_router.astype(F32)
    top_val, top_idx = lax.top_k(logits, TOP_K)
    top_gate = jax.nn.softmax(top_val, axis=-1)
    combine = jnp.sum(jax.nn.one_hot(top_idx, N_EXPERTS, dtype=F32) * top_gate[..., None], axis=-2)
    out = jnp.zeros_like(h)
    for e in range(N_EXPERTS):
        out = out + combine[..., e:e + 1].astype(h.dtype) * swiglu(h, w_gu[e], w_down[e])
    return out


def setup_inputs(seed: int = 0) -> dict:
    key = jax.random.key(seed)
    ks = jax.random.split(key, 28)
    D = D_MODEL

    def nrm(i, shape, scale):
        return scale * jax.random.normal(ks[i], shape, F32)

    def gain(i, shape):
        return 1.0 + nrm(i, shape, 0.05)

    f_bias = jnp.linspace(M_FBIAS_LO, M_FBIAS_HI, M_HEADS, dtype=F32)
    m_gate_bias = jnp.concatenate([nrm(6, (DEPTH, M_HEADS), 0.1),
                                   f_bias[None, :] + nrm(7, (DEPTH, M_HEADS), 0.1)], axis=-1)
    return {
        "x": nrm(0, (BATCH, SEQ, D), 1.0),
        "p": nrm(1, (DEPTH, BATCH, SEQ, PLE_DIM), 1.0),
        "attn_norm": gain(2, (DEPTH, D)),
        "w_in": nrm(3, (DEPTH, D, IN_WIDTH), D ** -0.5),
        "m_conv_w": nrm(4, (DEPTH, M_CONV, 2 * M_HEADS * M_DK), M_CONV ** -0.5),
        "m_conv_b": nrm(5, (DEPTH, 2 * M_HEADS * M_DK), 0.02),
        "m_gate_bias": m_gate_bias,
        "m_head_norm": gain(8, (DEPTH, BRANCH_WIDTH)),
        "a_q_norm": gain(9, (DEPTH, A_DQK)),
        "a_k_norm": gain(10, (DEPTH, A_DQK)),
        "a_lambda": nrm(11, (DEPTH, 4, A_DQK), 0.1),
        "a_head_norm": gain(12, (DEPTH, BRANCH_WIDTH)),
        "pool_w": nrm(13, (DEPTH, P_GROUPS, P_GC, P_GC), P_GC ** -0.5),
        "pool_scale": 1.0 + nrm(14, (DEPTH, BRANCH_WIDTH), 0.1),
        "w_branch": nrm(15, (DEPTH, N_BRANCHES, BRANCH_WIDTH, D), BRANCH_WIDTH ** -0.5),
        "w_out": nrm(16, (DEPTH, D, D), D ** -0.5),
        "ffn_norm": gain(17, (DEPTH, D)),
        "dense_w_gu": nrm(18, (N_DENSE, D, 2 * D_FF), D ** -0.5),
        "dense_w_down": nrm(19, (N_DENSE, D_FF, D), D_FF ** -0.5),
        "router_w": nrm(20, (N_MOE, D, N_EXPERTS), D ** -0.5),
        "router_b": nrm(21, (N_MOE, N_EXPERTS), 0.01),
        "moe_w_gu": nrm(22, (N_MOE, N_EXPERTS, D, 2 * D_FF_EXPERT), D ** -0.5),
        "moe_w_down": nrm(23, (N_MOE, N_EXPERTS, D_FF_EXPERT, D), D_FF_EXPERT ** -0.5),
        "ple_norm": gain(24, (DEPTH, D)),
        "ple_w_gate": nrm(25, (DEPTH, D, D), D ** -0.5),
        "ple_w_proj": nrm(26, (DEPTH, PLE_DIM, D), PLE_DIM ** -0.5),
    }


def reference(x, p, attn_norm, w_in, m_conv_w, m_conv_b, m_gate_bias, m_head_norm,
              a_q_norm, a_k_norm, a_lambda, a_head_norm, pool_w, pool_scale,
              w_branch, w_out, ffn_norm, dense_w_gu, dense_w_down, router_w, router_b,
              moe_w_gu, moe_w_down, ple_norm, ple_w_gate, ple_w_proj):
    B, S, D = x.shape
    split_points = np.cumsum(np.array(IN_SPLITS))[:-1].tolist()
    for layer in range(DEPTH):
        h = rms_norm(x, attn_norm[layer])
        (m_qk, m_v, m_o, m_i, m_f, a_q, a_k, a_v, p_u, g_pre) = jnp.split(h @ w_in[layer], split_points, axis=-1)
        h_m = mlstm_branch(m_qk, m_v, m_o, m_i, m_f, m_conv_w[layer], m_conv_b[layer],
                           m_gate_bias[layer], m_head_norm[layer])
        lam_init = 0.8 - 0.6 * math.exp(-0.3 * layer)
        h_a = diff_attention_branch(a_q, a_k, a_v, a_q_norm[layer], a_k_norm[layer],
                                    a_lambda[layer], a_head_norm[layer], lam_init)
        h_p = pool_branch(p_u, pool_w[layer], pool_scale[layer])
        hb = jnp.stack([h_m, h_a, h_p], axis=2)
        yb = jnp.einsum('bsrc,rcd->bsrd', hb, w_branch[layer])
        gates = jax.nn.sigmoid(g_pre.reshape(B, S, N_BRANCHES, D))
        x = x + jnp.sum(gates * yb, axis=2) @ w_out[layer]
        hf = rms_norm(x, ffn_norm[layer])
        if layer % 2 == 0:
            j = layer // 2
            x = x + swiglu(hf, dense_w_gu[j], dense_w_down[j])
        else:
            j = layer // 2
            x = x + moe_swiglu(hf, router_w[j], router_b[j], moe_w_gu[j], moe_w_down[j])
        pg = jax.nn.sigmoid(rms_norm(x, ple_norm[layer]) @ ple_w_gate[layer])
        x = x + pg * (p[layer] @ ple_w_proj[layer])
    return x
```

```cpp
#include <hip/hip_runtime.h>
#include <cstdio>
#include <cstdint>
#include <cmath>
#define N_LAUNCH_PER_PHASE 0
namespace pg8 {
#define PG8_LAS __attribute__((address_space(3)))
typedef unsigned short bf16_t;
typedef short bf16x8 __attribute__((ext_vector_type(8)));
typedef float f32x4 __attribute__((ext_vector_type(4)));
typedef unsigned u32x4 __attribute__((ext_vector_type(4)));
constexpr int BM = 256, BK = 64, HALF = 128, HTB = HALF * BK * 2  , STAGE_BYTES = 8 * HTB, NXCD = 8, WGM = 8;

__host__ __device__ __forceinline__ int lds_byte(int r, int c) { const int st = (r >> 4) * 2 + (c >> 5), rr = r & 15, cc = c & 31, ob = rr * 64 + cc * 2; return st * 1024 + (ob ^ (((ob >> 9) & 1) << 5)); }
__host__ __device__ __forceinline__ void stage_rc(int b, int& R, int& C) { const int st = b / 1024, sb = b % 1024, swz = sb ^ (((sb >> 9) & 1) << 5); R = (st >> 1) * 16 + swz / 64; C = (st & 1) * 32 + (swz % 64) / 2; }
__host__ __device__ __forceinline__ int perm32(int rho) { const int n = rho >> 4, i = rho & 15; return 8 * (i >> 2) + 4 * n + (i & 3); }

struct Unit { int pm, pn, ko; };
struct Gemm { const bf16_t* A; const bf16_t* Bt; int M, N, K, ld; };

struct StaticOrder {
    int nM, nN, nwg, G, c;
    __host__ __device__ void init(int M, int N, int G_, int c_) { nM = M / BM; nN = N / BM; nwg = nM * nN; G = G_; c = c_; }
    __host__ __device__ bool next(int i, Unit& u) const {
        const long L = (long)i * G + c; if (L >= nwg) return false;
        int wgid = (int)L; { const int q = nwg / NXCD, r = nwg % NXCD, xcd = wgid % NXCD, off = wgid / NXCD; wgid = (xcd < r ? xcd * (q + 1) : r * (q + 1) + (xcd - r) * q) + off; }
        const int nig = WGM * nN, gid = wgid / nig, fm = gid * WGM, gsz = (nM - fm) < WGM ? (nM - fm) : WGM;
        u.pm = fm + ((wgid % nig) % gsz); u.pn = (wgid % nig) / gsz; u.ko = 0; return true;
    }
    __device__ __forceinline__ void a_ready(const Unit&) const {}
    __device__ __forceinline__ void done(const Unit&) const {}
};
__device__ __forceinline__ unsigned cvt_pk_bf16(float lo, float hi) { unsigned r; asm volatile("v_cvt_pk_bf16_f32 %0, %1, %2" : "=v"(r) : "v"(lo), "v"(hi)); return r; }
typedef float f32x2 __attribute__((ext_vector_type(2)));
typedef int i32x4 __attribute__((ext_vector_type(4)));
template <bool I8> struct AccOf { typedef f32x4 type; };
template <> struct AccOf<true> { typedef i32x4 type; };
__device__ __forceinline__ f32x4 mma16(bf16x8 a, bf16x8 b, f32x4 c) { return __builtin_amdgcn_mfma_f32_16x16x32_bf16(a, b, c, 0, 0, 0); }
__device__ __forceinline__ i32x4 mma16(bf16x8 a, bf16x8 b, i32x4 c) { return __builtin_amdgcn_mfma_i32_16x16x64_i8(__builtin_bit_cast(i32x4, a), __builtin_bit_cast(i32x4, b), c, 0, 0, 0); }
template <class Epi, class Sched, bool ALIGN_EPI = false, bool SP2 = false>
__device__ __forceinline__ void gemm_phase(PG8_LAS unsigned char* lds, const Gemm g, const Sched& S, const Epi& E) {
    int tid_o = threadIdx.x; asm volatile("" : "+v"(tid_o));
    const int tid = tid_o, wid = __builtin_amdgcn_readfirstlane(tid >> 6), lane = tid & 63, wr = wid >> 2, wc = wid & 3, fr = lane & 15, fq = lane >> 4;
    const int K = g.ld, nt = g.K / BK;
    unsigned voffA[2], voffB[2];
#pragma unroll
    for (int i = 0; i < 2; ++i) { int R, C; stage_rc(tid * 16 + i * 8192, R, C); const int Rb = Epi::PERM ? ((R & ~31) + perm32(R & 31)) : R;
        voffA[i] = (unsigned)(R * K + C) * 2u; voffB[i] = (unsigned)(Rb * K + C) * 2u; }
    const size_t kstep = (size_t)(BK * 2);
    const size_t hstep = (size_t)HALF * K * 2;
    const size_t tstep = 2 * hstep;
    const unsigned ldsw = (unsigned)wid * 1024u;
    const int aoff = lds_byte(wr * 64 + fr, fq * 8), boff = lds_byte(wc * 32 + fr, fq * 8);
#define PG8_SA(b, h) (((b) * 2 + (h)) * HTB)
#define PG8_SB(b, h) ((4 + (b) * 2 + (h)) * HTB)
#define PG8_STAGE(bufoff, gbase, voff) do { _Pragma("unroll") for (int _i = 0; _i < 2; ++_i) \
        __builtin_amdgcn_global_load_lds((const unsigned*)((const char*)(gbase) + (voff)[_i]), (PG8_LAS unsigned*)(lds + (bufoff) + ldsw + _i * 8192), 16, 0, 0); } while (0)
#define PG8_LDA(dst, b, h) do { _Pragma("unroll") for (int m = 0; m < 4; ++m) _Pragma("unroll") for (int k = 0; k < 2; ++k) dst[m][k] = *(const PG8_LAS bf16x8*)(lds + PG8_SA(b, h) + aoff + m * 2048 + k * 1024); } while (0)
#define PG8_LDB(dst, b, h) do { _Pragma("unroll") for (int n = 0; n < 2; ++n) _Pragma("unroll") for (int k = 0; k < 2; ++k) dst[n][k] = *(const PG8_LAS bf16x8*)(lds + PG8_SB(b, h) + boff + n * 2048 + k * 1024); } while (0)
#define PG8_MMA(ai, bj, At, Bt) do { __builtin_amdgcn_s_setprio(1); _Pragma("unroll") for (int m = 0; m < 4; ++m) _Pragma("unroll") for (int n = 0; n < 2; ++n) _Pragma("unroll") for (int k = 0; k < 2; ++k) \
        acc[ai][bj][m][n] = mma16(Bt[n][k], At[m][k], acc[ai][bj][m][n]); __builtin_amdgcn_s_setprio(0); } while (0)
#define PG8_WAIT_V(n) asm volatile("s_waitcnt vmcnt(" #n ")" ::: "memory")
#define PG8_WAIT_L(n) asm volatile("s_waitcnt lgkmcnt(" #n ")" ::: "memory")
#define PG8_BAR __builtin_amdgcn_s_barrier()
#define PG8_SCHED __builtin_amdgcn_sched_barrier(0)
    Unit cur, nxt; int ui = 0;
    if (!S.next(0, cur)) return;
    typedef typename AccOf<Epi::I8>::type acc_t;
    acc_t acc[2][2][4][2];
#pragma unroll
    for (int a = 0; a < 2; ++a)
#pragma unroll
        for (int b = 0; b < 2; ++b)
#pragma unroll
            for (int m = 0; m < 4; ++m)
#pragma unroll
                for (int n = 0; n < 2; ++n) acc[a][b][m][n] = (acc_t){0, 0, 0, 0};
    bf16x8 At[4][2], B0[2][2], B1[2][2];
    const char* cA = (const char*)g.A + (size_t)cur.pm * tstep + (size_t)cur.ko * 2; const char* cB = (const char*)g.Bt + (size_t)cur.pn * tstep + (size_t)cur.ko * 2;
    S.a_ready(cur);
    if constexpr (SP2) {
        PG8_STAGE(PG8_SB(0, 0), cB, voffB); PG8_STAGE(PG8_SB(0, 1), cB + hstep, voffB); PG8_STAGE(PG8_SA(0, 0), cA, voffA); PG8_STAGE(PG8_SA(0, 1), cA + hstep, voffA);
        if (wr == 1) PG8_BAR;
        PG8_WAIT_V(2); PG8_BAR;
        PG8_STAGE(PG8_SB(1, 0), cB + kstep, voffB); PG8_STAGE(PG8_SA(1, 0), cA + kstep, voffA); PG8_STAGE(PG8_SB(1, 1), cB + hstep + kstep, voffB);
        PG8_WAIT_V(6); PG8_BAR;
    } else {
        PG8_STAGE(PG8_SB(0, 0), cB, voffB); PG8_STAGE(PG8_SA(0, 0), cA, voffA); PG8_STAGE(PG8_SB(0, 1), cB + hstep, voffB); PG8_STAGE(PG8_SA(0, 1), cA + hstep, voffA);
        if (wr == 1) PG8_BAR;
        PG8_WAIT_V(4); PG8_BAR;
        PG8_STAGE(PG8_SB(1, 0), cB + kstep, voffB); PG8_STAGE(PG8_SA(1, 0), cA + kstep, voffA); PG8_STAGE(PG8_SB(1, 1), cB + hstep + kstep, voffB);
        PG8_WAIT_V(6); PG8_BAR;
    }
    for (;;) {
        const bool has_next = S.next(ui + 1, nxt);
        const char* nA = has_next ? (const char*)g.A + (size_t)nxt.pm * tstep + (size_t)nxt.ko * 2 : cA; const char* nB = has_next ? (const char*)g.Bt + (size_t)nxt.pn * tstep + (size_t)nxt.ko * 2 : cB;
#pragma unroll 1
        for (int t = 0; t < nt; t += 2) {
            const bool last = (t == nt - 2);
            const char* a1 = cA + (size_t)(t + 1) * kstep;
            const char* a2 = last ? nA : cA + (size_t)(t + 2) * kstep; const char* b2 = last ? nB : cB + (size_t)(t + 2) * kstep;
            const char* a3 = a2 + kstep; const char* b3 = b2 + kstep;
            if (last && has_next) S.a_ready(nxt);
            if constexpr (SP2) {
            PG8_LDB(B0, 0, 0); PG8_LDB(B1, 0, 1); PG8_SCHED; PG8_LDA(At, 0, 0); PG8_STAGE(PG8_SA(1, 1), a1 + hstep, voffA);
            PG8_WAIT_V(8); PG8_WAIT_L(0); PG8_BAR; PG8_MMA(0, 0, At, B0); PG8_MMA(0, 1, At, B1); PG8_BAR; PG8_SCHED;
            PG8_LDA(At, 0, 1); PG8_STAGE(PG8_SB(0, 0), b2, voffB); PG8_STAGE(PG8_SB(0, 1), b2 + hstep, voffB); PG8_STAGE(PG8_SA(0, 0), a2, voffA);
            PG8_WAIT_V(8); PG8_WAIT_L(0); PG8_BAR; PG8_MMA(1, 0, At, B0); PG8_MMA(1, 1, At, B1); PG8_BAR; PG8_SCHED;
            PG8_LDB(B0, 1, 0); PG8_LDB(B1, 1, 1); PG8_SCHED; PG8_LDA(At, 1, 0); PG8_STAGE(PG8_SA(0, 1), a2 + hstep, voffA);
            PG8_WAIT_V(8); PG8_WAIT_L(0); PG8_BAR; PG8_MMA(0, 0, At, B0); PG8_MMA(0, 1, At, B1); PG8_BAR; PG8_SCHED;
            PG8_LDA(At, 1, 1); PG8_STAGE(PG8_SB(1, 0), b3, voffB); PG8_STAGE(PG8_SB(1, 1), b3 + hstep, voffB); PG8_STAGE(PG8_SA(1, 0), a3, voffA);
            PG8_WAIT_V(8); PG8_WAIT_L(0); PG8_BAR; PG8_MMA(1, 0, At, B0); PG8_MMA(1, 1, At, B1); PG8_BAR; PG8_SCHED;
            } else {
            PG8_LDB(B0, 0, 0); PG8_SCHED; PG8_LDA(At, 0, 0); PG8_STAGE(PG8_SA(1, 1), a1 + hstep, voffA);
            PG8_WAIT_L(8); PG8_BAR; PG8_WAIT_L(0); PG8_MMA(0, 0, At, B0); PG8_BAR; PG8_SCHED;
            PG8_LDB(B1, 0, 1); PG8_STAGE(PG8_SB(0, 0), b2, voffB);
            PG8_BAR; PG8_WAIT_L(0); PG8_MMA(0, 1, At, B1); PG8_BAR;
            PG8_LDA(At, 0, 1); PG8_STAGE(PG8_SA(0, 0), a2, voffA);
            PG8_BAR; PG8_WAIT_L(0); PG8_MMA(1, 0, At, B0); PG8_BAR; PG8_SCHED;
            PG8_STAGE(PG8_SB(0, 1), b2 + hstep, voffB);
            PG8_WAIT_V(6); PG8_BAR; PG8_MMA(1, 1, At, B1); PG8_BAR;
            PG8_LDB(B0, 1, 0); PG8_SCHED; PG8_LDA(At, 1, 0); PG8_STAGE(PG8_SA(0, 1), a2 + hstep, voffA);
            PG8_WAIT_L(8); PG8_BAR; PG8_WAIT_L(0); PG8_MMA(0, 0, At, B0); PG8_BAR; PG8_SCHED;
            PG8_LDB(B1, 1, 1); PG8_STAGE(PG8_SB(1, 0), b3, voffB);
            PG8_BAR; PG8_WAIT_L(0); PG8_MMA(0, 1, At, B1); PG8_BAR;
            PG8_LDA(At, 1, 1); PG8_STAGE(PG8_SA(1, 0), a3, voffA);
            PG8_BAR; PG8_WAIT_L(0); PG8_MMA(1, 0, At, B0); PG8_BAR; PG8_SCHED;
            PG8_STAGE(PG8_SB(1, 1), b3 + hstep, voffB);
            PG8_WAIT_V(6); PG8_BAR; PG8_MMA(1, 1, At, B1); PG8_BAR;
            }
        }
        if constexpr (ALIGN_EPI) { if (wr == 0) PG8_BAR; }
        if constexpr (!Epi::AFTER_DRAIN) { E(acc, cur, wr, wc, fr, fq); S.done(cur); }
        if (!has_next) break;
#pragma unroll
        for (int a = 0; a < 2; ++a)
#pragma unroll
            for (int b = 0; b < 2; ++b)
#pragma unroll
                for (int m = 0; m < 4; ++m)
#pragma unroll
                    for (int n = 0; n < 2; ++n) acc[a][b][m][n] = (acc_t){0, 0, 0, 0};
        cur = nxt; cA = nA; cB = nB; ++ui;
        if constexpr (ALIGN_EPI) { if (wr == 1) PG8_BAR; }
    }
    PG8_WAIT_V(0);
    if constexpr (!ALIGN_EPI) { if (wr == 0) PG8_BAR; }
    PG8_BAR;
    if constexpr (Epi::AFTER_DRAIN) { E.fused(acc, cur, wr, wc, fr, fq, lds, wid, lane); S.done(cur); }
#undef PG8_SA
#undef PG8_SB
#undef PG8_STAGE
#undef PG8_LDA
#undef PG8_LDB
#undef PG8_MMA
#undef PG8_WAIT_V
#undef PG8_WAIT_L
#undef PG8_BAR
#undef PG8_SCHED
}
}
namespace pg8 {
constexpr float kLog2e = 1.4426950408889634f;
__device__ __forceinline__ float fsigmoid(float x) { return __builtin_amdgcn_rcpf(1.f + __builtin_amdgcn_exp2f(-kLog2e * x)); }
__device__ __forceinline__ u32x4 pack8(const f32x4& a, const f32x4& b) { u32x4 w; w.x = cvt_pk_bf16(a[0], a[1]); w.y = cvt_pk_bf16(a[2], a[3]); w.z = cvt_pk_bf16(b[0], b[1]); w.w = cvt_pk_bf16(b[2], b[3]); return w; }
__device__ __forceinline__ void unpack8(const u32x4& w, f32x4& a, f32x4& b) {
    a[0] = __builtin_bit_cast(float, w.x << 16); a[1] = __builtin_bit_cast(float, w.x & 0xffff0000u); a[2] = __builtin_bit_cast(float, w.y << 16); a[3] = __builtin_bit_cast(float, w.y & 0xffff0000u);
    b[0] = __builtin_bit_cast(float, w.z << 16); b[1] = __builtin_bit_cast(float, w.z & 0xffff0000u); b[2] = __builtin_bit_cast(float, w.w << 16); b[3] = __builtin_bit_cast(float, w.w & 0xffff0000u);
}
__device__ __forceinline__ float row_rstd(const float* ssq, int row) {
    const f32x4* p = (const f32x4*)(ssq + (size_t)row * 16); const f32x4 a = p[0], b = p[1], c = p[2], d = p[3];
    const float s = ((a[0] + a[1]) + (a[2] + a[3])) + ((b[0] + b[1]) + (b[2] + b[3])) + ((c[0] + c[1]) + (c[2] + c[3])) + ((d[0] + d[1]) + (d[2] + d[3]));
    return __builtin_amdgcn_rsqf(s * (1.f / 1024.f) + 1e-6f);
}
__device__ __forceinline__ float sumsq8(const f32x4& a, const f32x4& b) { return (a[0] * a[0] + a[1] * a[1]) + (a[2] * a[2] + a[3] * a[3]) + (b[0] * b[0] + b[1] * b[1]) + (b[2] * b[2] + b[3] * b[3]); }
__device__ __forceinline__ float quad_sum_fq(float s) { s += __shfl_xor(s, 16); s += __shfl_xor(s, 32); return s; }

struct EpiProj {
    static constexpr bool PERM = true, AFTER_DRAIN = false, I8 = false;
    bf16_t* O; const float* ssq;
    __device__ __forceinline__ void operator()(const f32x4 (&acc)[2][2][4][2], const Unit& u, int wr, int wc, int fr, int fq) const {
        const bool sg = (u.pn == 6) || (u.pn == 7) || (u.pn >= 16);
        const int row0 = u.pm * BM + wr * 64 + fr, col0 = u.pn * BM + wc * 32 + 8 * fq;
#pragma unroll
        for (int ai = 0; ai < 2; ++ai)
#pragma unroll
            for (int m = 0; m < 4; ++m) { const int row = row0 + ai * HALF + m * 16; const float r = row_rstd(ssq, row); bf16_t* rowp = O + (size_t)row * 7168 + col0;
#pragma unroll
                for (int bj = 0; bj < 2; ++bj) { f32x4 v0 = acc[ai][bj][m][0] * r, v1 = acc[ai][bj][m][1] * r;
                    if (sg) {
#pragma unroll
                        for (int j = 0; j < 4; ++j) { v0[j] = fsigmoid(v0[j]); v1[j] = fsigmoid(v1[j]); } }
                    *(u32x4*)(rowp + bj * HALF) = pack8(v0, v1); } }
    }
};
struct EpiPlain {
    static constexpr bool PERM = true, AFTER_DRAIN = false, I8 = false;
    bf16_t* O;
    __device__ __forceinline__ void operator()(const f32x4 (&acc)[2][2][4][2], const Unit& u, int wr, int wc, int fr, int fq) const {
        const int row0 = u.pm * BM + wr * 64 + fr, col0 = u.pn * BM + wc * 32 + 8 * fq;
#pragma unroll
        for (int ai = 0; ai < 2; ++ai)
#pragma unroll
            for (int m = 0; m < 4; ++m) { bf16_t* rowp = O + (size_t)(row0 + ai * HALF + m * 16) * 1024 + col0;
#pragma unroll
                for (int bj = 0; bj < 2; ++bj) *(u32x4*)(rowp + bj * HALF) = pack8(acc[ai][bj][m][0], acc[ai][bj][m][1]); }
    }
};
template <int R> struct EpiZ {
    static constexpr bool PERM = true, AFTER_DRAIN = false, I8 = false;
    float* ZF; bf16_t* ZB; const bf16_t* PROJ;
    __device__ __forceinline__ void operator()(const f32x4 (&acc)[2][2][4][2], const Unit& u, int wr, int wc, int fr, int fq) const {
        const int row0 = u.pm * BM + wr * 64 + fr, col0 = u.pn * BM + wc * 32 + 8 * fq;
#pragma unroll
        for (int ai = 0; ai < 2; ++ai)
#pragma unroll
            for (int m = 0; m < 4; ++m) { const size_t row = (size_t)(row0 + ai * HALF + m * 16);
#pragma unroll
                for (int bj = 0; bj < 2; ++bj) { const int col = col0 + bj * HALF;
                    f32x4 g0, g1; unpack8(*(const u32x4*)(PROJ + row * 7168 + 4096 + R * 1024 + col), g0, g1);
                    f32x4 v0 = acc[ai][bj][m][0] * g0, v1 = acc[ai][bj][m][1] * g1; float* zp = ZF + row * 1024 + col;
                    if (R > 0) { v0 = v0 + *(const f32x4*)zp; v1 = v1 + *(const f32x4*)(zp + 4); }
                    if (R < 2) { *(f32x4*)zp = v0; *(f32x4*)(zp + 4) = v1; } else *(u32x4*)(ZB + row * 1024 + col) = pack8(v0, v1); } }
    }
};
struct EpiRes {
    static constexpr bool PERM = true, AFTER_DRAIN = false, I8 = false;
    bf16_t* XB; float* ssq;
    __device__ __forceinline__ void operator()(const f32x4 (&acc)[2][2][4][2], const Unit& u, int wr, int wc, int fr, int fq) const {
        const int row0 = u.pm * BM + wr * 64 + fr, col0 = u.pn * BM + wc * 32 + 8 * fq;
#pragma unroll
        for (int ai = 0; ai < 2; ++ai)
#pragma unroll
            for (int m = 0; m < 4; ++m) { const size_t row = (size_t)(row0 + ai * HALF + m * 16); float s = 0.f;
#pragma unroll
                for (int bj = 0; bj < 2; ++bj) { u32x4* xp = (u32x4*)(XB + row * 1024 + col0 + bj * HALF); f32x4 x0, x1; unpack8(*xp, x0, x1);
                    const f32x4 v0 = x0 + acc[ai][bj][m][0], v1 = x1 + acc[ai][bj][m][1];
                    *xp = pack8(v0, v1); s += sumsq8(v0, v1); }
                s = quad_sum_fq(s); if (fq == 0) ssq[row * 16 + u.pn * 4 + wc] = s; }
    }
};
template <bool LAST> struct EpiPle {
    static constexpr bool PERM = true, AFTER_DRAIN = false, I8 = false;
    float* OUT; bf16_t* XB; const float* ssq_in; float* ssq_out; const bf16_t* PP;
    __device__ __forceinline__ void operator()(const f32x4 (&acc)[2][2][4][2], const Unit& u, int wr, int wc, int fr, int fq) const {
        const int row0 = u.pm * BM + wr * 64 + fr, col0 = u.pn * BM + wc * 32 + 8 * fq;
#pragma unroll
        for (int ai = 0; ai < 2; ++ai)
#pragma unroll
            for (int m = 0; m < 4; ++m) { const size_t row = (size_t)(row0 + ai * HALF + m * 16); const float r = row_rstd(ssq_in, (int)row); float s = 0.f;
#pragma unroll
                for (int bj = 0; bj < 2; ++bj) { u32x4* xp = (u32x4*)(XB + row * 1024 + col0 + bj * HALF); f32x4 x0, x1; unpack8(*xp, x0, x1);
                    f32x4 p0, p1; unpack8(*(const u32x4*)(PP + row * 1024 + col0 + bj * HALF), p0, p1);
                    f32x4 v0 = acc[ai][bj][m][0] * r, v1 = acc[ai][bj][m][1] * r;
#pragma unroll
                    for (int j = 0; j < 4; ++j) { v0[j] = fsigmoid(v0[j]) * p0[j]; v1[j] = fsigmoid(v1[j]) * p1[j]; }
                    v0 = v0 + x0; v1 = v1 + x1;
                    if (LAST) { float* op = OUT + row * 1024 + col0 + bj * HALF; *(f32x4*)op = v0; *(f32x4*)(op + 4) = v1; }
                    else { *xp = pack8(v0, v1); s += sumsq8(v0, v1); } }
                if (!LAST) { s = quad_sum_fq(s); if (fq == 0) ssq_out[row * 16 + u.pn * 4 + wc] = s; } }
    }
};
template <bool MOE> struct EpiUp {
    static constexpr bool PERM = true, AFTER_DRAIN = false, I8 = false;
    bf16_t* ACT; int F; const float* rs; int ts0, ts1, ts2, ts3, ts4, ts5, ts6, ts7;
    __device__ __forceinline__ void operator()(const f32x4 (&acc)[2][2][4][2], const Unit& u, int wr, int wc, int fr, int fq) const {
        int pnl = u.pn, otile = u.pm;
        if (MOE) { const int e = u.pm >> 6, rt = u.pm & 63; pnl = u.pn - e * 28;
            const int tse = e == 0 ? ts0 : e == 1 ? ts1 : e == 2 ? ts2 : e == 3 ? ts3 : e == 4 ? ts4 : e == 5 ? ts5 : e == 6 ? ts6 : ts7; otile = tse + rt; }
        const int lrow0 = wr * 64 + fr, col0 = pnl * 128 + wc * 32 + 8 * fq;
#pragma unroll
        for (int ai = 0; ai < 2; ++ai)
#pragma unroll
            for (int m = 0; m < 4; ++m) { const int lrow = lrow0 + ai * HALF + m * 16;
                const float r = MOE ? rs[(size_t)u.pm * BM + lrow] : row_rstd(rs, u.pm * BM + lrow);
                f32x4 g0 = acc[ai][0][m][0] * r, g1 = acc[ai][0][m][1] * r, u0 = acc[ai][1][m][0] * r, u1 = acc[ai][1][m][1] * r;
#pragma unroll
                for (int j = 0; j < 4; ++j) { g0[j] = g0[j] * fsigmoid(g0[j]) * u0[j]; g1[j] = g1[j] * fsigmoid(g1[j]) * u1[j]; }
                *(u32x4*)(ACT + (size_t)(otile * BM + lrow) * F + col0) = pack8(g0, g1); }
    }
};
struct EpiDownMoe {
    static constexpr bool PERM = true, AFTER_DRAIN = false, I8 = false;
    bf16_t* Y; bf16_t* Yx; int klen;
    __device__ __forceinline__ void operator()(const f32x4 (&acc)[2][2][4][2], const Unit& u, int wr, int wc, int fr, int fq) const {
        bf16_t* Y = this->Y; if (u.ko) { const int s = u.ko / klen; Y = Yx + ((size_t)(s - 1) * 2048 - 32768) * 1024; }
        const int row0 = u.pm * BM + wr * 64 + fr, col0 = (u.pn & 3) * BM + wc * 32 + 8 * fq;
#pragma unroll
        for (int ai = 0; ai < 2; ++ai)
#pragma unroll
            for (int m = 0; m < 4; ++m) { bf16_t* rowp = Y + (size_t)(row0 + ai * HALF + m * 16) * 1024 + col0;
#pragma unroll
                for (int bj = 0; bj < 2; ++bj) *(u32x4*)(rowp + bj * HALF) = pack8(acc[ai][bj][m][0], acc[ai][bj][m][1]); }
    }
};
template <bool UP, int KSPLIT = 1, int KLEN = 0> struct MoeOrder {
    int R, nN, nwg, G, c; int ts0, ts1, ts2, ts3, ts4, ts5, ts6, ts7; int pm0;
    __device__ __forceinline__ bool next(int i, Unit& u) const {
        const long L = (long)i * G + c; if (L >= nwg) return false;
        const int ks = (int)(L % KSPLIT); u.ko = ks * KLEN;
        int wgid = (int)(L / KSPLIT); const int nwg = this->nwg / KSPLIT; { const int q = nwg / NXCD, r = nwg % NXCD, xcd = wgid % NXCD, off = wgid / NXCD; wgid = (xcd < r ? xcd * (q + 1) : r * (q + 1) + (xcd - r) * q) + off; }
        const int nig = WGM * nN, gid = wgid / nig, fm = gid * WGM, gsz = (R - fm) < WGM ? (R - fm) : WGM;
        const int pmc = pm0 + fm + ((wgid % nig) % gsz), pnl = (wgid % nig) / gsz;
        const int e = (pmc >= ts1) + (pmc >= ts2) + (pmc >= ts3) + (pmc >= ts4) + (pmc >= ts5) + (pmc >= ts6) + (pmc >= ts7);
        const int tse = e == 0 ? ts0 : e == 1 ? ts1 : e == 2 ? ts2 : e == 3 ? ts3 : e == 4 ? ts4 : e == 5 ? ts5 : e == 6 ? ts6 : ts7;
        if (UP) { u.pm = e * 64 + (pmc - tse); u.pn = e * 28 + pnl; } else { u.pm = pmc; u.pn = e * 4 + pnl; }
        return true;
    }
    __device__ __forceinline__ void a_ready(const Unit&) const {}
    __device__ __forceinline__ void done(const Unit&) const {}
};
struct EpiZs {
    static constexpr bool PERM = true, AFTER_DRAIN = false, I8 = false;
    bf16_t* ZB; const unsigned char* G8;
    __device__ __forceinline__ void operator()(const f32x4 (&acc)[2][2][4][2], const Unit& u, int wr, int wc, int fr, int fq) const {
        typedef unsigned u32x2 __attribute__((ext_vector_type(2)));
        const int r = u.pm >> 6, pm = u.pm & 63, pn = u.pn & 3;
        const int row0 = pm * BM + wr * 64 + fr, col0 = pn * BM + wc * 32 + 8 * fq;
#pragma unroll
        for (int ai = 0; ai < 2; ++ai)
#pragma unroll
            for (int m = 0; m < 4; ++m) { const size_t row = (size_t)(row0 + ai * HALF + m * 16);
#pragma unroll
                for (int bj = 0; bj < 2; ++bj) { const int col = col0 + bj * HALF;
                    const u32x2 gw = *(const u32x2*)(G8 + row * 3072 + r * 1024 + col); f32x4 g0, g1;
#pragma unroll
                    for (int j = 0; j < 4; ++j) { g0[j] = (float)((gw.x >> (8 * j)) & 0xffu) * (1.f / 255.f); g1[j] = (float)((gw.y >> (8 * j)) & 0xffu) * (1.f / 255.f); }
                    f32x4 v0 = acc[ai][bj][m][0] * g0, v1 = acc[ai][bj][m][1] * g1; u32x4* zp = (u32x4*)(ZB + row * 1024 + col);
                    if (r > 0) { f32x4 z0, z1; unpack8(*zp, z0, z1); v0 = v0 + z0; v1 = v1 + z1; }
                    *zp = pack8(v0, v1); } }
    }
};
struct MergeOrder {
    StaticOrder S;
    __device__ __forceinline__ bool next(int i, Unit& u) const { const int t = i / 3, r = i - 3 * t; if (!S.next(t, u)) return false; u.pm += r * 64; u.pn += r * 4; return true; }
    __device__ __forceinline__ void a_ready(const Unit&) const {}
    __device__ __forceinline__ void done(const Unit&) const {}
};
struct PpOrder {
    StaticOrder S;
    __device__ __forceinline__ bool next(int i, Unit& u) const { if (!S.next(i, u)) return false; u.pn += (u.pm >> 6) * 4; return true; }
    __device__ __forceinline__ void a_ready(const Unit&) const {}
    __device__ __forceinline__ void done(const Unit&) const {}
};
struct EpiPP {
    static constexpr bool PERM = true, AFTER_DRAIN = false, I8 = false;
    bf16_t* Y;
    __device__ __forceinline__ void operator()(const f32x4 (&acc)[2][2][4][2], const Unit& u, int wr, int wc, int fr, int fq) const {
        const int row0 = u.pm * BM + wr * 64 + fr, col0 = (u.pn & 3) * BM + wc * 32 + 8 * fq;
#pragma unroll
        for (int ai = 0; ai < 2; ++ai)
#pragma unroll
            for (int m = 0; m < 4; ++m) { bf16_t* rowp = Y + (size_t)(row0 + ai * HALF + m * 16) * 1024 + col0;
#pragma unroll
                for (int bj = 0; bj < 2; ++bj) *(u32x4*)(rowp + bj * HALF) = pack8(acc[ai][bj][m][0], acc[ai][bj][m][1]); }
    }
};
struct EpiUp8 {
    static constexpr bool PERM = true, AFTER_DRAIN = false, I8 = true;
    bf16_t* ACT; const float* rs; const float* sb; int ts0, ts1, ts2, ts3, ts4, ts5, ts6, ts7;
    __device__ __forceinline__ void operator()(const i32x4 (&acc)[2][2][4][2], const Unit& u, int wr, int wc, int fr, int fq) const {
        const int e = u.pm >> 6, rt = u.pm & 63, pnl = u.pn - e * 28;
        const int tse = e == 0 ? ts0 : e == 1 ? ts1 : e == 2 ? ts2 : e == 3 ? ts3 : e == 4 ? ts4 : e == 5 ? ts5 : e == 6 ? ts6 : ts7, otile = tse + rt;
        const int lrow0 = wr * 64 + fr, col0 = pnl * 128 + wc * 32 + 8 * fq;
        const float* sbp = sb + (size_t)u.pn * 256 + wc * 32 + 8 * fq;
        const f32x4 sg0 = *(const f32x4*)sbp, sg1 = *(const f32x4*)(sbp + 4), su0 = *(const f32x4*)(sbp + 128), su1 = *(const f32x4*)(sbp + 132);
#pragma unroll
        for (int ai = 0; ai < 2; ++ai)
#pragma unroll
            for (int m = 0; m < 4; ++m) { const int lrow = lrow0 + ai * HALF + m * 16;
                const float r = rs[(size_t)u.pm * BM + lrow];
                const f32x4 rg0 = sg0 * r, rg1 = sg1 * r, ru0 = su0 * r, ru1 = su1 * r; f32x4 g0, g1, u0, u1;
#pragma unroll
                for (int j = 0; j < 4; ++j) { g0[j] = (float)acc[ai][0][m][0][j] * rg0[j]; g1[j] = (float)acc[ai][0][m][1][j] * rg1[j]; u0[j] = (float)acc[ai][1][m][0][j] * ru0[j]; u1[j] = (float)acc[ai][1][m][1][j] * ru1[j]; }
#pragma unroll
                for (int j = 0; j < 4; ++j) { g0[j] = g0[j] * fsigmoid(g0[j]) * u0[j]; g1[j] = g1[j] * fsigmoid(g1[j]) * u1[j]; }
                *(u32x4*)(ACT + (size_t)(otile * BM + lrow) * 3584 + col0) = pack8(g0, g1); }
    }
};
struct EpiProj8 {
    static constexpr bool PERM = true, AFTER_DRAIN = false, I8 = true;
    bf16_t* O; const float* rs1; const float* sb; bf16_t* AQ; bf16_t* AK; const float* q_gain; const float* k_gain; unsigned char* G8;
    __device__ __forceinline__ void operator()(const i32x4 (&acc)[2][2][4][2], const Unit& u, int wr, int wc, int fr, int fq) const {
        const bool sg = (u.pn == 6) || (u.pn == 7);
        const bool mg = u.pn >= 16;
        const bool qk = (u.pn >= 8) && (u.pn < 12);
        const int row0 = u.pm * BM + wr * 64 + fr, col0 = u.pn * BM + wc * 32 + 8 * fq;
        f32x4 s0[2], s1[2];
#pragma unroll
        for (int bj = 0; bj < 2; ++bj) { s0[bj] = *(const f32x4*)(sb + col0 + bj * HALF); s1[bj] = *(const f32x4*)(sb + col0 + bj * HALF + 4); }
        if (qk) {
            const bool isk = u.pn >= 10; const int gidx = (u.pn - (isk ? 10 : 8)) * 4 + wc;
            const float* gp = (isk ? k_gain : q_gain) + 8 * fq; const float qs = isk ? 1.f : 0.125f * kLog2e;
            f32x4 gn[2][2];
#pragma unroll
            for (int bj = 0; bj < 2; ++bj) { gn[bj][0] = *(const f32x4*)(gp + bj * 32) * qs; gn[bj][1] = *(const f32x4*)(gp + bj * 32 + 4) * qs; }
            bf16_t* Ob = (isk ? AK : AQ) + gidx * 64 + 8 * fq;
#pragma unroll
            for (int ai = 0; ai < 2; ++ai)
#pragma unroll
                for (int m = 0; m < 4; ++m) { const int row = row0 + ai * HALF + m * 16; const float r = rs1[row]; const f32x4 r0[2] = {s0[0] * r, s0[1] * r}, r1[2] = {s1[0] * r, s1[1] * r}; f32x4 v[2][2]; float ss = 0.f;
#pragma unroll
                    for (int bj = 0; bj < 2; ++bj) {
#pragma unroll
                        for (int j = 0; j < 4; ++j) { v[bj][0][j] = (float)acc[ai][bj][m][0][j] * (r0[bj][j]); v[bj][1][j] = (float)acc[ai][bj][m][1][j] * (r1[bj][j]); }
                        ss += sumsq8(v[bj][0], v[bj][1]); }
                    ss = quad_sum_fq(ss); const float rn = __builtin_amdgcn_rsqf(ss * (1.f / 64.f) + 1e-6f);
#pragma unroll
                    for (int bj = 0; bj < 2; ++bj) *(u32x4*)(Ob + (size_t)row * 512 + bj * 32) = pack8(v[bj][0] * gn[bj][0] * rn, v[bj][1] * gn[bj][1] * rn); }
            return;
        }
        if (mg) {
            typedef unsigned u32x2 __attribute__((ext_vector_type(2)));
#pragma unroll
            for (int ai = 0; ai < 2; ++ai)
#pragma unroll
                for (int m = 0; m < 4; ++m) { const int row = row0 + ai * HALF + m * 16; const float r = rs1[row]; unsigned char* gp = G8 + (size_t)row * 3072 + (col0 - 4096);
#pragma unroll
                    for (int bj = 0; bj < 2; ++bj) { unsigned w[2];
#pragma unroll
                        for (int n = 0; n < 2; ++n) { const f32x4 s = (n ? s1[bj] : s0[bj]) * r; unsigned pk = 0;
#pragma unroll
                            for (int j = 0; j < 4; ++j) { const float g = fsigmoid((float)acc[ai][bj][m][n][j] * s[j]); pk |= (unsigned)__builtin_rintf(g * 255.f) << (8 * j); }
                            w[n] = pk; }
                        *(u32x2*)(gp + bj * HALF) = (u32x2){w[0], w[1]}; } }
            return;
        }
#pragma unroll
        for (int ai = 0; ai < 2; ++ai)
#pragma unroll
            for (int m = 0; m < 4; ++m) { const int row = row0 + ai * HALF + m * 16; const float r = rs1[row]; bf16_t* rowp = O + (size_t)row * 7168 + col0;
#pragma unroll
                for (int bj = 0; bj < 2; ++bj) { f32x4 v0, v1; const f32x4 q0 = s0[bj] * r, q1 = s1[bj] * r;
#pragma unroll
                    for (int j = 0; j < 4; ++j) { v0[j] = (float)acc[ai][bj][m][0][j] * q0[j]; v1[j] = (float)acc[ai][bj][m][1][j] * q1[j]; }
                    if (sg) {
#pragma unroll
                        for (int j = 0; j < 4; ++j) { v0[j] = fsigmoid(v0[j]); v1[j] = fsigmoid(v1[j]); } }
                    *(u32x4*)(rowp + bj * HALF) = pack8(v0, v1); } }
    }
};
struct EpiUp8d {
    static constexpr bool PERM = true, AFTER_DRAIN = false, I8 = true;
    bf16_t* ACT; const float* rs1; const float* sb;
    __device__ __forceinline__ void operator()(const i32x4 (&acc)[2][2][4][2], const Unit& u, int wr, int wc, int fr, int fq) const {
        const int row0 = u.pm * BM + wr * 64 + fr, col0 = u.pn * 128 + wc * 32 + 8 * fq;
        const float* sbp = sb + (size_t)u.pn * 256 + wc * 32 + 8 * fq;
        const f32x4 sg0 = *(const f32x4*)sbp, sg1 = *(const f32x4*)(sbp + 4), su0 = *(const f32x4*)(sbp + 128), su1 = *(const f32x4*)(sbp + 132);
#pragma unroll
        for (int ai = 0; ai < 2; ++ai)
#pragma unroll
            for (int m = 0; m < 4; ++m) { const int row = row0 + ai * HALF + m * 16; const float r = rs1[row];
                const f32x4 rg0 = sg0 * r, rg1 = sg1 * r, ru0 = su0 * r, ru1 = su1 * r; f32x4 g0, g1, u0, u1;
#pragma unroll
                for (int j = 0; j < 4; ++j) { g0[j] = (float)acc[ai][0][m][0][j] * rg0[j]; g1[j] = (float)acc[ai][0][m][1][j] * rg1[j]; u0[j] = (float)acc[ai][1][m][0][j] * ru0[j]; u1[j] = (float)acc[ai][1][m][1][j] * ru1[j]; }
#pragma unroll
                for (int j = 0; j < 4; ++j) { g0[j] = g0[j] * fsigmoid(g0[j]) * u0[j]; g1[j] = g1[j] * fsigmoid(g1[j]) * u1[j]; }
                *(u32x4*)(ACT + (size_t)row * 2816 + col0) = pack8(g0, g1); }
    }
};
}
namespace mix {
using bf16x8 = __attribute__((ext_vector_type(8))) short;
using s16x4  = __attribute__((ext_vector_type(4))) short;
using f32x16 = __attribute__((ext_vector_type(16))) float;
using f32x4  = __attribute__((ext_vector_type(4))) float;
using u32x4  = __attribute__((ext_vector_type(4))) unsigned;
typedef unsigned short bf16_t;
constexpr int KVB = 64, SHM_T = KVB * 128 * 2;
constexpr int OFF_V = 0, OFF_K = 2 * SHM_T, OFF_WS = 4 * SHM_T, OFF_A2 = OFF_WS + 8 * 256, OFF_M2 = OFF_A2 + 8192, OFF_MT = OFF_M2 + 8192, OFF_SC = OFF_MT + 8192, OFF_Q = OFF_SC + 256, MIX_LDS = OFF_Q + 64;
constexpr float kLog2e = 1.4426950408889634f;
#define KSWZ(row, colB) ((row) * 256 + ((colB) ^ (((row) & 7) << 4)))
#define SBAR() __builtin_amdgcn_sched_barrier(0)
__device__ __forceinline__ int crow(int r, int hi) { return (r & 3) + 8 * (r >> 2) + 4 * hi; }
__device__ __forceinline__ unsigned cvtpk(float lo, float hi) { unsigned r; asm volatile("v_cvt_pk_bf16_f32 %0, %1, %2" : "=v"(r) : "v"(lo), "v"(hi)); return r; }
__device__ __forceinline__ float bf2f(unsigned short h) { return __builtin_bit_cast(float, (unsigned)h << 16); }
__device__ __forceinline__ int v_st(int k, int c) { const int kk = (k & ~0xC) | ((k & 4) << 1) | ((k & 8) >> 1); return ((kk >> 3) * 4 + (c >> 5)) * 512 + ((kk & 7) * 32 + (c & 31)) * 2; }
__device__ __forceinline__ int v_rd_base(int lane) { return ((lane & 3) << 3) | (((lane >> 2) & 3) << 6) | (((lane >> 4) & 1) << 5) | (((lane >> 5) & 1) << 8); }
constexpr int v_rd_off(int d0, int ks, int half) { return d0 * 512 + ks * 4096 + half * 2048; }
template <int OFF> __device__ __forceinline__ s16x4 tr_read(int vb) { s16x4 r; asm volatile("ds_read_b64_tr_b16 %0, %1 offset:%2" : "=&v"(r) : "v"(vb), "i"(OFF) : "memory"); return r; }
template <int D0> __device__ __forceinline__ void pv_one(f32x16& od, int vb, bf16x8 pa0, bf16x8 pa1, bf16x8 pa2, bf16x8 pa3) {
    const s16x4 l0 = tr_read<v_rd_off(D0, 0, 0)>(vb), h0 = tr_read<v_rd_off(D0, 0, 1)>(vb), l1 = tr_read<v_rd_off(D0, 1, 0)>(vb), h1 = tr_read<v_rd_off(D0, 1, 1)>(vb);
    const s16x4 l2 = tr_read<v_rd_off(D0, 2, 0)>(vb), h2 = tr_read<v_rd_off(D0, 2, 1)>(vb), l3 = tr_read<v_rd_off(D0, 3, 0)>(vb), h3 = tr_read<v_rd_off(D0, 3, 1)>(vb);
    asm volatile("s_waitcnt lgkmcnt(0)" ::: "memory"); SBAR();
#define MIX_PK(L, H) (bf16x8){L[0], L[1], L[2], L[3], H[0], H[1], H[2], H[3]}
    od = __builtin_amdgcn_mfma_f32_32x32x16_bf16(pa0, MIX_PK(l0, h0), od, 0, 0, 0);
    od = __builtin_amdgcn_mfma_f32_32x32x16_bf16(pa1, MIX_PK(l1, h1), od, 0, 0, 0);
    od = __builtin_amdgcn_mfma_f32_32x32x16_bf16(pa2, MIX_PK(l2, h2), od, 0, 0, 0);
    od = __builtin_amdgcn_mfma_f32_32x32x16_bf16(pa3, MIX_PK(l3, h3), od, 0, 0, 0);
#undef MIX_PK
}
__device__ __forceinline__ void pv_d0(f32x16* o, int vb, bf16x8 pa0, bf16x8 pa1, bf16x8 pa2, bf16x8 pa3) {
    pv_one<0>(o[0], vb, pa0, pa1, pa2, pa3); pv_one<1>(o[1], vb, pa0, pa1, pa2, pa3); pv_one<2>(o[2], vb, pa0, pa1, pa2, pa3); pv_one<3>(o[3], vb, pa0, pa1, pa2, pa3);
}
__device__ __forceinline__ float swap_max(float v) { auto rr = __builtin_amdgcn_permlane32_swap(__float_as_uint(v), __float_as_uint(v), false, false); return fmaxf(__uint_as_float(rr[0]), __uint_as_float(rr[1])); }
__device__ __forceinline__ float swap_sum(float v) { auto rr = __builtin_amdgcn_permlane32_swap(__float_as_uint(v), __float_as_uint(v), false, false); return __uint_as_float(rr[0]) + __uint_as_float(rr[1]); }
__device__ __forceinline__ void p_to_frags(const f32x16& p0, const f32x16& p1, bf16x8& pa0, bf16x8& pa1, bf16x8& pa2, bf16x8& pa3) {
#define MIX_PK4(P, BASE, OUT) do { unsigned a0 = cvtpk(P[BASE + 0], P[BASE + 1]), a1 = cvtpk(P[BASE + 2], P[BASE + 3]);   \
    unsigned b0 = cvtpk(P[BASE + 4], P[BASE + 5]), b1 = cvtpk(P[BASE + 6], P[BASE + 7]);                              \
    auto r0 = __builtin_amdgcn_permlane32_swap(a0, b0, false, false); auto r1 = __builtin_amdgcn_permlane32_swap(a1, b1, false, false); \
    u32x4 w = {r0[0], r1[0], r0[1], r1[1]}; OUT = *reinterpret_cast<bf16x8*>(&w); } while (0)
    MIX_PK4(p0, 0, pa0); MIX_PK4(p0, 8, pa1); MIX_PK4(p1, 0, pa2); MIX_PK4(p1, 8, pa3);
#undef MIX_PK4
}
__device__ __forceinline__ float half_sum32(float v) {
#pragma unroll
    for (int o = 1; o < 32; o <<= 1) v += __shfl_xor(v, o);
    return v;
}
struct MixPtrs {
    const bf16_t* PROJ;
    const bf16_t *MQ, *MK, *AQ, *AK;
    const float* GATE;
    bf16_t *HM, *HA;
    const float *m_hgain, *a_hgain;
    const float* lamv;
};
template <int MODE>
__device__ __forceinline__ void unit(char* lds, const MixPtrs& P, int b, int h, int q0) {
    int tid_o = threadIdx.x; asm volatile("" : "+v"(tid_o));
    const int tid = tid_o, wid = __builtin_amdgcn_readfirstlane(tid >> 6), lane = tid & 63, r32 = lane & 31, hi = lane >> 5;
    constexpr int NQ = MODE == 0 ? 8 : 4;
    const int wq = MODE == 0 ? wid : (wid & 3), map = MODE == 0 ? 0 : (wid >> 2);
    const int qlo = q0 + 32 * wq, tq = qlo + r32;
    const size_t tok0 = (size_t)b * 2048;
    char* V_lds = lds + OFF_V; char* K_lds = lds + OFF_K;
    float* wsf = (float*)(lds + OFF_WS) + wid * 64; float* li_l = wsf; float* al_l = wsf + 32;
    float* A2 = (float*)(lds + OFF_A2); float* M2 = (float*)(lds + OFF_M2); float* MT = (float*)(lds + OFF_MT); float* SC = (float*)(lds + OFF_SC);
    const int NT = (q0 + (MODE == 0 ? 256 : 128)) / KVB;
    float M2row = 0.f, mtrow = 0.f;
    if (MODE == 0) {
        const int n = q0 + 256; const float* G = P.GATE + tok0 * 8;
        float lf[4], iv[4];
#pragma unroll
        for (int j = 0; j < 4; ++j) { const int t = 4 * tid + j; float f = 0.f, i = 0.f; if (t < n) { f = G[(size_t)t * 8 + 4 + h]; i = G[(size_t)t * 8 + h]; }
            lf[j] = fminf(f, 0.f) - 0.6931471805599453f * __builtin_amdgcn_logf(1.f + __builtin_amdgcn_exp2f(-kLog2e * fabsf(f))); iv[j] = i; }
        float s1 = lf[0], s2 = s1 + lf[1], s3 = s2 + lf[2], s4 = s3 + lf[3];
        float incl = s4;
#pragma unroll
        for (int o = 1; o < 64; o <<= 1) { const float t = __shfl_up(incl, o); if (lane >= o) incl += t; }
        if (lane == 63) SC[wid] = incl;
        __syncthreads();
        float wbase = 0.f;
#pragma unroll
        for (int w = 0; w < 8; ++w) { const float t = SC[w]; if (w < wid) wbase += t; }
        const float excl = wbase + incl - s4;
        const float B0 = excl + s1, B1 = excl + s2, B2 = excl + s3, B3 = excl + s4;
        const float a0 = iv[0] - B0, a1 = iv[1] - B1, a2 = iv[2] - B2, a3 = iv[3] - B3;
        const bool v0 = 4 * tid < n;
        const float NEG = -3.0e38f;
        const float m1 = v0 ? a0 : NEG, m2 = fmaxf(m1, v0 ? a1 : NEG), m3 = fmaxf(m2, v0 ? a2 : NEG), m4 = fmaxf(m3, v0 ? a3 : NEG);
        float mincl = m4;
#pragma unroll
        for (int o = 1; o < 64; o <<= 1) { const float t = __shfl_up(mincl, o); if (lane >= o) mincl = fmaxf(mincl, t); }
        float mprev = __shfl_up(mincl, 1); if (lane == 0) mprev = NEG;
        if (lane == 63) SC[8 + wid] = mincl;
        __syncthreads();
        float mbase = 0.f;
#pragma unroll
        for (int w = 0; w < 8; ++w) { const float t = SC[8 + w]; if (w < wid) mbase = fmaxf(mbase, t); }
        const float mex = fmaxf(mbase, mprev);
        const float x0 = fmaxf(mex, m1), x1 = fmaxf(mex, m2), x2 = fmaxf(mex, m3), x3 = fmaxf(mex, m4);
        if (v0) { *(f32x4*)(A2 + 4 * tid) = (f32x4){a0 * kLog2e, a1 * kLog2e, a2 * kLog2e, a3 * kLog2e};
                  *(f32x4*)(M2 + 4 * tid) = (f32x4){x0 * kLog2e, x1 * kLog2e, x2 * kLog2e, x3 * kLog2e};
                  *(f32x4*)(MT + 4 * tid) = (f32x4){B0 + x0, B1 + x1, B2 + x2, B3 + x3}; }
        __syncthreads();
        M2row = M2[tq]; mtrow = MT[tq];
    }
    bf16x8 qr[NQ];
    { const bf16_t* Qw = (MODE == 0 ? P.MQ : P.AQ) + (tok0 + tq) * 512 + h * 128 + map * 64 + hi * 8;
#pragma unroll
      for (int d0 = 0; d0 < NQ; ++d0) qr[d0] = *reinterpret_cast<const bf16x8*>(Qw + d0 * 16); }
    const bf16_t* Kg = (MODE == 0 ? P.MK : P.AK) + tok0 * 512 + h * 128;
    const bf16_t* Vg = P.PROJ + tok0 * 7168 + (MODE == 0 ? 1024 : 3072) + h * 128;
    const int sr = tid >> 4, sc = (tid & 15) * 8, vst0 = v_st(sr, sc), vst1 = v_st(32 + sr, sc);
    const int vb0 = (int)(uintptr_t)V_lds + v_rd_base(lane);
    bf16x8 vsA0, vsA1, ksA0, ksA1, vsB0, vsB1, ksB0, ksB1;
#define MIX_SLOAD(S, k0) do { vs##S##0 = *reinterpret_cast<const bf16x8*>(Vg + (size_t)((k0) + sr) * 7168 + sc); vs##S##1 = *reinterpret_cast<const bf16x8*>(Vg + (size_t)((k0) + 32 + sr) * 7168 + sc); \
    ks##S##0 = *reinterpret_cast<const bf16x8*>(Kg + (size_t)((k0) + sr) * 512 + sc); ks##S##1 = *reinterpret_cast<const bf16x8*>(Kg + (size_t)((k0) + 32 + sr) * 512 + sc); } while (0)
#define MIX_SWRITE(S, bb) do { *(bf16x8*)(V_lds + (bb) * SHM_T + vst0) = vs##S##0; *(bf16x8*)(V_lds + (bb) * SHM_T + vst1) = vs##S##1; \
    *(bf16x8*)(K_lds + (bb) * SHM_T + KSWZ(sr, sc * 2)) = ks##S##0; *(bf16x8*)(K_lds + (bb) * SHM_T + KSWZ(32 + sr, sc * 2)) = ks##S##1; } while (0)
#define MIX_BAR() do { asm volatile("s_waitcnt lgkmcnt(0)" ::: "memory"); __builtin_amdgcn_s_barrier(); asm volatile("" ::: "memory"); } while (0)
    f32x16 o[4];
#pragma unroll
    for (int d = 0; d < 4; ++d)
#pragma unroll
        for (int r = 0; r < 16; ++r) o[d][r] = 0.f;
    float m_run = -1e30f, l_run = 0.f;
    const float sl2 = MODE == 1 ? __builtin_amdgcn_exp2f(-2.f * (float)(h + 1)) * kLog2e : 0.f;
    auto mix_compute = [&](int j, int k0) __attribute__((always_inline)) {
        if (k0 <= qlo + 31) {
            const char* Kt = K_lds + (j & 1) * SHM_T;
            f32x16 p0, p1;
            if (MODE == 1) { const float base = sl2 * (float)(k0 - tq);
#pragma unroll
                for (int r = 0; r < 16; ++r) { p0[r] = fmaf(sl2, (float)crow(r, hi), base); p1[r] = fmaf(sl2, (float)(32 + crow(r, hi)), base); } }
            else {
#pragma unroll
                for (int r = 0; r < 16; ++r) { p0[r] = 0.f; p1[r] = 0.f; } }
#pragma unroll
            for (int d0 = 0; d0 < NQ; ++d0) { const int cb = (map * 64 + d0 * 16 + hi * 8) * 2;
                const bf16x8 b0 = *reinterpret_cast<const bf16x8*>(Kt + KSWZ(r32, cb)), b1 = *reinterpret_cast<const bf16x8*>(Kt + KSWZ(32 + r32, cb));
                p0 = __builtin_amdgcn_mfma_f32_32x32x16_bf16(b0, qr[d0], p0, 0, 0, 0);
                p1 = __builtin_amdgcn_mfma_f32_32x32x16_bf16(b1, qr[d0], p1, 0, 0, 0); }
            const bool diag = k0 + 63 > qlo;
            if (MODE == 1) {
                if (diag) {
#pragma unroll
                    for (int r = 0; r < 16; ++r) { if (k0 + crow(r, hi) > tq) p0[r] = -1e30f; if (k0 + 32 + crow(r, hi) > tq) p1[r] = -1e30f; }
                    asm volatile("" : "+v"(p0[0])); }
                float pmax = p0[0];
#pragma unroll
                for (int r = 1; r < 16; ++r) pmax = fmaxf(pmax, p0[r]);
#pragma unroll
                for (int r = 0; r < 16; ++r) pmax = fmaxf(pmax, p1[r]);
                pmax = swap_max(pmax);
                float mn = m_run, alpha = 1.f;
                if (!__all(pmax - m_run <= 8.f)) { mn = fmaxf(m_run, pmax); alpha = __builtin_amdgcn_exp2f(m_run - mn); m_run = mn; }
                float ps = 0.f;
#pragma unroll
                for (int r = 0; r < 16; ++r) { p0[r] = __builtin_amdgcn_exp2f(p0[r] - mn); p1[r] = __builtin_amdgcn_exp2f(p1[r] - mn); ps += p0[r] + p1[r]; }
                ps = swap_sum(ps); l_run = l_run * alpha + ps;
                if (__any(alpha < 1.f)) { if (hi == 0) al_l[r32] = alpha; asm volatile("s_waitcnt lgkmcnt(0)" ::: "memory");
#pragma unroll
                    for (int r = 0; r < 16; ++r) { const float a = al_l[crow(r, hi)];
#pragma unroll
                        for (int d = 0; d < 4; ++d) o[d][r] *= a; } }
            } else {
                float ps = 0.f;
                if (diag) {
#pragma unroll
                    for (int i = 0; i < 4; ++i) { const f32x4 aa = *(const f32x4*)(A2 + k0 + 8 * i + 4 * hi), ab = *(const f32x4*)(A2 + k0 + 32 + 8 * i + 4 * hi);
#pragma unroll
                        for (int q = 0; q < 4; ++q) { const int r = 4 * i + q;
                            float w0 = __builtin_amdgcn_exp2f(fminf(aa[q] - M2row, 0.f)), w1 = __builtin_amdgcn_exp2f(fminf(ab[q] - M2row, 0.f));
                            if (k0 + crow(r, hi) > tq) w0 = 0.f; if (k0 + 32 + crow(r, hi) > tq) w1 = 0.f;
                            p0[r] *= w0; p1[r] *= w1; ps += p0[r] + p1[r]; } }
                    asm volatile("" : "+v"(ps));
                } else {
#pragma unroll
                    for (int i = 0; i < 4; ++i) { const f32x4 aa = *(const f32x4*)(A2 + k0 + 8 * i + 4 * hi), ab = *(const f32x4*)(A2 + k0 + 32 + 8 * i + 4 * hi);
#pragma unroll
                        for (int q = 0; q < 4; ++q) { const int r = 4 * i + q;
                            p0[r] *= __builtin_amdgcn_exp2f(aa[q] - M2row); p1[r] *= __builtin_amdgcn_exp2f(ab[q] - M2row); ps += p0[r] + p1[r]; } }
                }
                ps = swap_sum(ps); l_run += ps;
            }
            bf16x8 pa0, pa1, pa2, pa3; p_to_frags(p0, p1, pa0, pa1, pa2, pa3);
            pv_d0(o, vb0 + (j & 1) * SHM_T, pa0, pa1, pa2, pa3);
        }
    };
    MIX_SLOAD(A, 0); MIX_SWRITE(A, 0); MIX_SLOAD(B, KVB);
#define MIX_TILE(SL, SW, JJ) do { const int j = (JJ); \
        MIX_BAR(); \
        const int k0 = j * KVB; \
        if (j + 2 < NT) MIX_SLOAD(SL, k0 + 2 * KVB); \
        mix_compute(j, k0); \
        if (j + 1 < NT) MIX_SWRITE(SW, (j + 1) & 1); } while (0)
    for (int jj = 0; jj < NT; jj += 2) { MIX_TILE(A, B, jj); MIX_TILE(B, A, jj + 1); }
#undef MIX_TILE
    __syncthreads();
#undef MIX_SLOAD
#undef MIX_SWRITE
#undef MIX_BAR
    int lane_e = lane; asm volatile("" : "+v"(lane_e));
    const int r32e = lane_e & 31, hie = lane_e >> 5;
    float rowscale;
    if (MODE == 1) rowscale = 1.f / l_run; else rowscale = 1.f / fmaxf(fabsf(l_run), __expf(-mtrow));
    if (hie == 0) li_l[r32e] = rowscale;
    asm volatile("s_waitcnt lgkmcnt(0)" ::: "memory");
    float rs[16];
#pragma unroll
    for (int r = 0; r < 16; ++r) rs[r] = li_l[crow(r, hie)];
#pragma unroll
    for (int d = 0; d < 4; ++d)
#pragma unroll
        for (int r = 0; r < 16; ++r) o[d][r] *= rs[r];
    if (MODE == 1) {
        __syncthreads();
        float* EX = (float*)lds + (size_t)wq * 4096 + lane_e;
        if (map == 1) {
#pragma unroll
            for (int d = 0; d < 4; ++d)
#pragma unroll
                for (int r = 0; r < 16; ++r) EX[(d * 16 + r) * 64] = o[d][r]; }
        __syncthreads();
        if (map == 0) { const float lam_l = P.lamv[0];
#pragma unroll
            for (int d = 0; d < 4; ++d)
#pragma unroll
                for (int r = 0; r < 16; ++r) o[d][r] -= lam_l * EX[(d * 16 + r) * 64]; }
    }
    if (MODE == 0 || map == 0) {
        float rn[16];
#pragma unroll
        for (int r = 0; r < 16; ++r) { float s = 0.f;
#pragma unroll
            for (int d = 0; d < 4; ++d) s += o[d][r] * o[d][r];
            s = half_sum32(s); rn[r] = __builtin_amdgcn_rsqf(s * (1.f / 128.f) + 1e-6f); }
        const float* hg = (MODE == 0 ? P.m_hgain : P.a_hgain) + h * 128;
        bf16_t* Ob = (MODE == 0 ? P.HM : P.HA) + (tok0 + qlo) * 512 + h * 128;
        unsigned short og[4][16];
        if (MODE == 0) {
#pragma unroll
            for (int d = 0; d < 4; ++d)
#pragma unroll
                for (int r = 0; r < 16; ++r) og[d][r] = P.PROJ[(tok0 + qlo + crow(r, hie)) * 7168 + 1536 + h * 128 + 32 * d + r32e]; }
#pragma unroll
        for (int d = 0; d < 4; ++d) { const int col = 32 * d + r32e; const float g = hg[col] * (MODE == 1 ? P.lamv[1] : 1.f);
#pragma unroll
            for (int r = 0; r < 16; ++r) { const int row = crow(r, hie); float v = o[d][r] * rn[r] * g;
                if (MODE == 0) v *= bf2f(og[d][r]);
                Ob[(size_t)row * 512 + col] = (bf16_t)(cvtpk(v, v) & 0xffffu); } }
    }
    __syncthreads();
}
template <bool DO_M, bool DO_A> __device__ __forceinline__ void mix_phase(char* lds, const MixPtrs& P, unsigned* queue) {
    volatile int* qw = (volatile int*)(lds + OFF_Q);
    if (DO_M) for (;;) {
        if (threadIdx.x == 0) *qw = (int)__hip_atomic_fetch_add(queue, 1u, __ATOMIC_RELAXED, __HIP_MEMORY_SCOPE_AGENT);
        __syncthreads();
        const int item = __builtin_amdgcn_readfirstlane(*qw);
        __syncthreads();
        if (item >= 256) break;
        unit<0>(lds, P, (item & 31) >> 2, item & 3, 256 * (7 - (item >> 5)));
    }
    if (DO_A) for (;;) {
        if (threadIdx.x == 0) *qw = (int)__hip_atomic_fetch_add(queue + 32, 1u, __ATOMIC_RELAXED, __HIP_MEMORY_SCOPE_AGENT);
        __syncthreads();
        const int item = __builtin_amdgcn_readfirstlane(*qw);
        __syncthreads();
        if (item >= 512) break;
        unit<1>(lds, P, (item & 31) >> 2, item & 3, 128 * (15 - (item >> 5)));
    }
}
}
namespace thin {
using pg8::bf16_t; using pg8::f32x4; using pg8::u32x4; using pg8::bf16x8;
typedef __attribute__((address_space(3))) float lds_f32;
__device__ __forceinline__ unsigned f2bf(float f) { unsigned u = __builtin_bit_cast(unsigned, f); return (u + 0x7fffu + ((u >> 16) & 1u)) >> 16; }
__device__ __forceinline__ unsigned pk2(float lo, float hi) { return f2bf(lo) | (f2bf(hi) << 16); }
__device__ __forceinline__ float wave_sum(float v) {
#pragma unroll
    for (int o = 1; o < 64; o <<= 1) v += __shfl_xor(v, o);
    return v;
}
__device__ __forceinline__ unsigned pack4_i8(float a, float b, float c, float d) {
    const int ia = (int)__builtin_rintf(a), ib = (int)__builtin_rintf(b), ic = (int)__builtin_rintf(c), id = (int)__builtin_rintf(d);
    return (unsigned)(ia & 0xff) | ((unsigned)(ib & 0xff) << 8) | ((unsigned)(ic & 0xff) << 16) | ((unsigned)(id & 0xff) << 24);
}
__device__ __forceinline__ float wave_max(float v) {
#pragma unroll
    for (int o = 1; o < 64; o <<= 1) v = fmaxf(v, __shfl_xor(v, o));
    return v;
}
__device__ __forceinline__ u32x4 quant16(const f32x4& a0, const f32x4& a1, const f32x4& a2, const f32x4& a3, float inv) {
    u32x4 w; w.x = pack4_i8(a0[0] * inv, a0[1] * inv, a0[2] * inv, a0[3] * inv); w.y = pack4_i8(a1[0] * inv, a1[1] * inv, a1[2] * inv, a1[3] * inv);
    w.z = pack4_i8(a2[0] * inv, a2[1] * inv, a2[2] * inv, a2[3] * inv); w.w = pack4_i8(a3[0] * inv, a3[1] * inv, a3[2] * inv, a3[3] * inv); return w;
}
__device__ __forceinline__ float absmax16(const f32x4& a0, const f32x4& a1, const f32x4& a2, const f32x4& a3) {
    float m = 0.f;
#pragma unroll
    for (int j = 0; j < 4; ++j) m = fmaxf(fmaxf(m, fmaxf(fabsf(a0[j]), fabsf(a1[j]))), fmaxf(fabsf(a2[j]), fabsf(a3[j])));
    return m;
}
__device__ __forceinline__ float row_rstd_wave(const float* ssq, int row, int lane, int vz) {
    float v = lane < 16 ? ssq[(size_t)(row + vz) * 16 + lane] : 0.f;
#pragma unroll
    for (int o = 1; o < 16; o <<= 1) v += __shfl_xor(v, o);
    v = __shfl(v, 0);
    return __builtin_amdgcn_rsqf(v * (1.f / 1024.f) + 1e-6f);
}
struct TrItem { const float* W; const float* gain; bf16_t* WT; int ldw, K, F, map, n0, k0; };
__device__ __forceinline__ void tr_load(const TrItem& I, float (&v)[16][4], int lane, int wave) {
    int so[4];
#pragma unroll
    for (int j = 0; j < 4; ++j) { const int n = I.n0 + lane + 64 * j; so[j] = I.map == 0 ? n : I.map == 1 ? (n < 2048 ? n : n + 8) : ((n & 255) >> 7) * I.F + (n >> 8) * 128 + (n & 127); }
    const float* Wk = I.W + (size_t)(I.k0 + wave * 16) * I.ldw;
#pragma unroll
    for (int r = 0; r < 16; ++r)
#pragma unroll
        for (int j = 0; j < 4; ++j) v[r][j] = Wk[(size_t)r * I.ldw + so[j]];
}
__device__ __forceinline__ void tr_store(const TrItem& I, const float (&v)[16][4], char* lds, int lane, int wave) {
    unsigned short* img = (unsigned short*)lds;
#pragma unroll
    for (int r = 0; r < 16; r += 2) { float g0 = 1.f, g1 = 1.f; if (I.gain) { g0 = I.gain[I.k0 + wave * 16 + r]; g1 = I.gain[I.k0 + wave * 16 + r + 1]; }
#pragma unroll
        for (int j = 0; j < 4; ++j) *(unsigned*)(img + (lane + 64 * j) * 130 + wave * 16 + r) = pk2(v[r][j] * g0, v[r + 1][j] * g1); }
    __syncthreads();
#pragma unroll 8
    for (int i = 0; i < 32; ++i) { const int n = wave * 32 + i; const unsigned w = *(const unsigned*)(img + n * 130 + 2 * lane);
        *(unsigned*)(I.WT + (size_t)(I.n0 + n) * I.K + I.k0 + 2 * lane) = w; }
    __syncthreads();
}
struct Q8Item { const float* W; const float* gain; unsigned char* W8; float* SB; int ldw, F, map, n0; };
__device__ __forceinline__ void q8_item(const Q8Item& I, char* lds, int lane, int wave) {
    unsigned* img = (unsigned*)lds;
    const int n = I.n0 + lane;
    int so1 = n < 2048 ? n : n + 8;
    if (n >= 2048 && n < 3072) { const int w = n & 255, bj = w >> 7, wc = (w >> 5) & 3, j = w & 31; so1 = 2056 + ((n - 2048) & ~255) + wc * 64 + bj * 32 + j; }
    const int so = I.map == 0 ? n : I.map == 1 ? so1 : ((n & 255) >> 7) * I.F + (n >> 8) * 128 + (n & 127);
    const float* Wk = I.W + (size_t)(wave * 128) * I.ldw + so;
    float va[32], vb[32];
#define Q8_LOAD(V, B) do { _Pragma("unroll") for (int r = 0; r < 32; ++r) V[r] = Wk[(size_t)((B) * 32 + r) * I.ldw]; } while (0)
#define Q8_PUT(V, B) do { _Pragma("unroll") for (int r = 0; r < 32; r += 2) { const int k = wave * 128 + (B) * 32 + r; \
        img[lane * 514 + (k >> 1)] = pk2(V[r] * I.gain[k], V[r + 1] * I.gain[k + 1]); } } while (0)
    Q8_LOAD(va, 0); Q8_LOAD(vb, 1); Q8_PUT(va, 0); Q8_LOAD(va, 2); Q8_PUT(vb, 1); Q8_LOAD(vb, 3); Q8_PUT(va, 2); Q8_PUT(vb, 3);
#undef Q8_LOAD
#undef Q8_PUT
    __syncthreads();
#pragma unroll 2
    for (int i = 0; i < 8; ++i) { const int nr = wave * 8 + i; const unsigned long long* rp = (const unsigned long long*)(img + nr * 514) + lane * 4;
        const unsigned long long d0 = rp[0], d1 = rp[1], d2 = rp[2], d3 = rp[3];
        u32x4 w0 = {(unsigned)d0, (unsigned)(d0 >> 32), (unsigned)d1, (unsigned)(d1 >> 32)}, w1 = {(unsigned)d2, (unsigned)(d2 >> 32), (unsigned)d3, (unsigned)(d3 >> 32)};
        f32x4 a0, a1, a2, a3; pg8::unpack8(w0, a0, a1); pg8::unpack8(w1, a2, a3);
        const float mx = wave_max(absmax16(a0, a1, a2, a3)), step = mx > 0.f ? mx * (1.f / 127.f) : 1.f;
        *((u32x4*)(I.W8 + (size_t)(I.n0 + nr) * 1024) + lane) = quant16(a0, a1, a2, a3, 1.f / step);
        if (lane == 0) I.SB[I.n0 + nr] = step; }
    __syncthreads();
}
struct ProIn {
    const float *x, *p, *attn_norm, *w_in, *pool_w, *pool_scale, *w_branch, *w_out, *ffn_norm, *dense_w_gu, *dense_w_down, *router_w, *moe_w_gu, *moe_w_down, *ple_norm, *ple_w_gate, *ple_w_proj;
    bf16_t *W_IN, *W_BR, *W_OUT, *W_GU0, *W_DN0, *W_GU1, *W_DN1, *W_PG, *W_PP, *XB, *PB; float *X, *SSQ, *WG, *WR; unsigned char* X8; float* RS1; unsigned char *W8_IN, *W8_GU0, *W8_GU1; float *SB_IN, *SB_GU0, *SB_GU1; float* GATE; const float* gate_bias;
};
__device__ __forceinline__ void prologue(const ProIn& a, char* lds, int vcu, int G) {
    int tid_o = threadIdx.x; asm volatile("" : "+v"(tid_o)); const int tid = tid_o, lane = tid & 63, wave = __builtin_amdgcn_readfirstlane(tid >> 6);
    const int gw = vcu * 8 + wave, NGW = G * 8;
    { constexpr int Q_GU1 = 8 * 112, Q_IN = 2 * 112, Q_GU0 = 88, NQ = Q_GU1 + Q_IN + Q_GU0;
#pragma unroll 1
      for (int it = vcu; it < NQ; it += G) { Q8Item I; int r = it;
          if (r < Q_GU1) { const int e = r / 112; r -= e * 112; I.W = a.moe_w_gu + (size_t)e * 1024 * 7168; I.ldw = 7168; I.gain = a.ffn_norm + 1024; I.F = 3584; I.map = 2; I.W8 = a.W8_GU1 + (size_t)e * 7168 * 1024; I.SB = a.SB_GU1 + e * 7168; }
          else if ((r -= Q_GU1) < Q_IN) { const int L = r / 112; r -= L * 112; I.W = a.w_in + (size_t)L * 1024 * 7176; I.ldw = 7176; I.gain = a.attn_norm + L * 1024; I.F = 0; I.map = 1; I.W8 = a.W8_IN + (size_t)L * 7168 * 1024; I.SB = a.SB_IN + L * 7168; }
          else { r -= Q_IN; I.W = a.dense_w_gu; I.ldw = 5632; I.gain = a.ffn_norm; I.F = 2816; I.map = 2; I.W8 = a.W8_GU0; I.SB = a.SB_GU0; }
          I.n0 = r * 64; q8_item(I, lds, lane, wave); } }
    constexpr int I_BR = 4 * 4, I_OUT = 8 * 4, I_DN0 = 22 * 4, I_DN1 = 28 * 4, I_PG = 8 * 4, I_PP = 2 * 4;
    constexpr int NITEMS = 4 * I_BR + 2 * I_OUT + I_DN0 + 8 * I_DN1 + 2 * I_PG + 2 * I_PP;
    auto decode = [&](int it, TrItem& I) {
        int r = it, N; I.gain = nullptr; I.F = 0; I.map = 0;
        if (r < 8 * I_DN1) { const int e = r / I_DN1; r -= e * I_DN1; I.W = a.moe_w_down + (size_t)e * 3584 * 1024; I.ldw = 1024; I.K = 3584; N = 1024; I.WT = a.W_DN1 + (size_t)e * 1024 * 3584; }
        else if ((r -= 8 * I_DN1) < I_DN0) { I.W = a.dense_w_down; I.ldw = 1024; I.K = 2816; N = 1024; I.WT = a.W_DN0; }
        else if ((r -= I_DN0) < 4 * I_BR) { const int q = r / I_BR, L = q >> 1, br = q & 1; r -= q * I_BR; I.W = a.w_branch + ((size_t)L * 3 + br) * 512 * 1024; I.ldw = 1024; I.K = 512; N = 1024; I.WT = a.W_BR + ((size_t)L * 3 + br) * 1024 * 512; }
        else if ((r -= 4 * I_BR) < 2 * I_OUT) { const int L = r / I_OUT; r -= L * I_OUT; I.W = a.w_out + (size_t)L * 1024 * 1024; I.ldw = 1024; I.K = 1024; N = 1024; I.WT = a.W_OUT + (size_t)L * 1024 * 1024; }
        else if ((r -= 2 * I_OUT) < 2 * I_PG) { const int L = r / I_PG; r -= L * I_PG; I.W = a.ple_w_gate + (size_t)L * 1024 * 1024; I.ldw = 1024; I.gain = a.ple_norm + L * 1024; I.K = 1024; N = 1024; I.WT = a.W_PG + (size_t)L * 1024 * 1024; }
        else { r -= 2 * I_PG; const int L = r / I_PP; r -= L * I_PP; I.W = a.ple_w_proj + (size_t)L * 256 * 1024; I.ldw = 1024; I.K = 256; N = 1024; I.WT = a.W_PP + (size_t)L * 1024 * 256; }
        const int nblk = N / 256; I.k0 = (r / nblk) * 128; I.n0 = (r % nblk) * 256;
    };
    { TrItem IA, IB; float va[16][4], vb[16][4]; int it = G - 1 - vcu;
      if (it < NITEMS) { decode(it, IA); tr_load(IA, va, lane, wave);
#pragma unroll 1
        for (;;) {
            const bool hb = it + G < NITEMS; if (hb) { decode(it + G, IB); tr_load(IB, vb, lane, wave); }
            tr_store(IA, va, lds, lane, wave);
            if (!hb) break;
            it += 2 * G; const bool ha = it < NITEMS; if (ha) { decode(it, IA); tr_load(IA, va, lane, wave); }
            tr_store(IB, vb, lds, lane, wave);
            if (!ha) break;
        } } }
    float wgx[4][4][8];
#pragma unroll
    for (int j = 0; j < 4; ++j)
#pragma unroll
        for (int i = 0; i < 4; ++i) { const int k = 4 * lane + 256 * j + i; const float gk = a.attn_norm[k]; const f32x4 w0 = *(const f32x4*)(a.w_in + (size_t)k * 7176 + 2048), w1 = *(const f32x4*)(a.w_in + (size_t)k * 7176 + 2052);
#pragma unroll
            for (int c = 0; c < 4; ++c) { wgx[j][i][c] = gk * w0[c]; wgx[j][i][4 + c] = gk * w1[c]; } }
    for (int m0 = gw * 2; m0 < 16384; m0 += NGW * 2) {
        f32x4 v[2][4];
#pragma unroll
        for (int q = 0; q < 2; ++q) { const f32x4* xr = (const f32x4*)(a.x + (size_t)(m0 + q) * 1024) + lane;
#pragma unroll
            for (int j = 0; j < 4; ++j) v[q][j] = xr[64 * j]; }
#pragma unroll
        for (int q = 0; q < 2; ++q) { const int m = m0 + q; unsigned long long* o8 = (unsigned long long*)(a.XB + (size_t)m * 1024) + lane; float s = 0.f;
#pragma unroll
            for (int j = 0; j < 4; ++j) { const f32x4 w = v[q][j]; s += (w[0] * w[0] + w[1] * w[1]) + (w[2] * w[2] + w[3] * w[3]);
                o8[64 * j] = (unsigned long long)pk2(w[0], w[1]) | ((unsigned long long)pk2(w[2], w[3]) << 32); }
            s = wave_sum(s);
            if (lane < 16) a.SSQ[(size_t)m * 16 + lane] = lane == 0 ? s : 0.f;
            float mx = 0.f;
#pragma unroll
            for (int j = 0; j < 4; ++j) mx = fmaxf(mx, fmaxf(fmaxf(fabsf(v[q][j][0]), fabsf(v[q][j][1])), fmaxf(fabsf(v[q][j][2]), fabsf(v[q][j][3]))));
            mx = wave_max(mx); const float step = mx > 0.f ? mx * (1.f / 127.f) : 1.f, inv = 1.f / step;
            unsigned* x8 = (unsigned*)(a.X8 + (size_t)m * 1024) + lane;
#pragma unroll
            for (int j = 0; j < 4; ++j) x8[64 * j] = pack4_i8(v[q][j][0] * inv, v[q][j][1] * inv, v[q][j][2] * inv, v[q][j][3] * inv);
            const float rstd = __builtin_amdgcn_rsqf(s * (1.f / 1024.f) + 1e-6f);
            if (lane == 0) a.RS1[m] = rstd * step;
            float d[8] = {0.f, 0.f, 0.f, 0.f, 0.f, 0.f, 0.f, 0.f};
#pragma unroll
            for (int j = 0; j < 4; ++j)
#pragma unroll
                for (int i = 0; i < 4; ++i)
#pragma unroll
                    for (int c = 0; c < 8; ++c) d[c] = fmaf(v[q][j][i], wgx[j][i][c], d[c]);
#pragma unroll
            for (int c = 0; c < 8; ++c) d[c] = wave_sum(d[c]);
            if (lane < 8) { float dv = d[0];
#pragma unroll
                for (int c = 1; c < 8; ++c) if (lane == c) dv = d[c];
                a.GATE[(size_t)m * 8 + lane] = dv * rstd + a.gate_bias[lane]; } }
    }
    { const size_t n8 = (size_t)2 * 16384 * 256 / 8; const size_t gt = (size_t)(vcu * 512 + tid), NT = (size_t)G * 512;
      for (size_t i0 = gt; i0 < n8; i0 += 4 * NT) { f32x4 v0[4], v1[4];
#pragma unroll
          for (int q = 0; q < 4; ++q) { const size_t i = i0 + q * NT; if (i < n8) { v0[q] = *(const f32x4*)(a.p + i * 8); v1[q] = *(const f32x4*)(a.p + i * 8 + 4); } }
#pragma unroll
          for (int q = 0; q < 4; ++q) { const size_t i = i0 + q * NT; if (i < n8) { u32x4 w; w.x = pk2(v0[q][0], v0[q][1]); w.y = pk2(v0[q][2], v0[q][3]); w.z = pk2(v1[q][0], v1[q][1]); w.w = pk2(v1[q][2], v1[q][3]); *(u32x4*)(a.PB + i * 8) = w; } } }
      for (size_t i = gt; i < 2 * 8192 + 8192; i += NT) {
          if (i < 2 * 8192) { const int L = (int)(i / 8192), k = (int)(i % 8192) / 8, j = (int)(i & 7); a.WG[i] = a.attn_norm[L * 1024 + k] * a.w_in[((size_t)L * 1024 + k) * 7176 + 2048 + j]; }
          else { const int q = (int)(i - 2 * 8192), k = q / 8; a.WR[q] = a.ffn_norm[1024 + k] * a.router_w[q]; } }
    }
    for (int task = vcu; task < 64; task += G) {
        const int L = task >> 5, g = (task >> 3) & 3, nb = task & 7;
        float* AsT = (float*)lds; float* Bs = AsT + 128 * 128;
        __syncthreads();
        const float* pw = a.pool_w + ((size_t)L * 4 + g) * 128 * 128; const float* ps = a.pool_scale + L * 512 + g * 128;
        const float* wb = a.w_branch + (((size_t)L * 3 + 2) * 512 + g * 128) * 1024 + nb * 128;
        for (int i = tid; i < 128 * 32; i += 512) { const int c = i >> 5, d4 = (i & 31) * 4; const f32x4 w = *(const f32x4*)(pw + c * 128 + d4), s = *(const f32x4*)(ps + d4);
            AsT[(d4 + 0) * 128 + c] = w[0] * s[0]; AsT[(d4 + 1) * 128 + c] = w[1] * s[1]; AsT[(d4 + 2) * 128 + c] = w[2] * s[2]; AsT[(d4 + 3) * 128 + c] = w[3] * s[3]; }
        for (int i = tid; i < 128 * 32; i += 512) { const int d = i >> 5, n4 = (i & 31) * 4; *(f32x4*)(Bs + d * 128 + n4) = *(const f32x4*)(wb + (size_t)d * 1024 + n4); }
        __syncthreads();
        const int nq = (tid & 31) * 4, cq = (tid >> 5) * 8;
        float acc[4][8];
#pragma unroll
        for (int i = 0; i < 4; ++i)
#pragma unroll
            for (int j = 0; j < 8; ++j) acc[i][j] = 0.f;
#pragma unroll 4
        for (int d = 0; d < 128; ++d) { const f32x4 bv = *(const f32x4*)(Bs + d * 128 + nq), a0 = *(const f32x4*)(AsT + d * 128 + cq), a1 = *(const f32x4*)(AsT + d * 128 + cq + 4);
#pragma unroll
            for (int i = 0; i < 4; ++i) {
#pragma unroll
                for (int j = 0; j < 4; ++j) { acc[i][j] = fmaf(bv[i], a0[j], acc[i][j]); acc[i][4 + j] = fmaf(bv[i], a1[j], acc[i][4 + j]); } } }
#pragma unroll
        for (int i = 0; i < 4; ++i) { u32x4 w; w.x = pk2(acc[i][0], acc[i][1]); w.y = pk2(acc[i][2], acc[i][3]); w.z = pk2(acc[i][4], acc[i][5]); w.w = pk2(acc[i][6], acc[i][7]);
            *(u32x4*)(a.W_BR + ((size_t)L * 3 + 2) * 1024 * 512 + (size_t)(nb * 128 + nq + i) * 512 + g * 128 + cq) = w; }
    }
    __syncthreads();
}
template <bool GATES> __device__ __forceinline__ void quant_act(const bf16_t* XB, const float* SSQ, unsigned char* X8, float* RS1, const float* WGt, const float* gate_bias, float* GATE, int vcu, int G) {
    int tid_o = threadIdx.x; asm volatile("" : "+v"(tid_o)); const int tid = tid_o, lane = tid & 63, wave = __builtin_amdgcn_readfirstlane(tid >> 6), gw = vcu * 8 + wave, NGW = G * 8;
    int vz = 0; asm volatile("" : "+v"(vz));
    float wgq[GATES ? 16 : 1][8];
    if (GATES) {
#pragma unroll
        for (int i = 0; i < 16; ++i) { const f32x4 w0 = *(const f32x4*)(WGt + (size_t)(16 * lane + i) * 8), w1 = *(const f32x4*)(WGt + (size_t)(16 * lane + i) * 8 + 4);
#pragma unroll
            for (int c = 0; c < 4; ++c) { wgq[i][c] = w0[c]; wgq[i][4 + c] = w1[c]; } } }
    constexpr int NR = GATES ? 2 : 8;
    for (int r0 = gw * NR; r0 < 16384; r0 += NGW * NR) {
        u32x4 v[NR][2]; float rs[NR];
#pragma unroll
        for (int q = 0; q < NR; ++q) { const u32x4* p = (const u32x4*)(XB + (size_t)(r0 + q) * 1024) + lane * 2; v[q][0] = p[0]; v[q][1] = p[1]; rs[q] = row_rstd_wave(SSQ, r0 + q, lane, vz); }
#pragma unroll
        for (int q = 0; q < NR; ++q) { f32x4 a0, a1, a2, a3; pg8::unpack8(v[q][0], a0, a1); pg8::unpack8(v[q][1], a2, a3);
            const float mx = wave_max(absmax16(a0, a1, a2, a3)), step = mx > 0.f ? mx * (1.f / 127.f) : 1.f;
            *((u32x4*)(X8 + (size_t)(r0 + q) * 1024) + lane) = quant16(a0, a1, a2, a3, 1.f / step);
            if (lane == 0) RS1[r0 + q] = rs[q] * step;
            if (GATES) { const float xv[16] = {a0[0], a0[1], a0[2], a0[3], a1[0], a1[1], a1[2], a1[3], a2[0], a2[1], a2[2], a2[3], a3[0], a3[1], a3[2], a3[3]};
                float d[8] = {0.f, 0.f, 0.f, 0.f, 0.f, 0.f, 0.f, 0.f};
#pragma unroll
                for (int i = 0; i < 16; ++i)
#pragma unroll
                    for (int c = 0; c < 8; ++c) d[c] = fmaf(xv[i], wgq[i][c], d[c]);
#pragma unroll
                for (int c = 0; c < 8; ++c) d[c] = wave_sum(d[c]);
                if (lane < 8) { float dv = d[0];
#pragma unroll
                    for (int c = 1; c < 8; ++c) if (lane == c) dv = d[c];
                    GATE[(size_t)(r0 + q) * 8 + lane] = dv * rs[q] + gate_bias[lane]; } } }
    }
}
struct PrepIn { const bf16_t *PROJ, *XB; const float *SSQ, *WG, *conv_w, *conv_b, *gate_bias, *q_gain, *k_gain; bf16_t *MQ, *MK, *AQ, *AK, *HP; float* GATE; };
__device__ __forceinline__ void prep(const PrepIn& a, char* lds, int vcu, int G) {
    int tid_o = threadIdx.x; asm volatile("" : "+v"(tid_o)); const int tid = tid_o, lane = tid & 63, wave = __builtin_amdgcn_readfirstlane(tid >> 6);
    float* cwl = (float*)lds;
    for (int i = tid; i < 4096 / 4; i += 512) ((f32x4*)cwl)[i] = ((const f32x4*)a.conv_w)[i];
    for (int i = tid; i < 1024 / 4; i += 512) ((f32x4*)(cwl + 4096))[i] = ((const f32x4*)a.conv_b)[i];
    __syncthreads();
    const int gw = vcu * 8 + wave, NGW = G * 8;
    const int c0 = lane * 16;
    int vz = 0; asm volatile("" : "+v"(vz));
    const int qg0 = (lane & 3) * 16;
    const float* qkg = (lane < 32 ? a.q_gain : a.k_gain) + qg0;
    const float qkscale = lane < 32 ? 0.125f * 1.4426950408889634f : 1.f;
    const int pc = lane * 8, pw = 2 << (lane >> 4);
    for (int chunk = gw; chunk < 16384 / 8; chunk += NGW) {
        const int row0 = chunk * 8, t0 = row0 & 2047;
        const bf16_t* pr0 = a.PROJ + (size_t)row0 * 7168;
        { u32x4 cv[11][2];
#pragma unroll
          for (int i = 0; i < 11; ++i) { const int d = i - 3, de = (d < 0 && t0 + d < 0) ? 0 : d; const bf16_t* p = pr0 + (long)de * 7168 + c0; cv[i][0] = *(const u32x4*)p; cv[i][1] = *(const u32x4*)(p + 8); }
          f32x4 wt[4][4], bs[4];
#pragma unroll
          for (int i = 0; i < 4; ++i) { bs[i] = *(const f32x4*)(cwl + 4096 + c0 + 4 * i);
#pragma unroll
              for (int j = 0; j < 4; ++j) wt[j][i] = *(const f32x4*)(cwl + j * 1024 + c0 + 4 * i); }
          const float ks = lane < 32 ? 1.f : 0.08838834764831845f;
#pragma unroll
          for (int r = 0; r < 8; ++r) { f32x4 y[4] = {bs[0], bs[1], bs[2], bs[3]};
#pragma unroll
              for (int j = 0; j < 4; ++j) { const float on = (t0 + r - 3 + j) >= 0 ? 1.f : 0.f; f32x4 x0, x1, x2, x3; pg8::unpack8(cv[r + j][0], x0, x1); pg8::unpack8(cv[r + j][1], x2, x3);
                  y[0] = y[0] + wt[j][0] * x0 * on; y[1] = y[1] + wt[j][1] * x1 * on; y[2] = y[2] + wt[j][2] * x2 * on; y[3] = y[3] + wt[j][3] * x3 * on; }
#pragma unroll
              for (int i = 0; i < 4; ++i)
#pragma unroll
                  for (int c = 0; c < 4; ++c) y[i][c] = y[i][c] * pg8::fsigmoid(y[i][c]) * ks;
              bf16_t* dst = (lane < 32 ? a.MQ : a.MK) + (size_t)(row0 + r) * 512 + (c0 & 511);
              *(u32x4*)dst = pg8::pack8(y[0], y[1]); *(u32x4*)(dst + 8) = pg8::pack8(y[2], y[3]); } }
        { u32x4 pv[23];
#pragma unroll
          for (int i = 0; i < 23; ++i) { const int d = i - 15, de = (d < 0 && t0 + d < 0) ? 0 : d; pv[i] = *(const u32x4*)(pr0 + (long)de * 7168 + 3584 + pc); }
#pragma unroll
          for (int r = 0; r < 8; ++r) { const int t = t0 + r, cnt = t + 1 < pw ? t + 1 : pw;
              f32x4 u0, u1; pg8::unpack8(pv[15 + r], u0, u1); f32x4 s0 = u0, s1 = u1;
#pragma unroll
              for (int j = 1; j < 16; ++j) { const float on = j < cnt ? 1.f : 0.f; f32x4 b0, b1; pg8::unpack8(pv[15 + r - j], b0, b1); s0 = s0 + b0 * on; s1 = s1 + b1 * on; }
              const float ic = 1.f / (float)cnt; s0 = s0 * ic - u0; s1 = s1 * ic - u1;
              *(u32x4*)(a.HP + (size_t)(row0 + r) * 512 + pc) = pg8::pack8(s0, s1); } }
    }
    __syncthreads();
}
struct RouteIn { const float *X, *SSQ, *WR, *router_b; const bf16_t* XB; bf16_t* XG; float* RSG; unsigned* cnt; int* TOKI; float* TOKG; };
__device__ __forceinline__ void route(const RouteIn& a, char* lds, int vcu, int G) {
    int tid_o = threadIdx.x; asm volatile("" : "+v"(tid_o)); const int tid = tid_o, lane = tid & 63, wave = __builtin_amdgcn_readfirstlane(tid >> 6);
    int vz = 0; asm volatile("" : "+v"(vz));
    int* lcnt = (int*)lds; int* lbase = lcnt + 8; int* lsel = lbase + 8;
    float* lgate = (float*)(lsel + 256);
    float* wrt = (float*)(lds + 8192);
    for (int i = tid; i < 8192; i += 512) wrt[(i & 7) * 1024 + (i >> 3)] = a.WR[i];
    for (int chunk = vcu; chunk < 16384 / 64; chunk += G) {
        if (tid < 8) lcnt[tid] = 0;
        __syncthreads();
        u32x4 xq[8][2]; float rsd[8];
#pragma unroll
        for (int rr = 0; rr < 8; ++rr) { const int row = chunk * 64 + wave * 8 + rr; const u32x4* src = (const u32x4*)(a.XB + (size_t)row * 1024) + lane * 2; xq[rr][0] = src[0]; xq[rr][1] = src[1];
            rsd[rr] = row_rstd_wave(a.SSQ, row, lane, vz); }
#pragma unroll
        for (int rr = 0; rr < 8; ++rr) { const int lrow = wave * 8 + rr;
            f32x4 a0, a1, a2, a3; pg8::unpack8(xq[rr][0], a0, a1); pg8::unpack8(xq[rr][1], a2, a3);
            const float xv[16] = {a0[0], a0[1], a0[2], a0[3], a1[0], a1[1], a1[2], a1[3], a2[0], a2[1], a2[2], a2[3], a3[0], a3[1], a3[2], a3[3]};
            float d[8];
#pragma unroll
            for (int c = 0; c < 8; ++c) { const f32x4* wp = (const f32x4*)(wrt + c * 1024 + 16 * lane); const f32x4 w0 = wp[0], w1 = wp[1], w2 = wp[2], w3 = wp[3];
                d[c] = ((xv[0] * w0[0] + xv[1] * w0[1]) + (xv[2] * w0[2] + xv[3] * w0[3])) + ((xv[4] * w1[0] + xv[5] * w1[1]) + (xv[6] * w1[2] + xv[7] * w1[3]))
                     + ((xv[8] * w2[0] + xv[9] * w2[1]) + (xv[10] * w2[2] + xv[11] * w2[3])) + ((xv[12] * w3[0] + xv[13] * w3[1]) + (xv[14] * w3[2] + xv[15] * w3[3])); }
            const float r = rsd[rr];
#pragma unroll
            for (int j = 0; j < 8; ++j) d[j] = wave_sum(d[j]) * r + a.router_b[j];
            int i0 = 0; float v0 = d[0];
#pragma unroll
            for (int j = 1; j < 8; ++j) if (d[j] > v0) { v0 = d[j]; i0 = j; }
            int i1 = -1; float v1 = -3.0e38f;
#pragma unroll
            for (int j = 0; j < 8; ++j) if (j != i0 && d[j] > v1) { v1 = d[j]; i1 = j; }
            if (lane == 0) { const float e1 = __expf(v1 - v0); const float g0 = 1.f / (1.f + e1);
                lsel[lrow * 4 + 0] = i0; lsel[lrow * 4 + 1] = atomicAdd(&lcnt[i0], 1); lsel[lrow * 4 + 2] = i1; lsel[lrow * 4 + 3] = atomicAdd(&lcnt[i1], 1);
                lgate[lrow * 2] = g0; lgate[lrow * 2 + 1] = e1 * g0; lgate[128 + lrow] = r; } }
        __syncthreads();
        if (tid < 8) lbase[tid] = (int)__hip_atomic_fetch_add(a.cnt + tid, (unsigned)lcnt[tid], __ATOMIC_RELAXED, __HIP_MEMORY_SCOPE_AGENT);
        __syncthreads();
        u32x4 xr[8][2];
#pragma unroll
        for (int rr = 0; rr < 8; ++rr) { const u32x4* src = (const u32x4*)(a.XB + (size_t)(chunk * 64 + wave * 8 + rr) * 1024) + lane * 2; xr[rr][0] = src[0]; xr[rr][1] = src[1]; }
#pragma unroll
        for (int rr = 0; rr < 8; ++rr) {
            const int lrow = wave * 8 + rr, row = chunk * 64 + lrow;
            const int e0 = lsel[lrow * 4], p0 = lbase[e0] + lsel[lrow * 4 + 1], e1 = lsel[lrow * 4 + 2], p1 = lbase[e1] + lsel[lrow * 4 + 3];
            f32x4 a0, a1, a2, a3; pg8::unpack8(xr[rr][0], a0, a1); pg8::unpack8(xr[rr][1], a2, a3);
            const float mx = wave_max(absmax16(a0, a1, a2, a3)), step = mx > 0.f ? mx * (1.f / 127.f) : 1.f; const u32x4 qq = quant16(a0, a1, a2, a3, 1.f / step);
            *((u32x4*)((unsigned char*)a.XG + ((size_t)e0 * 16384 + p0) * 1024) + lane) = qq;
            *((u32x4*)((unsigned char*)a.XG + ((size_t)e1 * 16384 + p1) * 1024) + lane) = qq;
            if (lane == 0) { const float r = lgate[128 + lrow] * step; a.RSG[(size_t)e0 * 16384 + p0] = r; a.RSG[(size_t)e1 * 16384 + p1] = r;
                a.TOKI[row * 4 + 0] = e0; a.TOKI[row * 4 + 1] = p0; a.TOKI[row * 4 + 2] = e1; a.TOKI[row * 4 + 3] = p1; a.TOKG[row * 2] = lgate[lrow * 2]; a.TOKG[row * 2 + 1] = lgate[lrow * 2 + 1]; }
        }
        __syncthreads();
    }
}
struct CombIn { float* X; bf16_t* XB; float* SSQ; const bf16_t* Y; const int* TOKI; const float* TOKG; int ts[8]; };
__device__ __forceinline__ void combine(const CombIn& a, int vcu, int G) {
    int tid_o = threadIdx.x; asm volatile("" : "+v"(tid_o)); const int tid = tid_o, lane = tid & 63, wave = __builtin_amdgcn_readfirstlane(tid >> 6), gw = vcu * 8 + wave, NGW = G * 8;
    int vz = 0; asm volatile("" : "+v"(vz));
    for (int r0 = gw * 4; r0 < 16384; r0 += NGW * 4) {
        int ti[4][4]; float tg[4][2];
#pragma unroll
        for (int q = 0; q < 4; ++q) { const int rv = r0 + q + vz;
#pragma unroll
            for (int i = 0; i < 4; ++i) ti[q][i] = a.TOKI[rv * 4 + i];
            tg[q][0] = a.TOKG[rv * 2]; tg[q][1] = a.TOKG[rv * 2 + 1]; }
        u32x4 y0[4][2], y1[4][2]; f32x4 xv[4][4]; int yr0[4], yr1[4];
#pragma unroll
        for (int q = 0; q < 4; ++q) { int t0 = 0, t1 = 0;
#pragma unroll
            for (int j = 0; j < 8; ++j) { if (j == ti[q][0]) t0 = a.ts[j]; if (j == ti[q][2]) t1 = a.ts[j]; }
            yr0[q] = t0 * 256 + ti[q][1]; yr1[q] = t1 * 256 + ti[q][3];
            const u32x4* p0 = (const u32x4*)(a.Y + (size_t)yr0[q] * 1024) + lane * 2; const u32x4* p1 = (const u32x4*)(a.Y + (size_t)yr1[q] * 1024) + lane * 2;
            y0[q][0] = p0[0]; y0[q][1] = p0[1]; y1[q][0] = p1[0]; y1[q][1] = p1[1];
            const u32x4* xp = (const u32x4*)(a.XB + (size_t)(r0 + q) * 1024) + lane * 2; pg8::unpack8(xp[0], xv[q][0], xv[q][1]); pg8::unpack8(xp[1], xv[q][2], xv[q][3]); }
#pragma unroll
        for (int q = 0; q < 4; ++q) { const int row = r0 + q; const float g0 = tg[q][0], g1 = tg[q][1]; f32x4 v[4]; float s = 0.f;
#pragma unroll
            for (int hh = 0; hh < 2; ++hh) { f32x4 a0, a1, b0, b1; pg8::unpack8(y0[q][hh], a0, a1); pg8::unpack8(y1[q][hh], b0, b1);
                v[2 * hh] = xv[q][2 * hh] + a0 * g0 + b0 * g1; v[2 * hh + 1] = xv[q][2 * hh + 1] + a1 * g0 + b1 * g1; }
            if (yr0[q] >= 32768) {
#pragma unroll
                for (int sl = 0; sl < 3; ++sl) { const u32x4* p2 = (const u32x4*)(a.Y + ((size_t)34816 + sl * 2048 + (yr0[q] - 32768)) * 1024) + lane * 2;
#pragma unroll
                    for (int hh = 0; hh < 2; ++hh) { f32x4 c0, c1; pg8::unpack8(p2[hh], c0, c1); v[2 * hh] = v[2 * hh] + c0 * g0; v[2 * hh + 1] = v[2 * hh + 1] + c1 * g0; } } }
            if (yr1[q] >= 32768) {
#pragma unroll
                for (int sl = 0; sl < 3; ++sl) { const u32x4* p3 = (const u32x4*)(a.Y + ((size_t)34816 + sl * 2048 + (yr1[q] - 32768)) * 1024) + lane * 2;
#pragma unroll
                    for (int hh = 0; hh < 2; ++hh) { f32x4 d0, d1; pg8::unpack8(p3[hh], d0, d1); v[2 * hh] = v[2 * hh] + d0 * g1; v[2 * hh + 1] = v[2 * hh + 1] + d1 * g1; } } }
#pragma unroll
            for (int i = 0; i < 4; ++i) s += (v[i][0] * v[i][0] + v[i][1] * v[i][1]) + (v[i][2] * v[i][2] + v[i][3] * v[i][3]);
            u32x4* xb = (u32x4*)(a.XB + (size_t)row * 1024) + lane * 2; xb[0] = pg8::pack8(v[0], v[1]); xb[1] = pg8::pack8(v[2], v[3]);
            s = wave_sum(s);
            if (lane < 16) a.SSQ[(size_t)row * 16 + lane] = lane == 0 ? s : 0.f; }
    }
}
}
#define LAS __attribute__((address_space(3)))
typedef unsigned short bf16_t;
constexpr int M = 16384, NWAVES = 8;
constexpr size_t MiB = 1u << 20;
constexpr size_t WS_CTL = 0, CTL_ZERO_BYTES = 1 * MiB;
constexpr size_t WS_SMALL = 1 * MiB;
constexpr size_t WS_TOKI = 2 * MiB, WS_TOKG = WS_TOKI + (size_t)M * 16;
constexpr size_t WS_SSQA = 3 * MiB, WS_SSQB = 4 * MiB, WS_GATE = 5 * MiB;
constexpr size_t WS_RSG = 6 * MiB;
constexpr size_t WS_W = 8 * MiB;
constexpr size_t WS_W_IN = WS_W, WS_W_BR = WS_W_IN + (size_t)2 * 7168 * 1024 * 2, WS_W_OUT = WS_W_BR + (size_t)6 * 1024 * 512 * 2, WS_W_GU0 = WS_W_OUT + (size_t)2 * 1024 * 1024 * 2,
                 WS_W_DN0 = WS_W_GU0 + (size_t)5632 * 1024 * 2, WS_W_GU1 = WS_W_DN0 + (size_t)1024 * 2816 * 2, WS_W_DN1 = WS_W_GU1 + (size_t)8 * 7168 * 1024 * 2,
                 WS_W_PG = WS_W_DN1 + (size_t)8 * 1024 * 3584 * 2, WS_W_PP = WS_W_PG + (size_t)2 * 1024 * 1024 * 2, WS_W_END = WS_W_PP + (size_t)2 * 1024 * 256 * 2;
constexpr size_t WS_XB = (WS_W_END + MiB - 1) / MiB * MiB, WS_PP = WS_XB + (size_t)M * 1024 * 2, WS_PB = WS_PP + (size_t)2 * M * 1024 * 2, WS_X8 = WS_PB + (size_t)2 * M * 256 * 2, WS_RS1 = WS_X8 + (size_t)M * 1024, WS_AREA = WS_RS1 + MiB;
constexpr size_t WS_PROJ = WS_AREA, WS_MQ = WS_PROJ + (size_t)M * 7168 * 2, WS_MK = WS_MQ + (size_t)M * 512 * 2, WS_AQ = WS_MK + (size_t)M * 512 * 2, WS_AK = WS_AQ + (size_t)M * 512 * 2,
                 WS_HM = WS_AK + (size_t)M * 512 * 2, WS_HA = WS_HM + (size_t)M * 512 * 2, WS_HP = WS_HA + (size_t)M * 512 * 2, WS_ZF = WS_HP + (size_t)M * 512 * 2, WS_ZB = WS_ZF + (size_t)M * 1024 * 4,
                 WS_G8 = WS_ZB + (size_t)M * 1024 * 2, WS_LAYER_END = WS_G8 + (size_t)M * 3072;
constexpr size_t WS_XG = WS_AREA, WS_Y = WS_AREA, WS_ACT = WS_XG + (size_t)8 * 16384 * 1024 * 2, WS_END = WS_ACT + (size_t)34816 * 3584 * 2;
static_assert(WS_LAYER_END <= WS_END && WS_ACT >= WS_MQ, "AREA views");
constexpr int CW_BAR = 4096, CW_QUEUE = 16384, CW_ECNT = 16384 + 256;

#define XB_TMO      128
#define XB_XCNT(j)  (256  + 64 * (j))
#define XB_XSUB(j)  (1280 + 64 * (j))
#define XB_XGEN(j)  (2304 + 64 * (j))
#define XB_TOP      3328
#define XB_TOPGEN   3392
#define XCD_BAR_WORDS 3456
#define XB_SPIN_CAP (1u << 18)

__device__ __forceinline__ unsigned xb_ld(unsigned* p)              { return __hip_atomic_load(p, __ATOMIC_RELAXED, __HIP_MEMORY_SCOPE_AGENT); }
__device__ __forceinline__ unsigned xb_add(unsigned* p, unsigned v) { return __hip_atomic_fetch_add(p, v, __ATOMIC_RELAXED, __HIP_MEMORY_SCOPE_AGENT); }
__device__ __forceinline__ unsigned xb_xcc_id() { return (unsigned)__builtin_amdgcn_s_getreg((3 << 11) | 20) & 0xFu; }
#define XB_SPIN(cond, bar) do { unsigned _sp = 0; while (cond) { __builtin_amdgcn_s_sleep(1); \
    if ((++_sp & 255u) == 0u) { if (xb_ld(&(bar)[XB_TMO])) break; if (_sp > XB_SPIN_CAP) { atomicAdd(&(bar)[XB_TMO], 1u); break; } } } } while (0)

struct XcdBarrier {
    unsigned* bar; unsigned x;
    volatile LAS unsigned* st;
};

__device__ __forceinline__ XcdBarrier xcd_barrier_post(unsigned* bar, volatile LAS unsigned* st) {
    XcdBarrier b; b.bar = bar; b.x = xb_xcc_id(); b.st = st;
    if (threadIdx.x == 0) (void)xb_add(&bar[XB_XCNT(b.x)], 1u);
    return b;
}
__device__ __forceinline__ void xcd_barrier_complete(unsigned* bar, unsigned x, unsigned& nloc, unsigned& nx) {
    const unsigned G = gridDim.x * gridDim.y * gridDim.z;
    unsigned sum, cnt, mine, sp = 0u;
    for (;;) {
        sum = 0u; cnt = 0u; mine = 0u;
#pragma unroll
        for (unsigned j = 0; j < 16; ++j) { const unsigned c = xb_ld(&bar[XB_XCNT(j)]); sum += c; cnt += (c > 0u) ? 1u : 0u; mine = (j == x) ? c : mine; }
        if (sum == G) break;
        __builtin_amdgcn_s_sleep(1);
        if ((++sp & 255u) == 0u) { if (xb_ld(&bar[XB_TMO])) break; if (sp > XB_SPIN_CAP) { atomicAdd(&bar[XB_TMO], 1u); break; } }
    }
    nloc = mine > 0u ? mine : 1u; nx = cnt > 0u ? cnt : 1u;
}

__device__ __forceinline__ void xcd_barrier(const XcdBarrier& b) {
    asm volatile("s_waitcnt vmcnt(0)" ::: "memory");
    __syncthreads();
    if (threadIdx.x == 0) {
        unsigned* bar = b.bar;
        __builtin_amdgcn_s_waitcnt(0);
        unsigned nloc = b.st[0], nx = b.st[1];
        if (nloc == 0u) { xcd_barrier_complete(bar, b.x, nloc, nx); b.st[0] = nloc; b.st[1] = nx; }
        const unsigned old = xb_add(&bar[XB_XSUB(b.x)], 1u);
        const unsigned gen = old / nloc;
        if (old + 1u == (gen + 1u) * nloc) {
            __builtin_amdgcn_fence(__ATOMIC_RELEASE, "agent");
            asm volatile("s_waitcnt vmcnt(0)" ::: "memory");
            const unsigned og = xb_add(&bar[XB_TOP], 1u);
            const unsigned tg = og / nx;
            if (og + 1u == (tg + 1u) * nx) xb_add(&bar[XB_TOPGEN], 1u);
            else XB_SPIN(xb_ld(&bar[XB_TOPGEN]) == tg, bar);
            __builtin_amdgcn_fence(__ATOMIC_ACQUIRE, "agent");
            xb_add(&bar[XB_XGEN(b.x)], 1u);
            asm volatile("s_waitcnt vmcnt(0)" ::: "memory");
        } else {
            XB_SPIN(xb_ld(&bar[XB_XGEN(b.x)]) == gen, bar);
            __builtin_amdgcn_fence(__ATOMIC_ACQUIRE, "agent");
            asm volatile("s_waitcnt vmcnt(0)" ::: "memory");
        }
    }
    __syncthreads();
}


struct Args { const float* in[26]; float* out; unsigned char* ws; int ph_lo, ph_hi; };
static_assert(sizeof(Args) == 26 * 8 + 8 + 8 + 8, "Args has no padding");

constexpr int LDS_BYTES = 147456, MISC_OFF = 131072 + 8192;

__global__ void __launch_bounds__(NWAVES * 64, 2) fwd_kernel(Args args) {
    extern __shared__ __attribute__((aligned(16))) unsigned char lds[];
    const int tid = threadIdx.x;
    const int G = gridDim.x; int vcu; { const int bx = blockIdx.x; vcu = (G % 8 == 0) ? (bx % 8) * (G / 8) + bx / 8 : bx; }
    volatile LAS unsigned* MISC = (volatile LAS unsigned*)((LAS unsigned char*)lds + MISC_OFF);
    if (tid < 32) MISC[tid] = 0u;
    __syncthreads();
    unsigned char* ws = args.ws;
    unsigned* ctl = (unsigned*)(ws + WS_CTL);
    const int lo = args.ph_lo, hi = args.ph_hi;
    const bool one_launch = (hi - lo) > 1;
    XcdBarrier bar; bar.bar = ctl + CW_BAR; bar.x = 0; bar.st = nullptr;
    if (one_launch) bar = xcd_barrier_post(ctl + CW_BAR, MISC + 8);
#ifndef EPI_ALIGN8
#define EPI_ALIGN8 true
#endif
#ifndef SITE_MASK
#define SITE_MASK 0xffff
#endif
#define EN(s) ((SITE_MASK >> (s)) & 1)
#define IN(k) (lo <= (k) && (k) < hi)
#define SEAM(k) do { if (IN(k) && IN((k) + 1)) xcd_barrier(bar); } while (0)
    LAS unsigned char* ring = (LAS unsigned char*)lds;
    const float* const* in = args.in;
    float* X = args.out;
#define SITE_WS size_t wso_ = 0; asm volatile("" : "+s"(wso_)); unsigned char* wsl = ws + wso_;
#define p_XB ((bf16_t*)(wsl + WS_XB))
#define p_PB ((bf16_t*)(wsl + WS_PB))
#define p_PPb ((bf16_t*)(wsl + WS_PP))
#define p_SSQA ((float*)(wsl + WS_SSQA))
#define p_SSQB ((float*)(wsl + WS_SSQB))
#define p_GATE ((float*)(wsl + WS_GATE))
#define p_RSG ((float*)(wsl + WS_RSG))
#define p_WG ((float*)(wsl + WS_SMALL))
#define p_WR (((float*)(wsl + WS_SMALL) + 2 * 8192))
#define p_PROJ ((bf16_t*)(wsl + WS_PROJ))
#define p_MQ ((bf16_t*)(wsl + WS_MQ))
#define p_MK ((bf16_t*)(wsl + WS_MK))
#define p_AQ ((bf16_t*)(wsl + WS_AQ))
#define p_AK ((bf16_t*)(wsl + WS_AK))
#define p_HM ((bf16_t*)(wsl + WS_HM))
#define p_HA ((bf16_t*)(wsl + WS_HA))
#define p_HP ((bf16_t*)(wsl + WS_HP))
#define p_ZB ((bf16_t*)(wsl + WS_ZB))
#define p_XG ((bf16_t*)(wsl + WS_XG))
#define p_Yb ((bf16_t*)(wsl + WS_Y))
#define p_ACT ((bf16_t*)(wsl + WS_ACT))
#define p_TOKI ((int*)(wsl + WS_TOKI))
#define p_TOKG ((float*)(wsl + WS_TOKG))
#define p_W_IN ((bf16_t*)(wsl + WS_W_IN))
#define p_W_BR ((bf16_t*)(wsl + WS_W_BR))
#define p_W_OUT ((bf16_t*)(wsl + WS_W_OUT))
#define p_W_GU0 ((bf16_t*)(wsl + WS_W_GU0))
#define p_W_DN0 ((bf16_t*)(wsl + WS_W_DN0))
#define p_W_GU1 ((bf16_t*)(wsl + WS_W_GU1))
#define p_W_DN1 ((bf16_t*)(wsl + WS_W_DN1))
#define p_W_PG ((bf16_t*)(wsl + WS_W_PG))
#define p_W_PP ((bf16_t*)(wsl + WS_W_PP))
    if (EN(0) && IN(0)) {
        SITE_WS
        thin::ProIn a; a.x = in[0]; a.p = in[1]; a.attn_norm = in[2]; a.w_in = in[3]; a.pool_w = in[12]; a.pool_scale = in[13]; a.w_branch = in[14]; a.w_out = in[15]; a.ffn_norm = in[16];
        a.dense_w_gu = in[17]; a.dense_w_down = in[18]; a.router_w = in[19]; a.moe_w_gu = in[21]; a.moe_w_down = in[22]; a.ple_norm = in[23]; a.ple_w_gate = in[24]; a.ple_w_proj = in[25];
        a.W_IN = p_W_IN; a.W_BR = p_W_BR; a.W_OUT = p_W_OUT; a.W_GU0 = p_W_GU0; a.W_DN0 = p_W_DN0; a.W_GU1 = p_W_GU1; a.W_DN1 = p_W_DN1; a.W_PG = p_W_PG; a.W_PP = p_W_PP; a.XB = p_XB; a.PB = p_PB; a.X = X; a.SSQ = p_SSQA; a.WG = p_WG; a.WR = p_WR; a.X8 = (unsigned char*)(wsl + WS_X8); a.RS1 = (float*)(wsl + WS_RS1);
        a.W8_IN = (unsigned char*)(wsl + WS_W_IN); a.SB_IN = (float*)(wsl + WS_W_IN + (size_t)14 * MiB); a.W8_GU0 = (unsigned char*)(wsl + WS_W_GU0); a.SB_GU0 = (float*)(wsl + WS_W_GU0 + (size_t)6 * MiB);
        a.W8_GU1 = (unsigned char*)(wsl + WS_W_GU1); a.SB_GU1 = (float*)(wsl + WS_W_GU1 + (size_t)56 * MiB); a.GATE = p_GATE; a.gate_bias = in[6];
        thin::prologue(a, (char*)lds, vcu, G);
    }
    SEAM(0);
#pragma unroll 1
    for (int L = 0; L < 2; ++L) {
        const int pb = 2 + 11 * L;
        if (EN(2) && IN(pb)) {
            SITE_WS
            pg8::Gemm g{(const bf16_t*)(wsl + WS_X8), (const bf16_t*)(wsl + WS_W_IN + (size_t)L * 7168 * 1024), M, 7168, 512, 512}; pg8::StaticOrder S; S.init(M, 7168, G, (int)blockIdx.x);
            pg8::EpiProj8 E{p_PROJ, (const float*)(wsl + WS_RS1), (const float*)(wsl + WS_W_IN + (size_t)14 * MiB) + L * 7168, p_AQ, p_AK, in[8] + L * 64, in[9] + L * 64, (unsigned char*)(wsl + WS_G8)};
            pg8::gemm_phase<pg8::EpiProj8, pg8::StaticOrder, EPI_ALIGN8, true>(ring, g, S, E);
        }
        SEAM(pb);
        if (EN(3) && IN(pb + 1)) {
            SITE_WS
            thin::PrepIn a; a.PROJ = p_PROJ; a.XB = p_XB; a.SSQ = p_SSQA; a.WG = p_WG + L * 8192; a.conv_w = in[4] + L * 4096; a.conv_b = in[5] + L * 1024; a.gate_bias = in[6] + L * 8;
            a.q_gain = in[8] + L * 64; a.k_gain = in[9] + L * 64; a.MQ = p_MQ; a.MK = p_MK; a.AQ = p_AQ; a.AK = p_AK; a.HP = p_HP; a.GATE = p_GATE;
            thin::prep(a, (char*)lds, vcu, G);
        }
        SEAM(pb + 1);
        if (EN(4) && IN(pb + 2)) {
            SITE_WS
            mix::MixPtrs P; P.PROJ = p_PROJ; P.MQ = p_MQ; P.MK = p_MK; P.AQ = p_AQ; P.AK = p_AK; P.GATE = p_GATE; P.HM = p_HM; P.HA = p_HA; P.m_hgain = in[7] + L * 512; P.a_hgain = in[11] + L * 512;
            { const float* lp = in[10] + L * 256; float d01 = 0.f, d23 = 0.f; for (int i = 0; i < 64; ++i) { d01 = fmaf(lp[i], lp[64 + i], d01); d23 = fmaf(lp[128 + i], lp[192 + i], d23); }
              const float lam_init = 0.8f - 0.6f * __expf(-0.3f * (float)L);
              float* lamv = (float*)((char*)lds + MISC_OFF + 64); if (tid == 0) { lamv[0] = __expf(d01) - __expf(d23) + lam_init; lamv[1] = 1.f - lam_init; } __syncthreads(); P.lamv = lamv; }
            mix::mix_phase<true, true>((char*)lds, P, ctl + CW_QUEUE + 64 * L);
        }
        SEAM(pb + 2);
        if (EN(5) && IN(pb + 3)) {
            SITE_WS
            pg8::MergeOrder S; S.S.init(M, 1024, G, (int)blockIdx.x);
            pg8::Gemm g{p_HM, p_W_BR + (size_t)L * 3 * 1024 * 512, 3 * M, 1024, 512, 512}; pg8::EpiZs E{p_ZB, (const unsigned char*)(wsl + WS_G8)};
            pg8::gemm_phase<pg8::EpiZs, pg8::MergeOrder, true, true>(ring, g, S, E);
        }
        SEAM(pb + 3);
        if (EN(6) && IN(pb + 4)) {
            SITE_WS
            pg8::Gemm g{p_ZB, p_W_OUT + (size_t)L * 1024 * 1024, M, 1024, 1024, 1024}; pg8::StaticOrder S; S.init(M, 1024, G, (int)blockIdx.x);
            pg8::EpiRes E{p_XB, p_SSQB};
            pg8::gemm_phase<pg8::EpiRes, pg8::StaticOrder, true, true>(ring, g, S, E);
        }
        SEAM(pb + 4);
        if (L == 0) {
            if (EN(7) && IN(pb + 5)) {
                SITE_WS
                thin::quant_act<false>(p_XB, p_SSQB, (unsigned char*)(wsl + WS_X8), (float*)(wsl + WS_RS1), nullptr, nullptr, nullptr, vcu, G);
                pg8::Gemm g{p_PB, p_W_PP, 2 * M, 1024, 256, 256};
                pg8::PpOrder S; S.S.init(2 * M, 1024, G, (int)blockIdx.x);
                pg8::EpiPP E{p_PPb};
                pg8::gemm_phase<pg8::EpiPP, pg8::PpOrder, true, true>(ring, g, S, E);
            }
            SEAM(pb + 5);
            if (EN(8) && IN(pb + 6)) {
                SITE_WS
                pg8::Gemm g{(const bf16_t*)(wsl + WS_X8), (const bf16_t*)(wsl + WS_W_GU0), M, 5632, 512, 512}; pg8::StaticOrder S; S.init(M, 5632, G, (int)blockIdx.x);
                pg8::EpiUp8d E{p_ACT, (const float*)(wsl + WS_RS1), (const float*)(wsl + WS_W_GU0 + (size_t)6 * MiB)};
                pg8::gemm_phase<pg8::EpiUp8d, pg8::StaticOrder, true, true>(ring, g, S, E);
            }
            SEAM(pb + 6);
            if (EN(9) && IN(pb + 7)) {
                SITE_WS
                pg8::Gemm g{p_ACT, p_W_DN0, M, 1024, 2816, 2816}; pg8::StaticOrder S; S.init(M, 1024, G, (int)blockIdx.x);
                pg8::EpiRes E{p_XB, p_SSQB};
                pg8::gemm_phase<pg8::EpiRes, pg8::StaticOrder, true, true>(ring, g, S, E);
            }
            SEAM(pb + 7);
        } else {
            if (EN(7) && IN(pb + 5)) {
                SITE_WS
                thin::RouteIn a; a.X = X; a.SSQ = p_SSQB; a.WR = p_WR; a.router_b = in[20]; a.XB = p_XB; a.XG = p_XG; a.RSG = p_RSG; a.cnt = ctl + CW_ECNT; a.TOKI = p_TOKI; a.TOKG = p_TOKG;
                thin::route(a, (char*)lds, vcu, G);
            }
            SEAM(pb + 5);
            int ts[9]; ts[0] = 0;
#pragma unroll
            for (int e = 0; e < 8; ++e) { const unsigned c = __hip_atomic_load(ctl + CW_ECNT + e, __ATOMIC_RELAXED, __HIP_MEMORY_SCOPE_AGENT); ts[e + 1] = ts[e] + (int)((c + 255u) >> 8); }
            if (EN(10) && IN(pb + 6)) {
                SITE_WS
                pg8::Gemm g{p_XG, p_W_GU1, 0, 0, 512, 512};
                pg8::MoeOrder<true> S{ts[8], 28, ts[8] * 28, G, (int)blockIdx.x, ts[0], ts[1], ts[2], ts[3], ts[4], ts[5], ts[6], ts[7], 0};
                pg8::EpiUp8 E{p_ACT, p_RSG, (const float*)(wsl + WS_W_GU1 + (size_t)56 * MiB), ts[0], ts[1], ts[2], ts[3], ts[4], ts[5], ts[6], ts[7]};
                pg8::gemm_phase<pg8::EpiUp8, pg8::MoeOrder<true>, EPI_ALIGN8, true>(ring, g, S, E);
            }
            SEAM(pb + 6);
            if (EN(11) && IN(pb + 7)) {
                SITE_WS
                const int RA = ts[8] < 128 ? ts[8] : 128, RB = ts[8] - RA;
                { pg8::Gemm g{p_ACT, p_W_DN1, 0, 0, 3584, 3584};
                  pg8::MoeOrder<false> S{RA, 4, RA * 4, G, (int)blockIdx.x, ts[0], ts[1], ts[2], ts[3], ts[4], ts[5], ts[6], ts[7], 0};
                  pg8::EpiDownMoe E{p_Yb, p_Yb, 3584};
                  pg8::gemm_phase<pg8::EpiDownMoe, pg8::MoeOrder<false>, true, true>(ring, g, S, E); }
                if (RB > 0) { pg8::Gemm g{p_ACT, p_W_DN1, 0, 0, 896, 3584};
                  pg8::MoeOrder<false, 4, 896> S{RB, 4, RB * 4 * 4, G, (int)(G - 1 - blockIdx.x), ts[0], ts[1], ts[2], ts[3], ts[4], ts[5], ts[6], ts[7], 128};
                  pg8::EpiDownMoe E{p_Yb, p_Yb + (size_t)34816 * 1024, 896};
                  pg8::gemm_phase<pg8::EpiDownMoe, pg8::MoeOrder<false, 4, 896>, true, true>(ring, g, S, E); }
            }
            SEAM(pb + 7);
            if (EN(12) && IN(pb + 8)) {
                SITE_WS
                thin::CombIn a; a.X = X; a.XB = p_XB; a.SSQ = p_SSQB; a.Y = p_Yb; a.TOKI = p_TOKI; a.TOKG = p_TOKG;
#pragma unroll
                for (int e = 0; e < 8; ++e) a.ts[e] = ts[e];
                thin::combine(a, vcu, G);
            }
            SEAM(pb + 8);
        }
        if (EN(13) && IN(pb + 9)) {
            SITE_WS
            pg8::Gemm g{p_XB, p_W_PG + (size_t)L * 1024 * 1024, M, 1024, 1024, 1024}; pg8::StaticOrder S; S.init(M, 1024, G, (int)blockIdx.x);
            if (L == 0) { pg8::EpiPle<false> E{X, p_XB, p_SSQB, p_SSQA, p_PPb}; pg8::gemm_phase<pg8::EpiPle<false>, pg8::StaticOrder, true, true>(ring, g, S, E); }
            else { pg8::EpiPle<true> E{X, p_XB, p_SSQB, p_SSQA, p_PPb + (size_t)M * 1024}; pg8::gemm_phase<pg8::EpiPle<true>, pg8::StaticOrder, true, true>(ring, g, S, E); }
        }
        if (L == 0) {
            SEAM(pb + 9);
            if (EN(7) && IN(pb + 10)) {
                SITE_WS
                thin::quant_act<true>(p_XB, p_SSQA, (unsigned char*)(wsl + WS_X8), (float*)(wsl + WS_RS1), p_WG + 8192, in[6] + 8, p_GATE, vcu, G);
            }
            SEAM(pb + 10);
        }
    }
#undef IN
#undef SEAM
#undef EN
#undef SITE_WS
#undef p_XB
#undef p_PB
#undef p_PPb
#undef p_SSQA
#undef p_SSQB
#undef p_GATE
#undef p_RSG
#undef p_WG
#undef p_WR
#undef p_PROJ
#undef p_MQ
#undef p_MK
#undef p_AQ
#undef p_AK
#undef p_HM
#undef p_HA
#undef p_HP
#undef p_ZB
#undef p_XG
#undef p_Yb
#undef p_ACT
#undef p_TOKI
#undef p_TOKG
#undef p_W_IN
#undef p_W_BR
#undef p_W_OUT
#undef p_W_GU0
#undef p_W_DN0
#undef p_W_GU1
#undef p_W_DN1
#undef p_W_PG
#undef p_W_PP

}

constexpr int N_PHASES = 24;
extern "C" void kernel_launch(void* const* d_in, const int* in_sizes, int n_in, void* d_out, int out_size, void* d_ws, size_t ws_size, hipStream_t stream) {
    static int grid = 0;
    if (grid == 0) {
        if (n_in != 26 || out_size != M * 1024 || ws_size < WS_END) { fprintf(stderr, "kernel_launch: unexpected shapes (n_in %d out %d ws %zu need %zu)\n", n_in, out_size, ws_size, (size_t)WS_END); grid = -1; return; }
        int dev = 0, cus = 0, per_cu = 0;
        if (hipGetDevice(&dev) != hipSuccess || hipDeviceGetAttribute(&cus, hipDeviceAttributeMultiprocessorCount, dev) != hipSuccess) { grid = -1; return; }
        if (hipFuncSetAttribute((const void*)fwd_kernel, hipFuncAttributeMaxDynamicSharedMemorySize, LDS_BYTES) != hipSuccess) { fprintf(stderr, "kernel_launch: hipFuncSetAttribute failed\n"); grid = -1; return; }
        if (hipOccupancyMaxActiveBlocksPerMultiprocessor(&per_cu, (const void*)fwd_kernel, NWAVES * 64, LDS_BYTES) != hipSuccess || per_cu < 1) { fprintf(stderr, "kernel_launch: occupancy query says %d blocks per CU\n", per_cu); }
        (void)hipGetLastError();
        grid = cus;
    }
    if (grid < 0) return;
    if (hipMemsetAsync((char*)d_ws + WS_CTL, 0, CTL_ZERO_BYTES, stream) != hipSuccess) return;
    Args a{};
    for (int i = 0; i < 26; ++i) a.in[i] = (const float*)d_in[i];
    a.out = (float*)d_out; a.ws = (unsigned char*)d_ws;
#if N_LAUNCH_PER_PHASE
    for (int ph = 0; ph < N_PHASES; ++ph) { if (ph == 1 || ph == 10 || ph == 23) continue;
        a.ph_lo = ph; a.ph_hi = ph + 1; hipLaunchKernelGGL(fwd_kernel, dim3(grid), dim3(NWAVES * 64), LDS_BYTES, stream, a); }
#else
    a.ph_lo = 0; a.ph_hi = N_PHASES;
    hipLaunchKernelGGL(fwd_kernel, dim3(grid), dim3(NWAVES * 64), LDS_BYTES, stream, a);
#endif
    const hipError_t le = hipPeekAtLastError();
    if (le != hipSuccess) fprintf(stderr, "kernel_launch: launch failed: %s\n", hipGetErrorName(le));
}
```

```cpp
#include <hip/hip_runtime.h>
#include <cstdio>
#include <cstdint>
#include <cmath>
#define N_LAUNCH_PER_PHASE 0
namespace pg8 {
#define PG8_LAS __attribute__((address_space(3)))
typedef unsigned short bf16_t;
typedef short bf16x8 __attribute__((ext_vector_type(8)));
typedef float f32x4 __attribute__((ext_vector_type(4)));
typedef unsigned u32x4 __attribute__((ext_vector_type(4)));
constexpr int BM = 256, BK = 64, HALF = 128, HTB = HALF * BK * 2  , STAGE_BYTES = 8 * HTB, NXCD = 8, WGM = 8;

__host__ __device__ __forceinline__ int lds_byte(int r, int c) { const int st = (r >> 4) * 2 + (c >> 5), rr = r & 15, cc = c & 31, ob = rr * 64 + cc * 2; return st * 1024 + (ob ^ (((ob >> 9) & 1) << 5)); }
__host__ __device__ __forceinline__ void stage_rc(int b, int& R, int& C) { const int st = b / 1024, sb = b % 1024, swz = sb ^ (((sb >> 9) & 1) << 5); R = (st >> 1) * 16 + swz / 64; C = (st & 1) * 32 + (swz % 64) / 2; }
__host__ __device__ __forceinline__ int perm32(int rho) { const int n = rho >> 4, i = rho & 15; return 8 * (i >> 2) + 4 * n + (i & 3); }

struct Unit { int pm, pn, ko; };
struct Gemm { const bf16_t* A; const bf16_t* Bt; int M, N, K, ld; };

struct StaticOrder {
    int nM, nN, nwg, G, c;
    __host__ __device__ void init(int M, int N, int G_, int c_) { nM = M / BM; nN = N / BM; nwg = nM * nN; G = G_; c = c_; }
    __host__ __device__ bool next(int i, Unit& u) const {
        const long L = (long)i * G + c; if (L >= nwg) return false;
        int wgid = (int)L; { const int q = nwg / NXCD, r = nwg % NXCD, xcd = wgid % NXCD, off = wgid / NXCD; wgid = (xcd < r ? xcd * (q + 1) : r * (q + 1) + (xcd - r) * q) + off; }
        const int nig = WGM * nN, gid = wgid / nig, fm = gid * WGM, gsz = (nM - fm) < WGM ? (nM - fm) : WGM;
        u.pm = fm + ((wgid % nig) % gsz); u.pn = (wgid % nig) / gsz; u.ko = 0; return true;
    }
    __device__ __forceinline__ void a_ready(const Unit&) const {}
    __device__ __forceinline__ void done(const Unit&) const {}
};
__device__ __forceinline__ unsigned cvt_pk_bf16(float lo, float hi) { unsigned r; asm volatile("v_cvt_pk_bf16_f32 %0, %1, %2" : "=v"(r) : "v"(lo), "v"(hi)); return r; }
typedef float f32x2 __attribute__((ext_vector_type(2)));
typedef int i32x4 __attribute__((ext_vector_type(4)));
template <bool I8> struct AccOf { typedef f32x4 type; };
template <> struct AccOf<true> { typedef i32x4 type; };
__device__ __forceinline__ f32x4 mma16(bf16x8 a, bf16x8 b, f32x4 c) { return __builtin_amdgcn_mfma_f32_16x16x32_bf16(a, b, c, 0, 0, 0); }
__device__ __forceinline__ i32x4 mma16(bf16x8 a, bf16x8 b, i32x4 c) { return __builtin_amdgcn_mfma_i32_16x16x64_i8(__builtin_bit_cast(i32x4, a), __builtin_bit_cast(i32x4, b), c, 0, 0, 0); }
template <class Epi, class Sched, bool ALIGN_EPI = false, bool SP2 = false>
__device__ __forceinline__ void gemm_phase(PG8_LAS unsigned char* lds, const Gemm g, const Sched& S, const Epi& E) {
    int tid_o = threadIdx.x; asm volatile("" : "+v"(tid_o));
    const int tid = tid_o, wid = __builtin_amdgcn_readfirstlane(tid >> 6), lane = tid & 63, wr = wid >> 2, wc = wid & 3, fr = lane & 15, fq = lane >> 4;
    const int K = g.ld, nt = g.K / BK;
    unsigned voffA[2], voffB[2];
#pragma unroll
    for (int i = 0; i < 2; ++i) { int R, C; stage_rc(tid * 16 + i * 8192, R, C); const int Rb = Epi::PERM ? ((R & ~31) + perm32(R & 31)) : R;
        voffA[i] = (unsigned)(R * K + C) * 2u; voffB[i] = (unsigned)(Rb * K + C) * 2u; }
    const size_t kstep = (size_t)(BK * 2);
    const size_t hstep = (size_t)HALF * K * 2;
    const size_t tstep = 2 * hstep;
    const unsigned ldsw = (unsigned)wid * 1024u;
    const int aoff = lds_byte(wr * 64 + fr, fq * 8), boff = lds_byte(wc * 32 + fr, fq * 8);
#define PG8_SA(b, h) (((b) * 2 + (h)) * HTB)
#define PG8_SB(b, h) ((4 + (b) * 2 + (h)) * HTB)
#define PG8_STAGE(bufoff, gbase, voff) do { _Pragma("unroll") for (int _i = 0; _i < 2; ++_i) \
        __builtin_amdgcn_global_load_lds((const unsigned*)((const char*)(gbase) + (voff)[_i]), (PG8_LAS unsigned*)(lds + (bufoff) + ldsw + _i * 8192), 16, 0, 0); } while (0)
#define PG8_LDA(dst, b, h) do { _Pragma("unroll") for (int m = 0; m < 4; ++m) _Pragma("unroll") for (int k = 0; k < 2; ++k) dst[m][k] = *(const PG8_LAS bf16x8*)(lds + PG8_SA(b, h) + aoff + m * 2048 + k * 1024); } while (0)
#define PG8_LDB(dst, b, h) do { _Pragma("unroll") for (int n = 0; n < 2; ++n) _Pragma("unroll") for (int k = 0; k < 2; ++k) dst[n][k] = *(const PG8_LAS bf16x8*)(lds + PG8_SB(b, h) + boff + n * 2048 + k * 1024); } while (0)
#define PG8_MMA(ai, bj, At, Bt) do { __builtin_amdgcn_s_setprio(1); _Pragma("unroll") for (int m = 0; m < 4; ++m) _Pragma("unroll") for (int n = 0; n < 2; ++n) _Pragma("unroll") for (int k = 0; k < 2; ++k) \
        acc[ai][bj][m][n] = mma16(Bt[n][k], At[m][k], acc[ai][bj][m][n]); __builtin_amdgcn_s_setprio(0); } while (0)
#define PG8_WAIT_V(n) asm volatile("s_waitcnt vmcnt(" #n ")" ::: "memory")
#define PG8_WAIT_L(n) asm volatile("s_waitcnt lgkmcnt(" #n ")" ::: "memory")
#define PG8_BAR __builtin_amdgcn_s_barrier()
#define PG8_SCHED __builtin_amdgcn_sched_barrier(0)
    Unit cur, nxt; int ui = 0;
    if (!S.next(0, cur)) return;
    typedef typename AccOf<Epi::I8>::type acc_t;
    acc_t acc[2][2][4][2];
#pragma unroll
    for (int a = 0; a < 2; ++a)
#pragma unroll
        for (int b = 0; b < 2; ++b)
#pragma unroll
            for (int m = 0; m < 4; ++m)
#pragma unroll
                for (int n = 0; n < 2; ++n) acc[a][b][m][n] = (acc_t){0, 0, 0, 0};
    bf16x8 At[4][2], B0[2][2], B1[2][2];
    const char* cA = (const char*)g.A + (size_t)cur.pm * tstep + (size_t)cur.ko * 2; const char* cB = (const char*)g.Bt + (size_t)cur.pn * tstep + (size_t)cur.ko * 2;
    S.a_ready(cur);
    if constexpr (SP2) {
        PG8_STAGE(PG8_SB(0, 0), cB, voffB); PG8_STAGE(PG8_SB(0, 1), cB + hstep, voffB); PG8_STAGE(PG8_SA(0, 0), cA, voffA); PG8_STAGE(PG8_SA(0, 1), cA + hstep, voffA);
        if (wr == 1) PG8_BAR;
        PG8_WAIT_V(2); PG8_BAR;
        PG8_STAGE(PG8_SB(1, 0), cB + kstep, voffB); PG8_STAGE(PG8_SA(1, 0), cA + kstep, voffA); PG8_STAGE(PG8_SB(1, 1), cB + hstep + kstep, voffB);
        PG8_WAIT_V(6); PG8_BAR;
    } else {
        PG8_STAGE(PG8_SB(0, 0), cB, voffB); PG8_STAGE(PG8_SA(0, 0), cA, voffA); PG8_STAGE(PG8_SB(0, 1), cB + hstep, voffB); PG8_STAGE(PG8_SA(0, 1), cA + hstep, voffA);
        if (wr == 1) PG8_BAR;
        PG8_WAIT_V(4); PG8_BAR;
        PG8_STAGE(PG8_SB(1, 0), cB + kstep, voffB); PG8_STAGE(PG8_SA(1, 0), cA + kstep, voffA); PG8_STAGE(PG8_SB(1, 1), cB + hstep + kstep, voffB);
        PG8_WAIT_V(6); PG8_BAR;
    }
    for (;;) {
        const bool has_next = S.next(ui + 1, nxt);
        const char* nA = has_next ? (const char*)g.A + (size_t)nxt.pm * tstep + (size_t)nxt.ko * 2 : cA; const char* nB = has_next ? (const char*)g.Bt + (size_t)nxt.pn * tstep + (size_t)nxt.ko * 2 : cB;
#pragma unroll 1
        for (int t = 0; t < nt; t += 2) {
            const bool last = (t == nt - 2);
            const char* a1 = cA + (size_t)(t + 1) * kstep;
            const char* a2 = last ? nA : cA + (size_t)(t + 2) * kstep; const char* b2 = last ? nB : cB + (size_t)(t + 2) * kstep;
            const char* a3 = a2 + kstep; const char* b3 = b2 + kstep;
            if (last && has_next) S.a_ready(nxt);
            if constexpr (SP2) {
            PG8_LDB(B0, 0, 0); PG8_LDB(B1, 0, 1); PG8_SCHED; PG8_LDA(At, 0, 0); PG8_STAGE(PG8_SA(1, 1), a1 + hstep, voffA);
            PG8_WAIT_V(8); PG8_WAIT_L(0); PG8_BAR; PG8_MMA(0, 0, At, B0); PG8_MMA(0, 1, At, B1); PG8_BAR; PG8_SCHED;
            PG8_LDA(At, 0, 1); PG8_STAGE(PG8_SB(0, 0), b2, voffB); PG8_STAGE(PG8_SB(0, 1), b2 + hstep, voffB); PG8_STAGE(PG8_SA(0, 0), a2, voffA);
            PG8_WAIT_V(8); PG8_WAIT_L(0); PG8_BAR; PG8_MMA(1, 0, At, B0); PG8_MMA(1, 1, At, B1); PG8_BAR; PG8_SCHED;
            PG8_LDB(B0, 1, 0); PG8_LDB(B1, 1, 1); PG8_SCHED; PG8_LDA(At, 1, 0); PG8_STAGE(PG8_SA(0, 1), a2 + hstep, voffA);
            PG8_WAIT_V(8); PG8_WAIT_L(0); PG8_BAR; PG8_MMA(0, 0, At, B0); PG8_MMA(0, 1, At, B1); PG8_BAR; PG8_SCHED;
            PG8_LDA(At, 1, 1); PG8_STAGE(PG8_SB(1, 0), b3, voffB); PG8_STAGE(PG8_SB(1, 1), b3 + hstep, voffB); PG8_STAGE(PG8_SA(1, 0), a3, voffA);
            PG8_WAIT_V(8); PG8_WAIT_L(0); PG8_BAR; PG8_MMA(1, 0, At, B0); PG8_MMA(1, 1, At, B1); PG8_BAR; PG8_SCHED;
            } else {
            PG8_LDB(B0, 0, 0); PG8_SCHED; PG8_LDA(At, 0, 0); PG8_STAGE(PG8_SA(1, 1), a1 + hstep, voffA);
            PG8_WAIT_L(8); PG8_BAR; PG8_WAIT_L(0); PG8_MMA(0, 0, At, B0); PG8_BAR; PG8_SCHED;
            PG8_LDB(B1, 0, 1); PG8_STAGE(PG8_SB(0, 0), b2, voffB);
            PG8_BAR; PG8_WAIT_L(0); PG8_MMA(0, 1, At, B1); PG8_BAR;
            PG8_LDA(At, 0, 1); PG8_STAGE(PG8_SA(0, 0), a2, voffA);
            PG8_BAR; PG8_WAIT_L(0); PG8_MMA(1, 0, At, B0); PG8_BAR; PG8_SCHED;
            PG8_STAGE(PG8_SB(0, 1), b2 + hstep, voffB);
            PG8_WAIT_V(6); PG8_BAR; PG8_MMA(1, 1, At, B1); PG8_BAR;
            PG8_LDB(B0, 1, 0); PG8_SCHED; PG8_LDA(At, 1, 0); PG8_STAGE(PG8_SA(0, 1), a2 + hstep, voffA);
            PG8_WAIT_L(8); PG8_BAR; PG8_WAIT_L(0); PG8_MMA(0, 0, At, B0); PG8_BAR; PG8_SCHED;
            PG8_LDB(B1, 1, 1); PG8_STAGE(PG8_SB(1, 0), b3, voffB);
            PG8_BAR; PG8_WAIT_L(0); PG8_MMA(0, 1, At, B1); PG8_BAR;
            PG8_LDA(At, 1, 1); PG8_STAGE(PG8_SA(1, 0), a3, voffA);
            PG8_BAR; PG8_WAIT_L(0); PG8_MMA(1, 0, At, B0); PG8_BAR; PG8_SCHED;
            PG8_STAGE(PG8_SB(1, 1), b3 + hstep, voffB);
            PG8_WAIT_V(6); PG8_BAR; PG8_MMA(1, 1, At, B1); PG8_BAR;
            }
        }
        if constexpr (ALIGN_EPI) { if (wr == 0) PG8_BAR; }
        if constexpr (!Epi::AFTER_DRAIN) { E(acc, cur, wr, wc, fr, fq); S.done(cur); }
        if (!has_next) break;
#pragma unroll
        for (int a = 0; a < 2; ++a)
#pragma unroll
            for (int b = 0; b < 2; ++b)
#pragma unroll
                for (int m = 0; m < 4; ++m)
#pragma unroll
                    for (int n = 0; n < 2; ++n) acc[a][b][m][n] = (acc_t){0, 0, 0, 0};
        cur = nxt; cA = nA; cB = nB; ++ui;
        if constexpr (ALIGN_EPI) { if (wr == 1) PG8_BAR; }
    }
    PG8_WAIT_V(0);
    if constexpr (!ALIGN_EPI) { if (wr == 0) PG8_BAR; }
    PG8_BAR;
    if constexpr (Epi::AFTER_DRAIN) { E.fused(acc, cur, wr, wc, fr, fq, lds, wid, lane); S.done(cur); }
#undef PG8_SA
#undef PG8_SB
#undef PG8_STAGE
#undef PG8_LDA
#undef PG8_LDB
#undef PG8_MMA
#undef PG8_WAIT_V
#undef PG8_WAIT_L
#undef PG8_BAR
#undef PG8_SCHED
}
}
namespace pg8 {
constexpr float kLog2e = 1.4426950408889634f;
__device__ __forceinline__ float fsigmoid(float x) { return __builtin_amdgcn_rcpf(1.f + __builtin_amdgcn_exp2f(-kLog2e * x)); }
__device__ __forceinline__ u32x4 pack8(const f32x4& a, const f32x4& b) { u32x4 w; w.x = cvt_pk_bf16(a[0], a[1]); w.y = cvt_pk_bf16(a[2], a[3]); w.z = cvt_pk_bf16(b[0], b[1]); w.w = cvt_pk_bf16(b[2], b[3]); return w; }
__device__ __forceinline__ void unpack8(const u32x4& w, f32x4& a, f32x4& b) {
    a[0] = __builtin_bit_cast(float, w.x << 16); a[1] = __builtin_bit_cast(float, w.x & 0xffff0000u); a[2] = __builtin_bit_cast(float, w.y << 16); a[3] = __builtin_bit_cast(float, w.y & 0xffff0000u);
    b[0] = __builtin_bit_cast(float, w.z << 16); b[1] = __builtin_bit_cast(float, w.z & 0xffff0000u); b[2] = __builtin_bit_cast(float, w.w << 16); b[3] = __builtin_bit_cast(float, w.w & 0xffff0000u);
}
__device__ __forceinline__ float row_rstd(const float* ssq, int row) {
    const f32x4* p = (const f32x4*)(ssq + (size_t)row * 16); const f32x4 a = p[0], b = p[1], c = p[2], d = p[3];
    const float s = ((a[0] + a[1]) + (a[2] + a[3])) + ((b[0] + b[1]) + (b[2] + b[3])) + ((c[0] + c[1]) + (c[2] + c[3])) + ((d[0] + d[1]) + (d[2] + d[3]));
    return __builtin_amdgcn_rsqf(s * (1.f / 1024.f) + 1e-6f);
}
__device__ __forceinline__ float sumsq8(const f32x4& a, const f32x4& b) { return (a[0] * a[0] + a[1] * a[1]) + (a[2] * a[2] + a[3] * a[3]) + (b[0] * b[0] + b[1] * b[1]) + (b[2] * b[2] + b[3] * b[3]); }
__device__ __forceinline__ float quad_sum_fq(float s) { s += __shfl_xor(s, 16); s += __shfl_xor(s, 32); return s; }

struct EpiProj {
    static constexpr bool PERM = true, AFTER_DRAIN = false, I8 = false;
    bf16_t* O; const float* ssq;
    __device__ __forceinline__ void operator()(const f32x4 (&acc)[2][2][4][2], const Unit& u, int wr, int wc, int fr, int fq) const {
        const bool sg = (u.pn == 6) || (u.pn == 7) || (u.pn >= 16);
        const int row0 = u.pm * BM + wr * 64 + fr, col0 = u.pn * BM + wc * 32 + 8 * fq;
#pragma unroll
        for (int ai = 0; ai < 2; ++ai)
#pragma unroll
            for (int m = 0; m < 4; ++m) { const int row = row0 + ai * HALF + m * 16; const float r = row_rstd(ssq, row); bf16_t* rowp = O + (size_t)row * 7168 + col0;
#pragma unroll
                for (int bj = 0; bj < 2; ++bj) { f32x4 v0 = acc[ai][bj][m][0] * r, v1 = acc[ai][bj][m][1] * r;
                    if (sg) {
#pragma unroll
                        for (int j = 0; j < 4; ++j) { v0[j] = fsigmoid(v0[j]); v1[j] = fsigmoid(v1[j]); } }
                    *(u32x4*)(rowp + bj * HALF) = pack8(v0, v1); } }
    }
};
struct EpiPlain {
    static constexpr bool PERM = true, AFTER_DRAIN = false, I8 = false;
    bf16_t* O;
    __device__ __forceinline__ void operator()(const f32x4 (&acc)[2][2][4][2], const Unit& u, int wr, int wc, int fr, int fq) const {
        const int row0 = u.pm * BM + wr * 64 + fr, col0 = u.pn * BM + wc * 32 + 8 * fq;
#pragma unroll
        for (int ai = 0; ai < 2; ++ai)
#pragma unroll
            for (int m = 0; m < 4; ++m) { bf16_t* rowp = O + (size_t)(row0 + ai * HALF + m * 16) * 1024 + col0;
#pragma unroll
                for (int bj = 0; bj < 2; ++bj) *(u32x4*)(rowp + bj * HALF) = pack8(acc[ai][bj][m][0], acc[ai][bj][m][1]); }
    }
};
template <int R> struct EpiZ {
    static constexpr bool PERM = true, AFTER_DRAIN = false, I8 = false;
    float* ZF; bf16_t* ZB; const bf16_t* PROJ;
    __device__ __forceinline__ void operator()(const f32x4 (&acc)[2][2][4][2], const Unit& u, int wr, int wc, int fr, int fq) const {
        const int row0 = u.pm * BM + wr * 64 + fr, col0 = u.pn * BM + wc * 32 + 8 * fq;
#pragma unroll
        for (int ai = 0; ai < 2; ++ai)
#pragma unroll
            for (int m = 0; m < 4; ++m) { const size_t row = (size_t)(row0 + ai * HALF + m * 16);
#pragma unroll
                for (int bj = 0; bj < 2; ++bj) { const int col = col0 + bj * HALF;
                    f32x4 g0, g1; unpack8(*(const u32x4*)(PROJ + row * 7168 + 4096 + R * 1024 + col), g0, g1);
                    f32x4 v0 = acc[ai][bj][m][0] * g0, v1 = acc[ai][bj][m][1] * g1; float* zp = ZF + row * 1024 + col;
                    if (R > 0) { v0 = v0 + *(const f32x4*)zp; v1 = v1 + *(const f32x4*)(zp + 4); }
                    if (R < 2) { *(f32x4*)zp = v0; *(f32x4*)(zp + 4) = v1; } else *(u32x4*)(ZB + row * 1024 + col) = pack8(v0, v1); } }
    }
};
struct EpiRes {
    static constexpr bool PERM = true, AFTER_DRAIN = false, I8 = false;
    bf16_t* XB; float* ssq;
    __device__ __forceinline__ void operator()(const f32x4 (&acc)[2][2][4][2], const Unit& u, int wr, int wc, int fr, int fq) const {
        const int row0 = u.pm * BM + wr * 64 + fr, col0 = u.pn * BM + wc * 32 + 8 * fq;
#pragma unroll
        for (int ai = 0; ai < 2; ++ai)
#pragma unroll
            for (int m = 0; m < 4; ++m) { const size_t row = (size_t)(row0 + ai * HALF + m * 16); float s = 0.f;
#pragma unroll
                for (int bj = 0; bj < 2; ++bj) { u32x4* xp = (u32x4*)(XB + row * 1024 + col0 + bj * HALF); f32x4 x0, x1; unpack8(*xp, x0, x1);
                    const f32x4 v0 = x0 + acc[ai][bj][m][0], v1 = x1 + acc[ai][bj][m][1];
                    *xp = pack8(v0, v1); s += sumsq8(v0, v1); }
                s = quad_sum_fq(s); if (fq == 0) ssq[row * 16 + u.pn * 4 + wc] = s; }
    }
};
template <bool LAST> struct EpiPle {
    static constexpr bool PERM = true, AFTER_DRAIN = false, I8 = false;
    float* OUT; bf16_t* XB; const float* ssq_in; float* ssq_out; const bf16_t* PP;
    __device__ __forceinline__ void operator()(const f32x4 (&acc)[2][2][4][2], const Unit& u, int wr, int wc, int fr, int fq) const {
        const int row0 = u.pm * BM + wr * 64 + fr, col0 = u.pn * BM + wc * 32 + 8 * fq;
#pragma unroll
        for (int ai = 0; ai < 2; ++ai)
#pragma unroll
            for (int m = 0; m < 4; ++m) { const size_t row = (size_t)(row0 + ai * HALF + m * 16); const float r = row_rstd(ssq_in, (int)row); float s = 0.f;
#pragma unroll
                for (int bj = 0; bj < 2; ++bj) { u32x4* xp = (u32x4*)(XB + row * 1024 + col0 + bj * HALF); f32x4 x0, x1; unpack8(*xp, x0, x1);
                    f32x4 p0, p1; unpack8(*(const u32x4*)(PP + row * 1024 + col0 + bj * HALF), p0, p1);
                    f32x4 v0 = acc[ai][bj][m][0] * r, v1 = acc[ai][bj][m][1] * r;
#pragma unroll
                    for (int j = 0; j < 4; ++j) { v0[j] = fsigmoid(v0[j]) * p0[j]; v1[j] = fsigmoid(v1[j]) * p1[j]; }
                    v0 = v0 + x0; v1 = v1 + x1;
                    if (LAST) { float* op = OUT + row * 1024 + col0 + bj * HALF; *(f32x4*)op = v0; *(f32x4*)(op + 4) = v1; }
                    else { *xp = pack8(v0, v1); s += sumsq8(v0, v1); } }
                if (!LAST) { s = quad_sum_fq(s); if (fq == 0) ssq_out[row * 16 + u.pn * 4 + wc] = s; } }
    }
};
template <bool MOE> struct EpiUp {
    static constexpr bool PERM = true, AFTER_DRAIN = false, I8 = false;
    bf16_t* ACT; int F; const float* rs; int ts0, ts1, ts2, ts3, ts4, ts5, ts6, ts7;
    __device__ __forceinline__ void operator()(const f32x4 (&acc)[2][2][4][2], const Unit& u, int wr, int wc, int fr, int fq) const {
        int pnl = u.pn, otile = u.pm;
        if (MOE) { const int e = u.pm >> 6, rt = u.pm & 63; pnl = u.pn - e * 28;
            const int tse = e == 0 ? ts0 : e == 1 ? ts1 : e == 2 ? ts2 : e == 3 ? ts3 : e == 4 ? ts4 : e == 5 ? ts5 : e == 6 ? ts6 : ts7; otile = tse + rt; }
        const int lrow0 = wr * 64 + fr, col0 = pnl * 128 + wc * 32 + 8 * fq;
#pragma unroll
        for (int ai = 0; ai < 2; ++ai)
#pragma unroll
            for (int m = 0; m < 4; ++m) { const int lrow = lrow0 + ai * HALF + m * 16;
                const float r = MOE ? rs[(size_t)u.pm * BM + lrow] : row_rstd(rs, u.pm * BM + lrow);
                f32x4 g0 = acc[ai][0][m][0] * r, g1 = acc[ai][0][m][1] * r, u0 = acc[ai][1][m][0] * r, u1 = acc[ai][1][m][1] * r;
#pragma unroll
                for (int j = 0; j < 4; ++j) { g0[j] = g0[j] * fsigmoid(g0[j]) * u0[j]; g1[j] = g1[j] * fsigmoid(g1[j]) * u1[j]; }
                *(u32x4*)(ACT + (size_t)(otile * BM + lrow) * F + col0) = pack8(g0, g1); }
    }
};
struct EpiDownMoe {
    static constexpr bool PERM = true, AFTER_DRAIN = false, I8 = false;
    bf16_t* Y; bf16_t* Yx; int klen;
    __device__ __forceinline__ void operator()(const f32x4 (&acc)[2][2][4][2], const Unit& u, int wr, int wc, int fr, int fq) const {
        bf16_t* Y = this->Y; if (u.ko) { const int s = u.ko / klen; Y = Yx + ((size_t)(s - 1) * 2048 - 32768) * 1024; }
        const int row0 = u.pm * BM + wr * 64 + fr, col0 = (u.pn & 3) * BM + wc * 32 + 8 * fq;
#pragma unroll
        for (int ai = 0; ai < 2; ++ai)
#pragma unroll
            for (int m = 0; m < 4; ++m) { bf16_t* rowp = Y + (size_t)(row0 + ai * HALF + m * 16) * 1024 + col0;
#pragma unroll
                for (int bj = 0; bj < 2; ++bj) *(u32x4*)(rowp + bj * HALF) = pack8(acc[ai][bj][m][0], acc[ai][bj][m][1]); }
    }
};
template <bool UP, int KSPLIT = 1, int KLEN = 0> struct MoeOrder {
    int R, nN, nwg, G, c; int ts0, ts1, ts2, ts3, ts4, ts5, ts6, ts7; int pm0;
    __device__ __forceinline__ bool next(int i, Unit& u) const {
        const long L = (long)i * G + c; if (L >= nwg) return false;
        const int ks = (int)(L % KSPLIT); u.ko = ks * KLEN;
        int wgid = (int)(L / KSPLIT); const int nwg = this->nwg / KSPLIT; { const int q = nwg / NXCD, r = nwg % NXCD, xcd = wgid % NXCD, off = wgid / NXCD; wgid = (xcd < r ? xcd * (q + 1) : r * (q + 1) + (xcd - r) * q) + off; }
        const int nig = WGM * nN, gid = wgid / nig, fm = gid * WGM, gsz = (R - fm) < WGM ? (R - fm) : WGM;
        const int pmc = pm0 + fm + ((wgid % nig) % gsz), pnl = (wgid % nig) / gsz;
        const int e = (pmc >= ts1) + (pmc >= ts2) + (pmc >= ts3) + (pmc >= ts4) + (pmc >= ts5) + (pmc >= ts6) + (pmc >= ts7);
        const int tse = e == 0 ? ts0 : e == 1 ? ts1 : e == 2 ? ts2 : e == 3 ? ts3 : e == 4 ? ts4 : e == 5 ? ts5 : e == 6 ? ts6 : ts7;
        if (UP) { u.pm = e * 64 + (pmc - tse); u.pn = e * 28 + pnl; } else { u.pm = pmc; u.pn = e * 4 + pnl; }
        return true;
    }
    __device__ __forceinline__ void a_ready(const Unit&) const {}
    __device__ __forceinline__ void done(const Unit&) const {}
};
struct EpiZs {
    static constexpr bool PERM = true, AFTER_DRAIN = false, I8 = false;
    bf16_t* ZB; const unsigned char* G8;
    __device__ __forceinline__ void operator()(const f32x4 (&acc)[2][2][4][2], const Unit& u, int wr, int wc, int fr, int fq) const {
        typedef unsigned u32x2 __attribute__((ext_vector_type(2)));
        const int r = u.pm >> 6, pm = u.pm & 63, pn = u.pn & 3;
        const int row0 = pm * BM + wr * 64 + fr, col0 = pn * BM + wc * 32 + 8 * fq;
#pragma unroll
        for (int ai = 0; ai < 2; ++ai)
#pragma unroll
            for (int m = 0; m < 4; ++m) { const size_t row = (size_t)(row0 + ai * HALF + m * 16);
#pragma unroll
                for (int bj = 0; bj < 2; ++bj) { const int col = col0 + bj * HALF;
                    const u32x2 gw = *(const u32x2*)(G8 + row * 3072 + r * 1024 + col); f32x4 g0, g1;
#pragma unroll
                    for (int j = 0; j < 4; ++j) { g0[j] = (float)((gw.x >> (8 * j)) & 0xffu) * (1.f / 255.f); g1[j] = (float)((gw.y >> (8 * j)) & 0xffu) * (1.f / 255.f); }
                    f32x4 v0 = acc[ai][bj][m][0] * g0, v1 = acc[ai][bj][m][1] * g1; u32x4* zp = (u32x4*)(ZB + row * 1024 + col);
                    if (r > 0) { f32x4 z0, z1; unpack8(*zp, z0, z1); v0 = v0 + z0; v1 = v1 + z1; }
                    *zp = pack8(v0, v1); } }
    }
};
struct MergeOrder {
    StaticOrder S;
    __device__ __forceinline__ bool next(int i, Unit& u) const { const int t = i / 3, r = i - 3 * t; if (!S.next(t, u)) return false; u.pm += r * 64; u.pn += r * 4; return true; }
    __device__ __forceinline__ void a_ready(const Unit&) const {}
    __device__ __forceinline__ void done(const Unit&) const {}
};
struct PpOrder {
    StaticOrder S;
    __device__ __forceinline__ bool next(int i, Unit& u) const { if (!S.next(i, u)) return false; u.pn += (u.pm >> 6) * 4; return true; }
    __device__ __forceinline__ void a_ready(const Unit&) const {}
    __device__ __forceinline__ void done(const Unit&) const {}
};
struct EpiPP {
    static constexpr bool PERM = true, AFTER_DRAIN = false, I8 = false;
    bf16_t* Y;
    __device__ __forceinline__ void operator()(const f32x4 (&acc)[2][2][4][2], const Unit& u, int wr, int wc, int fr, int fq) const {
        const int row0 = u.pm * BM + wr * 64 + fr, col0 = (u.pn & 3) * BM + wc * 32 + 8 * fq;
#pragma unroll
        for (int ai = 0; ai < 2; ++ai)
#pragma unroll
            for (int m = 0; m < 4; ++m) { bf16_t* rowp = Y + (size_t)(row0 + ai * HALF + m * 16) * 1024 + col0;
#pragma unroll
                for (int bj = 0; bj < 2; ++bj) *(u32x4*)(rowp + bj * HALF) = pack8(acc[ai][bj][m][0], acc[ai][bj][m][1]); }
    }
};
struct EpiUp8 {
    static constexpr bool PERM = true, AFTER_DRAIN = false, I8 = true;
    bf16_t* ACT; const float* rs; const float* sb; int ts0, ts1, ts2, ts3, ts4, ts5, ts6, ts7;
    __device__ __forceinline__ void operator()(const i32x4 (&acc)[2][2][4][2], const Unit& u, int wr, int wc, int fr, int fq) const {
        const int e = u.pm >> 6, rt = u.pm & 63, pnl = u.pn - e * 28;
        const int tse = e == 0 ? ts0 : e == 1 ? ts1 : e == 2 ? ts2 : e == 3 ? ts3 : e == 4 ? ts4 : e == 5 ? ts5 : e == 6 ? ts6 : ts7, otile = tse + rt;
        const int lrow0 = wr * 64 + fr, col0 = pnl * 128 + wc * 32 + 8 * fq;
        const float* sbp = sb + (size_t)u.pn * 256 + wc * 32 + 8 * fq;
        const f32x4 sg0 = *(const f32x4*)sbp, sg1 = *(const f32x4*)(sbp + 4), su0 = *(const f32x4*)(sbp + 128), su1 = *(const f32x4*)(sbp + 132);
#pragma unroll
        for (int ai = 0; ai < 2; ++ai)
#pragma unroll
            for (int m = 0; m < 4; ++m) { const int lrow = lrow0 + ai * HALF + m * 16;
                const float r = rs[(size_t)u.pm * BM + lrow];
                const f32x4 rg0 = sg0 * r, rg1 = sg1 * r, ru0 = su0 * r, ru1 = su1 * r; f32x4 g0, g1, u0, u1;
#pragma unroll
                for (int j = 0; j < 4; ++j) { g0[j] = (float)acc[ai][0][m][0][j] * rg0[j]; g1[j] = (float)acc[ai][0][m][1][j] * rg1[j]; u0[j] = (float)acc[ai][1][m][0][j] * ru0[j]; u1[j] = (float)acc[ai][1][m][1][j] * ru1[j]; }
#pragma unroll
                for (int j = 0; j < 4; ++j) { g0[j] = g0[j] * fsigmoid(g0[j]) * u0[j]; g1[j] = g1[j] * fsigmoid(g1[j]) * u1[j]; }
                *(u32x4*)(ACT + (size_t)(otile * BM + lrow) * 3584 + col0) = pack8(g0, g1); }
    }
};
struct EpiProj8 {
    static constexpr bool PERM = true, AFTER_DRAIN = false, I8 = true;
    bf16_t* O; const float* rs1; const float* sb; bf16_t* AQ; bf16_t* AK; const float* q_gain; const float* k_gain; unsigned char* G8;
    __device__ __forceinline__ void operator()(const i32x4 (&acc)[2][2][4][2], const Unit& u, int wr, int wc, int fr, int fq) const {
        const bool sg = (u.pn == 6) || (u.pn == 7);
        const bool mg = u.pn >= 16;
        const bool qk = (u.pn >= 8) && (u.pn < 12);
        const int row0 = u.pm * BM + wr * 64 + fr, col0 = u.pn * BM + wc * 32 + 8 * fq;
        f32x4 s0[2], s1[2];
#pragma unroll
        for (int bj = 0; bj < 2; ++bj) { s0[bj] = *(const f32x4*)(sb + col0 + bj * HALF); s1[bj] = *(const f32x4*)(sb + col0 + bj * HALF + 4); }
        if (qk) {
            const bool isk = u.pn >= 10; const int gidx = (u.pn - (isk ? 10 : 8)) * 4 + wc;
            const float* gp = (isk ? k_gain : q_gain) + 8 * fq; const float qs = isk ? 1.f : 0.125f * kLog2e;
            f32x4 gn[2][2];
#pragma unroll
            for (int bj = 0; bj < 2; ++bj) { gn[bj][0] = *(const f32x4*)(gp + bj * 32) * qs; gn[bj][1] = *(const f32x4*)(gp + bj * 32 + 4) * qs; }
            bf16_t* Ob = (isk ? AK : AQ) + gidx * 64 + 8 * fq;
#pragma unroll
            for (int ai = 0; ai < 2; ++ai)
#pragma unroll
                for (int m = 0; m < 4; ++m) { const int row = row0 + ai * HALF + m * 16; const float r = rs1[row]; const f32x4 r0[2] = {s0[0] * r, s0[1] * r}, r1[2] = {s1[0] * r, s1[1] * r}; f32x4 v[2][2]; float ss = 0.f;
#pragma unroll
                    for (int bj = 0; bj < 2; ++bj) {
#pragma unroll
                        for (int j = 0; j < 4; ++j) { v[bj][0][j] = (float)acc[ai][bj][m][0][j] * (r0[bj][j]); v[bj][1][j] = (float)acc[ai][bj][m][1][j] * (r1[bj][j]); }
                        ss += sumsq8(v[bj][0], v[bj][1]); }
                    ss = quad_sum_fq(ss); const float rn = __builtin_amdgcn_rsqf(ss * (1.f / 64.f) + 1e-6f);
#pragma unroll
                    for (int bj = 0; bj < 2; ++bj) *(u32x4*)(Ob + (size_t)row * 512 + bj * 32) = pack8(v[bj][0] * gn[bj][0] * rn, v[bj][1] * gn[bj][1] * rn); }
            return;
        }
        if (mg) {
            typedef unsigned u32x2 __attribute__((ext_vector_type(2)));
#pragma unroll
            for (int ai = 0; ai < 2; ++ai)
#pragma unroll
                for (int m = 0; m < 4; ++m) { const int row = row0 + ai * HALF + m * 16; const float r = rs1[row]; unsigned char* gp = G8 + (size_t)row * 3072 + (col0 - 4096);
#pragma unroll
                    for (int bj = 0; bj < 2; ++bj) { unsigned w[2];
#pragma unroll
                        for (int n = 0; n < 2; ++n) { const f32x4 s = (n ? s1[bj] : s0[bj]) * r; unsigned pk = 0;
#pragma unroll
                            for (int j = 0; j < 4; ++j) { const float g = fsigmoid((float)acc[ai][bj][m][n][j] * s[j]); pk |= (unsigned)__builtin_rintf(g * 255.f) << (8 * j); }
                            w[n] = pk; }
                        *(u32x2*)(gp + bj * HALF) = (u32x2){w[0], w[1]}; } }
            return;
        }
#pragma unroll
        for (int ai = 0; ai < 2; ++ai)
#pragma unroll
            for (int m = 0; m < 4; ++m) { const int row = row0 + ai * HALF + m * 16; const float r = rs1[row]; bf16_t* rowp = O + (size_t)row * 7168 + col0;
#pragma unroll
                for (int bj = 0; bj < 2; ++bj) { f32x4 v0, v1; const f32x4 q0 = s0[bj] * r, q1 = s1[bj] * r;
#pragma unroll
                    for (int j = 0; j < 4; ++j) { v0[j] = (float)acc[ai][bj][m][0][j] * q0[j]; v1[j] = (float)acc[ai][bj][m][1][j] * q1[j]; }
                    if (sg) {
#pragma unroll
                        for (int j = 0; j < 4; ++j) { v0[j] = fsigmoid(v0[j]); v1[j] = fsigmoid(v1[j]); } }
                    *(u32x4*)(rowp + bj * HALF) = pack8(v0, v1); } }
    }
};
struct EpiUp8d {
    static constexpr bool PERM = true, AFTER_DRAIN = false, I8 = true;
    bf16_t* ACT; const float* rs1; const float* sb;
    __device__ __forceinline__ void operator()(const i32x4 (&acc)[2][2][4][2], const Unit& u, int wr, int wc, int fr, int fq) const {
        const int row0 = u.pm * BM + wr * 64 + fr, col0 = u.pn * 128 + wc * 32 + 8 * fq;
        const float* sbp = sb + (size_t)u.pn * 256 + wc * 32 + 8 * fq;
        const f32x4 sg0 = *(const f32x4*)sbp, sg1 = *(const f32x4*)(sbp + 4), su0 = *(const f32x4*)(sbp + 128), su1 = *(const f32x4*)(sbp + 132);
#pragma unroll
        for (int ai = 0; ai < 2; ++ai)
#pragma unroll
            for (int m = 0; m < 4; ++m) { const int row = row0 + ai * HALF + m * 16; const float r = rs1[row];
                const f32x4 rg0 = sg0 * r, rg1 = sg1 * r, ru0 = su0 * r, ru1 = su1 * r; f32x4 g0, g1, u0, u1;
#pragma unroll
                for (int j = 0; j < 4; ++j) { g0[j] = (float)acc[ai][0][m][0][j] * rg0[j]; g1[j] = (float)acc[ai][0][m][1][j] * rg1[j]; u0[j] = (float)acc[ai][1][m][0][j] * ru0[j]; u1[j] = (float)acc[ai][1][m][1][j] * ru1[j]; }
#pragma unroll
                for (int j = 0; j < 4; ++j) { g0[j] = g0[j] * fsigmoid(g0[j]) * u0[j]; g1[j] = g1[j] * fsigmoid(g1[j]) * u1[j]; }
                *(u32x4*)(ACT + (size_t)row * 2816 + col0) = pack8(g0, g1); }
    }
};
}
namespace mix {
using bf16x8 = __attribute__((ext_vector_type(8))) short;
using s16x4  = __attribute__((ext_vector_type(4))) short;
using f32x16 = __attribute__((ext_vector_type(16))) float;
using f32x4  = __attribute__((ext_vector_type(4))) float;
using u32x4  = __attribute__((ext_vector_type(4))) unsigned;
typedef unsigned short bf16_t;
constexpr int KVB = 64, SHM_T = KVB * 128 * 2;
constexpr int OFF_V = 0, OFF_K = 2 * SHM_T, OFF_WS = 4 * SHM_T, OFF_A2 = OFF_WS + 8 * 256, OFF_M2 = OFF_A2 + 8192, OFF_MT = OFF_M2 + 8192, OFF_SC = OFF_MT + 8192, OFF_Q = OFF_SC + 256, MIX_LDS = OFF_Q + 64;
constexpr float kLog2e = 1.4426950408889634f;
#define KSWZ(row, colB) ((row) * 256 + ((colB) ^ (((row) & 7) << 4)))
#define SBAR() __builtin_amdgcn_sched_barrier(0)
__device__ __forceinline__ int crow(int r, int hi) { return (r & 3) + 8 * (r >> 2) + 4 * hi; }
__device__ __forceinline__ unsigned cvtpk(float lo, float hi) { unsigned r; asm volatile("v_cvt_pk_bf16_f32 %0, %1, %2" : "=v"(r) : "v"(lo), "v"(hi)); return r; }
__device__ __forceinline__ float bf2f(unsigned short h) { return __builtin_bit_cast(float, (unsigned)h << 16); }
__device__ __forceinline__ int v_st(int k, int c) { const int kk = (k & ~0xC) | ((k & 4) << 1) | ((k & 8) >> 1); return ((kk >> 3) * 4 + (c >> 5)) * 512 + ((kk & 7) * 32 + (c & 31)) * 2; }
__device__ __forceinline__ int v_rd_base(int lane) { return ((lane & 3) << 3) | (((lane >> 2) & 3) << 6) | (((lane >> 4) & 1) << 5) | (((lane >> 5) & 1) << 8); }
constexpr int v_rd_off(int d0, int ks, int half) { return d0 * 512 + ks * 4096 + half * 2048; }
template <int OFF> __device__ __forceinline__ s16x4 tr_read(int vb) { s16x4 r; asm volatile("ds_read_b64_tr_b16 %0, %1 offset:%2" : "=&v"(r) : "v"(vb), "i"(OFF) : "memory"); return r; }
template <int D0> __device__ __forceinline__ void pv_one(f32x16& od, int vb, bf16x8 pa0, bf16x8 pa1, bf16x8 pa2, bf16x8 pa3) {
    const s16x4 l0 = tr_read<v_rd_off(D0, 0, 0)>(vb), h0 = tr_read<v_rd_off(D0, 0, 1)>(vb), l1 = tr_read<v_rd_off(D0, 1, 0)>(vb), h1 = tr_read<v_rd_off(D0, 1, 1)>(vb);
    const s16x4 l2 = tr_read<v_rd_off(D0, 2, 0)>(vb), h2 = tr_read<v_rd_off(D0, 2, 1)>(vb), l3 = tr_read<v_rd_off(D0, 3, 0)>(vb), h3 = tr_read<v_rd_off(D0, 3, 1)>(vb);
    asm volatile("s_waitcnt lgkmcnt(0)" ::: "memory"); SBAR();
#define MIX_PK(L, H) (bf16x8){L[0], L[1], L[2], L[3], H[0], H[1], H[2], H[3]}
    od = __builtin_amdgcn_mfma_f32_32x32x16_bf16(pa0, MIX_PK(l0, h0), od, 0, 0, 0);
    od = __builtin_amdgcn_mfma_f32_32x32x16_bf16(pa1, MIX_PK(l1, h1), od, 0, 0, 0);
    od = __builtin_amdgcn_mfma_f32_32x32x16_bf16(pa2, MIX_PK(l2, h2), od, 0, 0, 0);
    od = __builtin_amdgcn_mfma_f32_32x32x16_bf16(pa3, MIX_PK(l3, h3), od, 0, 0, 0);
#undef MIX_PK
}
__device__ __forceinline__ void pv_d0(f32x16* o, int vb, bf16x8 pa0, bf16x8 pa1, bf16x8 pa2, bf16x8 pa3) {
    pv_one<0>(o[0], vb, pa0, pa1, pa2, pa3); pv_one<1>(o[1], vb, pa0, pa1, pa2, pa3); pv_one<2>(o[2], vb, pa0, pa1, pa2, pa3); pv_one<3>(o[3], vb, pa0, pa1, pa2, pa3);
}
__device__ __forceinline__ float swap_max(float v) { auto rr = __builtin_amdgcn_permlane32_swap(__float_as_uint(v), __float_as_uint(v), false, false); return fmaxf(__uint_as_float(rr[0]), __uint_as_float(rr[1])); }
__device__ __forceinline__ float swap_sum(float v) { auto rr = __builtin_amdgcn_permlane32_swap(__float_as_uint(v), __float_as_uint(v), false, false); return __uint_as_float(rr[0]) + __uint_as_float(rr[1]); }
__device__ __forceinline__ void p_to_frags(const f32x16& p0, const f32x16& p1, bf16x8& pa0, bf16x8& pa1, bf16x8& pa2, bf16x8& pa3) {
#define MIX_PK4(P, BASE, OUT) do { unsigned a0 = cvtpk(P[BASE + 0], P[BASE + 1]), a1 = cvtpk(P[BASE + 2], P[BASE + 3]);   \
    unsigned b0 = cvtpk(P[BASE + 4], P[BASE + 5]), b1 = cvtpk(P[BASE + 6], P[BASE + 7]);                              \
    auto r0 = __builtin_amdgcn_permlane32_swap(a0, b0, false, false); auto r1 = __builtin_amdgcn_permlane32_swap(a1, b1, false, false); \
    u32x4 w = {r0[0], r1[0], r0[1], r1[1]}; OUT = *reinterpret_cast<bf16x8*>(&w); } while (0)
    MIX_PK4(p0, 0, pa0); MIX_PK4(p0, 8, pa1); MIX_PK4(p1, 0, pa2); MIX_PK4(p1, 8, pa3);
#undef MIX_PK4
}
__device__ __forceinline__ float half_sum32(float v) {
#pragma unroll
    for (int o = 1; o < 32; o <<= 1) v += __shfl_xor(v, o);
    return v;
}
struct MixPtrs {
    const bf16_t* PROJ;
    const bf16_t *MQ, *MK, *AQ, *AK;
    const float* GATE;
    bf16_t *HM, *HA;
    const float *m_hgain, *a_hgain;
    const float* lamv;
};
template <int MODE>
__device__ __forceinline__ void unit(char* lds, const MixPtrs& P, int b, int h, int q0) {
    int tid_o = threadIdx.x; asm volatile("" : "+v"(tid_o));
    const int tid = tid_o, wid = __builtin_amdgcn_readfirstlane(tid >> 6), lane = tid & 63, r32 = lane & 31, hi = lane >> 5;
    constexpr int NQ = MODE == 0 ? 8 : 4;
    const int wq = MODE == 0 ? wid : (wid & 3), map = MODE == 0 ? 0 : (wid >> 2);
    const int qlo = q0 + 32 * wq, tq = qlo + r32;
    const size_t tok0 = (size_t)b * 2048;
    char* V_lds = lds + OFF_V; char* K_lds = lds + OFF_K;
    float* wsf = (float*)(lds + OFF_WS) + wid * 64; float* li_l = wsf; float* al_l = wsf + 32;
    float* A2 = (float*)(lds + OFF_A2); float* M2 = (float*)(lds + OFF_M2); float* MT = (float*)(lds + OFF_MT); float* SC = (float*)(lds + OFF_SC);
    const int NT = (q0 + (MODE == 0 ? 256 : 128)) / KVB;
    float M2row = 0.f, mtrow = 0.f;
    if (MODE == 0) {
        const int n = q0 + 256; const float* G = P.GATE + tok0 * 8;
        float lf[4], iv[4];
#pragma unroll
        for (int j = 0; j < 4; ++j) { const int t = 4 * tid + j; float f = 0.f, i = 0.f; if (t < n) { f = G[(size_t)t * 8 + 4 + h]; i = G[(size_t)t * 8 + h]; }
            lf[j] = fminf(f, 0.f) - 0.6931471805599453f * __builtin_amdgcn_logf(1.f + __builtin_amdgcn_exp2f(-kLog2e * fabsf(f))); iv[j] = i; }
        float s1 = lf[0], s2 = s1 + lf[1], s3 = s2 + lf[2], s4 = s3 + lf[3];
        float incl = s4;
#pragma unroll
        for (int o = 1; o < 64; o <<= 1) { const float t = __shfl_up(incl, o); if (lane >= o) incl += t; }
        if (lane == 63) SC[wid] = incl;
        __syncthreads();
        float wbase = 0.f;
#pragma unroll
        for (int w = 0; w < 8; ++w) { const float t = SC[w]; if (w < wid) wbase += t; }
        const float excl = wbase + incl - s4;
        const float B0 = excl + s1, B1 = excl + s2, B2 = excl + s3, B3 = excl + s4;
        const float a0 = iv[0] - B0, a1 = iv[1] - B1, a2 = iv[2] - B2, a3 = iv[3] - B3;
        const bool v0 = 4 * tid < n;
        const float NEG = -3.0e38f;
        const float m1 = v0 ? a0 : NEG, m2 = fmaxf(m1, v0 ? a1 : NEG), m3 = fmaxf(m2, v0 ? a2 : NEG), m4 = fmaxf(m3, v0 ? a3 : NEG);
        float mincl = m4;
#pragma unroll
        for (int o = 1; o < 64; o <<= 1) { const float t = __shfl_up(mincl, o); if (lane >= o) mincl = fmaxf(mincl, t); }
        float mprev = __shfl_up(mincl, 1); if (lane == 0) mprev = NEG;
        if (lane == 63) SC[8 + wid] = mincl;
        __syncthreads();
        float mbase = 0.f;
#pragma unroll
        for (int w = 0; w < 8; ++w) { const float t = SC[8 + w]; if (w < wid) mbase = fmaxf(mbase, t); }
        const float mex = fmaxf(mbase, mprev);
        const float x0 = fmaxf(mex, m1), x1 = fmaxf(mex, m2), x2 = fmaxf(mex, m3), x3 = fmaxf(mex, m4);
        if (v0) { *(f32x4*)(A2 + 4 * tid) = (f32x4){a0 * kLog2e, a1 * kLog2e, a2 * kLog2e, a3 * kLog2e};
                  *(f32x4*)(M2 + 4 * tid) = (f32x4){x0 * kLog2e, x1 * kLog2e, x2 * kLog2e, x3 * kLog2e};
                  *(f32x4*)(MT + 4 * tid) = (f32x4){B0 + x0, B1 + x1, B2 + x2, B3 + x3}; }
        __syncthreads();
        M2row = M2[tq]; mtrow = MT[tq];
    }
    bf16x8 qr[NQ];
    { const bf16_t* Qw = (MODE == 0 ? P.MQ : P.AQ) + (tok0 + tq) * 512 + h * 128 + map * 64 + hi * 8;
#pragma unroll
      for (int d0 = 0; d0 < NQ; ++d0) qr[d0] = *reinterpret_cast<const bf16x8*>(Qw + d0 * 16); }
    const bf16_t* Kg = (MODE == 0 ? P.MK : P.AK) + tok0 * 512 + h * 128;
    const bf16_t* Vg = P.PROJ + tok0 * 7168 + (MODE == 0 ? 1024 : 3072) + h * 128;
    const int sr = tid >> 4, sc = (tid & 15) * 8, vst0 = v_st(sr, sc), vst1 = v_st(32 + sr, sc);
    const int vb0 = (int)(uintptr_t)V_lds + v_rd_base(lane);
    bf16x8 vsA0, vsA1, ksA0, ksA1;
#define MIX_SLOAD(S, k0) do { vs##S##0 = *reinterpret_cast<const bf16x8*>(Vg + (size_t)((k0) + sr) * 7168 + sc); vs##S##1 = *reinterpret_cast<const bf16x8*>(Vg + (size_t)((k0) + 32 + sr) * 7168 + sc); \
    ks##S##0 = *reinterpret_cast<const bf16x8*>(Kg + (size_t)((k0) + sr) * 512 + sc); ks##S##1 = *reinterpret_cast<const bf16x8*>(Kg + (size_t)((k0) + 32 + sr) * 512 + sc); } while (0)
#define MIX_SWRITE(S, bb) do { *(bf16x8*)(V_lds + (bb) * SHM_T + vst0) = vs##S##0; *(bf16x8*)(V_lds + (bb) * SHM_T + vst1) = vs##S##1; \
    *(bf16x8*)(K_lds + (bb) * SHM_T + KSWZ(sr, sc * 2)) = ks##S##0; *(bf16x8*)(K_lds + (bb) * SHM_T + KSWZ(32 + sr, sc * 2)) = ks##S##1; } while (0)
#define MIX_BAR() do { asm volatile("s_waitcnt lgkmcnt(0)" ::: "memory"); __builtin_amdgcn_s_barrier(); asm volatile("" ::: "memory"); } while (0)
    f32x16 o[4];
#pragma unroll
    for (int d = 0; d < 4; ++d)
#pragma unroll
        for (int r = 0; r < 16; ++r) o[d][r] = 0.f;
    float m_run = -1e30f, l_run = 0.f;
    const float sl2 = MODE == 1 ? __builtin_amdgcn_exp2f(-2.f * (float)(h + 1)) * kLog2e : 0.f;
    auto mix_compute = [&](int j, int k0) __attribute__((always_inline)) {
        if (k0 <= qlo + 31) {
            const char* Kt = K_lds + (j & 1) * SHM_T;
            f32x16 p0, p1;
            if (MODE == 1) { const float base = sl2 * (float)(k0 - tq);
#pragma unroll
                for (int r = 0; r < 16; ++r) { p0[r] = fmaf(sl2, (float)crow(r, hi), base); p1[r] = fmaf(sl2, (float)(32 + crow(r, hi)), base); } }
            else {
#pragma unroll
                for (int r = 0; r < 16; ++r) { p0[r] = 0.f; p1[r] = 0.f; } }
            bf16x8 kb0[NQ], kb1[NQ];
#define MIX_KLD(D0) do { const int cb_ = (map * 64 + (D0) * 16 + hi * 8) * 2; kb0[D0] = *reinterpret_cast<const bf16x8*>(Kt + KSWZ(r32, cb_)); kb1[D0] = *reinterpret_cast<const bf16x8*>(Kt + KSWZ(32 + r32, cb_)); } while (0)
            MIX_KLD(0); MIX_KLD(1); SBAR();
#pragma unroll
            for (int d0 = 0; d0 < NQ; ++d0) {
                if (d0 + 2 < NQ) MIX_KLD(d0 + 2);
                p0 = __builtin_amdgcn_mfma_f32_32x32x16_bf16(kb0[d0], qr[d0], p0, 0, 0, 0);
                p1 = __builtin_amdgcn_mfma_f32_32x32x16_bf16(kb1[d0], qr[d0], p1, 0, 0, 0); SBAR(); }
#undef MIX_KLD
            const bool diag = k0 + 63 > qlo;
            if (MODE == 1) {
                if (diag) {
                    int tqm = tq; asm volatile("" : "+v"(tqm));
#pragma unroll
                    for (int r = 0; r < 16; ++r) { if (k0 + crow(r, hi) > tqm) p0[r] = -1e30f; if (k0 + 32 + crow(r, hi) > tqm) p1[r] = -1e30f; } }
                float pmax = p0[0];
#pragma unroll
                for (int r = 1; r < 16; ++r) pmax = fmaxf(pmax, p0[r]);
#pragma unroll
                for (int r = 0; r < 16; ++r) pmax = fmaxf(pmax, p1[r]);
                pmax = swap_max(pmax);
                float mn = m_run, alpha = 1.f;
                if (!__all(pmax - m_run <= 8.f)) { mn = fmaxf(m_run, pmax); alpha = __builtin_amdgcn_exp2f(m_run - mn); m_run = mn; }
                float ps = 0.f;
#pragma unroll
                for (int r = 0; r < 16; ++r) { p0[r] = __builtin_amdgcn_exp2f(p0[r] - mn); p1[r] = __builtin_amdgcn_exp2f(p1[r] - mn); ps += p0[r] + p1[r]; }
                ps = swap_sum(ps); l_run = l_run * alpha + ps;
                if (__any(alpha < 1.f)) { if (hi == 0) al_l[r32] = alpha; asm volatile("s_waitcnt lgkmcnt(0)" ::: "memory");
#pragma unroll
                    for (int r = 0; r < 16; ++r) { const float a = al_l[crow(r, hi)];
#pragma unroll
                        for (int d = 0; d < 4; ++d) o[d][r] *= a; } }
            } else {
                float ps = 0.f;
                if (diag) {
#pragma unroll
                    for (int i = 0; i < 4; ++i) { const f32x4 aa = *(const f32x4*)(A2 + k0 + 8 * i + 4 * hi), ab = *(const f32x4*)(A2 + k0 + 32 + 8 * i + 4 * hi);
#pragma unroll
                        for (int q = 0; q < 4; ++q) { const int r = 4 * i + q;
                            float w0 = __builtin_amdgcn_exp2f(fminf(aa[q] - M2row, 0.f)), w1 = __builtin_amdgcn_exp2f(fminf(ab[q] - M2row, 0.f));
                            if (k0 + crow(r, hi) > tq) w0 = 0.f; if (k0 + 32 + crow(r, hi) > tq) w1 = 0.f;
                            p0[r] *= w0; p1[r] *= w1; ps += p0[r] + p1[r]; } }
                    asm volatile("" : "+v"(ps));
                } else {
#pragma unroll
                    for (int i = 0; i < 4; ++i) { const f32x4 aa = *(const f32x4*)(A2 + k0 + 8 * i + 4 * hi), ab = *(const f32x4*)(A2 + k0 + 32 + 8 * i + 4 * hi);
#pragma unroll
                        for (int q = 0; q < 4; ++q) { const int r = 4 * i + q;
                            p0[r] *= __builtin_amdgcn_exp2f(aa[q] - M2row); p1[r] *= __builtin_amdgcn_exp2f(ab[q] - M2row); ps += p0[r] + p1[r]; } }
                }
                ps = swap_sum(ps); l_run += ps;
            }
            bf16x8 pa0, pa1, pa2, pa3; p_to_frags(p0, p1, pa0, pa1, pa2, pa3);
            pv_d0(o, vb0 + (j & 1) * SHM_T, pa0, pa1, pa2, pa3);
        }
    };
    MIX_SLOAD(A, 0); MIX_SWRITE(A, 0);
#define MIX_TILE(SL, SW, JJ) do { const int j = (JJ); \
        MIX_BAR(); \
        const int k0 = j * KVB; \
        if (j + 1 < NT) MIX_SLOAD(SL, k0 + KVB); \
        mix_compute(j, k0); \
        if (j + 1 < NT) MIX_SWRITE(SW, (j + 1) & 1); } while (0)
    for (int jj = 0; jj < NT; ++jj) { MIX_TILE(A, A, jj); }
#undef MIX_TILE
    __syncthreads();
#undef MIX_SLOAD
#undef MIX_SWRITE
#undef MIX_BAR
    int lane_e = lane; asm volatile("" : "+v"(lane_e));
    const int r32e = lane_e & 31, hie = lane_e >> 5;
    float rowscale;
    if (MODE == 1) rowscale = 1.f / l_run; else rowscale = 1.f / fmaxf(fabsf(l_run), __expf(-mtrow));
    if (hie == 0) li_l[r32e] = rowscale;
    asm volatile("s_waitcnt lgkmcnt(0)" ::: "memory");
    float rs[16];
#pragma unroll
    for (int r = 0; r < 16; ++r) rs[r] = li_l[crow(r, hie)];
#pragma unroll
    for (int d = 0; d < 4; ++d)
#pragma unroll
        for (int r = 0; r < 16; ++r) o[d][r] *= rs[r];
    if (MODE == 1) {
        __syncthreads();
        float* EX = (float*)lds + (size_t)wq * 4096 + lane_e;
        if (map == 1) {
#pragma unroll
            for (int d = 0; d < 4; ++d)
#pragma unroll
                for (int r = 0; r < 16; ++r) EX[(d * 16 + r) * 64] = o[d][r]; }
        __syncthreads();
        if (map == 0) { const float lam_l = P.lamv[0];
#pragma unroll
            for (int d = 0; d < 4; ++d)
#pragma unroll
                for (int r = 0; r < 16; ++r) o[d][r] -= lam_l * EX[(d * 16 + r) * 64]; }
    }
    if (MODE == 0 || map == 0) {
        float rn[16];
#pragma unroll
        for (int r = 0; r < 16; ++r) { float s = 0.f;
#pragma unroll
            for (int d = 0; d < 4; ++d) s += o[d][r] * o[d][r];
            s = half_sum32(s); rn[r] = __builtin_amdgcn_rsqf(s * (1.f / 128.f) + 1e-6f); }
        const float* hg = (MODE == 0 ? P.m_hgain : P.a_hgain) + h * 128;
        bf16_t* Ob = (MODE == 0 ? P.HM : P.HA) + (tok0 + qlo) * 512 + h * 128;
        unsigned short og[4][16];
        if (MODE == 0) {
#pragma unroll
            for (int d = 0; d < 4; ++d)
#pragma unroll
                for (int r = 0; r < 16; ++r) og[d][r] = P.PROJ[(tok0 + qlo + crow(r, hie)) * 7168 + 1536 + h * 128 + 32 * d + r32e]; }
#pragma unroll
        for (int d = 0; d < 4; ++d) { const int col = 32 * d + r32e; const float g = hg[col] * (MODE == 1 ? P.lamv[1] : 1.f);
#pragma unroll
            for (int r = 0; r < 16; ++r) { const int row = crow(r, hie); float v = o[d][r] * rn[r] * g;
                if (MODE == 0) v *= bf2f(og[d][r]);
                Ob[(size_t)row * 512 + col] = (bf16_t)(cvtpk(v, v) & 0xffffu); } }
    }
    __syncthreads();
}
template <bool DO_M, bool DO_A> __device__ __forceinline__ void mix_phase(char* lds, const MixPtrs& P, unsigned* queue) {
    volatile int* qw = (volatile int*)(lds + OFF_Q);
    if (DO_M) for (;;) {
        if (threadIdx.x == 0) *qw = (int)__hip_atomic_fetch_add(queue, 1u, __ATOMIC_RELAXED, __HIP_MEMORY_SCOPE_AGENT);
        __syncthreads();
        const int item = __builtin_amdgcn_readfirstlane(*qw);
        __syncthreads();
        if (item >= 256) break;
        unit<0>(lds, P, (item & 31) >> 2, item & 3, 256 * (7 - (item >> 5)));
    }
    if (DO_A) for (;;) {
        if (threadIdx.x == 0) *qw = (int)__hip_atomic_fetch_add(queue + 32, 1u, __ATOMIC_RELAXED, __HIP_MEMORY_SCOPE_AGENT);
        __syncthreads();
        const int item = __builtin_amdgcn_readfirstlane(*qw);
        __syncthreads();
        if (item >= 512) break;
        unit<1>(lds, P, (item & 31) >> 2, item & 3, 128 * (15 - (item >> 5)));
    }
}
}
namespace thin {
using pg8::bf16_t; using pg8::f32x4; using pg8::u32x4; using pg8::bf16x8;
typedef __attribute__((address_space(3))) float lds_f32;
__device__ __forceinline__ unsigned f2bf(float f) { unsigned u = __builtin_bit_cast(unsigned, f); return (u + 0x7fffu + ((u >> 16) & 1u)) >> 16; }
__device__ __forceinline__ unsigned pk2(float lo, float hi) { return f2bf(lo) | (f2bf(hi) << 16); }
__device__ __forceinline__ float wave_sum(float v) {
#pragma unroll
    for (int o = 1; o < 64; o <<= 1) v += __shfl_xor(v, o);
    return v;
}
__device__ __forceinline__ unsigned pack4_i8(float a, float b, float c, float d) {
    const int ia = (int)__builtin_rintf(a), ib = (int)__builtin_rintf(b), ic = (int)__builtin_rintf(c), id = (int)__builtin_rintf(d);
    return (unsigned)(ia & 0xff) | ((unsigned)(ib & 0xff) << 8) | ((unsigned)(ic & 0xff) << 16) | ((unsigned)(id & 0xff) << 24);
}
__device__ __forceinline__ float wave_max(float v) {
#pragma unroll
    for (int o = 1; o < 64; o <<= 1) v = fmaxf(v, __shfl_xor(v, o));
    return v;
}
__device__ __forceinline__ u32x4 quant16(const f32x4& a0, const f32x4& a1, const f32x4& a2, const f32x4& a3, float inv) {
    u32x4 w; w.x = pack4_i8(a0[0] * inv, a0[1] * inv, a0[2] * inv, a0[3] * inv); w.y = pack4_i8(a1[0] * inv, a1[1] * inv, a1[2] * inv, a1[3] * inv);
    w.z = pack4_i8(a2[0] * inv, a2[1] * inv, a2[2] * inv, a2[3] * inv); w.w = pack4_i8(a3[0] * inv, a3[1] * inv, a3[2] * inv, a3[3] * inv); return w;
}
__device__ __forceinline__ float absmax16(const f32x4& a0, const f32x4& a1, const f32x4& a2, const f32x4& a3) {
    float m = 0.f;
#pragma unroll
    for (int j = 0; j < 4; ++j) m = fmaxf(fmaxf(m, fmaxf(fabsf(a0[j]), fabsf(a1[j]))), fmaxf(fabsf(a2[j]), fabsf(a3[j])));
    return m;
}
__device__ __forceinline__ float row_rstd_wave(const float* ssq, int row, int lane, int vz) {
    float v = lane < 16 ? ssq[(size_t)(row + vz) * 16 + lane] : 0.f;
#pragma unroll
    for (int o = 1; o < 16; o <<= 1) v += __shfl_xor(v, o);
    v = __shfl(v, 0);
    return __builtin_amdgcn_rsqf(v * (1.f / 1024.f) + 1e-6f);
}
struct TrItem { const float* W; const float* gain; bf16_t* WT; int ldw, K, F, map, n0, k0; };
__device__ __forceinline__ void tr_load(const TrItem& I, float (&v)[16][4], int lane, int wave) {
    int so[4];
#pragma unroll
    for (int j = 0; j < 4; ++j) { const int n = I.n0 + lane + 64 * j; so[j] = I.map == 0 ? n : I.map == 1 ? (n < 2048 ? n : n + 8) : ((n & 255) >> 7) * I.F + (n >> 8) * 128 + (n & 127); }
    const float* Wk = I.W + (size_t)(I.k0 + wave * 16) * I.ldw;
#pragma unroll
    for (int r = 0; r < 16; ++r)
#pragma unroll
        for (int j = 0; j < 4; ++j) v[r][j] = Wk[(size_t)r * I.ldw + so[j]];
}
__device__ __forceinline__ void tr_store(const TrItem& I, const float (&v)[16][4], char* lds, int lane, int wave) {
    unsigned short* img = (unsigned short*)lds;
#pragma unroll
    for (int r = 0; r < 16; r += 2) { float g0 = 1.f, g1 = 1.f; if (I.gain) { g0 = I.gain[I.k0 + wave * 16 + r]; g1 = I.gain[I.k0 + wave * 16 + r + 1]; }
#pragma unroll
        for (int j = 0; j < 4; ++j) *(unsigned*)(img + (lane + 64 * j) * 130 + wave * 16 + r) = pk2(v[r][j] * g0, v[r + 1][j] * g1); }
    __syncthreads();
#pragma unroll 8
    for (int i = 0; i < 32; ++i) { const int n = wave * 32 + i; const unsigned w = *(const unsigned*)(img + n * 130 + 2 * lane);
        *(unsigned*)(I.WT + (size_t)(I.n0 + n) * I.K + I.k0 + 2 * lane) = w; }
    __syncthreads();
}
struct Q8Item { const float* W; const float* gain; unsigned char* W8; float* SB; int ldw, F, map, n0; };
__device__ __forceinline__ void q8_item(const Q8Item& I, char* lds, int lane, int wave) {
    unsigned* img = (unsigned*)lds;
    const int n = I.n0 + lane;
    int so1 = n < 2048 ? n : n + 8;
    if (n >= 2048 && n < 3072) { const int w = n & 255, bj = w >> 7, wc = (w >> 5) & 3, j = w & 31; so1 = 2056 + ((n - 2048) & ~255) + wc * 64 + bj * 32 + j; }
    const int so = I.map == 0 ? n : I.map == 1 ? so1 : ((n & 255) >> 7) * I.F + (n >> 8) * 128 + (n & 127);
    const float* Wk = I.W + (size_t)(wave * 128) * I.ldw + so;
    float va[32], vb[32];
#define Q8_LOAD(V, B) do { _Pragma("unroll") for (int r = 0; r < 32; ++r) V[r] = Wk[(size_t)((B) * 32 + r) * I.ldw]; } while (0)
#define Q8_PUT(V, B) do { _Pragma("unroll") for (int r = 0; r < 32; r += 2) { const int k = wave * 128 + (B) * 32 + r; \
        img[lane * 514 + (k >> 1)] = pk2(V[r] * I.gain[k], V[r + 1] * I.gain[k + 1]); } } while (0)
    Q8_LOAD(va, 0); Q8_LOAD(vb, 1); Q8_PUT(va, 0); Q8_LOAD(va, 2); Q8_PUT(vb, 1); Q8_LOAD(vb, 3); Q8_PUT(va, 2); Q8_PUT(vb, 3);
#undef Q8_LOAD
#undef Q8_PUT
    __syncthreads();
#pragma unroll 2
    for (int i = 0; i < 8; ++i) { const int nr = wave * 8 + i; const unsigned long long* rp = (const unsigned long long*)(img + nr * 514) + lane * 4;
        const unsigned long long d0 = rp[0], d1 = rp[1], d2 = rp[2], d3 = rp[3];
        u32x4 w0 = {(unsigned)d0, (unsigned)(d0 >> 32), (unsigned)d1, (unsigned)(d1 >> 32)}, w1 = {(unsigned)d2, (unsigned)(d2 >> 32), (unsigned)d3, (unsigned)(d3 >> 32)};
        f32x4 a0, a1, a2, a3; pg8::unpack8(w0, a0, a1); pg8::unpack8(w1, a2, a3);
        const float mx = wave_max(absmax16(a0, a1, a2, a3)), step = mx > 0.f ? mx * (1.f / 127.f) : 1.f;
        *((u32x4*)(I.W8 + (size_t)(I.n0 + nr) * 1024) + lane) = quant16(a0, a1, a2, a3, 1.f / step);
        if (lane == 0) I.SB[I.n0 + nr] = step; }
    __syncthreads();
}
struct ProIn {
    const float *x, *p, *attn_norm, *w_in, *pool_w, *pool_scale, *w_branch, *w_out, *ffn_norm, *dense_w_gu, *dense_w_down, *router_w, *moe_w_gu, *moe_w_down, *ple_norm, *ple_w_gate, *ple_w_proj;
    bf16_t *W_IN, *W_BR, *W_OUT, *W_GU0, *W_DN0, *W_GU1, *W_DN1, *W_PG, *W_PP, *XB, *PB; float *X, *SSQ, *WG, *WR; unsigned char* X8; float* RS1; unsigned char *W8_IN, *W8_GU0, *W8_GU1; float *SB_IN, *SB_GU0, *SB_GU1; float* GATE; const float* gate_bias;
};
__device__ __forceinline__ void prologue(const ProIn& a, char* lds, int vcu, int G) {
    int tid_o = threadIdx.x; asm volatile("" : "+v"(tid_o)); const int tid = tid_o, lane = tid & 63, wave = __builtin_amdgcn_readfirstlane(tid >> 6);
    const int gw = vcu * 8 + wave, NGW = G * 8;
    { constexpr int Q_GU1 = 8 * 112, Q_IN = 2 * 112, Q_GU0 = 88, NQ = Q_GU1 + Q_IN + Q_GU0;
#pragma unroll 1
      for (int it = vcu; it < NQ; it += G) { Q8Item I; int r = it;
          if (r < Q_GU1) { const int e = r / 112; r -= e * 112; I.W = a.moe_w_gu + (size_t)e * 1024 * 7168; I.ldw = 7168; I.gain = a.ffn_norm + 1024; I.F = 3584; I.map = 2; I.W8 = a.W8_GU1 + (size_t)e * 7168 * 1024; I.SB = a.SB_GU1 + e * 7168; }
          else if ((r -= Q_GU1) < Q_IN) { const int L = r / 112; r -= L * 112; I.W = a.w_in + (size_t)L * 1024 * 7176; I.ldw = 7176; I.gain = a.attn_norm + L * 1024; I.F = 0; I.map = 1; I.W8 = a.W8_IN + (size_t)L * 7168 * 1024; I.SB = a.SB_IN + L * 7168; }
          else { r -= Q_IN; I.W = a.dense_w_gu; I.ldw = 5632; I.gain = a.ffn_norm; I.F = 2816; I.map = 2; I.W8 = a.W8_GU0; I.SB = a.SB_GU0; }
          I.n0 = r * 64; q8_item(I, lds, lane, wave); } }
    constexpr int I_BR = 4 * 4, I_OUT = 8 * 4, I_DN0 = 22 * 4, I_DN1 = 28 * 4, I_PG = 8 * 4, I_PP = 2 * 4;
    constexpr int NITEMS = 4 * I_BR + 2 * I_OUT + I_DN0 + 8 * I_DN1 + 2 * I_PG + 2 * I_PP;
    auto decode = [&](int it, TrItem& I) {
        int r = it, N; I.gain = nullptr; I.F = 0; I.map = 0;
        if (r < 8 * I_DN1) { const int e = r / I_DN1; r -= e * I_DN1; I.W = a.moe_w_down + (size_t)e * 3584 * 1024; I.ldw = 1024; I.K = 3584; N = 1024; I.WT = a.W_DN1 + (size_t)e * 1024 * 3584; }
        else if ((r -= 8 * I_DN1) < I_DN0) { I.W = a.dense_w_down; I.ldw = 1024; I.K = 2816; N = 1024; I.WT = a.W_DN0; }
        else if ((r -= I_DN0) < 4 * I_BR) { const int q = r / I_BR, L = q >> 1, br = q & 1; r -= q * I_BR; I.W = a.w_branch + ((size_t)L * 3 + br) * 512 * 1024; I.ldw = 1024; I.K = 512; N = 1024; I.WT = a.W_BR + ((size_t)L * 3 + br) * 1024 * 512; }
        else if ((r -= 4 * I_BR) < 2 * I_OUT) { const int L = r / I_OUT; r -= L * I_OUT; I.W = a.w_out + (size_t)L * 1024 * 1024; I.ldw = 1024; I.K = 1024; N = 1024; I.WT = a.W_OUT + (size_t)L * 1024 * 1024; }
        else if ((r -= 2 * I_OUT) < 2 * I_PG) { const int L = r / I_PG; r -= L * I_PG; I.W = a.ple_w_gate + (size_t)L * 1024 * 1024; I.ldw = 1024; I.gain = a.ple_norm + L * 1024; I.K = 1024; N = 1024; I.WT = a.W_PG + (size_t)L * 1024 * 1024; }
        else { r -= 2 * I_PG; const int L = r / I_PP; r -= L * I_PP; I.W = a.ple_w_proj + (size_t)L * 256 * 1024; I.ldw = 1024; I.K = 256; N = 1024; I.WT = a.W_PP + (size_t)L * 1024 * 256; }
        const int nblk = N / 256; I.k0 = (r / nblk) * 128; I.n0 = (r % nblk) * 256;
    };
    { TrItem IA, IB; float va[16][4], vb[16][4]; int it = G - 1 - vcu;
      if (it < NITEMS) { decode(it, IA); tr_load(IA, va, lane, wave);
#pragma unroll 1
        for (;;) {
            const bool hb = it + G < NITEMS; if (hb) { decode(it + G, IB); tr_load(IB, vb, lane, wave); }
            tr_store(IA, va, lds, lane, wave);
            if (!hb) break;
            it += 2 * G; const bool ha = it < NITEMS; if (ha) { decode(it, IA); tr_load(IA, va, lane, wave); }
            tr_store(IB, vb, lds, lane, wave);
            if (!ha) break;
        } } }
    float wgx[4][4][8];
#pragma unroll
    for (int j = 0; j < 4; ++j)
#pragma unroll
        for (int i = 0; i < 4; ++i) { const int k = 4 * lane + 256 * j + i; const float gk = a.attn_norm[k]; const f32x4 w0 = *(const f32x4*)(a.w_in + (size_t)k * 7176 + 2048), w1 = *(const f32x4*)(a.w_in + (size_t)k * 7176 + 2052);
#pragma unroll
            for (int c = 0; c < 4; ++c) { wgx[j][i][c] = gk * w0[c]; wgx[j][i][4 + c] = gk * w1[c]; } }
    for (int m0 = gw * 2; m0 < 16384; m0 += NGW * 2) {
        f32x4 v[2][4];
#pragma unroll
        for (int q = 0; q < 2; ++q) { const f32x4* xr = (const f32x4*)(a.x + (size_t)(m0 + q) * 1024) + lane;
#pragma unroll
            for (int j = 0; j < 4; ++j) v[q][j] = xr[64 * j]; }
#pragma unroll
        for (int q = 0; q < 2; ++q) { const int m = m0 + q; unsigned long long* o8 = (unsigned long long*)(a.XB + (size_t)m * 1024) + lane; float s = 0.f;
#pragma unroll
            for (int j = 0; j < 4; ++j) { const f32x4 w = v[q][j]; s += (w[0] * w[0] + w[1] * w[1]) + (w[2] * w[2] + w[3] * w[3]);
                o8[64 * j] = (unsigned long long)pk2(w[0], w[1]) | ((unsigned long long)pk2(w[2], w[3]) << 32); }
            s = wave_sum(s);
            if (lane < 16) a.SSQ[(size_t)m * 16 + lane] = lane == 0 ? s : 0.f;
            float mx = 0.f;
#pragma unroll
            for (int j = 0; j < 4; ++j) mx = fmaxf(mx, fmaxf(fmaxf(fabsf(v[q][j][0]), fabsf(v[q][j][1])), fmaxf(fabsf(v[q][j][2]), fabsf(v[q][j][3]))));
            mx = wave_max(mx); const float step = mx > 0.f ? mx * (1.f / 127.f) : 1.f, inv = 1.f / step;
            unsigned* x8 = (unsigned*)(a.X8 + (size_t)m * 1024) + lane;
#pragma unroll
            for (int j = 0; j < 4; ++j) x8[64 * j] = pack4_i8(v[q][j][0] * inv, v[q][j][1] * inv, v[q][j][2] * inv, v[q][j][3] * inv);
            const float rstd = __builtin_amdgcn_rsqf(s * (1.f / 1024.f) + 1e-6f);
            if (lane == 0) a.RS1[m] = rstd * step;
            float d[8] = {0.f, 0.f, 0.f, 0.f, 0.f, 0.f, 0.f, 0.f};
#pragma unroll
            for (int j = 0; j < 4; ++j)
#pragma unroll
                for (int i = 0; i < 4; ++i)
#pragma unroll
                    for (int c = 0; c < 8; ++c) d[c] = fmaf(v[q][j][i], wgx[j][i][c], d[c]);
#pragma unroll
            for (int c = 0; c < 8; ++c) d[c] = wave_sum(d[c]);
            if (lane < 8) { float dv = d[0];
#pragma unroll
                for (int c = 1; c < 8; ++c) if (lane == c) dv = d[c];
                a.GATE[(size_t)m * 8 + lane] = dv * rstd + a.gate_bias[lane]; } }
    }
    { const size_t n8 = (size_t)2 * 16384 * 256 / 8; const size_t gt = (size_t)(vcu * 512 + tid), NT = (size_t)G * 512;
      for (size_t i0 = gt; i0 < n8; i0 += 4 * NT) { f32x4 v0[4], v1[4];
#pragma unroll
          for (int q = 0; q < 4; ++q) { const size_t i = i0 + q * NT; if (i < n8) { v0[q] = *(const f32x4*)(a.p + i * 8); v1[q] = *(const f32x4*)(a.p + i * 8 + 4); } }
#pragma unroll
          for (int q = 0; q < 4; ++q) { const size_t i = i0 + q * NT; if (i < n8) { u32x4 w; w.x = pk2(v0[q][0], v0[q][1]); w.y = pk2(v0[q][2], v0[q][3]); w.z = pk2(v1[q][0], v1[q][1]); w.w = pk2(v1[q][2], v1[q][3]); *(u32x4*)(a.PB + i * 8) = w; } } }
      for (size_t i = gt; i < 2 * 8192 + 8192; i += NT) {
          if (i < 2 * 8192) { const int L = (int)(i / 8192), k = (int)(i % 8192) / 8, j = (int)(i & 7); a.WG[i] = a.attn_norm[L * 1024 + k] * a.w_in[((size_t)L * 1024 + k) * 7176 + 2048 + j]; }
          else { const int q = (int)(i - 2 * 8192), k = q / 8; a.WR[q] = a.ffn_norm[1024 + k] * a.router_w[q]; } }
    }
    for (int task = vcu; task < 64; task += G) {
        const int L = task >> 5, g = (task >> 3) & 3, nb = task & 7;
        float* AsT = (float*)lds; float* Bs = AsT + 128 * 128;
        __syncthreads();
        const float* pw = a.pool_w + ((size_t)L * 4 + g) * 128 * 128; const float* ps = a.pool_scale + L * 512 + g * 128;
        const float* wb = a.w_branch + (((size_t)L * 3 + 2) * 512 + g * 128) * 1024 + nb * 128;
        for (int i = tid; i < 128 * 32; i += 512) { const int c = i >> 5, d4 = (i & 31) * 4; const f32x4 w = *(const f32x4*)(pw + c * 128 + d4), s = *(const f32x4*)(ps + d4);
            AsT[(d4 + 0) * 128 + c] = w[0] * s[0]; AsT[(d4 + 1) * 128 + c] = w[1] * s[1]; AsT[(d4 + 2) * 128 + c] = w[2] * s[2]; AsT[(d4 + 3) * 128 + c] = w[3] * s[3]; }
        for (int i = tid; i < 128 * 32; i += 512) { const int d = i >> 5, n4 = (i & 31) * 4; *(f32x4*)(Bs + d * 128 + n4) = *(const f32x4*)(wb + (size_t)d * 1024 + n4); }
        __syncthreads();
        const int nq = (tid & 31) * 4, cq = (tid >> 5) * 8;
        float acc[4][8];
#pragma unroll
        for (int i = 0; i < 4; ++i)
#pragma unroll
            for (int j = 0; j < 8; ++j) acc[i][j] = 0.f;
#pragma unroll 4
        for (int d = 0; d < 128; ++d) { const f32x4 bv = *(const f32x4*)(Bs + d * 128 + nq), a0 = *(const f32x4*)(AsT + d * 128 + cq), a1 = *(const f32x4*)(AsT + d * 128 + cq + 4);
#pragma unroll
            for (int i = 0; i < 4; ++i) {
#pragma unroll
                for (int j = 0; j < 4; ++j) { acc[i][j] = fmaf(bv[i], a0[j], acc[i][j]); acc[i][4 + j] = fmaf(bv[i], a1[j], acc[i][4 + j]); } } }
#pragma unroll
        for (int i = 0; i < 4; ++i) { u32x4 w; w.x = pk2(acc[i][0], acc[i][1]); w.y = pk2(acc[i][2], acc[i][3]); w.z = pk2(acc[i][4], acc[i][5]); w.w = pk2(acc[i][6], acc[i][7]);
            *(u32x4*)(a.W_BR + ((size_t)L * 3 + 2) * 1024 * 512 + (size_t)(nb * 128 + nq + i) * 512 + g * 128 + cq) = w; }
    }
    __syncthreads();
}
template <bool GATES> __device__ __forceinline__ void quant_act(const bf16_t* XB, const float* SSQ, unsigned char* X8, float* RS1, const float* WGt, const float* gate_bias, float* GATE, int vcu, int G) {
    int tid_o = threadIdx.x; asm volatile("" : "+v"(tid_o)); const int tid = tid_o, lane = tid & 63, wave = __builtin_amdgcn_readfirstlane(tid >> 6), gw = vcu * 8 + wave, NGW = G * 8;
    int vz = 0; asm volatile("" : "+v"(vz));
    float wgq[GATES ? 16 : 1][8];
    if (GATES) {
#pragma unroll
        for (int i = 0; i < 16; ++i) { const f32x4 w0 = *(const f32x4*)(WGt + (size_t)(16 * lane + i) * 8), w1 = *(const f32x4*)(WGt + (size_t)(16 * lane + i) * 8 + 4);
#pragma unroll
            for (int c = 0; c < 4; ++c) { wgq[i][c] = w0[c]; wgq[i][4 + c] = w1[c]; } } }
    constexpr int NR = GATES ? 2 : 8;
    for (int r0 = gw * NR; r0 < 16384; r0 += NGW * NR) {
        u32x4 v[NR][2]; float rs[NR];
#pragma unroll
        for (int q = 0; q < NR; ++q) { const u32x4* p = (const u32x4*)(XB + (size_t)(r0 + q) * 1024) + lane * 2; v[q][0] = p[0]; v[q][1] = p[1]; rs[q] = row_rstd_wave(SSQ, r0 + q, lane, vz); }
#pragma unroll
        for (int q = 0; q < NR; ++q) { f32x4 a0, a1, a2, a3; pg8::unpack8(v[q][0], a0, a1); pg8::unpack8(v[q][1], a2, a3);
            const float mx = wave_max(absmax16(a0, a1, a2, a3)), step = mx > 0.f ? mx * (1.f / 127.f) : 1.f;
            *((u32x4*)(X8 + (size_t)(r0 + q) * 1024) + lane) = quant16(a0, a1, a2, a3, 1.f / step);
            if (lane == 0) RS1[r0 + q] = rs[q] * step;
            if (GATES) { const float xv[16] = {a0[0], a0[1], a0[2], a0[3], a1[0], a1[1], a1[2], a1[3], a2[0], a2[1], a2[2], a2[3], a3[0], a3[1], a3[2], a3[3]};
                float d[8] = {0.f, 0.f, 0.f, 0.f, 0.f, 0.f, 0.f, 0.f};
#pragma unroll
                for (int i = 0; i < 16; ++i)
#pragma unroll
                    for (int c = 0; c < 8; ++c) d[c] = fmaf(xv[i], wgq[i][c], d[c]);
#pragma unroll
                for (int c = 0; c < 8; ++c) d[c] = wave_sum(d[c]);
                if (lane < 8) { float dv = d[0];
#pragma unroll
                    for (int c = 1; c < 8; ++c) if (lane == c) dv = d[c];
                    GATE[(size_t)(r0 + q) * 8 + lane] = dv * rs[q] + gate_bias[lane]; } } }
    }
}
struct PrepIn { const bf16_t *PROJ, *XB; const float *SSQ, *WG, *conv_w, *conv_b, *gate_bias, *q_gain, *k_gain; bf16_t *MQ, *MK, *AQ, *AK, *HP; float* GATE; };
__device__ __forceinline__ void prep(const PrepIn& a, char* lds, int vcu, int G) {
    int tid_o = threadIdx.x; asm volatile("" : "+v"(tid_o)); const int tid = tid_o, lane = tid & 63, wave = __builtin_amdgcn_readfirstlane(tid >> 6);
    float* cwl = (float*)lds;
    for (int i = tid; i < 4096 / 4; i += 512) ((f32x4*)cwl)[i] = ((const f32x4*)a.conv_w)[i];
    for (int i = tid; i < 1024 / 4; i += 512) ((f32x4*)(cwl + 4096))[i] = ((const f32x4*)a.conv_b)[i];
    __syncthreads();
    const int gw = vcu * 8 + wave, NGW = G * 8;
    const int c0 = lane * 16;
    int vz = 0; asm volatile("" : "+v"(vz));
    const int qg0 = (lane & 3) * 16;
    const float* qkg = (lane < 32 ? a.q_gain : a.k_gain) + qg0;
    const float qkscale = lane < 32 ? 0.125f * 1.4426950408889634f : 1.f;
    const int pc = lane * 8, pw = 2 << (lane >> 4);
    for (int chunk = gw; chunk < 16384 / 8; chunk += NGW) {
        const int row0 = chunk * 8, t0 = row0 & 2047;
        const bf16_t* pr0 = a.PROJ + (size_t)row0 * 7168;
        { u32x4 cv[11][2];
#pragma unroll
          for (int i = 0; i < 11; ++i) { const int d = i - 3, de = (d < 0 && t0 + d < 0) ? 0 : d; const bf16_t* p = pr0 + (long)de * 7168 + c0; cv[i][0] = *(const u32x4*)p; cv[i][1] = *(const u32x4*)(p + 8); }
          f32x4 wt[4][4], bs[4];
#pragma unroll
          for (int i = 0; i < 4; ++i) { bs[i] = *(const f32x4*)(cwl + 4096 + c0 + 4 * i);
#pragma unroll
              for (int j = 0; j < 4; ++j) wt[j][i] = *(const f32x4*)(cwl + j * 1024 + c0 + 4 * i); }
          const float ks = lane < 32 ? 1.f : 0.08838834764831845f;
#pragma unroll
          for (int r = 0; r < 8; ++r) { f32x4 y[4] = {bs[0], bs[1], bs[2], bs[3]};
#pragma unroll
              for (int j = 0; j < 4; ++j) { const float on = (t0 + r - 3 + j) >= 0 ? 1.f : 0.f; f32x4 x0, x1, x2, x3; pg8::unpack8(cv[r + j][0], x0, x1); pg8::unpack8(cv[r + j][1], x2, x3);
                  y[0] = y[0] + wt[j][0] * x0 * on; y[1] = y[1] + wt[j][1] * x1 * on; y[2] = y[2] + wt[j][2] * x2 * on; y[3] = y[3] + wt[j][3] * x3 * on; }
#pragma unroll
              for (int i = 0; i < 4; ++i)
#pragma unroll
                  for (int c = 0; c < 4; ++c) y[i][c] = y[i][c] * pg8::fsigmoid(y[i][c]) * ks;
              bf16_t* dst = (lane < 32 ? a.MQ : a.MK) + (size_t)(row0 + r) * 512 + (c0 & 511);
              *(u32x4*)dst = pg8::pack8(y[0], y[1]); *(u32x4*)(dst + 8) = pg8::pack8(y[2], y[3]); } }
        { u32x4 pv[23];
#pragma unroll
          for (int i = 0; i < 23; ++i) { const int d = i - 15, de = (d < 0 && t0 + d < 0) ? 0 : d; pv[i] = *(const u32x4*)(pr0 + (long)de * 7168 + 3584 + pc); }
#pragma unroll
          for (int r = 0; r < 8; ++r) { const int t = t0 + r, cnt = t + 1 < pw ? t + 1 : pw;
              f32x4 u0, u1; pg8::unpack8(pv[15 + r], u0, u1); f32x4 s0 = u0, s1 = u1;
#pragma unroll
              for (int j = 1; j < 16; ++j) { const float on = j < cnt ? 1.f : 0.f; f32x4 b0, b1; pg8::unpack8(pv[15 + r - j], b0, b1); s0 = s0 + b0 * on; s1 = s1 + b1 * on; }
              const float ic = 1.f / (float)cnt; s0 = s0 * ic - u0; s1 = s1 * ic - u1;
              *(u32x4*)(a.HP + (size_t)(row0 + r) * 512 + pc) = pg8::pack8(s0, s1); } }
    }
    __syncthreads();
}
struct RouteIn { const float *X, *SSQ, *WR, *router_b; const bf16_t* XB; bf16_t* XG; float* RSG; unsigned* cnt; int* TOKI; float* TOKG; };
__device__ __forceinline__ void route(const RouteIn& a, char* lds, int vcu, int G) {
    int tid_o = threadIdx.x; asm volatile("" : "+v"(tid_o)); const int tid = tid_o, lane = tid & 63, wave = __builtin_amdgcn_readfirstlane(tid >> 6);
    int vz = 0; asm volatile("" : "+v"(vz));
    int* lcnt = (int*)lds; int* lbase = lcnt + 8; int* lsel = lbase + 8;
    float* lgate = (float*)(lsel + 256);
    float* wrt = (float*)(lds + 8192);
    for (int i = tid; i < 8192; i += 512) wrt[(i & 7) * 1024 + (i >> 3)] = a.WR[i];
    for (int chunk = vcu; chunk < 16384 / 64; chunk += G) {
        if (tid < 8) lcnt[tid] = 0;
        __syncthreads();
        u32x4 xq[8][2]; float rsd[8];
#pragma unroll
        for (int rr = 0; rr < 8; ++rr) { const int row = chunk * 64 + wave * 8 + rr; const u32x4* src = (const u32x4*)(a.XB + (size_t)row * 1024) + lane * 2; xq[rr][0] = src[0]; xq[rr][1] = src[1];
            rsd[rr] = row_rstd_wave(a.SSQ, row, lane, vz); }
#pragma unroll
        for (int rr = 0; rr < 8; ++rr) { const int lrow = wave * 8 + rr;
            f32x4 a0, a1, a2, a3; pg8::unpack8(xq[rr][0], a0, a1); pg8::unpack8(xq[rr][1], a2, a3);
            const float xv[16] = {a0[0], a0[1], a0[2], a0[3], a1[0], a1[1], a1[2], a1[3], a2[0], a2[1], a2[2], a2[3], a3[0], a3[1], a3[2], a3[3]};
            float d[8];
#pragma unroll
            for (int c = 0; c < 8; ++c) { const f32x4* wp = (const f32x4*)(wrt + c * 1024 + 16 * lane); const f32x4 w0 = wp[0], w1 = wp[1], w2 = wp[2], w3 = wp[3];
                d[c] = ((xv[0] * w0[0] + xv[1] * w0[1]) + (xv[2] * w0[2] + xv[3] * w0[3])) + ((xv[4] * w1[0] + xv[5] * w1[1]) + (xv[6] * w1[2] + xv[7] * w1[3]))
                     + ((xv[8] * w2[0] + xv[9] * w2[1]) + (xv[10] * w2[2] + xv[11] * w2[3])) + ((xv[12] * w3[0] + xv[13] * w3[1]) + (xv[14] * w3[2] + xv[15] * w3[3])); }
            const float r = rsd[rr];
#pragma unroll
            for (int j = 0; j < 8; ++j) d[j] = wave_sum(d[j]) * r + a.router_b[j];
            int i0 = 0; float v0 = d[0];
#pragma unroll
            for (int j = 1; j < 8; ++j) if (d[j] > v0) { v0 = d[j]; i0 = j; }
            int i1 = -1; float v1 = -3.0e38f;
#pragma unroll
            for (int j = 0; j < 8; ++j) if (j != i0 && d[j] > v1) { v1 = d[j]; i1 = j; }
            if (lane == 0) { const float e1 = __expf(v1 - v0); const float g0 = 1.f / (1.f + e1);
                lsel[lrow * 4 + 0] = i0; lsel[lrow * 4 + 1] = atomicAdd(&lcnt[i0], 1); lsel[lrow * 4 + 2] = i1; lsel[lrow * 4 + 3] = atomicAdd(&lcnt[i1], 1);
                lgate[lrow * 2] = g0; lgate[lrow * 2 + 1] = e1 * g0; lgate[128 + lrow] = r; } }
        __syncthreads();
        if (tid < 8) lbase[tid] = (int)__hip_atomic_fetch_add(a.cnt + tid, (unsigned)lcnt[tid], __ATOMIC_RELAXED, __HIP_MEMORY_SCOPE_AGENT);
        __syncthreads();
        u32x4 xr[8][2];
#pragma unroll
        for (int rr = 0; rr < 8; ++rr) { const u32x4* src = (const u32x4*)(a.XB + (size_t)(chunk * 64 + wave * 8 + rr) * 1024) + lane * 2; xr[rr][0] = src[0]; xr[rr][1] = src[1]; }
#pragma unroll
        for (int rr = 0; rr < 8; ++rr) {
            const int lrow = wave * 8 + rr, row = chunk * 64 + lrow;
            const int e0 = lsel[lrow * 4], p0 = lbase[e0] + lsel[lrow * 4 + 1], e1 = lsel[lrow * 4 + 2], p1 = lbase[e1] + lsel[lrow * 4 + 3];
            f32x4 a0, a1, a2, a3; pg8::unpack8(xr[rr][0], a0, a1); pg8::unpack8(xr[rr][1], a2, a3);
            const float mx = wave_max(absmax16(a0, a1, a2, a3)), step = mx > 0.f ? mx * (1.f / 127.f) : 1.f; const u32x4 qq = quant16(a0, a1, a2, a3, 1.f / step);
            *((u32x4*)((unsigned char*)a.XG + ((size_t)e0 * 16384 + p0) * 1024) + lane) = qq;
            *((u32x4*)((unsigned char*)a.XG + ((size_t)e1 * 16384 + p1) * 1024) + lane) = qq;
            if (lane == 0) { const float r = lgate[128 + lrow] * step; a.RSG[(size_t)e0 * 16384 + p0] = r; a.RSG[(size_t)e1 * 16384 + p1] = r;
                a.TOKI[row * 4 + 0] = e0; a.TOKI[row * 4 + 1] = p0; a.TOKI[row * 4 + 2] = e1; a.TOKI[row * 4 + 3] = p1; a.TOKG[row * 2] = lgate[lrow * 2]; a.TOKG[row * 2 + 1] = lgate[lrow * 2 + 1]; }
        }
        __syncthreads();
    }
}
struct CombIn { float* X; bf16_t* XB; float* SSQ; const bf16_t* Y; const int* TOKI; const float* TOKG; int ts[8]; };
__device__ __forceinline__ void combine(const CombIn& a, int vcu, int G) {
    int tid_o = threadIdx.x; asm volatile("" : "+v"(tid_o)); const int tid = tid_o, lane = tid & 63, wave = __builtin_amdgcn_readfirstlane(tid >> 6), gw = vcu * 8 + wave, NGW = G * 8;
    int vz = 0; asm volatile("" : "+v"(vz));
    for (int r0 = gw * 4; r0 < 16384; r0 += NGW * 4) {
        int ti[4][4]; float tg[4][2];
#pragma unroll
        for (int q = 0; q < 4; ++q) { const int rv = r0 + q + vz;
#pragma unroll
            for (int i = 0; i < 4; ++i) ti[q][i] = a.TOKI[rv * 4 + i];
            tg[q][0] = a.TOKG[rv * 2]; tg[q][1] = a.TOKG[rv * 2 + 1]; }
        u32x4 y0[4][2], y1[4][2]; f32x4 xv[4][4]; int yr0[4], yr1[4];
#pragma unroll
        for (int q = 0; q < 4; ++q) { int t0 = 0, t1 = 0;
#pragma unroll
            for (int j = 0; j < 8; ++j) { if (j == ti[q][0]) t0 = a.ts[j]; if (j == ti[q][2]) t1 = a.ts[j]; }
            yr0[q] = t0 * 256 + ti[q][1]; yr1[q] = t1 * 256 + ti[q][3];
            const u32x4* p0 = (const u32x4*)(a.Y + (size_t)yr0[q] * 1024) + lane * 2; const u32x4* p1 = (const u32x4*)(a.Y + (size_t)yr1[q] * 1024) + lane * 2;
            y0[q][0] = p0[0]; y0[q][1] = p0[1]; y1[q][0] = p1[0]; y1[q][1] = p1[1];
            const u32x4* xp = (const u32x4*)(a.XB + (size_t)(r0 + q) * 1024) + lane * 2; pg8::unpack8(xp[0], xv[q][0], xv[q][1]); pg8::unpack8(xp[1], xv[q][2], xv[q][3]); }
#pragma unroll
        for (int q = 0; q < 4; ++q) { const int row = r0 + q; const float g0 = tg[q][0], g1 = tg[q][1]; f32x4 v[4]; float s = 0.f;
#pragma unroll
            for (int hh = 0; hh < 2; ++hh) { f32x4 a0, a1, b0, b1; pg8::unpack8(y0[q][hh], a0, a1); pg8::unpack8(y1[q][hh], b0, b1);
                v[2 * hh] = xv[q][2 * hh] + a0 * g0 + b0 * g1; v[2 * hh + 1] = xv[q][2 * hh + 1] + a1 * g0 + b1 * g1; }
            if (yr0[q] >= 32768) {
#pragma unroll
                for (int sl = 0; sl < 3; ++sl) { const u32x4* p2 = (const u32x4*)(a.Y + ((size_t)34816 + sl * 2048 + (yr0[q] - 32768)) * 1024) + lane * 2;
#pragma unroll
                    for (int hh = 0; hh < 2; ++hh) { f32x4 c0, c1; pg8::unpack8(p2[hh], c0, c1); v[2 * hh] = v[2 * hh] + c0 * g0; v[2 * hh + 1] = v[2 * hh + 1] + c1 * g0; } } }
            if (yr1[q] >= 32768) {
#pragma unroll
                for (int sl = 0; sl < 3; ++sl) { const u32x4* p3 = (const u32x4*)(a.Y + ((size_t)34816 + sl * 2048 + (yr1[q] - 32768)) * 1024) + lane * 2;
#pragma unroll
                    for (int hh = 0; hh < 2; ++hh) { f32x4 d0, d1; pg8::unpack8(p3[hh], d0, d1); v[2 * hh] = v[2 * hh] + d0 * g1; v[2 * hh + 1] = v[2 * hh + 1] + d1 * g1; } } }
#pragma unroll
            for (int i = 0; i < 4; ++i) s += (v[i][0] * v[i][0] + v[i][1] * v[i][1]) + (v[i][2] * v[i][2] + v[i][3] * v[i][3]);
            u32x4* xb = (u32x4*)(a.XB + (size_t)row * 1024) + lane * 2; xb[0] = pg8::pack8(v[0], v[1]); xb[1] = pg8::pack8(v[2], v[3]);
            s = wave_sum(s);
            if (lane < 16) a.SSQ[(size_t)row * 16 + lane] = lane == 0 ? s : 0.f; }
    }
}
}
#define LAS __attribute__((address_space(3)))
typedef unsigned short bf16_t;
constexpr int M = 16384, NWAVES = 8;
constexpr size_t MiB = 1u << 20;
constexpr size_t WS_CTL = 0, CTL_ZERO_BYTES = 1 * MiB;
constexpr size_t WS_SMALL = 1 * MiB;
constexpr size_t WS_TOKI = 2 * MiB, WS_TOKG = WS_TOKI + (size_t)M * 16;
constexpr size_t WS_SSQA = 3 * MiB, WS_SSQB = 4 * MiB, WS_GATE = 5 * MiB;
constexpr size_t WS_RSG = 6 * MiB;
constexpr size_t WS_W = 8 * MiB;
constexpr size_t WS_W_IN = WS_W, WS_W_BR = WS_W_IN + (size_t)2 * 7168 * 1024 * 2, WS_W_OUT = WS_W_BR + (size_t)6 * 1024 * 512 * 2, WS_W_GU0 = WS_W_OUT + (size_t)2 * 1024 * 1024 * 2,
                 WS_W_DN0 = WS_W_GU0 + (size_t)5632 * 1024 * 2, WS_W_GU1 = WS_W_DN0 + (size_t)1024 * 2816 * 2, WS_W_DN1 = WS_W_GU1 + (size_t)8 * 7168 * 1024 * 2,
                 WS_W_PG = WS_W_DN1 + (size_t)8 * 1024 * 3584 * 2, WS_W_PP = WS_W_PG + (size_t)2 * 1024 * 1024 * 2, WS_W_END = WS_W_PP + (size_t)2 * 1024 * 256 * 2;
constexpr size_t WS_XB = (WS_W_END + MiB - 1) / MiB * MiB, WS_PP = WS_XB + (size_t)M * 1024 * 2, WS_PB = WS_PP + (size_t)2 * M * 1024 * 2, WS_X8 = WS_PB + (size_t)2 * M * 256 * 2, WS_RS1 = WS_X8 + (size_t)M * 1024, WS_AREA = WS_RS1 + MiB;
constexpr size_t WS_PROJ = WS_AREA, WS_MQ = WS_PROJ + (size_t)M * 7168 * 2, WS_MK = WS_MQ + (size_t)M * 512 * 2, WS_AQ = WS_MK + (size_t)M * 512 * 2, WS_AK = WS_AQ + (size_t)M * 512 * 2,
                 WS_HM = WS_AK + (size_t)M * 512 * 2, WS_HA = WS_HM + (size_t)M * 512 * 2, WS_HP = WS_HA + (size_t)M * 512 * 2, WS_ZF = WS_HP + (size_t)M * 512 * 2, WS_ZB = WS_ZF + (size_t)M * 1024 * 4,
                 WS_G8 = WS_ZB + (size_t)M * 1024 * 2, WS_LAYER_END = WS_G8 + (size_t)M * 3072;
constexpr size_t WS_XG = WS_AREA, WS_Y = WS_AREA, WS_ACT = WS_XG + (size_t)8 * 16384 * 1024 * 2, WS_END = WS_ACT + (size_t)34816 * 3584 * 2;
static_assert(WS_LAYER_END <= WS_END && WS_ACT >= WS_MQ, "AREA views");
constexpr int CW_BAR = 4096, CW_QUEUE = 16384, CW_ECNT = 16384 + 256;

#define XB_TMO      128
#define XB_XCNT(j)  (256  + 64 * (j))
#define XB_XSUB(j)  (1280 + 64 * (j))
#define XB_XGEN(j)  (2304 + 64 * (j))
#define XB_TOP      3328
#define XB_TOPGEN   3392
#define XCD_BAR_WORDS 3456
#define XB_SPIN_CAP (1u << 18)

__device__ __forceinline__ unsigned xb_ld(unsigned* p)              { return __hip_atomic_load(p, __ATOMIC_RELAXED, __HIP_MEMORY_SCOPE_AGENT); }
__device__ __forceinline__ unsigned xb_add(unsigned* p, unsigned v) { return __hip_atomic_fetch_add(p, v, __ATOMIC_RELAXED, __HIP_MEMORY_SCOPE_AGENT); }
__device__ __forceinline__ unsigned xb_xcc_id() { return (unsigned)__builtin_amdgcn_s_getreg((3 << 11) | 20) & 0xFu; }
#define XB_SPIN(cond, bar) do { unsigned _sp = 0; while (cond) { __builtin_amdgcn_s_sleep(1); \
    if ((++_sp & 255u) == 0u) { if (xb_ld(&(bar)[XB_TMO])) break; if (_sp > XB_SPIN_CAP) { atomicAdd(&(bar)[XB_TMO], 1u); break; } } } } while (0)

struct XcdBarrier {
    unsigned* bar; unsigned x;
    volatile LAS unsigned* st;
};

__device__ __forceinline__ XcdBarrier xcd_barrier_post(unsigned* bar, volatile LAS unsigned* st) {
    XcdBarrier b; b.bar = bar; b.x = xb_xcc_id(); b.st = st;
    if (threadIdx.x == 0) (void)xb_add(&bar[XB_XCNT(b.x)], 1u);
    return b;
}
__device__ __forceinline__ void xcd_barrier_complete(unsigned* bar, unsigned x, unsigned& nloc, unsigned& nx) {
    const unsigned G = gridDim.x * gridDim.y * gridDim.z;
    unsigned sum, cnt, mine, sp = 0u;
    for (;;) {
        sum = 0u; cnt = 0u; mine = 0u;
#pragma unroll
        for (unsigned j = 0; j < 16; ++j) { const unsigned c = xb_ld(&bar[XB_XCNT(j)]); sum += c; cnt += (c > 0u) ? 1u : 0u; mine = (j == x) ? c : mine; }
        if (sum == G) break;
        __builtin_amdgcn_s_sleep(1);
        if ((++sp & 255u) == 0u) { if (xb_ld(&bar[XB_TMO])) break; if (sp > XB_SPIN_CAP) { atomicAdd(&bar[XB_TMO], 1u); break; } }
    }
    nloc = mine > 0u ? mine : 1u; nx = cnt > 0u ? cnt : 1u;
}

__device__ __forceinline__ void xcd_barrier(const XcdBarrier& b) {
    asm volatile("s_waitcnt vmcnt(0)" ::: "memory");
    __syncthreads();
    if (threadIdx.x == 0) {
        unsigned* bar = b.bar;
        __builtin_amdgcn_s_waitcnt(0);
        unsigned nloc = b.st[0], nx = b.st[1];
        if (nloc == 0u) { xcd_barrier_complete(bar, b.x, nloc, nx); b.st[0] = nloc; b.st[1] = nx; }
        const unsigned old = xb_add(&bar[XB_XSUB(b.x)], 1u);
        const unsigned gen = old / nloc;
        if (old + 1u == (gen + 1u) * nloc) {
            __builtin_amdgcn_fence(__ATOMIC_RELEASE, "agent");
            asm volatile("s_waitcnt vmcnt(0)" ::: "memory");
            const unsigned og = xb_add(&bar[XB_TOP], 1u);
            const unsigned tg = og / nx;
            if (og + 1u == (tg + 1u) * nx) xb_add(&bar[XB_TOPGEN], 1u);
            else XB_SPIN(xb_ld(&bar[XB_TOPGEN]) == tg, bar);
            __builtin_amdgcn_fence(__ATOMIC_ACQUIRE, "agent");
            xb_add(&bar[XB_XGEN(b.x)], 1u);
            asm volatile("s_waitcnt vmcnt(0)" ::: "memory");
        } else {
            XB_SPIN(xb_ld(&bar[XB_XGEN(b.x)]) == gen, bar);
            __builtin_amdgcn_fence(__ATOMIC_ACQUIRE, "agent");
            asm volatile("s_waitcnt vmcnt(0)" ::: "memory");
        }
    }
    __syncthreads();
}


struct Args { const float* in[26]; float* out; unsigned char* ws; int ph_lo, ph_hi; };
static_assert(sizeof(Args) == 26 * 8 + 8 + 8 + 8, "Args has no padding");

constexpr int LDS_BYTES = 147456, MISC_OFF = 131072 + 8192;

__global__ void __launch_bounds__(NWAVES * 64, 2) fwd_kernel(Args args) {
    extern __shared__ __attribute__((aligned(16))) unsigned char lds[];
    const int tid = threadIdx.x;
    const int G = gridDim.x; int vcu; { const int bx = blockIdx.x; vcu = (G % 8 == 0) ? (bx % 8) * (G / 8) + bx / 8 : bx; }
    volatile LAS unsigned* MISC = (volatile LAS unsigned*)((LAS unsigned char*)lds + MISC_OFF);
    if (tid < 32) MISC[tid] = 0u;
    __syncthreads();
    unsigned char* ws = args.ws;
    unsigned* ctl = (unsigned*)(ws + WS_CTL);
    const int lo = args.ph_lo, hi = args.ph_hi;
    const bool one_launch = (hi - lo) > 1;
    XcdBarrier bar; bar.bar = ctl + CW_BAR; bar.x = 0; bar.st = nullptr;
    if (one_launch) bar = xcd_barrier_post(ctl + CW_BAR, MISC + 8);
#ifndef EPI_ALIGN8
#define EPI_ALIGN8 true
#endif
#ifndef SITE_MASK
#define SITE_MASK 0xffff
#endif
#define EN(s) ((SITE_MASK >> (s)) & 1)
#define IN(k) (lo <= (k) && (k) < hi)
#define SEAM(k) do { if (IN(k) && IN((k) + 1)) xcd_barrier(bar); } while (0)
    LAS unsigned char* ring = (LAS unsigned char*)lds;
    const float* const* in = args.in;
    float* X = args.out;
#define SITE_WS size_t wso_ = 0; asm volatile("" : "+s"(wso_)); unsigned char* wsl = ws + wso_;
#define p_XB ((bf16_t*)(wsl + WS_XB))
#define p_PB ((bf16_t*)(wsl + WS_PB))
#define p_PPb ((bf16_t*)(wsl + WS_PP))
#define p_SSQA ((float*)(wsl + WS_SSQA))
#define p_SSQB ((float*)(wsl + WS_SSQB))
#define p_GATE ((float*)(wsl + WS_GATE))
#define p_RSG ((float*)(wsl + WS_RSG))
#define p_WG ((float*)(wsl + WS_SMALL))
#define p_WR (((float*)(wsl + WS_SMALL) + 2 * 8192))
#define p_PROJ ((bf16_t*)(wsl + WS_PROJ))
#define p_MQ ((bf16_t*)(wsl + WS_MQ))
#define p_MK ((bf16_t*)(wsl + WS_MK))
#define p_AQ ((bf16_t*)(wsl + WS_AQ))
#define p_AK ((bf16_t*)(wsl + WS_AK))
#define p_HM ((bf16_t*)(wsl + WS_HM))
#define p_HA ((bf16_t*)(wsl + WS_HA))
#define p_HP ((bf16_t*)(wsl + WS_HP))
#define p_ZB ((bf16_t*)(wsl + WS_ZB))
#define p_XG ((bf16_t*)(wsl + WS_XG))
#define p_Yb ((bf16_t*)(wsl + WS_Y))
#define p_ACT ((bf16_t*)(wsl + WS_ACT))
#define p_TOKI ((int*)(wsl + WS_TOKI))
#define p_TOKG ((float*)(wsl + WS_TOKG))
#define p_W_IN ((bf16_t*)(wsl + WS_W_IN))
#define p_W_BR ((bf16_t*)(wsl + WS_W_BR))
#define p_W_OUT ((bf16_t*)(wsl + WS_W_OUT))
#define p_W_GU0 ((bf16_t*)(wsl + WS_W_GU0))
#define p_W_DN0 ((bf16_t*)(wsl + WS_W_DN0))
#define p_W_GU1 ((bf16_t*)(wsl + WS_W_GU1))
#define p_W_DN1 ((bf16_t*)(wsl + WS_W_DN1))
#define p_W_PG ((bf16_t*)(wsl + WS_W_PG))
#define p_W_PP ((bf16_t*)(wsl + WS_W_PP))
    if (EN(0) && IN(0)) {
        SITE_WS
        thin::ProIn a; a.x = in[0]; a.p = in[1]; a.attn_norm = in[2]; a.w_in = in[3]; a.pool_w = in[12]; a.pool_scale = in[13]; a.w_branch = in[14]; a.w_out = in[15]; a.ffn_norm = in[16];
        a.dense_w_gu = in[17]; a.dense_w_down = in[18]; a.router_w = in[19]; a.moe_w_gu = in[21]; a.moe_w_down = in[22]; a.ple_norm = in[23]; a.ple_w_gate = in[24]; a.ple_w_proj = in[25];
        a.W_IN = p_W_IN; a.W_BR = p_W_BR; a.W_OUT = p_W_OUT; a.W_GU0 = p_W_GU0; a.W_DN0 = p_W_DN0; a.W_GU1 = p_W_GU1; a.W_DN1 = p_W_DN1; a.W_PG = p_W_PG; a.W_PP = p_W_PP; a.XB = p_XB; a.PB = p_PB; a.X = X; a.SSQ = p_SSQA; a.WG = p_WG; a.WR = p_WR; a.X8 = (unsigned char*)(wsl + WS_X8); a.RS1 = (float*)(wsl + WS_RS1);
        a.W8_IN = (unsigned char*)(wsl + WS_W_IN); a.SB_IN = (float*)(wsl + WS_W_IN + (size_t)14 * MiB); a.W8_GU0 = (unsigned char*)(wsl + WS_W_GU0); a.SB_GU0 = (float*)(wsl + WS_W_GU0 + (size_t)6 * MiB);
        a.W8_GU1 = (unsigned char*)(wsl + WS_W_GU1); a.SB_GU1 = (float*)(wsl + WS_W_GU1 + (size_t)56 * MiB); a.GATE = p_GATE; a.gate_bias = in[6];
        thin::prologue(a, (char*)lds, vcu, G);
    }
    SEAM(0);
#pragma unroll 1
    for (int L = 0; L < 2; ++L) {
        const int pb = 2 + 11 * L;
        if (EN(2) && IN(pb)) {
            SITE_WS
            pg8::Gemm g{(const bf16_t*)(wsl + WS_X8), (const bf16_t*)(wsl + WS_W_IN + (size_t)L * 7168 * 1024), M, 7168, 512, 512}; pg8::StaticOrder S; S.init(M, 7168, G, (int)blockIdx.x);
            pg8::EpiProj8 E{p_PROJ, (const float*)(wsl + WS_RS1), (const float*)(wsl + WS_W_IN + (size_t)14 * MiB) + L * 7168, p_AQ, p_AK, in[8] + L * 64, in[9] + L * 64, (unsigned char*)(wsl + WS_G8)};
            pg8::gemm_phase<pg8::EpiProj8, pg8::StaticOrder, EPI_ALIGN8, true>(ring, g, S, E);
        }
        SEAM(pb);
        if (EN(3) && IN(pb + 1)) {
            SITE_WS
            thin::PrepIn a; a.PROJ = p_PROJ; a.XB = p_XB; a.SSQ = p_SSQA; a.WG = p_WG + L * 8192; a.conv_w = in[4] + L * 4096; a.conv_b = in[5] + L * 1024; a.gate_bias = in[6] + L * 8;
            a.q_gain = in[8] + L * 64; a.k_gain = in[9] + L * 64; a.MQ = p_MQ; a.MK = p_MK; a.AQ = p_AQ; a.AK = p_AK; a.HP = p_HP; a.GATE = p_GATE;
            thin::prep(a, (char*)lds, vcu, G);
        }
        SEAM(pb + 1);
        if (EN(4) && IN(pb + 2)) {
            SITE_WS
            mix::MixPtrs P; P.PROJ = p_PROJ; P.MQ = p_MQ; P.MK = p_MK; P.AQ = p_AQ; P.AK = p_AK; P.GATE = p_GATE; P.HM = p_HM; P.HA = p_HA; P.m_hgain = in[7] + L * 512; P.a_hgain = in[11] + L * 512;
            { const float* lp = in[10] + L * 256; float d01 = 0.f, d23 = 0.f; for (int i = 0; i < 64; ++i) { d01 = fmaf(lp[i], lp[64 + i], d01); d23 = fmaf(lp[128 + i], lp[192 + i], d23); }
              const float lam_init = 0.8f - 0.6f * __expf(-0.3f * (float)L);
              float* lamv = (float*)((char*)lds + MISC_OFF + 64); if (tid == 0) { lamv[0] = __expf(d01) - __expf(d23) + lam_init; lamv[1] = 1.f - lam_init; } __syncthreads(); P.lamv = lamv; }
            mix::mix_phase<true, true>((char*)lds, P, ctl + CW_QUEUE + 64 * L);
        }
        SEAM(pb + 2);
        if (EN(5) && IN(pb + 3)) {
            SITE_WS
            pg8::MergeOrder S; S.S.init(M, 1024, G, (int)blockIdx.x);
            pg8::Gemm g{p_HM, p_W_BR + (size_t)L * 3 * 1024 * 512, 3 * M, 1024, 512, 512}; pg8::EpiZs E{p_ZB, (const unsigned char*)(wsl + WS_G8)};
            pg8::gemm_phase<pg8::EpiZs, pg8::MergeOrder, true, true>(ring, g, S, E);
        }
        SEAM(pb + 3);
        if (EN(6) && IN(pb + 4)) {
            SITE_WS
            pg8::Gemm g{p_ZB, p_W_OUT + (size_t)L * 1024 * 1024, M, 1024, 1024, 1024}; pg8::StaticOrder S; S.init(M, 1024, G, (int)blockIdx.x);
            pg8::EpiRes E{p_XB, p_SSQB};
            pg8::gemm_phase<pg8::EpiRes, pg8::StaticOrder, true, true>(ring, g, S, E);
        }
        SEAM(pb + 4);
        if (L == 0) {
            if (EN(7) && IN(pb + 5)) {
                SITE_WS
                thin::quant_act<false>(p_XB, p_SSQB, (unsigned char*)(wsl + WS_X8), (float*)(wsl + WS_RS1), nullptr, nullptr, nullptr, vcu, G);
                pg8::Gemm g{p_PB, p_W_PP, 2 * M, 1024, 256, 256};
                pg8::PpOrder S; S.S.init(2 * M, 1024, G, (int)blockIdx.x);
                pg8::EpiPP E{p_PPb};
                pg8::gemm_phase<pg8::EpiPP, pg8::PpOrder, true, true>(ring, g, S, E);
            }
            SEAM(pb + 5);
            if (EN(8) && IN(pb + 6)) {
                SITE_WS
                pg8::Gemm g{(const bf16_t*)(wsl + WS_X8), (const bf16_t*)(wsl + WS_W_GU0), M, 5632, 512, 512}; pg8::StaticOrder S; S.init(M, 5632, G, (int)blockIdx.x);
                pg8::EpiUp8d E{p_ACT, (const float*)(wsl + WS_RS1), (const float*)(wsl + WS_W_GU0 + (size_t)6 * MiB)};
                pg8::gemm_phase<pg8::EpiUp8d, pg8::StaticOrder, true, true>(ring, g, S, E);
            }
            SEAM(pb + 6);
            if (EN(9) && IN(pb + 7)) {
                SITE_WS
                pg8::Gemm g{p_ACT, p_W_DN0, M, 1024, 2816, 2816}; pg8::StaticOrder S; S.init(M, 1024, G, (int)blockIdx.x);
                pg8::EpiRes E{p_XB, p_SSQB};
                pg8::gemm_phase<pg8::EpiRes, pg8::StaticOrder, true, true>(ring, g, S, E);
            }
            SEAM(pb + 7);
        } else {
            if (EN(7) && IN(pb + 5)) {
                SITE_WS
                thin::RouteIn a; a.X = X; a.SSQ = p_SSQB; a.WR = p_WR; a.router_b = in[20]; a.XB = p_XB; a.XG = p_XG; a.RSG = p_RSG; a.cnt = ctl + CW_ECNT; a.TOKI = p_TOKI; a.TOKG = p_TOKG;
                thin::route(a, (char*)lds, vcu, G);
            }
            SEAM(pb + 5);
            int ts[9]; ts[0] = 0;
#pragma unroll
            for (int e = 0; e < 8; ++e) { const unsigned c = __hip_atomic_load(ctl + CW_ECNT + e, __ATOMIC_RELAXED, __HIP_MEMORY_SCOPE_AGENT); ts[e + 1] = ts[e] + (int)((c + 255u) >> 8); }
            if (EN(10) && IN(pb + 6)) {
                SITE_WS
                pg8::Gemm g{p_XG, p_W_GU1, 0, 0, 512, 512};
                pg8::MoeOrder<true> S{ts[8], 28, ts[8] * 28, G, (int)blockIdx.x, ts[0], ts[1], ts[2], ts[3], ts[4], ts[5], ts[6], ts[7], 0};
                pg8::EpiUp8 E{p_ACT, p_RSG, (const float*)(wsl + WS_W_GU1 + (size_t)56 * MiB), ts[0], ts[1], ts[2], ts[3], ts[4], ts[5], ts[6], ts[7]};
                pg8::gemm_phase<pg8::EpiUp8, pg8::MoeOrder<true>, EPI_ALIGN8, true>(ring, g, S, E);
            }
            SEAM(pb + 6);
            if (EN(11) && IN(pb + 7)) {
                SITE_WS
                const int RA = ts[8] < 128 ? ts[8] : 128, RB = ts[8] - RA;
                { pg8::Gemm g{p_ACT, p_W_DN1, 0, 0, 3584, 3584};
                  pg8::MoeOrder<false> S{RA, 4, RA * 4, G, (int)blockIdx.x, ts[0], ts[1], ts[2], ts[3], ts[4], ts[5], ts[6], ts[7], 0};
                  pg8::EpiDownMoe E{p_Yb, p_Yb, 3584};
                  pg8::gemm_phase<pg8::EpiDownMoe, pg8::MoeOrder<false>, true, true>(ring, g, S, E); }
                if (RB > 0) { pg8::Gemm g{p_ACT, p_W_DN1, 0, 0, 896, 3584};
                  pg8::MoeOrder<false, 4, 896> S{RB, 4, RB * 4 * 4, G, (int)(G - 1 - blockIdx.x), ts[0], ts[1], ts[2], ts[3], ts[4], ts[5], ts[6], ts[7], 128};
                  pg8::EpiDownMoe E{p_Yb, p_Yb + (size_t)34816 * 1024, 896};
                  pg8::gemm_phase<pg8::EpiDownMoe, pg8::MoeOrder<false, 4, 896>, true, true>(ring, g, S, E); }
            }
            SEAM(pb + 7);
            if (EN(12) && IN(pb + 8)) {
                SITE_WS
                thin::CombIn a; a.X = X; a.XB = p_XB; a.SSQ = p_SSQB; a.Y = p_Yb; a.TOKI = p_TOKI; a.TOKG = p_TOKG;
#pragma unroll
                for (int e = 0; e < 8; ++e) a.ts[e] = ts[e];
                thin::combine(a, vcu, G);
            }
            SEAM(pb + 8);
        }
        if (EN(13) && IN(pb + 9)) {
            SITE_WS
            pg8::Gemm g{p_XB, p_W_PG + (size_t)L * 1024 * 1024, M, 1024, 1024, 1024}; pg8::StaticOrder S; S.init(M, 1024, G, (int)blockIdx.x);
            if (L == 0) { pg8::EpiPle<false> E{X, p_XB, p_SSQB, p_SSQA, p_PPb}; pg8::gemm_phase<pg8::EpiPle<false>, pg8::StaticOrder, true, true>(ring, g, S, E); }
            else { pg8::EpiPle<true> E{X, p_XB, p_SSQB, p_SSQA, p_PPb + (size_t)M * 1024}; pg8::gemm_phase<pg8::EpiPle<true>, pg8::StaticOrder, true, true>(ring, g, S, E); }
        }
        if (L == 0) {
            SEAM(pb + 9);
            if (EN(7) && IN(pb + 10)) {
                SITE_WS
                thin::quant_act<true>(p_XB, p_SSQA, (unsigned char*)(wsl + WS_X8), (float*)(wsl + WS_RS1), p_WG + 8192, in[6] + 8, p_GATE, vcu, G);
            }
            SEAM(pb + 10);
        }
    }
#undef IN
#undef SEAM
#undef EN
#undef SITE_WS
#undef p_XB
#undef p_PB
#undef p_PPb
#undef p_SSQA
#undef p_SSQB
#undef p_GATE
#undef p_RSG
#undef p_WG
#undef p_WR
#undef p_PROJ
#undef p_MQ
#undef p_MK
#undef p_AQ
#undef p_AK
#undef p_HM
#undef p_HA
#undef p_HP
#undef p_ZB
#undef p_XG
#undef p_Yb
#undef p_ACT
#undef p_TOKI
#undef p_TOKG
#undef p_W_IN
#undef p_W_BR
#undef p_W_OUT
#undef p_W_GU0
#undef p_W_DN0
#undef p_W_GU1
#undef p_W_DN1
#undef p_W_PG
#undef p_W_PP

}

constexpr int N_PHASES = 24;
extern "C" void kernel_launch(void* const* d_in, const int* in_sizes, int n_in, void* d_out, int out_size, void* d_ws, size_t ws_size, hipStream_t stream) {
    static int grid = 0;
    if (grid == 0) {
        if (n_in != 26 || out_size != M * 1024 || ws_size < WS_END) { fprintf(stderr, "kernel_launch: unexpected shapes (n_in %d out %d ws %zu need %zu)\n", n_in, out_size, ws_size, (size_t)WS_END); grid = -1; return; }
        int dev = 0, cus = 0, per_cu = 0;
        if (hipGetDevice(&dev) != hipSuccess || hipDeviceGetAttribute(&cus, hipDeviceAttributeMultiprocessorCount, dev) != hipSuccess) { grid = -1; return; }
        if (hipFuncSetAttribute((const void*)fwd_kernel, hipFuncAttributeMaxDynamicSharedMemorySize, LDS_BYTES) != hipSuccess) { fprintf(stderr, "kernel_launch: hipFuncSetAttribute failed\n"); grid = -1; return; }
        if (hipOccupancyMaxActiveBlocksPerMultiprocessor(&per_cu, (const void*)fwd_kernel, NWAVES * 64, LDS_BYTES) != hipSuccess || per_cu < 1) { fprintf(stderr, "kernel_launch: occupancy query says %d blocks per CU\n", per_cu); }
        (void)hipGetLastError();
        grid = cus;
    }
    if (grid < 0) return;
    if (hipMemsetAsync((char*)d_ws + WS_CTL, 0, CTL_ZERO_BYTES, stream) != hipSuccess) return;
    Args a{};
    for (int i = 0; i < 26; ++i) a.in[i] = (const float*)d_in[i];
    a.out = (float*)d_out; a.ws = (unsigned char*)d_ws;
#if N_LAUNCH_PER_PHASE
    for (int ph = 0; ph < N_PHASES; ++ph) { if (ph == 1 || ph == 10 || ph == 23) continue;
        a.ph_lo = ph; a.ph_hi = ph + 1; hipLaunchKernelGGL(fwd_kernel, dim3(grid), dim3(NWAVES * 64), LDS_BYTES, stream, a); }
#else
    a.ph_lo = 0; a.ph_hi = N_PHASES;
    hipLaunchKernelGGL(fwd_kernel, dim3(grid), dim3(NWAVES * 64), LDS_BYTES, stream, a);
#endif
    const hipError_t le = hipPeekAtLastError();
    if (le != hipSuccess) fprintf(stderr, "kernel_launch: launch failed: %s\n", hipGetErrorName(le));
}
```

```cpp
#include <hip/hip_runtime.h>
#include <cstdio>
#include <cstdint>
#include <cmath>
#define N_LAUNCH_PER_PHASE 0
namespace pg8 {
#define PG8_LAS __attribute__((address_space(3)))
typedef unsigned short bf16_t;
typedef short bf16x8 __attribute__((ext_vector_type(8)));
typedef float f32x4 __attribute__((ext_vector_type(4)));
typedef unsigned u32x4 __attribute__((ext_vector_type(4)));
constexpr int BM = 256, BK = 64, HALF = 128, HTB = HALF * BK * 2  , STAGE_BYTES = 8 * HTB, NXCD = 8, WGM = 8;

__host__ __device__ __forceinline__ int lds_byte(int r, int c) { const int st = (r >> 4) * 2 + (c >> 5), rr = r & 15, cc = c & 31, ob = rr * 64 + cc * 2; return st * 1024 + (ob ^ (((ob >> 9) & 1) << 5)); }
__host__ __device__ __forceinline__ void stage_rc(int b, int& R, int& C) { const int st = b / 1024, sb = b % 1024, swz = sb ^ (((sb >> 9) & 1) << 5); R = (st >> 1) * 16 + swz / 64; C = (st & 1) * 32 + (swz % 64) / 2; }
__host__ __device__ __forceinline__ int perm32(int rho) { const int n = rho >> 4, i = rho & 15; return 8 * (i >> 2) + 4 * n + (i & 3); }

struct Unit { int pm, pn, ko; };
struct Gemm { const bf16_t* A; const bf16_t* Bt; int M, N, K, ld; };

struct StaticOrder {
    int nM, nN, nwg, G, c;
    __host__ __device__ void init(int M, int N, int G_, int c_) { nM = M / BM; nN = N / BM; nwg = nM * nN; G = G_; c = c_; }
    __host__ __device__ bool next(int i, Unit& u) const {
        const long L = (long)i * G + c; if (L >= nwg) return false;
        int wgid = (int)L; { const int q = nwg / NXCD, r = nwg % NXCD, xcd = wgid % NXCD, off = wgid / NXCD; wgid = (xcd < r ? xcd * (q + 1) : r * (q + 1) + (xcd - r) * q) + off; }
        const int nig = WGM * nN, gid = wgid / nig, fm = gid * WGM, gsz = (nM - fm) < WGM ? (nM - fm) : WGM;
        u.pm = fm + ((wgid % nig) % gsz); u.pn = (wgid % nig) / gsz; u.ko = 0; return true;
    }
    __device__ __forceinline__ void a_ready(const Unit&) const {}
    __device__ __forceinline__ void done(const Unit&) const {}
};
__device__ __forceinline__ unsigned cvt_pk_bf16(float lo, float hi) { unsigned r; asm volatile("v_cvt_pk_bf16_f32 %0, %1, %2" : "=v"(r) : "v"(lo), "v"(hi)); return r; }
typedef float f32x2 __attribute__((ext_vector_type(2)));
typedef int i32x4 __attribute__((ext_vector_type(4)));
template <bool I8> struct AccOf { typedef f32x4 type; };
template <> struct AccOf<true> { typedef i32x4 type; };
__device__ __forceinline__ f32x4 mma16(bf16x8 a, bf16x8 b, f32x4 c) { return __builtin_amdgcn_mfma_f32_16x16x32_bf16(a, b, c, 0, 0, 0); }
__device__ __forceinline__ i32x4 mma16(bf16x8 a, bf16x8 b, i32x4 c) { return __builtin_amdgcn_mfma_i32_16x16x64_i8(__builtin_bit_cast(i32x4, a), __builtin_bit_cast(i32x4, b), c, 0, 0, 0); }
template <class Epi, class Sched, bool ALIGN_EPI = false, bool SP2 = false>
__device__ __forceinline__ void gemm_phase(PG8_LAS unsigned char* lds, const Gemm g, const Sched& S, const Epi& E) {
    int tid_o = threadIdx.x; asm volatile("" : "+v"(tid_o));
    const int tid = tid_o, wid = __builtin_amdgcn_readfirstlane(tid >> 6), lane = tid & 63, wr = wid >> 2, wc = wid & 3, fr = lane & 15, fq = lane >> 4;
    const int K = g.ld, nt = g.K / BK;
    unsigned voffA[2], voffB[2];
#pragma unroll
    for (int i = 0; i < 2; ++i) { int R, C; stage_rc(tid * 16 + i * 8192, R, C); const int Rb = Epi::PERM ? ((R & ~31) + perm32(R & 31)) : R;
        voffA[i] = (unsigned)(R * K + C) * 2u; voffB[i] = (unsigned)(Rb * K + C) * 2u; }
    const size_t kstep = (size_t)(BK * 2);
    const size_t hstep = (size_t)HALF * K * 2;
    const size_t tstep = 2 * hstep;
    const unsigned ldsw = (unsigned)wid * 1024u;
    const int aoff = lds_byte(wr * 64 + fr, fq * 8), boff = lds_byte(wc * 32 + fr, fq * 8);
#define PG8_SA(b, h) (((b) * 2 + (h)) * HTB)
#define PG8_SB(b, h) ((4 + (b) * 2 + (h)) * HTB)
#define PG8_STAGE(bufoff, gbase, voff) do { _Pragma("unroll") for (int _i = 0; _i < 2; ++_i) \
        __builtin_amdgcn_global_load_lds((const unsigned*)((const char*)(gbase) + (voff)[_i]), (PG8_LAS unsigned*)(lds + (bufoff) + ldsw + _i * 8192), 16, 0, 0); } while (0)
#define PG8_LDA(dst, b, h) do { _Pragma("unroll") for (int m = 0; m < 4; ++m) _Pragma("unroll") for (int k = 0; k < 2; ++k) dst[m][k] = *(const PG8_LAS bf16x8*)(lds + PG8_SA(b, h) + aoff + m * 2048 + k * 1024); } while (0)
#define PG8_LDB(dst, b, h) do { _Pragma("unroll") for (int n = 0; n < 2; ++n) _Pragma("unroll") for (int k = 0; k < 2; ++k) dst[n][k] = *(const PG8_LAS bf16x8*)(lds + PG8_SB(b, h) + boff + n * 2048 + k * 1024); } while (0)
#define PG8_MMA(ai, bj, At, Bt) do { __builtin_amdgcn_s_setprio(1); _Pragma("unroll") for (int m = 0; m < 4; ++m) _Pragma("unroll") for (int n = 0; n < 2; ++n) _Pragma("unroll") for (int k = 0; k < 2; ++k) \
        acc[ai][bj][m][n] = mma16(Bt[n][k], At[m][k], acc[ai][bj][m][n]); __builtin_amdgcn_s_setprio(0); } while (0)
#define PG8_WAIT_V(n) asm volatile("s_waitcnt vmcnt(" #n ")" ::: "memory")
#define PG8_WAIT_L(n) asm volatile("s_waitcnt lgkmcnt(" #n ")" ::: "memory")
#define PG8_BAR __builtin_amdgcn_s_barrier()
#define PG8_SCHED __builtin_amdgcn_sched_barrier(0)
    Unit cur, nxt; int ui = 0;
    if (!S.next(0, cur)) return;
    typedef typename AccOf<Epi::I8>::type acc_t;
    acc_t acc[2][2][4][2];
#pragma unroll
    for (int a = 0; a < 2; ++a)
#pragma unroll
        for (int b = 0; b < 2; ++b)
#pragma unroll
            for (int m = 0; m < 4; ++m)
#pragma unroll
                for (int n = 0; n < 2; ++n) acc[a][b][m][n] = (acc_t){0, 0, 0, 0};
    bf16x8 At[4][2], B0[2][2], B1[2][2];
    const char* cA = (const char*)g.A + (size_t)cur.pm * tstep + (size_t)cur.ko * 2; const char* cB = (const char*)g.Bt + (size_t)cur.pn * tstep + (size_t)cur.ko * 2;
    S.a_ready(cur);
    if constexpr (SP2) {
        PG8_STAGE(PG8_SB(0, 0), cB, voffB); PG8_STAGE(PG8_SB(0, 1), cB + hstep, voffB); PG8_STAGE(PG8_SA(0, 0), cA, voffA); PG8_STAGE(PG8_SA(0, 1), cA + hstep, voffA);
        if (wr == 1) PG8_BAR;
        PG8_WAIT_V(2); PG8_BAR;
        PG8_STAGE(PG8_SB(1, 0), cB + kstep, voffB); PG8_STAGE(PG8_SA(1, 0), cA + kstep, voffA); PG8_STAGE(PG8_SB(1, 1), cB + hstep + kstep, voffB);
        PG8_WAIT_V(6); PG8_BAR;
    } else {
        PG8_STAGE(PG8_SB(0, 0), cB, voffB); PG8_STAGE(PG8_SA(0, 0), cA, voffA); PG8_STAGE(PG8_SB(0, 1), cB + hstep, voffB); PG8_STAGE(PG8_SA(0, 1), cA + hstep, voffA);
        if (wr == 1) PG8_BAR;
        PG8_WAIT_V(4); PG8_BAR;
        PG8_STAGE(PG8_SB(1, 0), cB + kstep, voffB); PG8_STAGE(PG8_SA(1, 0), cA + kstep, voffA); PG8_STAGE(PG8_SB(1, 1), cB + hstep + kstep, voffB);
        PG8_WAIT_V(6); PG8_BAR;
    }
    for (;;) {
        const bool has_next = S.next(ui + 1, nxt);
        const char* nA = has_next ? (const char*)g.A + (size_t)nxt.pm * tstep + (size_t)nxt.ko * 2 : cA; const char* nB = has_next ? (const char*)g.Bt + (size_t)nxt.pn * tstep + (size_t)nxt.ko * 2 : cB;
#pragma unroll 1
        for (int t = 0; t < nt; t += 2) {
            const bool last = (t == nt - 2);
            const char* a1 = cA + (size_t)(t + 1) * kstep;
            const char* a2 = last ? nA : cA + (size_t)(t + 2) * kstep; const char* b2 = last ? nB : cB + (size_t)(t + 2) * kstep;
            const char* a3 = a2 + kstep; const char* b3 = b2 + kstep;
            if (last && has_next) S.a_ready(nxt);
            if constexpr (SP2) {
            PG8_LDB(B0, 0, 0); PG8_LDB(B1, 0, 1); PG8_SCHED; PG8_LDA(At, 0, 0); PG8_STAGE(PG8_SA(1, 1), a1 + hstep, voffA);
            PG8_WAIT_V(8); PG8_WAIT_L(0); PG8_BAR; PG8_MMA(0, 0, At, B0); PG8_MMA(0, 1, At, B1); PG8_BAR; PG8_SCHED;
            PG8_LDA(At, 0, 1); PG8_STAGE(PG8_SB(0, 0), b2, voffB); PG8_STAGE(PG8_SB(0, 1), b2 + hstep, voffB); PG8_STAGE(PG8_SA(0, 0), a2, voffA);
            PG8_WAIT_V(8); PG8_WAIT_L(0); PG8_BAR; PG8_MMA(1, 0, At, B0); PG8_MMA(1, 1, At, B1); PG8_BAR; PG8_SCHED;
            PG8_LDB(B0, 1, 0); PG8_LDB(B1, 1, 1); PG8_SCHED; PG8_LDA(At, 1, 0); PG8_STAGE(PG8_SA(0, 1), a2 + hstep, voffA);
            PG8_WAIT_V(8); PG8_WAIT_L(0); PG8_BAR; PG8_MMA(0, 0, At, B0); PG8_MMA(0, 1, At, B1); PG8_BAR; PG8_SCHED;
            PG8_LDA(At, 1, 1); PG8_STAGE(PG8_SB(1, 0), b3, voffB); PG8_STAGE(PG8_SB(1, 1), b3 + hstep, voffB); PG8_STAGE(PG8_SA(1, 0), a3, voffA);
            PG8_WAIT_V(8); PG8_WAIT_L(0); PG8_BAR; PG8_MMA(1, 0, At, B0); PG8_MMA(1, 1, At, B1); PG8_BAR; PG8_SCHED;
            } else {
            PG8_LDB(B0, 0, 0); PG8_SCHED; PG8_LDA(At, 0, 0); PG8_STAGE(PG8_SA(1, 1), a1 + hstep, voffA);
            PG8_WAIT_L(8); PG8_BAR; PG8_WAIT_L(0); PG8_MMA(0, 0, At, B0); PG8_BAR; PG8_SCHED;
            PG8_LDB(B1, 0, 1); PG8_STAGE(PG8_SB(0, 0), b2, voffB);
            PG8_BAR; PG8_WAIT_L(0); PG8_MMA(0, 1, At, B1); PG8_BAR;
            PG8_LDA(At, 0, 1); PG8_STAGE(PG8_SA(0, 0), a2, voffA);
            PG8_BAR; PG8_WAIT_L(0); PG8_MMA(1, 0, At, B0); PG8_BAR; PG8_SCHED;
            PG8_STAGE(PG8_SB(0, 1), b2 + hstep, voffB);
            PG8_WAIT_V(6); PG8_BAR; PG8_MMA(1, 1, At, B1); PG8_BAR;
            PG8_LDB(B0, 1, 0); PG8_SCHED; PG8_LDA(At, 1, 0); PG8_STAGE(PG8_SA(0, 1), a2 + hstep, voffA);
            PG8_WAIT_L(8); PG8_BAR; PG8_WAIT_L(0); PG8_MMA(0, 0, At, B0); PG8_BAR; PG8_SCHED;
            PG8_LDB(B1, 1, 1); PG8_STAGE(PG8_SB(1, 0), b3, voffB);
            PG8_BAR; PG8_WAIT_L(0); PG8_MMA(0, 1, At, B1); PG8_BAR;
            PG8_LDA(At, 1, 1); PG8_STAGE(PG8_SA(1, 0), a3, voffA);
            PG8_BAR; PG8_WAIT_L(0); PG8_MMA(1, 0, At, B0); PG8_BAR; PG8_SCHED;
            PG8_STAGE(PG8_SB(1, 1), b3 + hstep, voffB);
            PG8_WAIT_V(6); PG8_BAR; PG8_MMA(1, 1, At, B1); PG8_BAR;
            }
        }
        if constexpr (ALIGN_EPI) { if (wr == 0) PG8_BAR; }
        if constexpr (!Epi::AFTER_DRAIN) { E(acc, cur, wr, wc, fr, fq); S.done(cur); }
        if (!has_next) break;
#pragma unroll
        for (int a = 0; a < 2; ++a)
#pragma unroll
            for (int b = 0; b < 2; ++b)
#pragma unroll
                for (int m = 0; m < 4; ++m)
#pragma unroll
                    for (int n = 0; n < 2; ++n) acc[a][b][m][n] = (acc_t){0, 0, 0, 0};
        cur = nxt; cA = nA; cB = nB; ++ui;
        if constexpr (ALIGN_EPI) { if (wr == 1) PG8_BAR; }
    }
    PG8_WAIT_V(0);
    if constexpr (!ALIGN_EPI) { if (wr == 0) PG8_BAR; }
    PG8_BAR;
    if constexpr (Epi::AFTER_DRAIN) { E.fused(acc, cur, wr, wc, fr, fq, lds, wid, lane); S.done(cur); }
#undef PG8_SA
#undef PG8_SB
#undef PG8_STAGE
#undef PG8_LDA
#undef PG8_LDB
#undef PG8_MMA
#undef PG8_WAIT_V
#undef PG8_WAIT_L
#undef PG8_BAR
#undef PG8_SCHED
}
}
namespace pg8 {
constexpr float kLog2e = 1.4426950408889634f;
__device__ __forceinline__ float fsigmoid(float x) { return __builtin_amdgcn_rcpf(1.f + __builtin_amdgcn_exp2f(-kLog2e * x)); }
__device__ __forceinline__ u32x4 pack8(const f32x4& a, const f32x4& b) { u32x4 w; w.x = cvt_pk_bf16(a[0], a[1]); w.y = cvt_pk_bf16(a[2], a[3]); w.z = cvt_pk_bf16(b[0], b[1]); w.w = cvt_pk_bf16(b[2], b[3]); return w; }
__device__ __forceinline__ void unpack8(const u32x4& w, f32x4& a, f32x4& b) {
    a[0] = __builtin_bit_cast(float, w.x << 16); a[1] = __builtin_bit_cast(float, w.x & 0xffff0000u); a[2] = __builtin_bit_cast(float, w.y << 16); a[3] = __builtin_bit_cast(float, w.y & 0xffff0000u);
    b[0] = __builtin_bit_cast(float, w.z << 16); b[1] = __builtin_bit_cast(float, w.z & 0xffff0000u); b[2] = __builtin_bit_cast(float, w.w << 16); b[3] = __builtin_bit_cast(float, w.w & 0xffff0000u);
}
__device__ __forceinline__ float row_rstd(const float* ssq, int row) {
    const f32x4* p = (const f32x4*)(ssq + (size_t)row * 16); const f32x4 a = p[0], b = p[1], c = p[2], d = p[3];
    const float s = ((a[0] + a[1]) + (a[2] + a[3])) + ((b[0] + b[1]) + (b[2] + b[3])) + ((c[0] + c[1]) + (c[2] + c[3])) + ((d[0] + d[1]) + (d[2] + d[3]));
    return __builtin_amdgcn_rsqf(s * (1.f / 1024.f) + 1e-6f);
}
__device__ __forceinline__ float sumsq8(const f32x4& a, const f32x4& b) { return (a[0] * a[0] + a[1] * a[1]) + (a[2] * a[2] + a[3] * a[3]) + (b[0] * b[0] + b[1] * b[1]) + (b[2] * b[2] + b[3] * b[3]); }
__device__ __forceinline__ float quad_sum_fq(float s) { s += __shfl_xor(s, 16); s += __shfl_xor(s, 32); return s; }

struct EpiProj {
    static constexpr bool PERM = true, AFTER_DRAIN = false, I8 = false;
    bf16_t* O; const float* ssq;
    __device__ __forceinline__ void operator()(const f32x4 (&acc)[2][2][4][2], const Unit& u, int wr, int wc, int fr, int fq) const {
        const bool sg = (u.pn == 6) || (u.pn == 7) || (u.pn >= 16);
        const int row0 = u.pm * BM + wr * 64 + fr, col0 = u.pn * BM + wc * 32 + 8 * fq;
#pragma unroll
        for (int ai = 0; ai < 2; ++ai)
#pragma unroll
            for (int m = 0; m < 4; ++m) { const int row = row0 + ai * HALF + m * 16; const float r = row_rstd(ssq, row); bf16_t* rowp = O + (size_t)row * 7168 + col0;
#pragma unroll
                for (int bj = 0; bj < 2; ++bj) { f32x4 v0 = acc[ai][bj][m][0] * r, v1 = acc[ai][bj][m][1] * r;
                    if (sg) {
#pragma unroll
                        for (int j = 0; j < 4; ++j) { v0[j] = fsigmoid(v0[j]); v1[j] = fsigmoid(v1[j]); } }
                    *(u32x4*)(rowp + bj * HALF) = pack8(v0, v1); } }
    }
};
struct EpiPlain {
    static constexpr bool PERM = true, AFTER_DRAIN = false, I8 = false;
    bf16_t* O;
    __device__ __forceinline__ void operator()(const f32x4 (&acc)[2][2][4][2], const Unit& u, int wr, int wc, int fr, int fq) const {
        const int row0 = u.pm * BM + wr * 64 + fr, col0 = u.pn * BM + wc * 32 + 8 * fq;
#pragma unroll
        for (int ai = 0; ai < 2; ++ai)
#pragma unroll
            for (int m = 0; m < 4; ++m) { bf16_t* rowp = O + (size_t)(row0 + ai * HALF + m * 16) * 1024 + col0;
#pragma unroll
                for (int bj = 0; bj < 2; ++bj) *(u32x4*)(rowp + bj * HALF) = pack8(acc[ai][bj][m][0], acc[ai][bj][m][1]); }
    }
};
template <int R> struct EpiZ {
    static constexpr bool PERM = true, AFTER_DRAIN = false, I8 = false;
    float* ZF; bf16_t* ZB; const bf16_t* PROJ;
    __device__ __forceinline__ void operator()(const f32x4 (&acc)[2][2][4][2], const Unit& u, int wr, int wc, int fr, int fq) const {
        const int row0 = u.pm * BM + wr * 64 + fr, col0 = u.pn * BM + wc * 32 + 8 * fq;
#pragma unroll
        for (int ai = 0; ai < 2; ++ai)
#pragma unroll
            for (int m = 0; m < 4; ++m) { const size_t row = (size_t)(row0 + ai * HALF + m * 16);
#pragma unroll
                for (int bj = 0; bj < 2; ++bj) { const int col = col0 + bj * HALF;
                    f32x4 g0, g1; unpack8(*(const u32x4*)(PROJ + row * 7168 + 4096 + R * 1024 + col), g0, g1);
                    f32x4 v0 = acc[ai][bj][m][0] * g0, v1 = acc[ai][bj][m][1] * g1; float* zp = ZF + row * 1024 + col;
                    if (R > 0) { v0 = v0 + *(const f32x4*)zp; v1 = v1 + *(const f32x4*)(zp + 4); }
                    if (R < 2) { *(f32x4*)zp = v0; *(f32x4*)(zp + 4) = v1; } else *(u32x4*)(ZB + row * 1024 + col) = pack8(v0, v1); } }
    }
};
struct EpiRes {
    static constexpr bool PERM = true, AFTER_DRAIN = false, I8 = false;
    bf16_t* XB; float* ssq;
    __device__ __forceinline__ void operator()(const f32x4 (&acc)[2][2][4][2], const Unit& u, int wr, int wc, int fr, int fq) const {
        const int row0 = u.pm * BM + wr * 64 + fr, col0 = u.pn * BM + wc * 32 + 8 * fq;
        bf16_t* const xb0 = XB + (size_t)row0 * 1024 + col0;
        u32x4 xin[2][4][2];
#pragma unroll
        for (int ai = 0; ai < 2; ++ai)
#pragma unroll
            for (int m = 0; m < 4; ++m)
#pragma unroll
                for (int bj = 0; bj < 2; ++bj) xin[ai][m][bj] = *(const u32x4*)(xb0 + (size_t)(ai * HALF + m * 16) * 1024 + bj * HALF);
#pragma unroll
        for (int ai = 0; ai < 2; ++ai)
#pragma unroll
            for (int m = 0; m < 4; ++m) { const size_t row = (size_t)(row0 + ai * HALF + m * 16); float s = 0.f;
#pragma unroll
                for (int bj = 0; bj < 2; ++bj) { f32x4 x0, x1; unpack8(xin[ai][m][bj], x0, x1);
                    const f32x4 v0 = x0 + acc[ai][bj][m][0], v1 = x1 + acc[ai][bj][m][1];
                    *(u32x4*)(xb0 + (size_t)(ai * HALF + m * 16) * 1024 + bj * HALF) = pack8(v0, v1); s += sumsq8(v0, v1); }
                s = quad_sum_fq(s); if (fq == 0) ssq[row * 16 + u.pn * 4 + wc] = s; }
    }
};
template <bool LAST> struct EpiPle {
    static constexpr bool PERM = true, AFTER_DRAIN = false, I8 = false;
    float* OUT; bf16_t* XB; const float* ssq_in; float* ssq_out; const bf16_t* PP;
    __device__ __forceinline__ void operator()(const f32x4 (&acc)[2][2][4][2], const Unit& u, int wr, int wc, int fr, int fq) const {
        const int row0 = u.pm * BM + wr * 64 + fr, col0 = u.pn * BM + wc * 32 + 8 * fq;
        bf16_t* const xb0 = XB + (size_t)row0 * 1024 + col0; const bf16_t* const pp0 = PP + (size_t)row0 * 1024 + col0;
        float rs[2][4];
        { f32x4 sq[2][4];
#pragma unroll
          for (int ai = 0; ai < 2; ++ai)
#pragma unroll
              for (int m = 0; m < 4; ++m) sq[ai][m] = *(const f32x4*)(ssq_in + (size_t)(row0 + ai * HALF + m * 16) * 16 + 4 * fq);
#pragma unroll
          for (int ai = 0; ai < 2; ++ai)
#pragma unroll
              for (int m = 0; m < 4; ++m) rs[ai][m] = __builtin_amdgcn_rsqf(quad_sum_fq((sq[ai][m][0] + sq[ai][m][1]) + (sq[ai][m][2] + sq[ai][m][3])) * (1.f / 1024.f) + 1e-6f); }
        constexpr int MB = 2;
#pragma unroll
        for (int ai = 0; ai < 2; ++ai)
#pragma unroll
          for (int mb = 0; mb < 4; mb += MB) {
            u32x4 xin[MB][2], pin[MB][2];
#pragma unroll
            for (int mm = 0; mm < MB; ++mm)
#pragma unroll
                for (int bj = 0; bj < 2; ++bj) { xin[mm][bj] = *(const u32x4*)(xb0 + (size_t)(ai * HALF + (mb + mm) * 16) * 1024 + bj * HALF); pin[mm][bj] = *(const u32x4*)(pp0 + (size_t)(ai * HALF + (mb + mm) * 16) * 1024 + bj * HALF); }
#pragma unroll
            for (int mm = 0; mm < MB; ++mm) { const int m = mb + mm; const size_t row = (size_t)(row0 + ai * HALF + m * 16); const float r = rs[ai][m]; float s = 0.f;
#pragma unroll
                for (int bj = 0; bj < 2; ++bj) { f32x4 x0, x1; unpack8(xin[mm][bj], x0, x1);
                    f32x4 p0, p1; unpack8(pin[mm][bj], p0, p1);
                    f32x4 v0 = acc[ai][bj][m][0] * r, v1 = acc[ai][bj][m][1] * r;
#pragma unroll
                    for (int j = 0; j < 4; ++j) { v0[j] = fsigmoid(v0[j]) * p0[j]; v1[j] = fsigmoid(v1[j]) * p1[j]; }
                    v0 = v0 + x0; v1 = v1 + x1;
                    if (LAST) { float* op = OUT + row * 1024 + col0 + bj * HALF; *(f32x4*)op = v0; *(f32x4*)(op + 4) = v1; }
                    else { *(u32x4*)(xb0 + (size_t)(ai * HALF + m * 16) * 1024 + bj * HALF) = pack8(v0, v1); s += sumsq8(v0, v1); } }
                if (!LAST) { s = quad_sum_fq(s); if (fq == 0) ssq_out[row * 16 + u.pn * 4 + wc] = s; } }
          }
    }
};
template <bool MOE> struct EpiUp {
    static constexpr bool PERM = true, AFTER_DRAIN = false, I8 = false;
    bf16_t* ACT; int F; const float* rs; int ts0, ts1, ts2, ts3, ts4, ts5, ts6, ts7;
    __device__ __forceinline__ void operator()(const f32x4 (&acc)[2][2][4][2], const Unit& u, int wr, int wc, int fr, int fq) const {
        int pnl = u.pn, otile = u.pm;
        if (MOE) { const int e = u.pm >> 6, rt = u.pm & 63; pnl = u.pn - e * 28;
            const int tse = e == 0 ? ts0 : e == 1 ? ts1 : e == 2 ? ts2 : e == 3 ? ts3 : e == 4 ? ts4 : e == 5 ? ts5 : e == 6 ? ts6 : ts7; otile = tse + rt; }
        const int lrow0 = wr * 64 + fr, col0 = pnl * 128 + wc * 32 + 8 * fq;
#pragma unroll
        for (int ai = 0; ai < 2; ++ai)
#pragma unroll
            for (int m = 0; m < 4; ++m) { const int lrow = lrow0 + ai * HALF + m * 16;
                const float r = MOE ? rs[(size_t)u.pm * BM + lrow] : row_rstd(rs, u.pm * BM + lrow);
                f32x4 g0 = acc[ai][0][m][0] * r, g1 = acc[ai][0][m][1] * r, u0 = acc[ai][1][m][0] * r, u1 = acc[ai][1][m][1] * r;
#pragma unroll
                for (int j = 0; j < 4; ++j) { g0[j] = g0[j] * fsigmoid(g0[j]) * u0[j]; g1[j] = g1[j] * fsigmoid(g1[j]) * u1[j]; }
                *(u32x4*)(ACT + (size_t)(otile * BM + lrow) * F + col0) = pack8(g0, g1); }
    }
};
struct EpiDownMoe {
    static constexpr bool PERM = true, AFTER_DRAIN = false, I8 = false;
    bf16_t* Y; bf16_t* Yx; int klen;
    __device__ __forceinline__ void operator()(const f32x4 (&acc)[2][2][4][2], const Unit& u, int wr, int wc, int fr, int fq) const {
        bf16_t* Y = this->Y; if (u.ko) { const int s = u.ko / klen; Y = Yx + ((size_t)(s - 1) * 2048 - 32768) * 1024; }
        const int row0 = u.pm * BM + wr * 64 + fr, col0 = (u.pn & 3) * BM + wc * 32 + 8 * fq;
#pragma unroll
        for (int ai = 0; ai < 2; ++ai)
#pragma unroll
            for (int m = 0; m < 4; ++m) { bf16_t* rowp = Y + (size_t)(row0 + ai * HALF + m * 16) * 1024 + col0;
#pragma unroll
                for (int bj = 0; bj < 2; ++bj) *(u32x4*)(rowp + bj * HALF) = pack8(acc[ai][bj][m][0], acc[ai][bj][m][1]); }
    }
};
template <bool UP, int KSPLIT = 1, int KLEN = 0> struct MoeOrder {
    int R, nN, nwg, G, c; int ts0, ts1, ts2, ts3, ts4, ts5, ts6, ts7; int pm0;
    __device__ __forceinline__ bool next(int i, Unit& u) const {
        const long L = (long)i * G + c; if (L >= nwg) return false;
        const int ks = (int)(L % KSPLIT); u.ko = ks * KLEN;
        int wgid = (int)(L / KSPLIT); const int nwg = this->nwg / KSPLIT; { const int q = nwg / NXCD, r = nwg % NXCD, xcd = wgid % NXCD, off = wgid / NXCD; wgid = (xcd < r ? xcd * (q + 1) : r * (q + 1) + (xcd - r) * q) + off; }
        const int nig = WGM * nN, gid = wgid / nig, fm = gid * WGM, gsz = (R - fm) < WGM ? (R - fm) : WGM;
        const int pmc = pm0 + fm + ((wgid % nig) % gsz), pnl = (wgid % nig) / gsz;
        const int e = (pmc >= ts1) + (pmc >= ts2) + (pmc >= ts3) + (pmc >= ts4) + (pmc >= ts5) + (pmc >= ts6) + (pmc >= ts7);
        const int tse = e == 0 ? ts0 : e == 1 ? ts1 : e == 2 ? ts2 : e == 3 ? ts3 : e == 4 ? ts4 : e == 5 ? ts5 : e == 6 ? ts6 : ts7;
        if (UP) { u.pm = e * 64 + (pmc - tse); u.pn = e * 28 + pnl; } else { u.pm = pmc; u.pn = e * 4 + pnl; }
        return true;
    }
    __device__ __forceinline__ void a_ready(const Unit&) const {}
    __device__ __forceinline__ void done(const Unit&) const {}
};
struct EpiZs {
    static constexpr bool PERM = true, AFTER_DRAIN = false, I8 = false;
    bf16_t* ZB; const unsigned char* G8;
    __device__ __forceinline__ void operator()(const f32x4 (&acc)[2][2][4][2], const Unit& u, int wr, int wc, int fr, int fq) const {
        typedef unsigned u32x2 __attribute__((ext_vector_type(2)));
        const int r = u.pm >> 6, pm = u.pm & 63, pn = u.pn & 3;
        const int row0 = pm * BM + wr * 64 + fr, col0 = pn * BM + wc * 32 + 8 * fq;
        bf16_t* const zb0 = ZB + (size_t)row0 * 1024 + col0; const unsigned char* const g0p = G8 + (size_t)row0 * 3072 + r * 1024 + col0;
        u32x2 gw[2][4][2];
#pragma unroll
        for (int ai = 0; ai < 2; ++ai)
#pragma unroll
            for (int m = 0; m < 4; ++m)
#pragma unroll
                for (int bj = 0; bj < 2; ++bj) gw[ai][m][bj] = *(const u32x2*)(g0p + (size_t)(ai * HALF + m * 16) * 3072 + bj * HALF);
#pragma unroll
        for (int ai = 0; ai < 2; ++ai) {
            u32x4 zin[4][2];
            if (r > 0) {
#pragma unroll
                for (int m = 0; m < 4; ++m)
#pragma unroll
                    for (int bj = 0; bj < 2; ++bj) zin[m][bj] = *(const u32x4*)(zb0 + (size_t)(ai * HALF + m * 16) * 1024 + bj * HALF); }
#pragma unroll
            for (int m = 0; m < 4; ++m)
#pragma unroll
                for (int bj = 0; bj < 2; ++bj) { const u32x2 g = gw[ai][m][bj]; f32x4 g0, g1;
#pragma unroll
                    for (int j = 0; j < 4; ++j) { g0[j] = (float)((g.x >> (8 * j)) & 0xffu) * (1.f / 255.f); g1[j] = (float)((g.y >> (8 * j)) & 0xffu) * (1.f / 255.f); }
                    f32x4 v0 = acc[ai][bj][m][0] * g0, v1 = acc[ai][bj][m][1] * g1;
                    if (r > 0) { f32x4 z0, z1; unpack8(zin[m][bj], z0, z1); v0 = v0 + z0; v1 = v1 + z1; }
                    *(u32x4*)(zb0 + (size_t)(ai * HALF + m * 16) * 1024 + bj * HALF) = pack8(v0, v1); }
        }
    }
};
struct MergeOrder {
    StaticOrder S;
    __device__ __forceinline__ bool next(int i, Unit& u) const { const int t = i / 3, r = i - 3 * t; if (!S.next(t, u)) return false; u.pm += r * 64; u.pn += r * 4; return true; }
    __device__ __forceinline__ void a_ready(const Unit&) const {}
    __device__ __forceinline__ void done(const Unit&) const {}
};
struct PpOrder {
    StaticOrder S;
    __device__ __forceinline__ bool next(int i, Unit& u) const { if (!S.next(i, u)) return false; u.pn += (u.pm >> 6) * 4; return true; }
    __device__ __forceinline__ void a_ready(const Unit&) const {}
    __device__ __forceinline__ void done(const Unit&) const {}
};
struct EpiPP {
    static constexpr bool PERM = true, AFTER_DRAIN = false, I8 = false;
    bf16_t* Y;
    __device__ __forceinline__ void operator()(const f32x4 (&acc)[2][2][4][2], const Unit& u, int wr, int wc, int fr, int fq) const {
        const int row0 = u.pm * BM + wr * 64 + fr, col0 = (u.pn & 3) * BM + wc * 32 + 8 * fq;
#pragma unroll
        for (int ai = 0; ai < 2; ++ai)
#pragma unroll
            for (int m = 0; m < 4; ++m) { bf16_t* rowp = Y + (size_t)(row0 + ai * HALF + m * 16) * 1024 + col0;
#pragma unroll
                for (int bj = 0; bj < 2; ++bj) *(u32x4*)(rowp + bj * HALF) = pack8(acc[ai][bj][m][0], acc[ai][bj][m][1]); }
    }
};
struct EpiUp8 {
    static constexpr bool PERM = true, AFTER_DRAIN = false, I8 = true;
    bf16_t* ACT; const float* rs; const float* sb; int ts0, ts1, ts2, ts3, ts4, ts5, ts6, ts7;
    __device__ __forceinline__ void operator()(const i32x4 (&acc)[2][2][4][2], const Unit& u, int wr, int wc, int fr, int fq) const {
        const int e = u.pm >> 6, rt = u.pm & 63, pnl = u.pn - e * 28;
        const int tse = e == 0 ? ts0 : e == 1 ? ts1 : e == 2 ? ts2 : e == 3 ? ts3 : e == 4 ? ts4 : e == 5 ? ts5 : e == 6 ? ts6 : ts7, otile = tse + rt;
        const int lrow0 = wr * 64 + fr, col0 = pnl * 128 + wc * 32 + 8 * fq;
        const float* sbp = sb + (size_t)u.pn * 256 + wc * 32 + 8 * fq;
        const f32x4 sg0 = *(const f32x4*)sbp, sg1 = *(const f32x4*)(sbp + 4), su0 = *(const f32x4*)(sbp + 128), su1 = *(const f32x4*)(sbp + 132);
        float rr[2][4];
#pragma unroll
        for (int ai = 0; ai < 2; ++ai)
#pragma unroll
            for (int m = 0; m < 4; ++m) rr[ai][m] = rs[(size_t)u.pm * BM + lrow0 + ai * HALF + m * 16];
#pragma unroll
        for (int ai = 0; ai < 2; ++ai)
#pragma unroll
            for (int m = 0; m < 4; ++m) { const int lrow = lrow0 + ai * HALF + m * 16;
                const float r = rr[ai][m];
                const f32x4 rg0 = sg0 * r, rg1 = sg1 * r, ru0 = su0 * r, ru1 = su1 * r; f32x4 g0, g1, u0, u1;
#pragma unroll
                for (int j = 0; j < 4; ++j) { g0[j] = (float)acc[ai][0][m][0][j] * rg0[j]; g1[j] = (float)acc[ai][0][m][1][j] * rg1[j]; u0[j] = (float)acc[ai][1][m][0][j] * ru0[j]; u1[j] = (float)acc[ai][1][m][1][j] * ru1[j]; }
#pragma unroll
                for (int j = 0; j < 4; ++j) { g0[j] = g0[j] * fsigmoid(g0[j]) * u0[j]; g1[j] = g1[j] * fsigmoid(g1[j]) * u1[j]; }
                *(u32x4*)(ACT + (size_t)(otile * BM + lrow) * 3584 + col0) = pack8(g0, g1); }
    }
};
struct EpiProj8 {
    static constexpr bool PERM = true, AFTER_DRAIN = false, I8 = true;
    bf16_t* O; const float* rs1; const float* sb; bf16_t* AQ; bf16_t* AK; const float* q_gain; const float* k_gain; unsigned char* G8;
    __device__ __forceinline__ void operator()(const i32x4 (&acc)[2][2][4][2], const Unit& u, int wr, int wc, int fr, int fq) const {
        const bool sg = (u.pn == 6) || (u.pn == 7);
        const bool mg = u.pn >= 16;
        const bool qk = (u.pn >= 8) && (u.pn < 12);
        const int row0 = u.pm * BM + wr * 64 + fr, col0 = u.pn * BM + wc * 32 + 8 * fq;
        f32x4 s0[2], s1[2];
#pragma unroll
        for (int bj = 0; bj < 2; ++bj) { s0[bj] = *(const f32x4*)(sb + col0 + bj * HALF); s1[bj] = *(const f32x4*)(sb + col0 + bj * HALF + 4); }
        float rr[2][4];
#pragma unroll
        for (int ai = 0; ai < 2; ++ai)
#pragma unroll
            for (int m = 0; m < 4; ++m) rr[ai][m] = rs1[row0 + ai * HALF + m * 16];
        if (qk) {
            const bool isk = u.pn >= 10; const int gidx = (u.pn - (isk ? 10 : 8)) * 4 + wc;
            const float* gp = (isk ? k_gain : q_gain) + 8 * fq; const float qs = isk ? 1.f : 0.125f * kLog2e;
            f32x4 gn[2][2];
#pragma unroll
            for (int bj = 0; bj < 2; ++bj) { gn[bj][0] = *(const f32x4*)(gp + bj * 32) * qs; gn[bj][1] = *(const f32x4*)(gp + bj * 32 + 4) * qs; }
            bf16_t* Ob = (isk ? AK : AQ) + gidx * 64 + 8 * fq;
#pragma unroll
            for (int ai = 0; ai < 2; ++ai)
#pragma unroll
                for (int m = 0; m < 4; ++m) { const int row = row0 + ai * HALF + m * 16; const float r = rr[ai][m]; const f32x4 r0[2] = {s0[0] * r, s0[1] * r}, r1[2] = {s1[0] * r, s1[1] * r}; f32x4 v[2][2]; float ss = 0.f;
#pragma unroll
                    for (int bj = 0; bj < 2; ++bj) {
#pragma unroll
                        for (int j = 0; j < 4; ++j) { v[bj][0][j] = (float)acc[ai][bj][m][0][j] * (r0[bj][j]); v[bj][1][j] = (float)acc[ai][bj][m][1][j] * (r1[bj][j]); }
                        ss += sumsq8(v[bj][0], v[bj][1]); }
                    ss = quad_sum_fq(ss); const float rn = __builtin_amdgcn_rsqf(ss * (1.f / 64.f) + 1e-6f);
#pragma unroll
                    for (int bj = 0; bj < 2; ++bj) *(u32x4*)(Ob + (size_t)row * 512 + bj * 32) = pack8(v[bj][0] * gn[bj][0] * rn, v[bj][1] * gn[bj][1] * rn); }
            return;
        }
        if (mg) {
            typedef unsigned u32x2 __attribute__((ext_vector_type(2)));
#pragma unroll
            for (int ai = 0; ai < 2; ++ai)
#pragma unroll
                for (int m = 0; m < 4; ++m) { const int row = row0 + ai * HALF + m * 16; const float r = rr[ai][m]; unsigned char* gp = G8 + (size_t)row * 3072 + (col0 - 4096);
#pragma unroll
                    for (int bj = 0; bj < 2; ++bj) { unsigned w[2];
#pragma unroll
                        for (int n = 0; n < 2; ++n) { const f32x4 s = (n ? s1[bj] : s0[bj]) * r; unsigned pk = 0;
#pragma unroll
                            for (int j = 0; j < 4; ++j) { const float g = fsigmoid((float)acc[ai][bj][m][n][j] * s[j]); pk |= (unsigned)fmaxf(__builtin_rintf(g * 255.f), 1.f) << (8 * j); }
                            w[n] = pk; }
                        *(u32x2*)(gp + bj * HALF) = (u32x2){w[0], w[1]}; } }
            return;
        }
#pragma unroll
        for (int ai = 0; ai < 2; ++ai)
#pragma unroll
            for (int m = 0; m < 4; ++m) { const int row = row0 + ai * HALF + m * 16; const float r = rr[ai][m]; bf16_t* rowp = O + (size_t)row * 7168 + col0;
#pragma unroll
                for (int bj = 0; bj < 2; ++bj) { f32x4 v0, v1; const f32x4 q0 = s0[bj] * r, q1 = s1[bj] * r;
#pragma unroll
                    for (int j = 0; j < 4; ++j) { v0[j] = (float)acc[ai][bj][m][0][j] * q0[j]; v1[j] = (float)acc[ai][bj][m][1][j] * q1[j]; }
                    if (sg) {
#pragma unroll
                        for (int j = 0; j < 4; ++j) { v0[j] = fsigmoid(v0[j]); v1[j] = fsigmoid(v1[j]); } }
                    *(u32x4*)(rowp + bj * HALF) = pack8(v0, v1); } }
    }
};
struct EpiUp8d {
    static constexpr bool PERM = true, AFTER_DRAIN = false, I8 = true;
    bf16_t* ACT; const float* rs1; const float* sb;
    __device__ __forceinline__ void operator()(const i32x4 (&acc)[2][2][4][2], const Unit& u, int wr, int wc, int fr, int fq) const {
        const int row0 = u.pm * BM + wr * 64 + fr, col0 = u.pn * 128 + wc * 32 + 8 * fq;
        const float* sbp = sb + (size_t)u.pn * 256 + wc * 32 + 8 * fq;
        const f32x4 sg0 = *(const f32x4*)sbp, sg1 = *(const f32x4*)(sbp + 4), su0 = *(const f32x4*)(sbp + 128), su1 = *(const f32x4*)(sbp + 132);
        float rr[2][4];
#pragma unroll
        for (int ai = 0; ai < 2; ++ai)
#pragma unroll
            for (int m = 0; m < 4; ++m) rr[ai][m] = rs1[row0 + ai * HALF + m * 16];
#pragma unroll
        for (int ai = 0; ai < 2; ++ai)
#pragma unroll
            for (int m = 0; m < 4; ++m) { const int row = row0 + ai * HALF + m * 16; const float r = rr[ai][m];
                const f32x4 rg0 = sg0 * r, rg1 = sg1 * r, ru0 = su0 * r, ru1 = su1 * r; f32x4 g0, g1, u0, u1;
#pragma unroll
                for (int j = 0; j < 4; ++j) { g0[j] = (float)acc[ai][0][m][0][j] * rg0[j]; g1[j] = (float)acc[ai][0][m][1][j] * rg1[j]; u0[j] = (float)acc[ai][1][m][0][j] * ru0[j]; u1[j] = (float)acc[ai][1][m][1][j] * ru1[j]; }
#pragma unroll
                for (int j = 0; j < 4; ++j) { g0[j] = g0[j] * fsigmoid(g0[j]) * u0[j]; g1[j] = g1[j] * fsigmoid(g1[j]) * u1[j]; }
                *(u32x4*)(ACT + (size_t)row * 2816 + col0) = pack8(g0, g1); }
    }
};
}
namespace mix {
using bf16x8 = __attribute__((ext_vector_type(8))) short;
using s16x4  = __attribute__((ext_vector_type(4))) short;
using f32x16 = __attribute__((ext_vector_type(16))) float;
using f32x4  = __attribute__((ext_vector_type(4))) float;
using u32x4  = __attribute__((ext_vector_type(4))) unsigned;
typedef unsigned short bf16_t;
constexpr int KVB = 64, SHM_T = KVB * 128 * 2;
constexpr int OFF_V = 0, OFF_K = 2 * SHM_T, OFF_WS = 4 * SHM_T, OFF_A2 = OFF_WS + 8 * 256, OFF_M2 = OFF_A2 + 8192, OFF_MT = OFF_M2 + 8192, OFF_SC = OFF_MT + 8192, OFF_Q = OFF_SC + 256, MIX_LDS = OFF_Q + 64;
constexpr float kLog2e = 1.4426950408889634f;
#define KSWZ(row, colB) ((row) * 256 + ((colB) ^ (((row) & 7) << 4)))
#define SBAR() __builtin_amdgcn_sched_barrier(0)
__device__ __forceinline__ int crow(int r, int hi) { return (r & 3) + 8 * (r >> 2) + 4 * hi; }
__device__ __forceinline__ unsigned cvtpk(float lo, float hi) { unsigned r; asm volatile("v_cvt_pk_bf16_f32 %0, %1, %2" : "=v"(r) : "v"(lo), "v"(hi)); return r; }
__device__ __forceinline__ float bf2f(unsigned short h) { return __builtin_bit_cast(float, (unsigned)h << 16); }
__device__ __forceinline__ int v_st(int k, int c) { const int kk = (k & ~0xC) | ((k & 4) << 1) | ((k & 8) >> 1); return ((kk >> 3) * 4 + (c >> 5)) * 512 + ((kk & 7) * 32 + (c & 31)) * 2; }
__device__ __forceinline__ int v_rd_base(int lane) { return ((lane & 3) << 3) | (((lane >> 2) & 3) << 6) | (((lane >> 4) & 1) << 5) | (((lane >> 5) & 1) << 8); }
constexpr int v_rd_off(int d0, int ks, int half) { return d0 * 512 + ks * 4096 + half * 2048; }
template <int OFF> __device__ __forceinline__ s16x4 tr_read(int vb) { s16x4 r; asm volatile("ds_read_b64_tr_b16 %0, %1 offset:%2" : "=&v"(r) : "v"(vb), "i"(OFF) : "memory"); return r; }
template <int D0> __device__ __forceinline__ void pv_one(f32x16& od, int vb, bf16x8 pa0, bf16x8 pa1, bf16x8 pa2, bf16x8 pa3) {
    const s16x4 l0 = tr_read<v_rd_off(D0, 0, 0)>(vb), h0 = tr_read<v_rd_off(D0, 0, 1)>(vb), l1 = tr_read<v_rd_off(D0, 1, 0)>(vb), h1 = tr_read<v_rd_off(D0, 1, 1)>(vb);
    const s16x4 l2 = tr_read<v_rd_off(D0, 2, 0)>(vb), h2 = tr_read<v_rd_off(D0, 2, 1)>(vb), l3 = tr_read<v_rd_off(D0, 3, 0)>(vb), h3 = tr_read<v_rd_off(D0, 3, 1)>(vb);
    asm volatile("s_waitcnt lgkmcnt(0)" ::: "memory"); SBAR();
#define MIX_PK(L, H) (bf16x8){L[0], L[1], L[2], L[3], H[0], H[1], H[2], H[3]}
    od = __builtin_amdgcn_mfma_f32_32x32x16_bf16(pa0, MIX_PK(l0, h0), od, 0, 0, 0);
    od = __builtin_amdgcn_mfma_f32_32x32x16_bf16(pa1, MIX_PK(l1, h1), od, 0, 0, 0);
    od = __builtin_amdgcn_mfma_f32_32x32x16_bf16(pa2, MIX_PK(l2, h2), od, 0, 0, 0);
    od = __builtin_amdgcn_mfma_f32_32x32x16_bf16(pa3, MIX_PK(l3, h3), od, 0, 0, 0);
#undef MIX_PK
}
__device__ __forceinline__ void pv_d0(f32x16* o, int vb, bf16x8 pa0, bf16x8 pa1, bf16x8 pa2, bf16x8 pa3) {
    pv_one<0>(o[0], vb, pa0, pa1, pa2, pa3); pv_one<1>(o[1], vb, pa0, pa1, pa2, pa3); pv_one<2>(o[2], vb, pa0, pa1, pa2, pa3); pv_one<3>(o[3], vb, pa0, pa1, pa2, pa3);
}
__device__ __forceinline__ float swap_max(float v) { auto rr = __builtin_amdgcn_permlane32_swap(__float_as_uint(v), __float_as_uint(v), false, false); return fmaxf(__uint_as_float(rr[0]), __uint_as_float(rr[1])); }
__device__ __forceinline__ float swap_sum(float v) { auto rr = __builtin_amdgcn_permlane32_swap(__float_as_uint(v), __float_as_uint(v), false, false); return __uint_as_float(rr[0]) + __uint_as_float(rr[1]); }
__device__ __forceinline__ void p_to_frags(const f32x16& p0, const f32x16& p1, bf16x8& pa0, bf16x8& pa1, bf16x8& pa2, bf16x8& pa3) {
#define MIX_PK4(P, BASE, OUT) do { unsigned a0 = cvtpk(P[BASE + 0], P[BASE + 1]), a1 = cvtpk(P[BASE + 2], P[BASE + 3]);   \
    unsigned b0 = cvtpk(P[BASE + 4], P[BASE + 5]), b1 = cvtpk(P[BASE + 6], P[BASE + 7]);                              \
    auto r0 = __builtin_amdgcn_permlane32_swap(a0, b0, false, false); auto r1 = __builtin_amdgcn_permlane32_swap(a1, b1, false, false); \
    u32x4 w = {r0[0], r1[0], r0[1], r1[1]}; OUT = *reinterpret_cast<bf16x8*>(&w); } while (0)
    MIX_PK4(p0, 0, pa0); MIX_PK4(p0, 8, pa1); MIX_PK4(p1, 0, pa2); MIX_PK4(p1, 8, pa3);
#undef MIX_PK4
}
__device__ __forceinline__ float half_sum32(float v) {
#pragma unroll
    for (int o = 1; o < 32; o <<= 1) v += __shfl_xor(v, o);
    return v;
}
struct MixPtrs {
    const bf16_t* PROJ;
    const bf16_t *MQ, *MK, *AQ, *AK;
    const float* GATE;
    bf16_t *HM, *HA;
    const float *m_hgain, *a_hgain;
    const float* lamv;
};
template <int MODE>
__device__ __forceinline__ void unit(char* lds, const MixPtrs& P, int b, int h, int q0) {
    int tid_o = threadIdx.x; asm volatile("" : "+v"(tid_o));
    const int tid = tid_o, wid = __builtin_amdgcn_readfirstlane(tid >> 6), lane = tid & 63, r32 = lane & 31, hi = lane >> 5;
    constexpr int NQ = MODE == 0 ? 8 : 4;
    const int wq = MODE == 0 ? wid : (wid & 3), map = MODE == 0 ? 0 : (wid >> 2);
    const int qlo = q0 + 32 * wq, tq = qlo + r32;
    const size_t tok0 = (size_t)b * 2048;
    char* V_lds = lds + OFF_V; char* K_lds = lds + OFF_K;
    float* wsf = (float*)(lds + OFF_WS) + wid * 64; float* li_l = wsf; float* al_l = wsf + 32;
    float* A2 = (float*)(lds + OFF_A2); float* M2 = (float*)(lds + OFF_M2); float* MT = (float*)(lds + OFF_MT); float* SC = (float*)(lds + OFF_SC);
    const int NT = (q0 + (MODE == 0 ? 256 : 128)) / KVB;
    float M2row = 0.f, mtrow = 0.f;
    if (MODE == 0) {
        const int n = q0 + 256; const float* G = P.GATE + tok0 * 8;
        float lf[4], iv[4];
#pragma unroll
        for (int j = 0; j < 4; ++j) { const int t = 4 * tid + j; float f = 0.f, i = 0.f; if (t < n) { f = G[(size_t)t * 8 + 4 + h]; i = G[(size_t)t * 8 + h]; }
            lf[j] = fminf(f, 0.f) - 0.6931471805599453f * __builtin_amdgcn_logf(1.f + __builtin_amdgcn_exp2f(-kLog2e * fabsf(f))); iv[j] = i; }
        float s1 = lf[0], s2 = s1 + lf[1], s3 = s2 + lf[2], s4 = s3 + lf[3];
        float incl = s4;
#pragma unroll
        for (int o = 1; o < 64; o <<= 1) { const float t = __shfl_up(incl, o); if (lane >= o) incl += t; }
        if (lane == 63) SC[wid] = incl;
        __syncthreads();
        float wbase = 0.f;
#pragma unroll
        for (int w = 0; w < 8; ++w) { const float t = SC[w]; if (w < wid) wbase += t; }
        const float excl = wbase + incl - s4;
        const float B0 = excl + s1, B1 = excl + s2, B2 = excl + s3, B3 = excl + s4;
        const float a0 = iv[0] - B0, a1 = iv[1] - B1, a2 = iv[2] - B2, a3 = iv[3] - B3;
        const bool v0 = 4 * tid < n;
        const float NEG = -3.0e38f;
        const float m1 = v0 ? a0 : NEG, m2 = fmaxf(m1, v0 ? a1 : NEG), m3 = fmaxf(m2, v0 ? a2 : NEG), m4 = fmaxf(m3, v0 ? a3 : NEG);
        float mincl = m4;
#pragma unroll
        for (int o = 1; o < 64; o <<= 1) { const float t = __shfl_up(mincl, o); if (lane >= o) mincl = fmaxf(mincl, t); }
        float mprev = __shfl_up(mincl, 1); if (lane == 0) mprev = NEG;
        if (lane == 63) SC[8 + wid] = mincl;
        __syncthreads();
        float mbase = 0.f;
#pragma unroll
        for (int w = 0; w < 8; ++w) { const float t = SC[8 + w]; if (w < wid) mbase = fmaxf(mbase, t); }
        const float mex = fmaxf(mbase, mprev);
        const float x0 = fmaxf(mex, m1), x1 = fmaxf(mex, m2), x2 = fmaxf(mex, m3), x3 = fmaxf(mex, m4);
        if (v0) { *(f32x4*)(A2 + 4 * tid) = (f32x4){a0 * kLog2e, a1 * kLog2e, a2 * kLog2e, a3 * kLog2e};
                  *(f32x4*)(M2 + 4 * tid) = (f32x4){x0 * kLog2e, x1 * kLog2e, x2 * kLog2e, x3 * kLog2e};
                  *(f32x4*)(MT + 4 * tid) = (f32x4){B0 + x0, B1 + x1, B2 + x2, B3 + x3}; }
        __syncthreads();
        M2row = M2[tq]; mtrow = MT[tq];
    }
    bf16x8 qr[NQ];
    { const bf16_t* Qw = (MODE == 0 ? P.MQ : P.AQ) + (tok0 + tq) * 512 + h * 128 + map * 64 + hi * 8;
#pragma unroll
      for (int d0 = 0; d0 < NQ; ++d0) qr[d0] = *reinterpret_cast<const bf16x8*>(Qw + d0 * 16); }
    const bf16_t* Kg = (MODE == 0 ? P.MK : P.AK) + tok0 * 512 + h * 128;
    const bf16_t* Vg = P.PROJ + tok0 * 7168 + (MODE == 0 ? 1024 : 3072) + h * 128;
    const int sr = tid >> 4, sc = (tid & 15) * 8, vst0 = v_st(sr, sc), vst1 = v_st(32 + sr, sc);
    const int vb0 = (int)(uintptr_t)V_lds + v_rd_base(lane);
    bf16x8 vsA0, vsA1, ksA0, ksA1;
#define MIX_SLOAD(S, k0) do { vs##S##0 = *reinterpret_cast<const bf16x8*>(Vg + (size_t)((k0) + sr) * 7168 + sc); vs##S##1 = *reinterpret_cast<const bf16x8*>(Vg + (size_t)((k0) + 32 + sr) * 7168 + sc); \
    ks##S##0 = *reinterpret_cast<const bf16x8*>(Kg + (size_t)((k0) + sr) * 512 + sc); ks##S##1 = *reinterpret_cast<const bf16x8*>(Kg + (size_t)((k0) + 32 + sr) * 512 + sc); } while (0)
#define MIX_SWRITE(S, bb) do { *(bf16x8*)(V_lds + (bb) * SHM_T + vst0) = vs##S##0; *(bf16x8*)(V_lds + (bb) * SHM_T + vst1) = vs##S##1; \
    *(bf16x8*)(K_lds + (bb) * SHM_T + KSWZ(sr, sc * 2)) = ks##S##0; *(bf16x8*)(K_lds + (bb) * SHM_T + KSWZ(32 + sr, sc * 2)) = ks##S##1; } while (0)
#define MIX_BAR() do { asm volatile("s_waitcnt lgkmcnt(0)" ::: "memory"); __builtin_amdgcn_s_barrier(); asm volatile("" ::: "memory"); } while (0)
    f32x16 o[4];
#pragma unroll
    for (int d = 0; d < 4; ++d)
#pragma unroll
        for (int r = 0; r < 16; ++r) o[d][r] = 0.f;
    float m_run = -1e30f, l_run = 0.f;
    const float sl2 = MODE == 1 ? __builtin_amdgcn_exp2f(-2.f * (float)(h + 1)) * kLog2e : 0.f;
    auto mix_compute = [&](int j, int k0) __attribute__((always_inline)) {
        if (k0 <= qlo + 31) {
            const char* Kt = K_lds + (j & 1) * SHM_T;
            f32x16 p0, p1;
            if (MODE == 1) { const float base = sl2 * (float)(k0 - tq);
#pragma unroll
                for (int r = 0; r < 16; ++r) { p0[r] = fmaf(sl2, (float)crow(r, hi), base); p1[r] = fmaf(sl2, (float)(32 + crow(r, hi)), base); } }
            else {
#pragma unroll
                for (int r = 0; r < 16; ++r) { p0[r] = 0.f; p1[r] = 0.f; } }
            bf16x8 kb0[NQ], kb1[NQ];
#define MIX_KLD(D0) do { const int cb_ = (map * 64 + (D0) * 16 + hi * 8) * 2; kb0[D0] = *reinterpret_cast<const bf16x8*>(Kt + KSWZ(r32, cb_)); kb1[D0] = *reinterpret_cast<const bf16x8*>(Kt + KSWZ(32 + r32, cb_)); } while (0)
            MIX_KLD(0); MIX_KLD(1); SBAR();
#pragma unroll
            for (int d0 = 0; d0 < NQ; ++d0) {
                if (d0 + 2 < NQ) MIX_KLD(d0 + 2);
                p0 = __builtin_amdgcn_mfma_f32_32x32x16_bf16(kb0[d0], qr[d0], p0, 0, 0, 0);
                p1 = __builtin_amdgcn_mfma_f32_32x32x16_bf16(kb1[d0], qr[d0], p1, 0, 0, 0); SBAR(); }
#undef MIX_KLD
            const bool diag = k0 + 63 > qlo;
            if (MODE == 1) {
                if (diag) {
                    int tqm = tq; asm volatile("" : "+v"(tqm));
#pragma unroll
                    for (int r = 0; r < 16; ++r) { if (k0 + crow(r, hi) > tqm) p0[r] = -1e30f; if (k0 + 32 + crow(r, hi) > tqm) p1[r] = -1e30f; } }
                float pmax = p0[0];
#pragma unroll
                for (int r = 1; r < 16; ++r) pmax = fmaxf(pmax, p0[r]);
#pragma unroll
                for (int r = 0; r < 16; ++r) pmax = fmaxf(pmax, p1[r]);
                pmax = swap_max(pmax);
                float mn = m_run, alpha = 1.f;
                if (!__all(pmax - m_run <= 8.f)) { mn = fmaxf(m_run, pmax); alpha = __builtin_amdgcn_exp2f(m_run - mn); m_run = mn; }
                float ps = 0.f;
#pragma unroll
                for (int r = 0; r < 16; ++r) { p0[r] = __builtin_amdgcn_exp2f(p0[r] - mn); p1[r] = __builtin_amdgcn_exp2f(p1[r] - mn); ps += p0[r] + p1[r]; }
                ps = swap_sum(ps); l_run = l_run * alpha + ps;
                if (__any(alpha < 1.f)) { if (hi == 0) al_l[r32] = alpha; asm volatile("s_waitcnt lgkmcnt(0)" ::: "memory");
#pragma unroll
                    for (int r = 0; r < 16; ++r) { const float a = al_l[crow(r, hi)];
#pragma unroll
                        for (int d = 0; d < 4; ++d) o[d][r] *= a; } }
            } else {
                float ps = 0.f;
                if (diag) {
#pragma unroll
                    for (int i = 0; i < 4; ++i) { const f32x4 aa = *(const f32x4*)(A2 + k0 + 8 * i + 4 * hi), ab = *(const f32x4*)(A2 + k0 + 32 + 8 * i + 4 * hi);
#pragma unroll
                        for (int q = 0; q < 4; ++q) { const int r = 4 * i + q;
                            float w0 = __builtin_amdgcn_exp2f(fminf(aa[q] - M2row, 0.f)), w1 = __builtin_amdgcn_exp2f(fminf(ab[q] - M2row, 0.f));
                            if (k0 + crow(r, hi) > tq) w0 = 0.f; if (k0 + 32 + crow(r, hi) > tq) w1 = 0.f;
                            p0[r] *= w0; p1[r] *= w1; ps += p0[r] + p1[r]; } }
                    asm volatile("" : "+v"(ps));
                } else {
#pragma unroll
                    for (int i = 0; i < 4; ++i) { const f32x4 aa = *(const f32x4*)(A2 + k0 + 8 * i + 4 * hi), ab = *(const f32x4*)(A2 + k0 + 32 + 8 * i + 4 * hi);
#pragma unroll
                        for (int q = 0; q < 4; ++q) { const int r = 4 * i + q;
                            p0[r] *= __builtin_amdgcn_exp2f(aa[q] - M2row); p1[r] *= __builtin_amdgcn_exp2f(ab[q] - M2row); ps += p0[r] + p1[r]; } }
                }
                ps = swap_sum(ps); l_run += ps;
            }
            bf16x8 pa0, pa1, pa2, pa3; p_to_frags(p0, p1, pa0, pa1, pa2, pa3);
            pv_d0(o, vb0 + (j & 1) * SHM_T, pa0, pa1, pa2, pa3);
        }
    };
    MIX_SLOAD(A, 0); MIX_SWRITE(A, 0);
#define MIX_TILE(SL, SW, JJ) do { const int j = (JJ); \
        MIX_BAR(); \
        const int k0 = j * KVB; \
        if (j + 1 < NT) MIX_SLOAD(SL, k0 + KVB); \
        mix_compute(j, k0); \
        if (j + 1 < NT) MIX_SWRITE(SW, (j + 1) & 1); } while (0)
    for (int jj = 0; jj < NT; ++jj) { MIX_TILE(A, A, jj); }
#undef MIX_TILE
    __syncthreads();
#undef MIX_SLOAD
#undef MIX_SWRITE
#undef MIX_BAR
    int lane_e = lane; asm volatile("" : "+v"(lane_e));
    const int r32e = lane_e & 31, hie = lane_e >> 5;
    float rowscale;
    if (MODE == 1) rowscale = 1.f / l_run; else rowscale = 1.f / fmaxf(fabsf(l_run), __expf(-mtrow));
    if (hie == 0) li_l[r32e] = rowscale;
    asm volatile("s_waitcnt lgkmcnt(0)" ::: "memory");
    float rs[16];
#pragma unroll
    for (int r = 0; r < 16; ++r) rs[r] = li_l[crow(r, hie)];
#pragma unroll
    for (int d = 0; d < 4; ++d)
#pragma unroll
        for (int r = 0; r < 16; ++r) o[d][r] *= rs[r];
    if (MODE == 1) {
        __syncthreads();
        float* EX = (float*)lds + (size_t)wq * 4096 + lane_e;
        if (map == 1) {
#pragma unroll
            for (int d = 0; d < 4; ++d)
#pragma unroll
                for (int r = 0; r < 16; ++r) EX[(d * 16 + r) * 64] = o[d][r]; }
        __syncthreads();
        if (map == 0) { const float lam_l = P.lamv[0];
#pragma unroll
            for (int d = 0; d < 4; ++d)
#pragma unroll
                for (int r = 0; r < 16; ++r) o[d][r] -= lam_l * EX[(d * 16 + r) * 64]; }
    }
    if (MODE == 0 || map == 0) {
        float rn[16];
#pragma unroll
        for (int r = 0; r < 16; ++r) { float s = 0.f;
#pragma unroll
            for (int d = 0; d < 4; ++d) s += o[d][r] * o[d][r];
            s = half_sum32(s); rn[r] = __builtin_amdgcn_rsqf(s * (1.f / 128.f) + 1e-6f); }
        const float* hg = (MODE == 0 ? P.m_hgain : P.a_hgain) + h * 128;
        bf16_t* Ob = (MODE == 0 ? P.HM : P.HA) + (tok0 + qlo) * 512 + h * 128;
        unsigned short og[4][16];
        if (MODE == 0) {
#pragma unroll
            for (int d = 0; d < 4; ++d)
#pragma unroll
                for (int r = 0; r < 16; ++r) og[d][r] = P.PROJ[(tok0 + qlo + crow(r, hie)) * 7168 + 1536 + h * 128 + 32 * d + r32e]; }
#pragma unroll
        for (int d = 0; d < 4; ++d) { const int col = 32 * d + r32e; const float g = hg[col] * (MODE == 1 ? P.lamv[1] : 1.f);
#pragma unroll
            for (int r = 0; r < 16; ++r) { const int row = crow(r, hie); float v = o[d][r] * rn[r] * g;
                if (MODE == 0) v *= bf2f(og[d][r]);
                Ob[(size_t)row * 512 + col] = (bf16_t)(cvtpk(v, v) & 0xffffu); } }
    }
    __syncthreads();
}
template <bool DO_M, bool DO_A> __device__ __forceinline__ void mix_phase(char* lds, const MixPtrs& P, unsigned* queue) {
    volatile int* qw = (volatile int*)(lds + OFF_Q);
    if (DO_M) for (;;) {
        if (threadIdx.x == 0) *qw = (int)__hip_atomic_fetch_add(queue, 1u, __ATOMIC_RELAXED, __HIP_MEMORY_SCOPE_AGENT);
        __syncthreads();
        const int item = __builtin_amdgcn_readfirstlane(*qw);
        __syncthreads();
        if (item >= 256) break;
        unit<0>(lds, P, (item & 31) >> 2, item & 3, 256 * (7 - (item >> 5)));
    }
    if (DO_A) for (;;) {
        if (threadIdx.x == 0) *qw = (int)__hip_atomic_fetch_add(queue + 32, 1u, __ATOMIC_RELAXED, __HIP_MEMORY_SCOPE_AGENT);
        __syncthreads();
        const int item = __builtin_amdgcn_readfirstlane(*qw);
        __syncthreads();
        if (item >= 512) break;
        unit<1>(lds, P, (item & 31) >> 2, item & 3, 128 * (15 - (item >> 5)));
    }
}
}
namespace thin {
using pg8::bf16_t; using pg8::f32x4; using pg8::u32x4; using pg8::bf16x8;
typedef __attribute__((address_space(3))) float lds_f32;
__device__ __forceinline__ unsigned f2bf(float f) { unsigned u = __builtin_bit_cast(unsigned, f); return (u + 0x7fffu + ((u >> 16) & 1u)) >> 16; }
__device__ __forceinline__ unsigned pk2(float lo, float hi) { return f2bf(lo) | (f2bf(hi) << 16); }
__device__ __forceinline__ float wave_sum(float v) {
#pragma unroll
    for (int o = 1; o < 64; o <<= 1) v += __shfl_xor(v, o);
    return v;
}
__device__ __forceinline__ unsigned pack4_i8(float a, float b, float c, float d) {
    const int ia = (int)__builtin_rintf(a), ib = (int)__builtin_rintf(b), ic = (int)__builtin_rintf(c), id = (int)__builtin_rintf(d);
    return (unsigned)(ia & 0xff) | ((unsigned)(ib & 0xff) << 8) | ((unsigned)(ic & 0xff) << 16) | ((unsigned)(id & 0xff) << 24);
}
__device__ __forceinline__ float wave_max(float v) {
#pragma unroll
    for (int o = 1; o < 64; o <<= 1) v = fmaxf(v, __shfl_xor(v, o));
    return v;
}
__device__ __forceinline__ u32x4 quant16(const f32x4& a0, const f32x4& a1, const f32x4& a2, const f32x4& a3, float inv) {
    u32x4 w; w.x = pack4_i8(a0[0] * inv, a0[1] * inv, a0[2] * inv, a0[3] * inv); w.y = pack4_i8(a1[0] * inv, a1[1] * inv, a1[2] * inv, a1[3] * inv);
    w.z = pack4_i8(a2[0] * inv, a2[1] * inv, a2[2] * inv, a2[3] * inv); w.w = pack4_i8(a3[0] * inv, a3[1] * inv, a3[2] * inv, a3[3] * inv); return w;
}
__device__ __forceinline__ float absmax16(const f32x4& a0, const f32x4& a1, const f32x4& a2, const f32x4& a3) {
    float m = 0.f;
#pragma unroll
    for (int j = 0; j < 4; ++j) m = fmaxf(fmaxf(m, fmaxf(fabsf(a0[j]), fabsf(a1[j]))), fmaxf(fabsf(a2[j]), fabsf(a3[j])));
    return m;
}
__device__ __forceinline__ float row_rstd_wave(const float* ssq, int row, int lane, int vz) {
    float v = lane < 16 ? ssq[(size_t)(row + vz) * 16 + lane] : 0.f;
#pragma unroll
    for (int o = 1; o < 16; o <<= 1) v += __shfl_xor(v, o);
    v = __shfl(v, 0);
    return __builtin_amdgcn_rsqf(v * (1.f / 1024.f) + 1e-6f);
}
struct TrItem { const float* W; const float* gain; bf16_t* WT; int ldw, K, F, map, n0, k0; };
__device__ __forceinline__ void tr_load(const TrItem& I, float (&v)[16][4], int lane, int wave) {
    int so[4];
#pragma unroll
    for (int j = 0; j < 4; ++j) { const int n = I.n0 + lane + 64 * j; so[j] = I.map == 0 ? n : I.map == 1 ? (n < 2048 ? n : n + 8) : ((n & 255) >> 7) * I.F + (n >> 8) * 128 + (n & 127); }
    const float* Wk = I.W + (size_t)(I.k0 + wave * 16) * I.ldw;
#pragma unroll
    for (int r = 0; r < 16; ++r)
#pragma unroll
        for (int j = 0; j < 4; ++j) v[r][j] = Wk[(size_t)r * I.ldw + so[j]];
}
__device__ __forceinline__ void tr_store(const TrItem& I, const float (&v)[16][4], char* lds, int lane, int wave) {
    unsigned short* img = (unsigned short*)lds;
#pragma unroll
    for (int r = 0; r < 16; r += 2) { float g0 = 1.f, g1 = 1.f; if (I.gain) { g0 = I.gain[I.k0 + wave * 16 + r]; g1 = I.gain[I.k0 + wave * 16 + r + 1]; }
#pragma unroll
        for (int j = 0; j < 4; ++j) *(unsigned*)(img + (lane + 64 * j) * 130 + wave * 16 + r) = pk2(v[r][j] * g0, v[r + 1][j] * g1); }
    __syncthreads();
#pragma unroll 8
    for (int i = 0; i < 32; ++i) { const int n = wave * 32 + i; const unsigned w = *(const unsigned*)(img + n * 130 + 2 * lane);
        *(unsigned*)(I.WT + (size_t)(I.n0 + n) * I.K + I.k0 + 2 * lane) = w; }
    __syncthreads();
}
struct Q8Item { const float* W; const float* gain; unsigned char* W8; float* SB; int ldw, F, map, n0; };
__device__ __forceinline__ void q8_item(const Q8Item& I, char* lds, int lane, int wave) {
    unsigned* img = (unsigned*)lds;
    const int n = I.n0 + lane;
    int so1 = n < 2048 ? n : n + 8;
    if (n >= 2048 && n < 3072) { const int w = n & 255, bj = w >> 7, wc = (w >> 5) & 3, j = w & 31; so1 = 2056 + ((n - 2048) & ~255) + wc * 64 + bj * 32 + j; }
    const int so = I.map == 0 ? n : I.map == 1 ? so1 : ((n & 255) >> 7) * I.F + (n >> 8) * 128 + (n & 127);
    const float* Wk = I.W + (size_t)(wave * 128) * I.ldw + so;
    float va[32], vb[32];
#define Q8_LOAD(V, B) do { _Pragma("unroll") for (int r = 0; r < 32; ++r) V[r] = Wk[(size_t)((B) * 32 + r) * I.ldw]; } while (0)
#define Q8_PUT(V, B) do { _Pragma("unroll") for (int r = 0; r < 32; r += 2) { const int k = wave * 128 + (B) * 32 + r; \
        img[lane * 514 + (k >> 1)] = pk2(V[r] * I.gain[k], V[r + 1] * I.gain[k + 1]); } } while (0)
    Q8_LOAD(va, 0); Q8_LOAD(vb, 1); Q8_PUT(va, 0); Q8_LOAD(va, 2); Q8_PUT(vb, 1); Q8_LOAD(vb, 3); Q8_PUT(va, 2); Q8_PUT(vb, 3);
#undef Q8_LOAD
#undef Q8_PUT
    __syncthreads();
#pragma unroll 2
    for (int i = 0; i < 8; ++i) { const int nr = wave * 8 + i; const unsigned long long* rp = (const unsigned long long*)(img + nr * 514) + lane * 4;
        const unsigned long long d0 = rp[0], d1 = rp[1], d2 = rp[2], d3 = rp[3];
        u32x4 w0 = {(unsigned)d0, (unsigned)(d0 >> 32), (unsigned)d1, (unsigned)(d1 >> 32)}, w1 = {(unsigned)d2, (unsigned)(d2 >> 32), (unsigned)d3, (unsigned)(d3 >> 32)};
        f32x4 a0, a1, a2, a3; pg8::unpack8(w0, a0, a1); pg8::unpack8(w1, a2, a3);
        const float mx = wave_max(absmax16(a0, a1, a2, a3)), step = mx > 0.f ? mx * (1.f / 127.f) : 1.f;
        *((u32x4*)(I.W8 + (size_t)(I.n0 + nr) * 1024) + lane) = quant16(a0, a1, a2, a3, 1.f / step);
        if (lane == 0) I.SB[I.n0 + nr] = step; }
    __syncthreads();
}
struct ProIn {
    const float *x, *p, *attn_norm, *w_in, *pool_w, *pool_scale, *w_branch, *w_out, *ffn_norm, *dense_w_gu, *dense_w_down, *router_w, *moe_w_gu, *moe_w_down, *ple_norm, *ple_w_gate, *ple_w_proj;
    bf16_t *W_IN, *W_BR, *W_OUT, *W_GU0, *W_DN0, *W_GU1, *W_DN1, *W_PG, *W_PP, *XB, *PB; float *X, *SSQ, *WG, *WR; unsigned char* X8; float* RS1; unsigned char *W8_IN, *W8_GU0, *W8_GU1; float *SB_IN, *SB_GU0, *SB_GU1; float* GATE; const float* gate_bias;
};
__device__ __forceinline__ void prologue(const ProIn& a, char* lds, int vcu, int G) {
    int tid_o = threadIdx.x; asm volatile("" : "+v"(tid_o)); const int tid = tid_o, lane = tid & 63, wave = __builtin_amdgcn_readfirstlane(tid >> 6);
    const int gw = vcu * 8 + wave, NGW = G * 8;
    { constexpr int Q_GU1 = 8 * 112, Q_IN = 2 * 112, Q_GU0 = 88, NQ = Q_GU1 + Q_IN + Q_GU0;
#pragma unroll 1
      for (int it = vcu; it < NQ; it += G) { Q8Item I; int r = it;
          if (r < Q_GU1) { const int e = r / 112; r -= e * 112; I.W = a.moe_w_gu + (size_t)e * 1024 * 7168; I.ldw = 7168; I.gain = a.ffn_norm + 1024; I.F = 3584; I.map = 2; I.W8 = a.W8_GU1 + (size_t)e * 7168 * 1024; I.SB = a.SB_GU1 + e * 7168; }
          else if ((r -= Q_GU1) < Q_IN) { const int L = r / 112; r -= L * 112; I.W = a.w_in + (size_t)L * 1024 * 7176; I.ldw = 7176; I.gain = a.attn_norm + L * 1024; I.F = 0; I.map = 1; I.W8 = a.W8_IN + (size_t)L * 7168 * 1024; I.SB = a.SB_IN + L * 7168; }
          else { r -= Q_IN; I.W = a.dense_w_gu; I.ldw = 5632; I.gain = a.ffn_norm; I.F = 2816; I.map = 2; I.W8 = a.W8_GU0; I.SB = a.SB_GU0; }
          I.n0 = r * 64; q8_item(I, lds, lane, wave); } }
    constexpr int I_BR = 4 * 4, I_OUT = 8 * 4, I_DN0 = 22 * 4, I_DN1 = 28 * 4, I_PG = 8 * 4, I_PP = 2 * 4;
    constexpr int NITEMS = 4 * I_BR + 2 * I_OUT + I_DN0 + 8 * I_DN1 + 2 * I_PG + 2 * I_PP;
    auto decode = [&](int it, TrItem& I) {
        int r = it, N; I.gain = nullptr; I.F = 0; I.map = 0;
        if (r < 8 * I_DN1) { const int e = r / I_DN1; r -= e * I_DN1; I.W = a.moe_w_down + (size_t)e * 3584 * 1024; I.ldw = 1024; I.K = 3584; N = 1024; I.WT = a.W_DN1 + (size_t)e * 1024 * 3584; }
        else if ((r -= 8 * I_DN1) < I_DN0) { I.W = a.dense_w_down; I.ldw = 1024; I.K = 2816; N = 1024; I.WT = a.W_DN0; }
        else if ((r -= I_DN0) < 4 * I_BR) { const int q = r / I_BR, L = q >> 1, br = q & 1; r -= q * I_BR; I.W = a.w_branch + ((size_t)L * 3 + br) * 512 * 1024; I.ldw = 1024; I.K = 512; N = 1024; I.WT = a.W_BR + ((size_t)L * 3 + br) * 1024 * 512; }
        else if ((r -= 4 * I_BR) < 2 * I_OUT) { const int L = r / I_OUT; r -= L * I_OUT; I.W = a.w_out + (size_t)L * 1024 * 1024; I.ldw = 1024; I.K = 1024; N = 1024; I.WT = a.W_OUT + (size_t)L * 1024 * 1024; }
        else if ((r -= 2 * I_OUT) < 2 * I_PG) { const int L = r / I_PG; r -= L * I_PG; I.W = a.ple_w_gate + (size_t)L * 1024 * 1024; I.ldw = 1024; I.gain = a.ple_norm + L * 1024; I.K = 1024; N = 1024; I.WT = a.W_PG + (size_t)L * 1024 * 1024; }
        else { r -= 2 * I_PG; const int L = r / I_PP; r -= L * I_PP; I.W = a.ple_w_proj + (size_t)L * 256 * 1024; I.ldw = 1024; I.K = 256; N = 1024; I.WT = a.W_PP + (size_t)L * 1024 * 256; }
        const int nblk = N / 256; I.k0 = (r / nblk) * 128; I.n0 = (r % nblk) * 256;
    };
    { TrItem IA, IB; float va[16][4], vb[16][4]; int it = G - 1 - vcu;
      if (it < NITEMS) { decode(it, IA); tr_load(IA, va, lane, wave);
#pragma unroll 1
        for (;;) {
            const bool hb = it + G < NITEMS; if (hb) { decode(it + G, IB); tr_load(IB, vb, lane, wave); }
            tr_store(IA, va, lds, lane, wave);
            if (!hb) break;
            it += 2 * G; const bool ha = it < NITEMS; if (ha) { decode(it, IA); tr_load(IA, va, lane, wave); }
            tr_store(IB, vb, lds, lane, wave);
            if (!ha) break;
        } } }
    float wgx[4][4][8];
#pragma unroll
    for (int j = 0; j < 4; ++j)
#pragma unroll
        for (int i = 0; i < 4; ++i) { const int k = 4 * lane + 256 * j + i; const float gk = a.attn_norm[k]; const f32x4 w0 = *(const f32x4*)(a.w_in + (size_t)k * 7176 + 2048), w1 = *(const f32x4*)(a.w_in + (size_t)k * 7176 + 2052);
#pragma unroll
            for (int c = 0; c < 4; ++c) { wgx[j][i][c] = gk * w0[c]; wgx[j][i][4 + c] = gk * w1[c]; } }
    for (int m0 = gw * 2; m0 < 16384; m0 += NGW * 2) {
        f32x4 v[2][4];
#pragma unroll
        for (int q = 0; q < 2; ++q) { const f32x4* xr = (const f32x4*)(a.x + (size_t)(m0 + q) * 1024) + lane;
#pragma unroll
            for (int j = 0; j < 4; ++j) v[q][j] = xr[64 * j]; }
#pragma unroll
        for (int q = 0; q < 2; ++q) { const int m = m0 + q; unsigned long long* o8 = (unsigned long long*)(a.XB + (size_t)m * 1024) + lane; float s = 0.f;
#pragma unroll
            for (int j = 0; j < 4; ++j) { const f32x4 w = v[q][j]; s += (w[0] * w[0] + w[1] * w[1]) + (w[2] * w[2] + w[3] * w[3]);
                o8[64 * j] = (unsigned long long)pk2(w[0], w[1]) | ((unsigned long long)pk2(w[2], w[3]) << 32); }
            s = wave_sum(s);
            if (lane < 16) a.SSQ[(size_t)m * 16 + lane] = lane == 0 ? s : 0.f;
            float mx = 0.f;
#pragma unroll
            for (int j = 0; j < 4; ++j) mx = fmaxf(mx, fmaxf(fmaxf(fabsf(v[q][j][0]), fabsf(v[q][j][1])), fmaxf(fabsf(v[q][j][2]), fabsf(v[q][j][3]))));
            mx = wave_max(mx); const float step = mx > 0.f ? mx * (1.f / 127.f) : 1.f, inv = 1.f / step;
            unsigned* x8 = (unsigned*)(a.X8 + (size_t)m * 1024) + lane;
#pragma unroll
            for (int j = 0; j < 4; ++j) x8[64 * j] = pack4_i8(v[q][j][0] * inv, v[q][j][1] * inv, v[q][j][2] * inv, v[q][j][3] * inv);
            const float rstd = __builtin_amdgcn_rsqf(s * (1.f / 1024.f) + 1e-6f);
            if (lane == 0) a.RS1[m] = rstd * step;
            float d[8] = {0.f, 0.f, 0.f, 0.f, 0.f, 0.f, 0.f, 0.f};
#pragma unroll
            for (int j = 0; j < 4; ++j)
#pragma unroll
                for (int i = 0; i < 4; ++i)
#pragma unroll
                    for (int c = 0; c < 8; ++c) d[c] = fmaf(v[q][j][i], wgx[j][i][c], d[c]);
#pragma unroll
            for (int c = 0; c < 8; ++c) d[c] = wave_sum(d[c]);
            if (lane < 8) { float dv = d[0];
#pragma unroll
                for (int c = 1; c < 8; ++c) if (lane == c) dv = d[c];
                a.GATE[(size_t)m * 8 + lane] = dv * rstd + a.gate_bias[lane]; } }
    }
    { const size_t n8 = (size_t)2 * 16384 * 256 / 8; const size_t gt = (size_t)(vcu * 512 + tid), NT = (size_t)G * 512;
      for (size_t i0 = gt; i0 < n8; i0 += 4 * NT) { f32x4 v0[4], v1[4];
#pragma unroll
          for (int q = 0; q < 4; ++q) { const size_t i = i0 + q * NT; if (i < n8) { v0[q] = *(const f32x4*)(a.p + i * 8); v1[q] = *(const f32x4*)(a.p + i * 8 + 4); } }
#pragma unroll
          for (int q = 0; q < 4; ++q) { const size_t i = i0 + q * NT; if (i < n8) { u32x4 w; w.x = pk2(v0[q][0], v0[q][1]); w.y = pk2(v0[q][2], v0[q][3]); w.z = pk2(v1[q][0], v1[q][1]); w.w = pk2(v1[q][2], v1[q][3]); *(u32x4*)(a.PB + i * 8) = w; } } }
      for (size_t i = gt; i < 2 * 8192 + 8192; i += NT) {
          if (i < 2 * 8192) { const int L = (int)(i / 8192), k = (int)(i % 8192) / 8, j = (int)(i & 7); a.WG[i] = a.attn_norm[L * 1024 + k] * a.w_in[((size_t)L * 1024 + k) * 7176 + 2048 + j]; }
          else { const int q = (int)(i - 2 * 8192), k = q / 8; a.WR[q] = a.ffn_norm[1024 + k] * a.router_w[q]; } }
    }
    for (int task = vcu; task < 64; task += G) {
        const int L = task >> 5, g = (task >> 3) & 3, nb = task & 7;
        float* AsT = (float*)lds; float* Bs = AsT + 128 * 128;
        __syncthreads();
        const float* pw = a.pool_w + ((size_t)L * 4 + g) * 128 * 128; const float* ps = a.pool_scale + L * 512 + g * 128;
        const float* wb = a.w_branch + (((size_t)L * 3 + 2) * 512 + g * 128) * 1024 + nb * 128;
        for (int i = tid; i < 128 * 32; i += 512) { const int c = i >> 5, d4 = (i & 31) * 4; const f32x4 w = *(const f32x4*)(pw + c * 128 + d4), s = *(const f32x4*)(ps + d4);
            AsT[(d4 + 0) * 128 + c] = w[0] * s[0]; AsT[(d4 + 1) * 128 + c] = w[1] * s[1]; AsT[(d4 + 2) * 128 + c] = w[2] * s[2]; AsT[(d4 + 3) * 128 + c] = w[3] * s[3]; }
        for (int i = tid; i < 128 * 32; i += 512) { const int d = i >> 5, n4 = (i & 31) * 4; *(f32x4*)(Bs + d * 128 + n4) = *(const f32x4*)(wb + (size_t)d * 1024 + n4); }
        __syncthreads();
        const int nq = (tid & 31) * 4, cq = (tid >> 5) * 8;
        float acc[4][8];
#pragma unroll
        for (int i = 0; i < 4; ++i)
#pragma unroll
            for (int j = 0; j < 8; ++j) acc[i][j] = 0.f;
#pragma unroll 4
        for (int d = 0; d < 128; ++d) { const f32x4 bv = *(const f32x4*)(Bs + d * 128 + nq), a0 = *(const f32x4*)(AsT + d * 128 + cq), a1 = *(const f32x4*)(AsT + d * 128 + cq + 4);
#pragma unroll
            for (int i = 0; i < 4; ++i) {
#pragma unroll
                for (int j = 0; j < 4; ++j) { acc[i][j] = fmaf(bv[i], a0[j], acc[i][j]); acc[i][4 + j] = fmaf(bv[i], a1[j], acc[i][4 + j]); } } }
#pragma unroll
        for (int i = 0; i < 4; ++i) { u32x4 w; w.x = pk2(acc[i][0], acc[i][1]); w.y = pk2(acc[i][2], acc[i][3]); w.z = pk2(acc[i][4], acc[i][5]); w.w = pk2(acc[i][6], acc[i][7]);
            *(u32x4*)(a.W_BR + ((size_t)L * 3 + 2) * 1024 * 512 + (size_t)(nb * 128 + nq + i) * 512 + g * 128 + cq) = w; }
    }
    __syncthreads();
}
template <bool GATES> __device__ __forceinline__ void quant_act(const bf16_t* XB, const float* SSQ, unsigned char* X8, float* RS1, const float* WGt, const float* gate_bias, float* GATE, int vcu, int G) {
    int tid_o = threadIdx.x; asm volatile("" : "+v"(tid_o)); const int tid = tid_o, lane = tid & 63, wave = __builtin_amdgcn_readfirstlane(tid >> 6), gw = vcu * 8 + wave, NGW = G * 8;
    int vz = 0; asm volatile("" : "+v"(vz));
    float wgq[GATES ? 16 : 1][8];
    if (GATES) {
#pragma unroll
        for (int i = 0; i < 16; ++i) { const f32x4 w0 = *(const f32x4*)(WGt + (size_t)(16 * lane + i) * 8), w1 = *(const f32x4*)(WGt + (size_t)(16 * lane + i) * 8 + 4);
#pragma unroll
            for (int c = 0; c < 4; ++c) { wgq[i][c] = w0[c]; wgq[i][4 + c] = w1[c]; } } }
    constexpr int NR = GATES ? 2 : 8;
    for (int r0 = gw * NR; r0 < 16384; r0 += NGW * NR) {
        u32x4 v[NR][2]; float rs[NR];
#pragma unroll
        for (int q = 0; q < NR; ++q) { const u32x4* p = (const u32x4*)(XB + (size_t)(r0 + q) * 1024) + lane * 2; v[q][0] = p[0]; v[q][1] = p[1]; rs[q] = row_rstd_wave(SSQ, r0 + q, lane, vz); }
#pragma unroll
        for (int q = 0; q < NR; ++q) { f32x4 a0, a1, a2, a3; pg8::unpack8(v[q][0], a0, a1); pg8::unpack8(v[q][1], a2, a3);
            const float mx = wave_max(absmax16(a0, a1, a2, a3)), step = mx > 0.f ? mx * (1.f / 127.f) : 1.f;
            *((u32x4*)(X8 + (size_t)(r0 + q) * 1024) + lane) = quant16(a0, a1, a2, a3, 1.f / step);
            if (lane == 0) RS1[r0 + q] = rs[q] * step;
            if (GATES) { const float xv[16] = {a0[0], a0[1], a0[2], a0[3], a1[0], a1[1], a1[2], a1[3], a2[0], a2[1], a2[2], a2[3], a3[0], a3[1], a3[2], a3[3]};
                float d[8] = {0.f, 0.f, 0.f, 0.f, 0.f, 0.f, 0.f, 0.f};
#pragma unroll
                for (int i = 0; i < 16; ++i)
#pragma unroll
                    for (int c = 0; c < 8; ++c) d[c] = fmaf(xv[i], wgq[i][c], d[c]);
#pragma unroll
                for (int c = 0; c < 8; ++c) d[c] = wave_sum(d[c]);
                if (lane < 8) { float dv = d[0];
#pragma unroll
                    for (int c = 1; c < 8; ++c) if (lane == c) dv = d[c];
                    GATE[(size_t)(r0 + q) * 8 + lane] = dv * rs[q] + gate_bias[lane]; } } }
    }
}
struct PrepIn { const bf16_t *PROJ, *XB; const float *SSQ, *WG, *conv_w, *conv_b, *gate_bias, *q_gain, *k_gain; bf16_t *MQ, *MK, *AQ, *AK, *HP; float* GATE; };
__device__ __forceinline__ void prep(const PrepIn& a, char* lds, int vcu, int G) {
    int tid_o = threadIdx.x; asm volatile("" : "+v"(tid_o)); const int tid = tid_o, lane = tid & 63, wave = __builtin_amdgcn_readfirstlane(tid >> 6);
    float* cwl = (float*)lds;
    for (int i = tid; i < 4096 / 4; i += 512) ((f32x4*)cwl)[i] = ((const f32x4*)a.conv_w)[i];
    for (int i = tid; i < 1024 / 4; i += 512) ((f32x4*)(cwl + 4096))[i] = ((const f32x4*)a.conv_b)[i];
    __syncthreads();
    const int gw = vcu * 8 + wave, NGW = G * 8;
    const int c0 = lane * 16;
    int vz = 0; asm volatile("" : "+v"(vz));
    const int qg0 = (lane & 3) * 16;
    const float* qkg = (lane < 32 ? a.q_gain : a.k_gain) + qg0;
    const float qkscale = lane < 32 ? 0.125f * 1.4426950408889634f : 1.f;
    const int pc = lane * 8, pw = 2 << (lane >> 4);
    for (int chunk = gw; chunk < 16384 / 8; chunk += NGW) {
        const int row0 = chunk * 8, t0 = row0 & 2047;
        const bf16_t* pr0 = a.PROJ + (size_t)row0 * 7168;
        { u32x4 cv[11][2];
#pragma unroll
          for (int i = 0; i < 11; ++i) { const int d = i - 3, de = (d < 0 && t0 + d < 0) ? 0 : d; const bf16_t* p = pr0 + (long)de * 7168 + c0; cv[i][0] = *(const u32x4*)p; cv[i][1] = *(const u32x4*)(p + 8); }
          f32x4 wt[4][4], bs[4];
#pragma unroll
          for (int i = 0; i < 4; ++i) { bs[i] = *(const f32x4*)(cwl + 4096 + c0 + 4 * i);
#pragma unroll
              for (int j = 0; j < 4; ++j) wt[j][i] = *(const f32x4*)(cwl + j * 1024 + c0 + 4 * i); }
          const float ks = lane < 32 ? 1.f : 0.08838834764831845f;
#pragma unroll
          for (int r = 0; r < 8; ++r) { f32x4 y[4] = {bs[0], bs[1], bs[2], bs[3]};
#pragma unroll
              for (int j = 0; j < 4; ++j) { const float on = (t0 + r - 3 + j) >= 0 ? 1.f : 0.f; f32x4 x0, x1, x2, x3; pg8::unpack8(cv[r + j][0], x0, x1); pg8::unpack8(cv[r + j][1], x2, x3);
                  y[0] = y[0] + wt[j][0] * x0 * on; y[1] = y[1] + wt[j][1] * x1 * on; y[2] = y[2] + wt[j][2] * x2 * on; y[3] = y[3] + wt[j][3] * x3 * on; }
#pragma unroll
              for (int i = 0; i < 4; ++i)
#pragma unroll
                  for (int c = 0; c < 4; ++c) y[i][c] = y[i][c] * pg8::fsigmoid(y[i][c]) * ks;
              bf16_t* dst = (lane < 32 ? a.MQ : a.MK) + (size_t)(row0 + r) * 512 + (c0 & 511);
              *(u32x4*)dst = pg8::pack8(y[0], y[1]); *(u32x4*)(dst + 8) = pg8::pack8(y[2], y[3]); } }
        { u32x4 pv[23];
#pragma unroll
          for (int i = 0; i < 23; ++i) { const int d = i - 15, de = (d < 0 && t0 + d < 0) ? 0 : d; pv[i] = *(const u32x4*)(pr0 + (long)de * 7168 + 3584 + pc); }
#pragma unroll
          for (int r = 0; r < 8; ++r) { const int t = t0 + r, cnt = t + 1 < pw ? t + 1 : pw;
              f32x4 u0, u1; pg8::unpack8(pv[15 + r], u0, u1); f32x4 s0 = u0, s1 = u1;
#pragma unroll
              for (int j = 1; j < 16; ++j) { const float on = j < cnt ? 1.f : 0.f; f32x4 b0, b1; pg8::unpack8(pv[15 + r - j], b0, b1); s0 = s0 + b0 * on; s1 = s1 + b1 * on; }
              const float ic = 1.f / (float)cnt; s0 = s0 * ic - u0; s1 = s1 * ic - u1;
              *(u32x4*)(a.HP + (size_t)(row0 + r) * 512 + pc) = pg8::pack8(s0, s1); } }
    }
    __syncthreads();
}
struct RouteIn { const float *X, *SSQ, *WR, *router_b; const bf16_t* XB; bf16_t* XG; float* RSG; unsigned* cnt; int* TOKI; float* TOKG; };
__device__ __forceinline__ void route(const RouteIn& a, char* lds, int vcu, int G) {
    int tid_o = threadIdx.x; asm volatile("" : "+v"(tid_o)); const int tid = tid_o, lane = tid & 63, wave = __builtin_amdgcn_readfirstlane(tid >> 6);
    int vz = 0; asm volatile("" : "+v"(vz));
    int* lcnt = (int*)lds; int* lbase = lcnt + 8; int* lsel = lbase + 8;
    float* lgate = (float*)(lsel + 256);
    float* wrt = (float*)(lds + 8192);
    for (int i = tid; i < 8192; i += 512) wrt[(i & 7) * 1024 + (i >> 3)] = a.WR[i];
    for (int chunk = vcu; chunk < 16384 / 64; chunk += G) {
        if (tid < 8) lcnt[tid] = 0;
        __syncthreads();
        u32x4 xq[8][2]; float rsd[8];
#pragma unroll
        for (int rr = 0; rr < 8; ++rr) { const int row = chunk * 64 + wave * 8 + rr; const u32x4* src = (const u32x4*)(a.XB + (size_t)row * 1024) + lane * 2; xq[rr][0] = src[0]; xq[rr][1] = src[1];
            rsd[rr] = row_rstd_wave(a.SSQ, row, lane, vz); }
#pragma unroll
        for (int rr = 0; rr < 8; ++rr) { const int lrow = wave * 8 + rr;
            f32x4 a0, a1, a2, a3; pg8::unpack8(xq[rr][0], a0, a1); pg8::unpack8(xq[rr][1], a2, a3);
            const float xv[16] = {a0[0], a0[1], a0[2], a0[3], a1[0], a1[1], a1[2], a1[3], a2[0], a2[1], a2[2], a2[3], a3[0], a3[1], a3[2], a3[3]};
            float d[8];
#pragma unroll
            for (int c = 0; c < 8; ++c) { const f32x4* wp = (const f32x4*)(wrt + c * 1024 + 16 * lane); const f32x4 w0 = wp[0], w1 = wp[1], w2 = wp[2], w3 = wp[3];
                d[c] = ((xv[0] * w0[0] + xv[1] * w0[1]) + (xv[2] * w0[2] + xv[3] * w0[3])) + ((xv[4] * w1[0] + xv[5] * w1[1]) + (xv[6] * w1[2] + xv[7] * w1[3]))
                     + ((xv[8] * w2[0] + xv[9] * w2[1]) + (xv[10] * w2[2] + xv[11] * w2[3])) + ((xv[12] * w3[0] + xv[13] * w3[1]) + (xv[14] * w3[2] + xv[15] * w3[3])); }
            const float r = rsd[rr];
#pragma unroll
            for (int j = 0; j < 8; ++j) d[j] = wave_sum(d[j]) * r + a.router_b[j];
            int i0 = 0; float v0 = d[0];
#pragma unroll
            for (int j = 1; j < 8; ++j) if (d[j] > v0) { v0 = d[j]; i0 = j; }
            int i1 = -1; float v1 = -3.0e38f;
#pragma unroll
            for (int j = 0; j < 8; ++j) if (j != i0 && d[j] > v1) { v1 = d[j]; i1 = j; }
            if (lane == 0) { const float e1 = __expf(v1 - v0); const float g0 = 1.f / (1.f + e1);
                lsel[lrow * 4 + 0] = i0; lsel[lrow * 4 + 1] = atomicAdd(&lcnt[i0], 1); lsel[lrow * 4 + 2] = i1; lsel[lrow * 4 + 3] = atomicAdd(&lcnt[i1], 1);
                lgate[lrow * 2] = g0; lgate[lrow * 2 + 1] = e1 * g0; lgate[128 + lrow] = r; } }
        __syncthreads();
        if (tid < 8) lbase[tid] = (int)__hip_atomic_fetch_add(a.cnt + tid, (unsigned)lcnt[tid], __ATOMIC_RELAXED, __HIP_MEMORY_SCOPE_AGENT);
        __syncthreads();
        u32x4 xr[8][2];
#pragma unroll
        for (int rr = 0; rr < 8; ++rr) { const u32x4* src = (const u32x4*)(a.XB + (size_t)(chunk * 64 + wave * 8 + rr) * 1024) + lane * 2; xr[rr][0] = src[0]; xr[rr][1] = src[1]; }
#pragma unroll
        for (int rr = 0; rr < 8; ++rr) {
            const int lrow = wave * 8 + rr, row = chunk * 64 + lrow;
            const int e0 = lsel[lrow * 4], p0 = lbase[e0] + lsel[lrow * 4 + 1], e1 = lsel[lrow * 4 + 2], p1 = lbase[e1] + lsel[lrow * 4 + 3];
            f32x4 a0, a1, a2, a3; pg8::unpack8(xr[rr][0], a0, a1); pg8::unpack8(xr[rr][1], a2, a3);
            const float mx = wave_max(absmax16(a0, a1, a2, a3)), step = mx > 0.f ? mx * (1.f / 127.f) : 1.f; const u32x4 qq = quant16(a0, a1, a2, a3, 1.f / step);
            *((u32x4*)((unsigned char*)a.XG + ((size_t)e0 * 16384 + p0) * 1024) + lane) = qq;
            *((u32x4*)((unsigned char*)a.XG + ((size_t)e1 * 16384 + p1) * 1024) + lane) = qq;
            if (lane == 0) { const float r = lgate[128 + lrow] * step; a.RSG[(size_t)e0 * 16384 + p0] = r; a.RSG[(size_t)e1 * 16384 + p1] = r;
                a.TOKI[row * 4 + 0] = e0; a.TOKI[row * 4 + 1] = p0; a.TOKI[row * 4 + 2] = e1; a.TOKI[row * 4 + 3] = p1; a.TOKG[row * 2] = lgate[lrow * 2]; a.TOKG[row * 2 + 1] = lgate[lrow * 2 + 1]; }
        }
        __syncthreads();
    }
}
struct CombIn { float* X; bf16_t* XB; float* SSQ; const bf16_t* Y; const int* TOKI; const float* TOKG; int ts[8]; };
__device__ __forceinline__ void combine(const CombIn& a, int vcu, int G) {
    int tid_o = threadIdx.x; asm volatile("" : "+v"(tid_o)); const int tid = tid_o, lane = tid & 63, wave = __builtin_amdgcn_readfirstlane(tid >> 6), gw = vcu * 8 + wave, NGW = G * 8;
    int vz = 0; asm volatile("" : "+v"(vz));
    for (int r0 = gw * 4; r0 < 16384; r0 += NGW * 4) {
        int ti[4][4]; float tg[4][2];
#pragma unroll
        for (int q = 0; q < 4; ++q) { const int rv = r0 + q + vz;
#pragma unroll
            for (int i = 0; i < 4; ++i) ti[q][i] = a.TOKI[rv * 4 + i];
            tg[q][0] = a.TOKG[rv * 2]; tg[q][1] = a.TOKG[rv * 2 + 1]; }
        u32x4 y0[4][2], y1[4][2]; f32x4 xv[4][4]; int yr0[4], yr1[4];
#pragma unroll
        for (int q = 0; q < 4; ++q) { int t0 = 0, t1 = 0;
#pragma unroll
            for (int j = 0; j < 8; ++j) { if (j == ti[q][0]) t0 = a.ts[j]; if (j == ti[q][2]) t1 = a.ts[j]; }
            yr0[q] = t0 * 256 + ti[q][1]; yr1[q] = t1 * 256 + ti[q][3];
            const u32x4* p0 = (const u32x4*)(a.Y + (size_t)yr0[q] * 1024) + lane * 2; const u32x4* p1 = (const u32x4*)(a.Y + (size_t)yr1[q] * 1024) + lane * 2;
            y0[q][0] = p0[0]; y0[q][1] = p0[1]; y1[q][0] = p1[0]; y1[q][1] = p1[1];
            const u32x4* xp = (const u32x4*)(a.XB + (size_t)(r0 + q) * 1024) + lane * 2; pg8::unpack8(xp[0], xv[q][0], xv[q][1]); pg8::unpack8(xp[1], xv[q][2], xv[q][3]); }
#pragma unroll
        for (int q = 0; q < 4; ++q) { const int row = r0 + q; const float g0 = tg[q][0], g1 = tg[q][1]; f32x4 v[4]; float s = 0.f;
#pragma unroll
            for (int hh = 0; hh < 2; ++hh) { f32x4 a0, a1, b0, b1; pg8::unpack8(y0[q][hh], a0, a1); pg8::unpack8(y1[q][hh], b0, b1);
                v[2 * hh] = xv[q][2 * hh] + a0 * g0 + b0 * g1; v[2 * hh + 1] = xv[q][2 * hh + 1] + a1 * g0 + b1 * g1; }
            if (yr0[q] >= 32768) {
#pragma unroll
                for (int sl = 0; sl < 3; ++sl) { const u32x4* p2 = (const u32x4*)(a.Y + ((size_t)34816 + sl * 2048 + (yr0[q] - 32768)) * 1024) + lane * 2;
#pragma unroll
                    for (int hh = 0; hh < 2; ++hh) { f32x4 c0, c1; pg8::unpack8(p2[hh], c0, c1); v[2 * hh] = v[2 * hh] + c0 * g0; v[2 * hh + 1] = v[2 * hh + 1] + c1 * g0; } } }
            if (yr1[q] >= 32768) {
#pragma unroll
                for (int sl = 0; sl < 3; ++sl) { const u32x4* p3 = (const u32x4*)(a.Y + ((size_t)34816 + sl * 2048 + (yr1[q] - 32768)) * 1024) + lane * 2;
#pragma unroll
                    for (int hh = 0; hh < 2; ++hh) { f32x4 d0, d1; pg8::unpack8(p3[hh], d0, d1); v[2 * hh] = v[2 * hh] + d0 * g1; v[2 * hh + 1] = v[2 * hh + 1] + d1 * g1; } } }
#pragma unroll
            for (int i = 0; i < 4; ++i) s += (v[i][0] * v[i][0] + v[i][1] * v[i][1]) + (v[i][2] * v[i][2] + v[i][3] * v[i][3]);
            u32x4* xb = (u32x4*)(a.XB + (size_t)row * 1024) + lane * 2; xb[0] = pg8::pack8(v[0], v[1]); xb[1] = pg8::pack8(v[2], v[3]);
            s = wave_sum(s);
            if (lane < 16) a.SSQ[(size_t)row * 16 + lane] = lane == 0 ? s : 0.f; }
    }
}
}
#define LAS __attribute__((address_space(3)))
typedef unsigned short bf16_t;
constexpr int M = 16384, NWAVES = 8;
constexpr size_t MiB = 1u << 20;
constexpr size_t WS_CTL = 0, CTL_ZERO_BYTES = 1 * MiB;
constexpr size_t WS_SMALL = 1 * MiB;
constexpr size_t WS_TOKI = 2 * MiB, WS_TOKG = WS_TOKI + (size_t)M * 16;
constexpr size_t WS_SSQA = 3 * MiB, WS_SSQB = 4 * MiB, WS_GATE = 5 * MiB;
constexpr size_t WS_RSG = 6 * MiB;
constexpr size_t WS_W = 8 * MiB;
constexpr size_t WS_W_IN = WS_W, WS_W_BR = WS_W_IN + (size_t)2 * 7168 * 1024 * 2, WS_W_OUT = WS_W_BR + (size_t)6 * 1024 * 512 * 2, WS_W_GU0 = WS_W_OUT + (size_t)2 * 1024 * 1024 * 2,
                 WS_W_DN0 = WS_W_GU0 + (size_t)5632 * 1024 * 2, WS_W_GU1 = WS_W_DN0 + (size_t)1024 * 2816 * 2, WS_W_DN1 = WS_W_GU1 + (size_t)8 * 7168 * 1024 * 2,
                 WS_W_PG = WS_W_DN1 + (size_t)8 * 1024 * 3584 * 2, WS_W_PP = WS_W_PG + (size_t)2 * 1024 * 1024 * 2, WS_W_END = WS_W_PP + (size_t)2 * 1024 * 256 * 2;
constexpr size_t WS_XB = (WS_W_END + MiB - 1) / MiB * MiB, WS_PP = WS_XB + (size_t)M * 1024 * 2, WS_PB = WS_PP + (size_t)2 * M * 1024 * 2, WS_X8 = WS_PB + (size_t)2 * M * 256 * 2, WS_RS1 = WS_X8 + (size_t)M * 1024, WS_AREA = WS_RS1 + MiB;
constexpr size_t WS_PROJ = WS_AREA, WS_MQ = WS_PROJ + (size_t)M * 7168 * 2, WS_MK = WS_MQ + (size_t)M * 512 * 2, WS_AQ = WS_MK + (size_t)M * 512 * 2, WS_AK = WS_AQ + (size_t)M * 512 * 2,
                 WS_HM = WS_AK + (size_t)M * 512 * 2, WS_HA = WS_HM + (size_t)M * 512 * 2, WS_HP = WS_HA + (size_t)M * 512 * 2, WS_ZF = WS_HP + (size_t)M * 512 * 2, WS_ZB = WS_ZF + (size_t)M * 1024 * 4,
                 WS_G8 = WS_ZB + (size_t)M * 1024 * 2, WS_LAYER_END = WS_G8 + (size_t)M * 3072;
constexpr size_t WS_XG = WS_AREA, WS_Y = WS_AREA, WS_ACT = WS_XG + (size_t)8 * 16384 * 1024 * 2, WS_END = WS_ACT + (size_t)34816 * 3584 * 2;
static_assert(WS_LAYER_END <= WS_END && WS_ACT >= WS_MQ, "AREA views");
constexpr int CW_BAR = 4096, CW_QUEUE = 16384, CW_ECNT = 16384 + 256;

#define XB_TMO      128
#define XB_XCNT(j)  (256  + 64 * (j))
#define XB_XSUB(j)  (1280 + 64 * (j))
#define XB_XGEN(j)  (2304 + 64 * (j))
#define XB_TOP      3328
#define XB_TOPGEN   3392
#define XCD_BAR_WORDS 3456
#define XB_SPIN_CAP (1u << 18)

__device__ __forceinline__ unsigned xb_ld(unsigned* p)              { return __hip_atomic_load(p, __ATOMIC_RELAXED, __HIP_MEMORY_SCOPE_AGENT); }
__device__ __forceinline__ unsigned xb_add(unsigned* p, unsigned v) { return __hip_atomic_fetch_add(p, v, __ATOMIC_RELAXED, __HIP_MEMORY_SCOPE_AGENT); }
__device__ __forceinline__ unsigned xb_xcc_id() { return (unsigned)__builtin_amdgcn_s_getreg((3 << 11) | 20) & 0xFu; }
#define XB_SPIN(cond, bar) do { unsigned _sp = 0; while (cond) { __builtin_amdgcn_s_sleep(1); \
    if ((++_sp & 255u) == 0u) { if (xb_ld(&(bar)[XB_TMO])) break; if (_sp > XB_SPIN_CAP) { atomicAdd(&(bar)[XB_TMO], 1u); break; } } } } while (0)

struct XcdBarrier {
    unsigned* bar; unsigned x;
    volatile LAS unsigned* st;
};

__device__ __forceinline__ XcdBarrier xcd_barrier_post(unsigned* bar, volatile LAS unsigned* st) {
    XcdBarrier b; b.bar = bar; b.x = xb_xcc_id(); b.st = st;
    if (threadIdx.x == 0) (void)xb_add(&bar[XB_XCNT(b.x)], 1u);
    return b;
}
__device__ __forceinline__ void xcd_barrier_complete(unsigned* bar, unsigned x, unsigned& nloc, unsigned& nx) {
    const unsigned G = gridDim.x * gridDim.y * gridDim.z;
    unsigned sum, cnt, mine, sp = 0u;
    for (;;) {
        sum = 0u; cnt = 0u; mine = 0u;
#pragma unroll
        for (unsigned j = 0; j < 16; ++j) { const unsigned c = xb_ld(&bar[XB_XCNT(j)]); sum += c; cnt += (c > 0u) ? 1u : 0u; mine = (j == x) ? c : mine; }
        if (sum == G) break;
        __builtin_amdgcn_s_sleep(1);
        if ((++sp & 255u) == 0u) { if (xb_ld(&bar[XB_TMO])) break; if (sp > XB_SPIN_CAP) { atomicAdd(&bar[XB_TMO], 1u); break; } }
    }
    nloc = mine > 0u ? mine : 1u; nx = cnt > 0u ? cnt : 1u;
}

__device__ __forceinline__ void xcd_barrier(const XcdBarrier& b) {
    asm volatile("s_waitcnt vmcnt(0)" ::: "memory");
    __syncthreads();
    if (threadIdx.x == 0) {
        unsigned* bar = b.bar;
        __builtin_amdgcn_s_waitcnt(0);
        unsigned nloc = b.st[0], nx = b.st[1];
        if (nloc == 0u) { xcd_barrier_complete(bar, b.x, nloc, nx); b.st[0] = nloc; b.st[1] = nx; }
        const unsigned old = xb_add(&bar[XB_XSUB(b.x)], 1u);
        const unsigned gen = old / nloc;
        if (old + 1u == (gen + 1u) * nloc) {
            __builtin_amdgcn_fence(__ATOMIC_RELEASE, "agent");
            asm volatile("s_waitcnt vmcnt(0)" ::: "memory");
            const unsigned og = xb_add(&bar[XB_TOP], 1u);
            const unsigned tg = og / nx;
            if (og + 1u == (tg + 1u) * nx) xb_add(&bar[XB_TOPGEN], 1u);
            else XB_SPIN(xb_ld(&bar[XB_TOPGEN]) == tg, bar);
            __builtin_amdgcn_fence(__ATOMIC_ACQUIRE, "agent");
            xb_add(&bar[XB_XGEN(b.x)], 1u);
            asm volatile("s_waitcnt vmcnt(0)" ::: "memory");
        } else {
            XB_SPIN(xb_ld(&bar[XB_XGEN(b.x)]) == gen, bar);
            __builtin_amdgcn_fence(__ATOMIC_ACQUIRE, "agent");
            asm volatile("s_waitcnt vmcnt(0)" ::: "memory");
        }
    }
    __syncthreads();
}


struct Args { const float* in[26]; float* out; unsigned char* ws; int ph_lo, ph_hi; };
static_assert(sizeof(Args) == 26 * 8 + 8 + 8 + 8, "Args has no padding");

constexpr int LDS_BYTES = 147456, MISC_OFF = 131072 + 8192;

__global__ void __launch_bounds__(NWAVES * 64, 2) fwd_kernel(Args args) {
    extern __shared__ __attribute__((aligned(16))) unsigned char lds[];
    const int tid = threadIdx.x;
    const int G = gridDim.x; int vcu; { const int bx = blockIdx.x; vcu = (G % 8 == 0) ? (bx % 8) * (G / 8) + bx / 8 : bx; }
    volatile LAS unsigned* MISC = (volatile LAS unsigned*)((LAS unsigned char*)lds + MISC_OFF);
    if (tid < 32) MISC[tid] = 0u;
    __syncthreads();
    unsigned char* ws = args.ws;
    unsigned* ctl = (unsigned*)(ws + WS_CTL);
    const int lo = args.ph_lo, hi = args.ph_hi;
    const bool one_launch = (hi - lo) > 1;
    XcdBarrier bar; bar.bar = ctl + CW_BAR; bar.x = 0; bar.st = nullptr;
    if (one_launch) bar = xcd_barrier_post(ctl + CW_BAR, MISC + 8);
#ifndef EPI_ALIGN8
#define EPI_ALIGN8 true
#endif
#ifndef SITE_MASK
#define SITE_MASK 0xffff
#endif
#define EN(s) ((SITE_MASK >> (s)) & 1)
#define IN(k) (lo <= (k) && (k) < hi)
#define SEAM(k) do { if (IN(k) && IN((k) + 1)) xcd_barrier(bar); } while (0)
    LAS unsigned char* ring = (LAS unsigned char*)lds;
    const float* const* in = args.in;
    float* X = args.out;
#define SITE_WS size_t wso_ = 0; asm volatile("" : "+s"(wso_)); unsigned char* wsl = ws + wso_;
#define p_XB ((bf16_t*)(wsl + WS_XB))
#define p_PB ((bf16_t*)(wsl + WS_PB))
#define p_PPb ((bf16_t*)(wsl + WS_PP))
#define p_SSQA ((float*)(wsl + WS_SSQA))
#define p_SSQB ((float*)(wsl + WS_SSQB))
#define p_GATE ((float*)(wsl + WS_GATE))
#define p_RSG ((float*)(wsl + WS_RSG))
#define p_WG ((float*)(wsl + WS_SMALL))
#define p_WR (((float*)(wsl + WS_SMALL) + 2 * 8192))
#define p_PROJ ((bf16_t*)(wsl + WS_PROJ))
#define p_MQ ((bf16_t*)(wsl + WS_MQ))
#define p_MK ((bf16_t*)(wsl + WS_MK))
#define p_AQ ((bf16_t*)(wsl + WS_AQ))
#define p_AK ((bf16_t*)(wsl + WS_AK))
#define p_HM ((bf16_t*)(wsl + WS_HM))
#define p_HA ((bf16_t*)(wsl + WS_HA))
#define p_HP ((bf16_t*)(wsl + WS_HP))
#define p_ZB ((bf16_t*)(wsl + WS_ZB))
#define p_XG ((bf16_t*)(wsl + WS_XG))
#define p_Yb ((bf16_t*)(wsl + WS_Y))
#define p_ACT ((bf16_t*)(wsl + WS_ACT))
#define p_TOKI ((int*)(wsl + WS_TOKI))
#define p_TOKG ((float*)(wsl + WS_TOKG))
#define p_W_IN ((bf16_t*)(wsl + WS_W_IN))
#define p_W_BR ((bf16_t*)(wsl + WS_W_BR))
#define p_W_OUT ((bf16_t*)(wsl + WS_W_OUT))
#define p_W_GU0 ((bf16_t*)(wsl + WS_W_GU0))
#define p_W_DN0 ((bf16_t*)(wsl + WS_W_DN0))
#define p_W_GU1 ((bf16_t*)(wsl + WS_W_GU1))
#define p_W_DN1 ((bf16_t*)(wsl + WS_W_DN1))
#define p_W_PG ((bf16_t*)(wsl + WS_W_PG))
#define p_W_PP ((bf16_t*)(wsl + WS_W_PP))
    if (EN(0) && IN(0)) {
        SITE_WS
        thin::ProIn a; a.x = in[0]; a.p = in[1]; a.attn_norm = in[2]; a.w_in = in[3]; a.pool_w = in[12]; a.pool_scale = in[13]; a.w_branch = in[14]; a.w_out = in[15]; a.ffn_norm = in[16];
        a.dense_w_gu = in[17]; a.dense_w_down = in[18]; a.router_w = in[19]; a.moe_w_gu = in[21]; a.moe_w_down = in[22]; a.ple_norm = in[23]; a.ple_w_gate = in[24]; a.ple_w_proj = in[25];
        a.W_IN = p_W_IN; a.W_BR = p_W_BR; a.W_OUT = p_W_OUT; a.W_GU0 = p_W_GU0; a.W_DN0 = p_W_DN0; a.W_GU1 = p_W_GU1; a.W_DN1 = p_W_DN1; a.W_PG = p_W_PG; a.W_PP = p_W_PP; a.XB = p_XB; a.PB = p_PB; a.X = X; a.SSQ = p_SSQA; a.WG = p_WG; a.WR = p_WR; a.X8 = (unsigned char*)(wsl + WS_X8); a.RS1 = (float*)(wsl + WS_RS1);
        a.W8_IN = (unsigned char*)(wsl + WS_W_IN); a.SB_IN = (float*)(wsl + WS_W_IN + (size_t)14 * MiB); a.W8_GU0 = (unsigned char*)(wsl + WS_W_GU0); a.SB_GU0 = (float*)(wsl + WS_W_GU0 + (size_t)6 * MiB);
        a.W8_GU1 = (unsigned char*)(wsl + WS_W_GU1); a.SB_GU1 = (float*)(wsl + WS_W_GU1 + (size_t)56 * MiB); a.GATE = p_GATE; a.gate_bias = in[6];
        thin::prologue(a, (char*)lds, vcu, G);
    }
    SEAM(0);
#pragma unroll 1
    for (int L = 0; L < 2; ++L) {
        const int pb = 2 + 11 * L;
        if (EN(2) && IN(pb)) {
            SITE_WS
            pg8::Gemm g{(const bf16_t*)(wsl + WS_X8), (const bf16_t*)(wsl + WS_W_IN + (size_t)L * 7168 * 1024), M, 7168, 512, 512}; pg8::StaticOrder S; S.init(M, 7168, G, (int)blockIdx.x);
            pg8::EpiProj8 E{p_PROJ, (const float*)(wsl + WS_RS1), (const float*)(wsl + WS_W_IN + (size_t)14 * MiB) + L * 7168, p_AQ, p_AK, in[8] + L * 64, in[9] + L * 64, (unsigned char*)(wsl + WS_G8)};
            pg8::gemm_phase<pg8::EpiProj8, pg8::StaticOrder, EPI_ALIGN8, true>(ring, g, S, E);
        }
        SEAM(pb);
        if (EN(3) && IN(pb + 1)) {
            SITE_WS
            thin::PrepIn a; a.PROJ = p_PROJ; a.XB = p_XB; a.SSQ = p_SSQA; a.WG = p_WG + L * 8192; a.conv_w = in[4] + L * 4096; a.conv_b = in[5] + L * 1024; a.gate_bias = in[6] + L * 8;
            a.q_gain = in[8] + L * 64; a.k_gain = in[9] + L * 64; a.MQ = p_MQ; a.MK = p_MK; a.AQ = p_AQ; a.AK = p_AK; a.HP = p_HP; a.GATE = p_GATE;
            thin::prep(a, (char*)lds, vcu, G);
        }
        SEAM(pb + 1);
        if (EN(4) && IN(pb + 2)) {
            SITE_WS
            mix::MixPtrs P; P.PROJ = p_PROJ; P.MQ = p_MQ; P.MK = p_MK; P.AQ = p_AQ; P.AK = p_AK; P.GATE = p_GATE; P.HM = p_HM; P.HA = p_HA; P.m_hgain = in[7] + L * 512; P.a_hgain = in[11] + L * 512;
            { const float* lp = in[10] + L * 256; float d01 = 0.f, d23 = 0.f; for (int i = 0; i < 64; ++i) { d01 = fmaf(lp[i], lp[64 + i], d01); d23 = fmaf(lp[128 + i], lp[192 + i], d23); }
              const float lam_init = 0.8f - 0.6f * __expf(-0.3f * (float)L);
              float* lamv = (float*)((char*)lds + MISC_OFF + 64); if (tid == 0) { lamv[0] = __expf(d01) - __expf(d23) + lam_init; lamv[1] = 1.f - lam_init; } __syncthreads(); P.lamv = lamv; }
            mix::mix_phase<true, true>((char*)lds, P, ctl + CW_QUEUE + 64 * L);
        }
        SEAM(pb + 2);
        if (EN(5) && IN(pb + 3)) {
            SITE_WS
            pg8::MergeOrder S; S.S.init(M, 1024, G, (int)blockIdx.x);
            pg8::Gemm g{p_HM, p_W_BR + (size_t)L * 3 * 1024 * 512, 3 * M, 1024, 512, 512}; pg8::EpiZs E{p_ZB, (const unsigned char*)(wsl + WS_G8)};
            pg8::gemm_phase<pg8::EpiZs, pg8::MergeOrder, true, true>(ring, g, S, E);
        }
        SEAM(pb + 3);
        if (EN(6) && IN(pb + 4)) {
            SITE_WS
            pg8::Gemm g{p_ZB, p_W_OUT + (size_t)L * 1024 * 1024, M, 1024, 1024, 1024}; pg8::StaticOrder S; S.init(M, 1024, G, (int)blockIdx.x);
            pg8::EpiRes E{p_XB, p_SSQB};
            pg8::gemm_phase<pg8::EpiRes, pg8::StaticOrder, true, true>(ring, g, S, E);
        }
        SEAM(pb + 4);
        if (L == 0) {
            if (EN(7) && IN(pb + 5)) {
                SITE_WS
                thin::quant_act<false>(p_XB, p_SSQB, (unsigned char*)(wsl + WS_X8), (float*)(wsl + WS_RS1), nullptr, nullptr, nullptr, vcu, G);
                pg8::Gemm g{p_PB, p_W_PP, 2 * M, 1024, 256, 256};
                pg8::PpOrder S; S.S.init(2 * M, 1024, G, (int)blockIdx.x);
                pg8::EpiPP E{p_PPb};
                pg8::gemm_phase<pg8::EpiPP, pg8::PpOrder, true, true>(ring, g, S, E);
            }
            SEAM(pb + 5);
            if (EN(8) && IN(pb + 6)) {
                SITE_WS
                pg8::Gemm g{(const bf16_t*)(wsl + WS_X8), (const bf16_t*)(wsl + WS_W_GU0), M, 5632, 512, 512}; pg8::StaticOrder S; S.init(M, 5632, G, (int)blockIdx.x);
                pg8::EpiUp8d E{p_ACT, (const float*)(wsl + WS_RS1), (const float*)(wsl + WS_W_GU0 + (size_t)6 * MiB)};
                pg8::gemm_phase<pg8::EpiUp8d, pg8::StaticOrder, true, true>(ring, g, S, E);
            }
            SEAM(pb + 6);
            if (EN(9) && IN(pb + 7)) {
                SITE_WS
                pg8::Gemm g{p_ACT, p_W_DN0, M, 1024, 2816, 2816}; pg8::StaticOrder S; S.init(M, 1024, G, (int)blockIdx.x);
                pg8::EpiRes E{p_XB, p_SSQB};
                pg8::gemm_phase<pg8::EpiRes, pg8::StaticOrder, true, true>(ring, g, S, E);
            }
            SEAM(pb + 7);
        } else {
            if (EN(7) && IN(pb + 5)) {
                SITE_WS
                thin::RouteIn a; a.X = X; a.SSQ = p_SSQB; a.WR = p_WR; a.router_b = in[20]; a.XB = p_XB; a.XG = p_XG; a.RSG = p_RSG; a.cnt = ctl + CW_ECNT; a.TOKI = p_TOKI; a.TOKG = p_TOKG;
                thin::route(a, (char*)lds, vcu, G);
            }
            SEAM(pb + 5);
            int ts[9]; ts[0] = 0;
#pragma unroll
            for (int e = 0; e < 8; ++e) { const unsigned c = __hip_atomic_load(ctl + CW_ECNT + e, __ATOMIC_RELAXED, __HIP_MEMORY_SCOPE_AGENT); ts[e + 1] = ts[e] + (int)((c + 255u) >> 8); }
            if (EN(10) && IN(pb + 6)) {
                SITE_WS
                pg8::Gemm g{p_XG, p_W_GU1, 0, 0, 512, 512};
                pg8::MoeOrder<true> S{ts[8], 28, ts[8] * 28, G, (int)blockIdx.x, ts[0], ts[1], ts[2], ts[3], ts[4], ts[5], ts[6], ts[7], 0};
                pg8::EpiUp8 E{p_ACT, p_RSG, (const float*)(wsl + WS_W_GU1 + (size_t)56 * MiB), ts[0], ts[1], ts[2], ts[3], ts[4], ts[5], ts[6], ts[7]};
                pg8::gemm_phase<pg8::EpiUp8, pg8::MoeOrder<true>, EPI_ALIGN8, true>(ring, g, S, E);
            }
            SEAM(pb + 6);
            if (EN(11) && IN(pb + 7)) {
                SITE_WS
                const int RA = ts[8] < 128 ? ts[8] : 128, RB = ts[8] - RA;
                { pg8::Gemm g{p_ACT, p_W_DN1, 0, 0, 3584, 3584};
                  pg8::MoeOrder<false> S{RA, 4, RA * 4, G, (int)blockIdx.x, ts[0], ts[1], ts[2], ts[3], ts[4], ts[5], ts[6], ts[7], 0};
                  pg8::EpiDownMoe E{p_Yb, p_Yb, 3584};
                  pg8::gemm_phase<pg8::EpiDownMoe, pg8::MoeOrder<false>, true, true>(ring, g, S, E); }
                if (RB > 0) { pg8::Gemm g{p_ACT, p_W_DN1, 0, 0, 896, 3584};
                  pg8::MoeOrder<false, 4, 896> S{RB, 4, RB * 4 * 4, G, (int)(G - 1 - blockIdx.x), ts[0], ts[1], ts[2], ts[3], ts[4], ts[5], ts[6], ts[7], 128};
                  pg8::EpiDownMoe E{p_Yb, p_Yb + (size_t)34816 * 1024, 896};
                  pg8::gemm_phase<pg8::EpiDownMoe, pg8::MoeOrder<false, 4, 896>, true, true>(ring, g, S, E); }
            }
            SEAM(pb + 7);
            if (EN(12) && IN(pb + 8)) {
                SITE_WS
                thin::CombIn a; a.X = X; a.XB = p_XB; a.SSQ = p_SSQB; a.Y = p_Yb; a.TOKI = p_TOKI; a.TOKG = p_TOKG;
#pragma unroll
                for (int e = 0; e < 8; ++e) a.ts[e] = ts[e];
                thin::combine(a, vcu, G);
            }
            SEAM(pb + 8);
        }
        if (EN(13) && IN(pb + 9)) {
            SITE_WS
            pg8::Gemm g{p_XB, p_W_PG + (size_t)L * 1024 * 1024, M, 1024, 1024, 1024}; pg8::StaticOrder S; S.init(M, 1024, G, (int)blockIdx.x);
            if (L == 0) { pg8::EpiPle<false> E{X, p_XB, p_SSQB, p_SSQA, p_PPb}; pg8::gemm_phase<pg8::EpiPle<false>, pg8::StaticOrder, true, true>(ring, g, S, E); }
            else { pg8::EpiPle<true> E{X, p_XB, p_SSQB, p_SSQA, p_PPb + (size_t)M * 1024}; pg8::gemm_phase<pg8::EpiPle<true>, pg8::StaticOrder, true, true>(ring, g, S, E); }
        }
        if (L == 0) {
            SEAM(pb + 9);
            if (EN(7) && IN(pb + 10)) {
                SITE_WS
                thin::quant_act<true>(p_XB, p_SSQA, (unsigned char*)(wsl + WS_X8), (float*)(wsl + WS_RS1), p_WG + 8192, in[6] + 8, p_GATE, vcu, G);
            }
            SEAM(pb + 10);
        }
    }
#undef IN
#undef SEAM
#undef EN
#undef SITE_WS
#undef p_XB
#undef p_PB
#undef p_PPb
#undef p_SSQA
#undef p_SSQB
#undef p_GATE
#undef p_RSG
#undef p_WG
#undef p_WR
#undef p_PROJ
#undef p_MQ
#undef p_MK
#undef p_AQ
#undef p_AK
#undef p_HM
#undef p_HA
#undef p_HP
#undef p_ZB
#undef p_XG
#undef p_Yb
#undef p_ACT
#undef p_TOKI
#undef p_TOKG
#undef p_W_IN
#undef p_W_BR
#undef p_W_OUT
#undef p_W_GU0
#undef p_W_DN0
#undef p_W_GU1
#undef p_W_DN1
#undef p_W_PG
#undef p_W_PP

}

constexpr int N_PHASES = 24;
extern "C" void kernel_launch(void* const* d_in, const int* in_sizes, int n_in, void* d_out, int out_size, void* d_ws, size_t ws_size, hipStream_t stream) {
    static int grid = 0;
    if (grid == 0) {
        if (n_in != 26 || out_size != M * 1024 || ws_size < WS_END) { fprintf(stderr, "kernel_launch: unexpected shapes (n_in %d out %d ws %zu need %zu)\n", n_in, out_size, ws_size, (size_t)WS_END); grid = -1; return; }
        int dev = 0, cus = 0, per_cu = 0;
        if (hipGetDevice(&dev) != hipSuccess || hipDeviceGetAttribute(&cus, hipDeviceAttributeMultiprocessorCount, dev) != hipSuccess) { grid = -1; return; }
        if (hipFuncSetAttribute((const void*)fwd_kernel, hipFuncAttributeMaxDynamicSharedMemorySize, LDS_BYTES) != hipSuccess) { fprintf(stderr, "kernel_launch: hipFuncSetAttribute failed\n"); grid = -1; return; }
        if (hipOccupancyMaxActiveBlocksPerMultiprocessor(&per_cu, (const void*)fwd_kernel, NWAVES * 64, LDS_BYTES) != hipSuccess || per_cu < 1) { fprintf(stderr, "kernel_launch: occupancy query says %d blocks per CU\n", per_cu); }
        (void)hipGetLastError();
        grid = cus;
    }
    if (grid < 0) return;
    if (hipMemsetAsync((char*)d_ws + WS_CTL, 0, CTL_ZERO_BYTES, stream) != hipSuccess) return;
    Args a{};
    for (int i = 0; i < 26; ++i) a.in[i] = (const float*)d_in[i];
    a.out = (float*)d_out; a.ws = (unsigned char*)d_ws;
#if N_LAUNCH_PER_PHASE
    for (int ph = 0; ph < N_PHASES; ++ph) { if (ph == 1 || ph == 10 || ph == 23) continue;
        a.ph_lo = ph; a.ph_hi = ph + 1; hipLaunchKernelGGL(fwd_kernel, dim3(grid), dim3(NWAVES * 64), LDS_BYTES, stream, a); }
#else
    a.ph_lo = 0; a.ph_hi = N_PHASES;
    hipLaunchKernelGGL(fwd_kernel, dim3(grid), dim3(NWAVES * 64), LDS_BYTES, stream, a);
#endif
    const hipError_t le = hipPeekAtLastError();
    if (le != hipSuccess) fprintf(stderr, "kernel_launch: launch failed: %s\n", hipGetErrorName(le));
}
```

```cpp
#include <hip/hip_runtime.h>
#include <cstdio>
#include <cstdint>
#include <cmath>
#define N_LAUNCH_PER_PHASE 0
namespace pg8 {
#define PG8_LAS __attribute__((address_space(3)))
typedef unsigned short bf16_t;
typedef short bf16x8 __attribute__((ext_vector_type(8)));
typedef float f32x4 __attribute__((ext_vector_type(4)));
typedef unsigned u32x4 __attribute__((ext_vector_type(4)));
constexpr int BM = 256, BK = 64, HALF = 128, HTB = HALF * BK * 2  , STAGE_BYTES = 8 * HTB, NXCD = 8, WGM = 8;

__host__ __device__ __forceinline__ int lds_byte(int r, int c) { const int st = (r >> 4) * 2 + (c >> 5), rr = r & 15, cc = c & 31, ob = rr * 64 + cc * 2; return st * 1024 + (ob ^ (((ob >> 9) & 1) << 5)); }
__host__ __device__ __forceinline__ void stage_rc(int b, int& R, int& C) { const int st = b / 1024, sb = b % 1024, swz = sb ^ (((sb >> 9) & 1) << 5); R = (st >> 1) * 16 + swz / 64; C = (st & 1) * 32 + (swz % 64) / 2; }
__host__ __device__ __forceinline__ int perm32(int rho) { const int n = rho >> 4, i = rho & 15; return 8 * (i >> 2) + 4 * n + (i & 3); }

struct Unit { int pm, pn, ko; };
struct Gemm { const bf16_t* A; const bf16_t* Bt; int M, N, K, ld; };

struct StaticOrder {
    int nM, nN, nwg, G, c;
    __host__ __device__ void init(int M, int N, int G_, int c_) { nM = M / BM; nN = N / BM; nwg = nM * nN; G = G_; c = c_; }
    __host__ __device__ bool next(int i, Unit& u) const {
        const long L = (long)i * G + c; if (L >= nwg) return false;
        int wgid = (int)L; { const int q = nwg / NXCD, r = nwg % NXCD, xcd = wgid % NXCD, off = wgid / NXCD; wgid = (xcd < r ? xcd * (q + 1) : r * (q + 1) + (xcd - r) * q) + off; }
        const int nig = WGM * nN, gid = wgid / nig, fm = gid * WGM, gsz = (nM - fm) < WGM ? (nM - fm) : WGM;
        u.pm = fm + ((wgid % nig) % gsz); u.pn = (wgid % nig) / gsz; u.ko = 0; return true;
    }
    __device__ __forceinline__ void a_ready(const Unit&) const {}
    __device__ __forceinline__ void done(const Unit&) const {}
};
__device__ __forceinline__ unsigned cvt_pk_bf16(float lo, float hi) { unsigned r; asm volatile("v_cvt_pk_bf16_f32 %0, %1, %2" : "=v"(r) : "v"(lo), "v"(hi)); return r; }
typedef float f32x2 __attribute__((ext_vector_type(2)));
typedef int i32x4 __attribute__((ext_vector_type(4)));
template <class E> struct EpiTraits { static constexpr bool CHAIN = false; };
template <bool I8> struct AccOf { typedef f32x4 type; };
template <> struct AccOf<true> { typedef i32x4 type; };
__device__ __forceinline__ f32x4 mma16(bf16x8 a, bf16x8 b, f32x4 c) { return __builtin_amdgcn_mfma_f32_16x16x32_bf16(a, b, c, 0, 0, 0); }
__device__ __forceinline__ i32x4 mma16(bf16x8 a, bf16x8 b, i32x4 c) { return __builtin_amdgcn_mfma_i32_16x16x64_i8(__builtin_bit_cast(i32x4, a), __builtin_bit_cast(i32x4, b), c, 0, 0, 0); }
template <class Epi, class Sched, bool ALIGN_EPI = false, bool SP2 = false>
__device__ __forceinline__ void gemm_phase(PG8_LAS unsigned char* lds, const Gemm g, const Sched& S, const Epi& E) {
    int tid_o = threadIdx.x; asm volatile("" : "+v"(tid_o));
    const int tid = tid_o, wid = __builtin_amdgcn_readfirstlane(tid >> 6), lane = tid & 63, wr = wid >> 2, wc = wid & 3, fr = lane & 15, fq = lane >> 4;
    const int K = g.ld, nt = g.K / BK;
    unsigned voffA[2], voffB[2];
#pragma unroll
    for (int i = 0; i < 2; ++i) { int R, C; stage_rc(tid * 16 + i * 8192, R, C); const int Rb = Epi::PERM ? ((R & ~31) + perm32(R & 31)) : R;
        voffA[i] = (unsigned)(R * K + C) * 2u; voffB[i] = (unsigned)(Rb * K + C) * 2u; }
    const size_t kstep = (size_t)(BK * 2);
    const size_t hstep = (size_t)HALF * K * 2;
    const size_t tstep = 2 * hstep;
    const unsigned ldsw = (unsigned)wid * 1024u;
    const int aoff = lds_byte(wr * 64 + fr, fq * 8), boff = lds_byte(wc * 32 + fr, fq * 8);
#define PG8_SA(b, h) (((b) * 2 + (h)) * HTB)
#define PG8_SB(b, h) ((4 + (b) * 2 + (h)) * HTB)
#define PG8_STAGE(bufoff, gbase, voff) do { _Pragma("unroll") for (int _i = 0; _i < 2; ++_i) \
        __builtin_amdgcn_global_load_lds((const unsigned*)((const char*)(gbase) + (voff)[_i]), (PG8_LAS unsigned*)(lds + (bufoff) + ldsw + _i * 8192), 16, 0, 0); } while (0)
#define PG8_LDA(dst, b, h) do { _Pragma("unroll") for (int m = 0; m < 4; ++m) _Pragma("unroll") for (int k = 0; k < 2; ++k) dst[m][k] = *(const PG8_LAS bf16x8*)(lds + PG8_SA(b, h) + aoff + m * 2048 + k * 1024); } while (0)
#define PG8_LDB(dst, b, h) do { _Pragma("unroll") for (int n = 0; n < 2; ++n) _Pragma("unroll") for (int k = 0; k < 2; ++k) dst[n][k] = *(const PG8_LAS bf16x8*)(lds + PG8_SB(b, h) + boff + n * 2048 + k * 1024); } while (0)
#define PG8_MMA(ai, bj, At, Bt) do { __builtin_amdgcn_s_setprio(1); _Pragma("unroll") for (int m = 0; m < 4; ++m) _Pragma("unroll") for (int n = 0; n < 2; ++n) _Pragma("unroll") for (int k = 0; k < 2; ++k) \
        acc[ai][bj][m][n] = mma16(Bt[n][k], At[m][k], acc[ai][bj][m][n]); __builtin_amdgcn_s_setprio(0); } while (0)
#define PG8_WAIT_V(n) asm volatile("s_waitcnt vmcnt(" #n ")" ::: "memory")
#define PG8_WAIT_L(n) asm volatile("s_waitcnt lgkmcnt(" #n ")" ::: "memory")
#define PG8_BAR __builtin_amdgcn_s_barrier()
#define PG8_SCHED __builtin_amdgcn_sched_barrier(0)
    Unit cur, nxt; int ui = 0;
    if (!S.next(0, cur)) return;
    typedef typename AccOf<Epi::I8>::type acc_t;
    acc_t acc[2][2][4][2];
#pragma unroll
    for (int a = 0; a < 2; ++a)
#pragma unroll
        for (int b = 0; b < 2; ++b)
#pragma unroll
            for (int m = 0; m < 4; ++m)
#pragma unroll
                for (int n = 0; n < 2; ++n) acc[a][b][m][n] = (acc_t){0, 0, 0, 0};
    bf16x8 At[4][2], B0[2][2], B1[2][2];
    const char* cA = (const char*)g.A + (size_t)cur.pm * tstep + (size_t)cur.ko * 2; const char* cB = (const char*)g.Bt + (size_t)cur.pn * tstep + (size_t)cur.ko * 2;
    S.a_ready(cur);
    if constexpr (SP2) {
        PG8_STAGE(PG8_SB(0, 0), cB, voffB); PG8_STAGE(PG8_SB(0, 1), cB + hstep, voffB); PG8_STAGE(PG8_SA(0, 0), cA, voffA); PG8_STAGE(PG8_SA(0, 1), cA + hstep, voffA);
        if (wr == 1) PG8_BAR;
        PG8_WAIT_V(2); PG8_BAR;
        PG8_STAGE(PG8_SB(1, 0), cB + kstep, voffB); PG8_STAGE(PG8_SA(1, 0), cA + kstep, voffA); PG8_STAGE(PG8_SB(1, 1), cB + hstep + kstep, voffB);
        PG8_WAIT_V(6); PG8_BAR;
    } else {
        PG8_STAGE(PG8_SB(0, 0), cB, voffB); PG8_STAGE(PG8_SA(0, 0), cA, voffA); PG8_STAGE(PG8_SB(0, 1), cB + hstep, voffB); PG8_STAGE(PG8_SA(0, 1), cA + hstep, voffA);
        if (wr == 1) PG8_BAR;
        PG8_WAIT_V(4); PG8_BAR;
        PG8_STAGE(PG8_SB(1, 0), cB + kstep, voffB); PG8_STAGE(PG8_SA(1, 0), cA + kstep, voffA); PG8_STAGE(PG8_SB(1, 1), cB + hstep + kstep, voffB);
        PG8_WAIT_V(6); PG8_BAR;
    }
    for (;;) {
        const bool has_next = S.next(ui + 1, nxt);
        const char* nA = has_next ? (const char*)g.A + (size_t)nxt.pm * tstep + (size_t)nxt.ko * 2 : cA; const char* nB = has_next ? (const char*)g.Bt + (size_t)nxt.pn * tstep + (size_t)nxt.ko * 2 : cB;
#pragma unroll 1
        for (int t = 0; t < nt; t += 2) {
            const bool last = (t == nt - 2);
            const char* a1 = cA + (size_t)(t + 1) * kstep;
            const char* a2 = last ? nA : cA + (size_t)(t + 2) * kstep; const char* b2 = last ? nB : cB + (size_t)(t + 2) * kstep;
            const char* a3 = a2 + kstep; const char* b3 = b2 + kstep;
            if (last && has_next) S.a_ready(nxt);
            if constexpr (SP2) {
            PG8_LDB(B0, 0, 0); PG8_LDB(B1, 0, 1); PG8_SCHED; PG8_LDA(At, 0, 0); PG8_STAGE(PG8_SA(1, 1), a1 + hstep, voffA);
            PG8_WAIT_V(8); PG8_WAIT_L(0); PG8_BAR; PG8_MMA(0, 0, At, B0); PG8_MMA(0, 1, At, B1); PG8_BAR; PG8_SCHED;
            PG8_LDA(At, 0, 1); PG8_STAGE(PG8_SB(0, 0), b2, voffB); PG8_STAGE(PG8_SB(0, 1), b2 + hstep, voffB); PG8_STAGE(PG8_SA(0, 0), a2, voffA);
            PG8_WAIT_V(8); PG8_WAIT_L(0); PG8_BAR; PG8_MMA(1, 0, At, B0); PG8_MMA(1, 1, At, B1); PG8_BAR; PG8_SCHED;
            PG8_LDB(B0, 1, 0); PG8_LDB(B1, 1, 1); PG8_SCHED; PG8_LDA(At, 1, 0); PG8_STAGE(PG8_SA(0, 1), a2 + hstep, voffA);
            PG8_WAIT_V(8); PG8_WAIT_L(0); PG8_BAR; PG8_MMA(0, 0, At, B0); PG8_MMA(0, 1, At, B1); PG8_BAR; PG8_SCHED;
            PG8_LDA(At, 1, 1); PG8_STAGE(PG8_SB(1, 0), b3, voffB); PG8_STAGE(PG8_SB(1, 1), b3 + hstep, voffB); PG8_STAGE(PG8_SA(1, 0), a3, voffA);
            PG8_WAIT_V(8); PG8_WAIT_L(0); PG8_BAR; PG8_MMA(1, 0, At, B0); PG8_MMA(1, 1, At, B1); PG8_BAR; PG8_SCHED;
            } else {
            PG8_LDB(B0, 0, 0); PG8_SCHED; PG8_LDA(At, 0, 0); PG8_STAGE(PG8_SA(1, 1), a1 + hstep, voffA);
            PG8_WAIT_L(8); PG8_BAR; PG8_WAIT_L(0); PG8_MMA(0, 0, At, B0); PG8_BAR; PG8_SCHED;
            PG8_LDB(B1, 0, 1); PG8_STAGE(PG8_SB(0, 0), b2, voffB);
            PG8_BAR; PG8_WAIT_L(0); PG8_MMA(0, 1, At, B1); PG8_BAR;
            PG8_LDA(At, 0, 1); PG8_STAGE(PG8_SA(0, 0), a2, voffA);
            PG8_BAR; PG8_WAIT_L(0); PG8_MMA(1, 0, At, B0); PG8_BAR; PG8_SCHED;
            PG8_STAGE(PG8_SB(0, 1), b2 + hstep, voffB);
            PG8_WAIT_V(6); PG8_BAR; PG8_MMA(1, 1, At, B1); PG8_BAR;
            PG8_LDB(B0, 1, 0); PG8_SCHED; PG8_LDA(At, 1, 0); PG8_STAGE(PG8_SA(0, 1), a2 + hstep, voffA);
            PG8_WAIT_L(8); PG8_BAR; PG8_WAIT_L(0); PG8_MMA(0, 0, At, B0); PG8_BAR; PG8_SCHED;
            PG8_LDB(B1, 1, 1); PG8_STAGE(PG8_SB(1, 0), b3, voffB);
            PG8_BAR; PG8_WAIT_L(0); PG8_MMA(0, 1, At, B1); PG8_BAR;
            PG8_LDA(At, 1, 1); PG8_STAGE(PG8_SA(1, 0), a3, voffA);
            PG8_BAR; PG8_WAIT_L(0); PG8_MMA(1, 0, At, B0); PG8_BAR; PG8_SCHED;
            PG8_STAGE(PG8_SB(1, 1), b3 + hstep, voffB);
            PG8_WAIT_V(6); PG8_BAR; PG8_MMA(1, 1, At, B1); PG8_BAR;
            }
        }
        if constexpr (ALIGN_EPI) { if (wr == 0) PG8_BAR; }
        if constexpr (EpiTraits<Epi>::CHAIN) { E.chain(acc, cur, wr, wc, fr, fq); S.done(cur); } else
        if constexpr (!Epi::AFTER_DRAIN) { E(acc, cur, wr, wc, fr, fq); S.done(cur); }
        if (!has_next) break;
        bool zero_acc = true; if constexpr (EpiTraits<Epi>::CHAIN) zero_acc = E.last(cur);
        if (zero_acc) {
#pragma unroll
        for (int a = 0; a < 2; ++a)
#pragma unroll
            for (int b = 0; b < 2; ++b)
#pragma unroll
                for (int m = 0; m < 4; ++m)
#pragma unroll
                    for (int n = 0; n < 2; ++n) acc[a][b][m][n] = (acc_t){0, 0, 0, 0};
        }
        cur = nxt; cA = nA; cB = nB; ++ui;
        if constexpr (ALIGN_EPI) { if (wr == 1) PG8_BAR; }
    }
    PG8_WAIT_V(0);
    if constexpr (!ALIGN_EPI) { if (wr == 0) PG8_BAR; }
    PG8_BAR;
    if constexpr (Epi::AFTER_DRAIN) { E.fused(acc, cur, wr, wc, fr, fq, lds, wid, lane); S.done(cur); }
#undef PG8_SA
#undef PG8_SB
#undef PG8_STAGE
#undef PG8_LDA
#undef PG8_LDB
#undef PG8_MMA
#undef PG8_WAIT_V
#undef PG8_WAIT_L
#undef PG8_BAR
#undef PG8_SCHED
}
}
namespace pg8 {
constexpr float kLog2e = 1.4426950408889634f;
__device__ __forceinline__ float fsigmoid(float x) { return __builtin_amdgcn_rcpf(1.f + __builtin_amdgcn_exp2f(-kLog2e * x)); }
__device__ __forceinline__ u32x4 pack8(const f32x4& a, const f32x4& b) { u32x4 w; w.x = cvt_pk_bf16(a[0], a[1]); w.y = cvt_pk_bf16(a[2], a[3]); w.z = cvt_pk_bf16(b[0], b[1]); w.w = cvt_pk_bf16(b[2], b[3]); return w; }
__device__ __forceinline__ void unpack8(const u32x4& w, f32x4& a, f32x4& b) {
    a[0] = __builtin_bit_cast(float, w.x << 16); a[1] = __builtin_bit_cast(float, w.x & 0xffff0000u); a[2] = __builtin_bit_cast(float, w.y << 16); a[3] = __builtin_bit_cast(float, w.y & 0xffff0000u);
    b[0] = __builtin_bit_cast(float, w.z << 16); b[1] = __builtin_bit_cast(float, w.z & 0xffff0000u); b[2] = __builtin_bit_cast(float, w.w << 16); b[3] = __builtin_bit_cast(float, w.w & 0xffff0000u);
}
__device__ __forceinline__ float row_rstd(const float* ssq, int row) {
    const f32x4* p = (const f32x4*)(ssq + (size_t)row * 16); const f32x4 a = p[0], b = p[1], c = p[2], d = p[3];
    const float s = ((a[0] + a[1]) + (a[2] + a[3])) + ((b[0] + b[1]) + (b[2] + b[3])) + ((c[0] + c[1]) + (c[2] + c[3])) + ((d[0] + d[1]) + (d[2] + d[3]));
    return __builtin_amdgcn_rsqf(s * (1.f / 1024.f) + 1e-6f);
}
__device__ __forceinline__ float sumsq8(const f32x4& a, const f32x4& b) { return (a[0] * a[0] + a[1] * a[1]) + (a[2] * a[2] + a[3] * a[3]) + (b[0] * b[0] + b[1] * b[1]) + (b[2] * b[2] + b[3] * b[3]); }
__device__ __forceinline__ float quad_sum_fq(float s) { s += __shfl_xor(s, 16); s += __shfl_xor(s, 32); return s; }

struct EpiProj {
    static constexpr bool PERM = true, AFTER_DRAIN = false, I8 = false;
    bf16_t* O; const float* ssq;
    __device__ __forceinline__ void operator()(const f32x4 (&acc)[2][2][4][2], const Unit& u, int wr, int wc, int fr, int fq) const {
        const bool sg = (u.pn == 6) || (u.pn == 7) || (u.pn >= 16);
        const int row0 = u.pm * BM + wr * 64 + fr, col0 = u.pn * BM + wc * 32 + 8 * fq;
#pragma unroll
        for (int ai = 0; ai < 2; ++ai)
#pragma unroll
            for (int m = 0; m < 4; ++m) { const int row = row0 + ai * HALF + m * 16; const float r = row_rstd(ssq, row); bf16_t* rowp = O + (size_t)row * 7168 + col0;
#pragma unroll
                for (int bj = 0; bj < 2; ++bj) { f32x4 v0 = acc[ai][bj][m][0] * r, v1 = acc[ai][bj][m][1] * r;
                    if (sg) {
#pragma unroll
                        for (int j = 0; j < 4; ++j) { v0[j] = fsigmoid(v0[j]); v1[j] = fsigmoid(v1[j]); } }
                    *(u32x4*)(rowp + bj * HALF) = pack8(v0, v1); } }
    }
};
struct EpiPlain {
    static constexpr bool PERM = true, AFTER_DRAIN = false, I8 = false;
    bf16_t* O;
    __device__ __forceinline__ void operator()(const f32x4 (&acc)[2][2][4][2], const Unit& u, int wr, int wc, int fr, int fq) const {
        const int row0 = u.pm * BM + wr * 64 + fr, col0 = u.pn * BM + wc * 32 + 8 * fq;
#pragma unroll
        for (int ai = 0; ai < 2; ++ai)
#pragma unroll
            for (int m = 0; m < 4; ++m) { bf16_t* rowp = O + (size_t)(row0 + ai * HALF + m * 16) * 1024 + col0;
#pragma unroll
                for (int bj = 0; bj < 2; ++bj) *(u32x4*)(rowp + bj * HALF) = pack8(acc[ai][bj][m][0], acc[ai][bj][m][1]); }
    }
};
template <int R> struct EpiZ {
    static constexpr bool PERM = true, AFTER_DRAIN = false, I8 = false;
    float* ZF; bf16_t* ZB; const bf16_t* PROJ;
    __device__ __forceinline__ void operator()(const f32x4 (&acc)[2][2][4][2], const Unit& u, int wr, int wc, int fr, int fq) const {
        const int row0 = u.pm * BM + wr * 64 + fr, col0 = u.pn * BM + wc * 32 + 8 * fq;
#pragma unroll
        for (int ai = 0; ai < 2; ++ai)
#pragma unroll
            for (int m = 0; m < 4; ++m) { const size_t row = (size_t)(row0 + ai * HALF + m * 16);
#pragma unroll
                for (int bj = 0; bj < 2; ++bj) { const int col = col0 + bj * HALF;
                    f32x4 g0, g1; unpack8(*(const u32x4*)(PROJ + row * 7168 + 4096 + R * 1024 + col), g0, g1);
                    f32x4 v0 = acc[ai][bj][m][0] * g0, v1 = acc[ai][bj][m][1] * g1; float* zp = ZF + row * 1024 + col;
                    if (R > 0) { v0 = v0 + *(const f32x4*)zp; v1 = v1 + *(const f32x4*)(zp + 4); }
                    if (R < 2) { *(f32x4*)zp = v0; *(f32x4*)(zp + 4) = v1; } else *(u32x4*)(ZB + row * 1024 + col) = pack8(v0, v1); } }
    }
};
struct EpiRes {
    static constexpr bool PERM = true, AFTER_DRAIN = false, I8 = false;
    bf16_t* XB; float* ssq;
    __device__ __forceinline__ void operator()(const f32x4 (&acc)[2][2][4][2], const Unit& u, int wr, int wc, int fr, int fq) const {
        const int row0 = u.pm * BM + wr * 64 + fr, col0 = u.pn * BM + wc * 32 + 8 * fq;
        bf16_t* const xb0 = XB + (size_t)row0 * 1024 + col0;
        u32x4 xin[2][4][2];
#pragma unroll
        for (int ai = 0; ai < 2; ++ai)
#pragma unroll
            for (int m = 0; m < 4; ++m)
#pragma unroll
                for (int bj = 0; bj < 2; ++bj) xin[ai][m][bj] = *(const u32x4*)(xb0 + (size_t)(ai * HALF + m * 16) * 1024 + bj * HALF);
#pragma unroll
        for (int ai = 0; ai < 2; ++ai)
#pragma unroll
            for (int m = 0; m < 4; ++m) { const size_t row = (size_t)(row0 + ai * HALF + m * 16); float s = 0.f;
#pragma unroll
                for (int bj = 0; bj < 2; ++bj) { f32x4 x0, x1; unpack8(xin[ai][m][bj], x0, x1);
                    const f32x4 v0 = x0 + acc[ai][bj][m][0], v1 = x1 + acc[ai][bj][m][1];
                    *(u32x4*)(xb0 + (size_t)(ai * HALF + m * 16) * 1024 + bj * HALF) = pack8(v0, v1); s += sumsq8(v0, v1); }
                s = quad_sum_fq(s); if (fq == 0) ssq[row * 16 + u.pn * 4 + wc] = s; }
    }
};
template <bool LAST> struct EpiPle {
    static constexpr bool PERM = true, AFTER_DRAIN = false, I8 = false;
    float* OUT; bf16_t* XB; const float* ssq_in; float* ssq_out; const bf16_t* PP;
    __device__ __forceinline__ void operator()(const f32x4 (&acc)[2][2][4][2], const Unit& u, int wr, int wc, int fr, int fq) const {
        const int row0 = u.pm * BM + wr * 64 + fr, col0 = u.pn * BM + wc * 32 + 8 * fq;
        bf16_t* const xb0 = XB + (size_t)row0 * 1024 + col0; const bf16_t* const pp0 = PP + (size_t)row0 * 1024 + col0;
        float rs[2][4];
        { f32x4 sq[2][4];
#pragma unroll
          for (int ai = 0; ai < 2; ++ai)
#pragma unroll
              for (int m = 0; m < 4; ++m) sq[ai][m] = *(const f32x4*)(ssq_in + (size_t)(row0 + ai * HALF + m * 16) * 16 + 4 * fq);
#pragma unroll
          for (int ai = 0; ai < 2; ++ai)
#pragma unroll
              for (int m = 0; m < 4; ++m) rs[ai][m] = __builtin_amdgcn_rsqf(quad_sum_fq((sq[ai][m][0] + sq[ai][m][1]) + (sq[ai][m][2] + sq[ai][m][3])) * (1.f / 1024.f) + 1e-6f); }
        constexpr int MB = 2;
#pragma unroll
        for (int ai = 0; ai < 2; ++ai)
#pragma unroll
          for (int mb = 0; mb < 4; mb += MB) {
            u32x4 xin[MB][2], pin[MB][2];
#pragma unroll
            for (int mm = 0; mm < MB; ++mm)
#pragma unroll
                for (int bj = 0; bj < 2; ++bj) { xin[mm][bj] = *(const u32x4*)(xb0 + (size_t)(ai * HALF + (mb + mm) * 16) * 1024 + bj * HALF); pin[mm][bj] = *(const u32x4*)(pp0 + (size_t)(ai * HALF + (mb + mm) * 16) * 1024 + bj * HALF); }
#pragma unroll
            for (int mm = 0; mm < MB; ++mm) { const int m = mb + mm; const size_t row = (size_t)(row0 + ai * HALF + m * 16); const float r = rs[ai][m]; float s = 0.f;
#pragma unroll
                for (int bj = 0; bj < 2; ++bj) { f32x4 x0, x1; unpack8(xin[mm][bj], x0, x1);
                    f32x4 p0, p1; unpack8(pin[mm][bj], p0, p1);
                    f32x4 v0 = acc[ai][bj][m][0] * r, v1 = acc[ai][bj][m][1] * r;
#pragma unroll
                    for (int j = 0; j < 4; ++j) { v0[j] = fsigmoid(v0[j]) * p0[j]; v1[j] = fsigmoid(v1[j]) * p1[j]; }
                    v0 = v0 + x0; v1 = v1 + x1;
                    if (LAST) { float* op = OUT + row * 1024 + col0 + bj * HALF; *(f32x4*)op = v0; *(f32x4*)(op + 4) = v1; }
                    else { *(u32x4*)(xb0 + (size_t)(ai * HALF + m * 16) * 1024 + bj * HALF) = pack8(v0, v1); s += sumsq8(v0, v1); } }
                if (!LAST) { s = quad_sum_fq(s); if (fq == 0) ssq_out[row * 16 + u.pn * 4 + wc] = s; } }
          }
    }
};
template <bool MOE> struct EpiUp {
    static constexpr bool PERM = true, AFTER_DRAIN = false, I8 = false;
    bf16_t* ACT; int F; const float* rs; int ts0, ts1, ts2, ts3, ts4, ts5, ts6, ts7;
    __device__ __forceinline__ void operator()(const f32x4 (&acc)[2][2][4][2], const Unit& u, int wr, int wc, int fr, int fq) const {
        int pnl = u.pn, otile = u.pm;
        if (MOE) { const int e = u.pm >> 6, rt = u.pm & 63; pnl = u.pn - e * 28;
            const int tse = e == 0 ? ts0 : e == 1 ? ts1 : e == 2 ? ts2 : e == 3 ? ts3 : e == 4 ? ts4 : e == 5 ? ts5 : e == 6 ? ts6 : ts7; otile = tse + rt; }
        const int lrow0 = wr * 64 + fr, col0 = pnl * 128 + wc * 32 + 8 * fq;
#pragma unroll
        for (int ai = 0; ai < 2; ++ai)
#pragma unroll
            for (int m = 0; m < 4; ++m) { const int lrow = lrow0 + ai * HALF + m * 16;
                const float r = MOE ? rs[(size_t)u.pm * BM + lrow] : row_rstd(rs, u.pm * BM + lrow);
                f32x4 g0 = acc[ai][0][m][0] * r, g1 = acc[ai][0][m][1] * r, u0 = acc[ai][1][m][0] * r, u1 = acc[ai][1][m][1] * r;
#pragma unroll
                for (int j = 0; j < 4; ++j) { g0[j] = g0[j] * fsigmoid(g0[j]) * u0[j]; g1[j] = g1[j] * fsigmoid(g1[j]) * u1[j]; }
                *(u32x4*)(ACT + (size_t)(otile * BM + lrow) * F + col0) = pack8(g0, g1); }
    }
};
struct EpiDownMoe {
    static constexpr bool PERM = true, AFTER_DRAIN = false, I8 = false;
    bf16_t* Y; bf16_t* Yx; int klen;
    __device__ __forceinline__ void operator()(const f32x4 (&acc)[2][2][4][2], const Unit& u, int wr, int wc, int fr, int fq) const {
        bf16_t* Y = this->Y; if (u.ko) { const int s = u.ko / klen; Y = Yx + ((size_t)(s - 1) * 2048 - 32768) * 1024; }
        const int row0 = u.pm * BM + wr * 64 + fr, col0 = (u.pn & 3) * BM + wc * 32 + 8 * fq;
#pragma unroll
        for (int ai = 0; ai < 2; ++ai)
#pragma unroll
            for (int m = 0; m < 4; ++m) { bf16_t* rowp = Y + (size_t)(row0 + ai * HALF + m * 16) * 1024 + col0;
#pragma unroll
                for (int bj = 0; bj < 2; ++bj) *(u32x4*)(rowp + bj * HALF) = pack8(acc[ai][bj][m][0], acc[ai][bj][m][1]); }
    }
};
template <bool UP, int KSPLIT = 1, int KLEN = 0> struct MoeOrder {
    int R, nN, nwg, G, c; int ts0, ts1, ts2, ts3, ts4, ts5, ts6, ts7; int pm0;
    __device__ __forceinline__ bool next(int i, Unit& u) const {
        const long L = (long)i * G + c; if (L >= nwg) return false;
        const int ks = (int)(L % KSPLIT); u.ko = ks * KLEN;
        int wgid = (int)(L / KSPLIT); const int nwg = this->nwg / KSPLIT; { const int q = nwg / NXCD, r = nwg % NXCD, xcd = wgid % NXCD, off = wgid / NXCD; wgid = (xcd < r ? xcd * (q + 1) : r * (q + 1) + (xcd - r) * q) + off; }
        const int nig = WGM * nN, gid = wgid / nig, fm = gid * WGM, gsz = (R - fm) < WGM ? (R - fm) : WGM;
        const int pmc = pm0 + fm + ((wgid % nig) % gsz), pnl = (wgid % nig) / gsz;
        const int e = (pmc >= ts1) + (pmc >= ts2) + (pmc >= ts3) + (pmc >= ts4) + (pmc >= ts5) + (pmc >= ts6) + (pmc >= ts7);
        const int tse = e == 0 ? ts0 : e == 1 ? ts1 : e == 2 ? ts2 : e == 3 ? ts3 : e == 4 ? ts4 : e == 5 ? ts5 : e == 6 ? ts6 : ts7;
        if (UP) { u.pm = e * 64 + (pmc - tse); u.pn = e * 28 + pnl; } else { u.pm = pmc; u.pn = e * 4 + pnl; }
        return true;
    }
    __device__ __forceinline__ void a_ready(const Unit&) const {}
    __device__ __forceinline__ void done(const Unit&) const {}
};
struct EpiZs {
    static constexpr bool PERM = true, AFTER_DRAIN = false, I8 = false;
    bf16_t* ZB; const unsigned char* G8;
    __device__ __forceinline__ bool last(const Unit& u) const { return (u.pm >> 6) == 2; }
    __device__ __forceinline__ void operator()(const f32x4 (&acc)[2][2][4][2], const Unit& u, int wr, int wc, int fr, int fq) const {}
    __device__ __forceinline__ void chain(f32x4 (&acc)[2][2][4][2], const Unit& u, int wr, int wc, int fr, int fq) const {
        typedef unsigned u32x2 __attribute__((ext_vector_type(2)));
        const int r = u.pm >> 6, pm = u.pm & 63, pn = u.pn & 3;
        const int row0 = pm * BM + wr * 64 + fr, col0 = pn * BM + wc * 32 + 8 * fq;
        const unsigned char* const g0p = G8 + (size_t)row0 * 3072 + r * 1024 + col0;
        if (r < 2) {
#pragma unroll
            for (int ai = 0; ai < 2; ++ai) {
                u32x2 ga[4][2], gb[4][2];
#pragma unroll
                for (int m = 0; m < 4; ++m)
#pragma unroll
                    for (int bj = 0; bj < 2; ++bj) { const unsigned char* p = g0p + (size_t)(ai * HALF + m * 16) * 3072 + bj * HALF; ga[m][bj] = *(const u32x2*)p; gb[m][bj] = *(const u32x2*)(p + 1024); }
#pragma unroll
                for (int m = 0; m < 4; ++m)
#pragma unroll
                    for (int bj = 0; bj < 2; ++bj)
#pragma unroll
                        for (int j = 0; j < 4; ++j) {
                            acc[ai][bj][m][0][j] *= (float)((ga[m][bj].x >> (8 * j)) & 0xffu) * __builtin_amdgcn_rcpf((float)((gb[m][bj].x >> (8 * j)) & 0xffu));
                            acc[ai][bj][m][1][j] *= (float)((ga[m][bj].y >> (8 * j)) & 0xffu) * __builtin_amdgcn_rcpf((float)((gb[m][bj].y >> (8 * j)) & 0xffu)); }
            }
        } else {
            bf16_t* const zb0 = ZB + (size_t)row0 * 1024 + col0;
            u32x2 gw[2][4][2];
#pragma unroll
            for (int ai = 0; ai < 2; ++ai)
#pragma unroll
                for (int m = 0; m < 4; ++m)
#pragma unroll
                    for (int bj = 0; bj < 2; ++bj) gw[ai][m][bj] = *(const u32x2*)(g0p + (size_t)(ai * HALF + m * 16) * 3072 + bj * HALF);
#pragma unroll
            for (int ai = 0; ai < 2; ++ai)
#pragma unroll
                for (int m = 0; m < 4; ++m)
#pragma unroll
                    for (int bj = 0; bj < 2; ++bj) { const u32x2 g = gw[ai][m][bj]; f32x4 g0, g1;
#pragma unroll
                        for (int j = 0; j < 4; ++j) { g0[j] = (float)((g.x >> (8 * j)) & 0xffu) * (1.f / 255.f); g1[j] = (float)((g.y >> (8 * j)) & 0xffu) * (1.f / 255.f); }
                        *(u32x4*)(zb0 + (size_t)(ai * HALF + m * 16) * 1024 + bj * HALF) = pack8(acc[ai][bj][m][0] * g0, acc[ai][bj][m][1] * g1); }
        }
    }
};
template <> struct EpiTraits<EpiZs> { static constexpr bool CHAIN = true; };
struct MergeOrder {
    StaticOrder S;
    __device__ __forceinline__ bool next(int i, Unit& u) const { const int t = i / 3, r = i - 3 * t; if (!S.next(t, u)) return false; u.pm += r * 64; u.pn += r * 4; return true; }
    __device__ __forceinline__ void a_ready(const Unit&) const {}
    __device__ __forceinline__ void done(const Unit&) const {}
};
struct PpOrder {
    StaticOrder S;
    __device__ __forceinline__ bool next(int i, Unit& u) const { if (!S.next(i, u)) return false; u.pn += (u.pm >> 6) * 4; return true; }
    __device__ __forceinline__ void a_ready(const Unit&) const {}
    __device__ __forceinline__ void done(const Unit&) const {}
};
struct EpiPP {
    static constexpr bool PERM = true, AFTER_DRAIN = false, I8 = false;
    bf16_t* Y;
    __device__ __forceinline__ void operator()(const f32x4 (&acc)[2][2][4][2], const Unit& u, int wr, int wc, int fr, int fq) const {
        const int row0 = u.pm * BM + wr * 64 + fr, col0 = (u.pn & 3) * BM + wc * 32 + 8 * fq;
#pragma unroll
        for (int ai = 0; ai < 2; ++ai)
#pragma unroll
            for (int m = 0; m < 4; ++m) { bf16_t* rowp = Y + (size_t)(row0 + ai * HALF + m * 16) * 1024 + col0;
#pragma unroll
                for (int bj = 0; bj < 2; ++bj) *(u32x4*)(rowp + bj * HALF) = pack8(acc[ai][bj][m][0], acc[ai][bj][m][1]); }
    }
};
struct EpiUp8 {
    static constexpr bool PERM = true, AFTER_DRAIN = false, I8 = true;
    bf16_t* ACT; const float* rs; const float* sb; int ts0, ts1, ts2, ts3, ts4, ts5, ts6, ts7;
    __device__ __forceinline__ void operator()(const i32x4 (&acc)[2][2][4][2], const Unit& u, int wr, int wc, int fr, int fq) const {
        const int e = u.pm >> 6, rt = u.pm & 63, pnl = u.pn - e * 28;
        const int tse = e == 0 ? ts0 : e == 1 ? ts1 : e == 2 ? ts2 : e == 3 ? ts3 : e == 4 ? ts4 : e == 5 ? ts5 : e == 6 ? ts6 : ts7, otile = tse + rt;
        const int lrow0 = wr * 64 + fr, col0 = pnl * 128 + wc * 32 + 8 * fq;
        const float* sbp = sb + (size_t)u.pn * 256 + wc * 32 + 8 * fq;
        const f32x4 sg0 = *(const f32x4*)sbp, sg1 = *(const f32x4*)(sbp + 4), su0 = *(const f32x4*)(sbp + 128), su1 = *(const f32x4*)(sbp + 132);
        float rr[2][4];
#pragma unroll
        for (int ai = 0; ai < 2; ++ai)
#pragma unroll
            for (int m = 0; m < 4; ++m) rr[ai][m] = rs[(size_t)u.pm * BM + lrow0 + ai * HALF + m * 16];
#pragma unroll
        for (int ai = 0; ai < 2; ++ai)
#pragma unroll
            for (int m = 0; m < 4; ++m) { const int lrow = lrow0 + ai * HALF + m * 16;
                const float r = rr[ai][m];
                const f32x4 rg0 = sg0 * r, rg1 = sg1 * r, ru0 = su0 * r, ru1 = su1 * r; f32x4 g0, g1, u0, u1;
#pragma unroll
                for (int j = 0; j < 4; ++j) { g0[j] = (float)acc[ai][0][m][0][j] * rg0[j]; g1[j] = (float)acc[ai][0][m][1][j] * rg1[j]; u0[j] = (float)acc[ai][1][m][0][j] * ru0[j]; u1[j] = (float)acc[ai][1][m][1][j] * ru1[j]; }
#pragma unroll
                for (int j = 0; j < 4; ++j) { g0[j] = g0[j] * fsigmoid(g0[j]) * u0[j]; g1[j] = g1[j] * fsigmoid(g1[j]) * u1[j]; }
                *(u32x4*)(ACT + (size_t)(otile * BM + lrow) * 3584 + col0) = pack8(g0, g1); }
    }
};
struct EpiProj8 {
    static constexpr bool PERM = true, AFTER_DRAIN = false, I8 = true;
    bf16_t* O; const float* rs1; const float* sb; bf16_t* AQ; bf16_t* AK; const float* q_gain; const float* k_gain; unsigned char* G8;
    __device__ __forceinline__ void operator()(const i32x4 (&acc)[2][2][4][2], const Unit& u, int wr, int wc, int fr, int fq) const {
        const bool sg = (u.pn == 6) || (u.pn == 7);
        const bool mg = u.pn >= 16;
        const bool qk = (u.pn >= 8) && (u.pn < 12);
        const int row0 = u.pm * BM + wr * 64 + fr, col0 = u.pn * BM + wc * 32 + 8 * fq;
        f32x4 s0[2], s1[2];
#pragma unroll
        for (int bj = 0; bj < 2; ++bj) { s0[bj] = *(const f32x4*)(sb + col0 + bj * HALF); s1[bj] = *(const f32x4*)(sb + col0 + bj * HALF + 4); }
        float rr[2][4];
#pragma unroll
        for (int ai = 0; ai < 2; ++ai)
#pragma unroll
            for (int m = 0; m < 4; ++m) rr[ai][m] = rs1[row0 + ai * HALF + m * 16];
        if (qk) {
            const bool isk = u.pn >= 10; const int gidx = (u.pn - (isk ? 10 : 8)) * 4 + wc;
            const float* gp = (isk ? k_gain : q_gain) + 8 * fq; const float qs = isk ? 1.f : 0.125f * kLog2e;
            f32x4 gn[2][2];
#pragma unroll
            for (int bj = 0; bj < 2; ++bj) { gn[bj][0] = *(const f32x4*)(gp + bj * 32) * qs; gn[bj][1] = *(const f32x4*)(gp + bj * 32 + 4) * qs; }
            bf16_t* Ob = (isk ? AK : AQ) + gidx * 64 + 8 * fq;
#pragma unroll
            for (int ai = 0; ai < 2; ++ai)
#pragma unroll
                for (int m = 0; m < 4; ++m) { const int row = row0 + ai * HALF + m * 16; const float r = rr[ai][m]; const f32x4 r0[2] = {s0[0] * r, s0[1] * r}, r1[2] = {s1[0] * r, s1[1] * r}; f32x4 v[2][2]; float ss = 0.f;
#pragma unroll
                    for (int bj = 0; bj < 2; ++bj) {
#pragma unroll
                        for (int j = 0; j < 4; ++j) { v[bj][0][j] = (float)acc[ai][bj][m][0][j] * (r0[bj][j]); v[bj][1][j] = (float)acc[ai][bj][m][1][j] * (r1[bj][j]); }
                        ss += sumsq8(v[bj][0], v[bj][1]); }
                    ss = quad_sum_fq(ss); const float rn = __builtin_amdgcn_rsqf(ss * (1.f / 64.f) + 1e-6f);
#pragma unroll
                    for (int bj = 0; bj < 2; ++bj) *(u32x4*)(Ob + (size_t)row * 512 + bj * 32) = pack8(v[bj][0] * gn[bj][0] * rn, v[bj][1] * gn[bj][1] * rn); }
            return;
        }
        if (mg) {
            typedef unsigned u32x2 __attribute__((ext_vector_type(2)));
#pragma unroll
            for (int ai = 0; ai < 2; ++ai)
#pragma unroll
                for (int m = 0; m < 4; ++m) { const int row = row0 + ai * HALF + m * 16; const float r = rr[ai][m]; unsigned char* gp = G8 + (size_t)row * 3072 + (col0 - 4096);
#pragma unroll
                    for (int bj = 0; bj < 2; ++bj) { unsigned w[2];
#pragma unroll
                        for (int n = 0; n < 2; ++n) { const f32x4 s = (n ? s1[bj] : s0[bj]) * r; unsigned pk = 0;
#pragma unroll
                            for (int j = 0; j < 4; ++j) { const float g = fsigmoid((float)acc[ai][bj][m][n][j] * s[j]); pk |= (unsigned)fmaxf(__builtin_rintf(g * 255.f), 1.f) << (8 * j); }
                            w[n] = pk; }
                        *(u32x2*)(gp + bj * HALF) = (u32x2){w[0], w[1]}; } }
            return;
        }
#pragma unroll
        for (int ai = 0; ai < 2; ++ai)
#pragma unroll
            for (int m = 0; m < 4; ++m) { const int row = row0 + ai * HALF + m * 16; const float r = rr[ai][m]; bf16_t* rowp = O + (size_t)row * 7168 + col0;
#pragma unroll
                for (int bj = 0; bj < 2; ++bj) { f32x4 v0, v1; const f32x4 q0 = s0[bj] * r, q1 = s1[bj] * r;
#pragma unroll
                    for (int j = 0; j < 4; ++j) { v0[j] = (float)acc[ai][bj][m][0][j] * q0[j]; v1[j] = (float)acc[ai][bj][m][1][j] * q1[j]; }
                    if (sg) {
#pragma unroll
                        for (int j = 0; j < 4; ++j) { v0[j] = fsigmoid(v0[j]); v1[j] = fsigmoid(v1[j]); } }
                    *(u32x4*)(rowp + bj * HALF) = pack8(v0, v1); } }
    }
};
struct EpiUp8d {
    static constexpr bool PERM = true, AFTER_DRAIN = false, I8 = true;
    bf16_t* ACT; const float* rs1; const float* sb;
    __device__ __forceinline__ void operator()(const i32x4 (&acc)[2][2][4][2], const Unit& u, int wr, int wc, int fr, int fq) const {
        const int row0 = u.pm * BM + wr * 64 + fr, col0 = u.pn * 128 + wc * 32 + 8 * fq;
        const float* sbp = sb + (size_t)u.pn * 256 + wc * 32 + 8 * fq;
        const f32x4 sg0 = *(const f32x4*)sbp, sg1 = *(const f32x4*)(sbp + 4), su0 = *(const f32x4*)(sbp + 128), su1 = *(const f32x4*)(sbp + 132);
        float rr[2][4];
#pragma unroll
        for (int ai = 0; ai < 2; ++ai)
#pragma unroll
            for (int m = 0; m < 4; ++m) rr[ai][m] = rs1[row0 + ai * HALF + m * 16];
#pragma unroll
        for (int ai = 0; ai < 2; ++ai)
#pragma unroll
            for (int m = 0; m < 4; ++m) { const int row = row0 + ai * HALF + m * 16; const float r = rr[ai][m];
                const f32x4 rg0 = sg0 * r, rg1 = sg1 * r, ru0 = su0 * r, ru1 = su1 * r; f32x4 g0, g1, u0, u1;
#pragma unroll
                for (int j = 0; j < 4; ++j) { g0[j] = (float)acc[ai][0][m][0][j] * rg0[j]; g1[j] = (float)acc[ai][0][m][1][j] * rg1[j]; u0[j] = (float)acc[ai][1][m][0][j] * ru0[j]; u1[j] = (float)acc[ai][1][m][1][j] * ru1[j]; }
#pragma unroll
                for (int j = 0; j < 4; ++j) { g0[j] = g0[j] * fsigmoid(g0[j]) * u0[j]; g1[j] = g1[j] * fsigmoid(g1[j]) * u1[j]; }
                *(u32x4*)(ACT + (size_t)row * 2816 + col0) = pack8(g0, g1); }
    }
};
}
namespace mix {
using bf16x8 = __attribute__((ext_vector_type(8))) short;
using s16x4  = __attribute__((ext_vector_type(4))) short;
using f32x16 = __attribute__((ext_vector_type(16))) float;
using f32x4  = __attribute__((ext_vector_type(4))) float;
using u32x4  = __attribute__((ext_vector_type(4))) unsigned;
typedef unsigned short bf16_t;
constexpr int KVB = 64, SHM_T = KVB * 128 * 2;
constexpr int OFF_V = 0, OFF_K = 2 * SHM_T, OFF_WS = 4 * SHM_T, OFF_A2 = OFF_WS + 8 * 256, OFF_M2 = OFF_A2 + 8192, OFF_MT = OFF_M2 + 8192, OFF_SC = OFF_MT + 8192, OFF_Q = OFF_SC + 256, MIX_LDS = OFF_Q + 64;
constexpr float kLog2e = 1.4426950408889634f;
#define KSWZ(row, colB) ((row) * 256 + ((colB) ^ (((row) & 7) << 4)))
#define SBAR() __builtin_amdgcn_sched_barrier(0)
__device__ __forceinline__ int crow(int r, int hi) { return (r & 3) + 8 * (r >> 2) + 4 * hi; }
__device__ __forceinline__ unsigned cvtpk(float lo, float hi) { unsigned r; asm volatile("v_cvt_pk_bf16_f32 %0, %1, %2" : "=v"(r) : "v"(lo), "v"(hi)); return r; }
__device__ __forceinline__ float bf2f(unsigned short h) { return __builtin_bit_cast(float, (unsigned)h << 16); }
__device__ __forceinline__ int v_st(int k, int c) { const int kk = (k & ~0xC) | ((k & 4) << 1) | ((k & 8) >> 1); return ((kk >> 3) * 4 + (c >> 5)) * 512 + ((kk & 7) * 32 + (c & 31)) * 2; }
__device__ __forceinline__ int v_rd_base(int lane) { return ((lane & 3) << 3) | (((lane >> 2) & 3) << 6) | (((lane >> 4) & 1) << 5) | (((lane >> 5) & 1) << 8); }
constexpr int v_rd_off(int d0, int ks, int half) { return d0 * 512 + ks * 4096 + half * 2048; }
template <int OFF> __device__ __forceinline__ s16x4 tr_read(int vb) { s16x4 r; asm volatile("ds_read_b64_tr_b16 %0, %1 offset:%2" : "=&v"(r) : "v"(vb), "i"(OFF) : "memory"); return r; }
template <int D0> __device__ __forceinline__ void pv_one(f32x16& od, int vb, bf16x8 pa0, bf16x8 pa1, bf16x8 pa2, bf16x8 pa3) {
    const s16x4 l0 = tr_read<v_rd_off(D0, 0, 0)>(vb), h0 = tr_read<v_rd_off(D0, 0, 1)>(vb), l1 = tr_read<v_rd_off(D0, 1, 0)>(vb), h1 = tr_read<v_rd_off(D0, 1, 1)>(vb);
    const s16x4 l2 = tr_read<v_rd_off(D0, 2, 0)>(vb), h2 = tr_read<v_rd_off(D0, 2, 1)>(vb), l3 = tr_read<v_rd_off(D0, 3, 0)>(vb), h3 = tr_read<v_rd_off(D0, 3, 1)>(vb);
    asm volatile("s_waitcnt lgkmcnt(0)" ::: "memory"); SBAR();
#define MIX_PK(L, H) (bf16x8){L[0], L[1], L[2], L[3], H[0], H[1], H[2], H[3]}
    od = __builtin_amdgcn_mfma_f32_32x32x16_bf16(pa0, MIX_PK(l0, h0), od, 0, 0, 0);
    od = __builtin_amdgcn_mfma_f32_32x32x16_bf16(pa1, MIX_PK(l1, h1), od, 0, 0, 0);
    od = __builtin_amdgcn_mfma_f32_32x32x16_bf16(pa2, MIX_PK(l2, h2), od, 0, 0, 0);
    od = __builtin_amdgcn_mfma_f32_32x32x16_bf16(pa3, MIX_PK(l3, h3), od, 0, 0, 0);
#undef MIX_PK
}
__device__ __forceinline__ void pv_d0(f32x16* o, int vb, bf16x8 pa0, bf16x8 pa1, bf16x8 pa2, bf16x8 pa3) {
    pv_one<0>(o[0], vb, pa0, pa1, pa2, pa3); pv_one<1>(o[1], vb, pa0, pa1, pa2, pa3); pv_one<2>(o[2], vb, pa0, pa1, pa2, pa3); pv_one<3>(o[3], vb, pa0, pa1, pa2, pa3);
}
__device__ __forceinline__ float swap_max(float v) { auto rr = __builtin_amdgcn_permlane32_swap(__float_as_uint(v), __float_as_uint(v), false, false); return fmaxf(__uint_as_float(rr[0]), __uint_as_float(rr[1])); }
__device__ __forceinline__ float swap_sum(float v) { auto rr = __builtin_amdgcn_permlane32_swap(__float_as_uint(v), __float_as_uint(v), false, false); return __uint_as_float(rr[0]) + __uint_as_float(rr[1]); }
__device__ __forceinline__ void p_to_frags(const f32x16& p0, const f32x16& p1, bf16x8& pa0, bf16x8& pa1, bf16x8& pa2, bf16x8& pa3) {
#define MIX_PK4(P, BASE, OUT) do { unsigned a0 = cvtpk(P[BASE + 0], P[BASE + 1]), a1 = cvtpk(P[BASE + 2], P[BASE + 3]);   \
    unsigned b0 = cvtpk(P[BASE + 4], P[BASE + 5]), b1 = cvtpk(P[BASE + 6], P[BASE + 7]);                              \
    auto r0 = __builtin_amdgcn_permlane32_swap(a0, b0, false, false); auto r1 = __builtin_amdgcn_permlane32_swap(a1, b1, false, false); \
    u32x4 w = {r0[0], r1[0], r0[1], r1[1]}; OUT = *reinterpret_cast<bf16x8*>(&w); } while (0)
    MIX_PK4(p0, 0, pa0); MIX_PK4(p0, 8, pa1); MIX_PK4(p1, 0, pa2); MIX_PK4(p1, 8, pa3);
#undef MIX_PK4
}
__device__ __forceinline__ float half_sum32(float v) {
#pragma unroll
    for (int o = 1; o < 32; o <<= 1) v += __shfl_xor(v, o);
    return v;
}
struct MixPtrs {
    const bf16_t* PROJ;
    const bf16_t *MQ, *MK, *AQ, *AK;
    const float* GATE;
    bf16_t *HM, *HA;
    const float *m_hgain, *a_hgain;
    const float* lamv;
};
template <int MODE>
__device__ __forceinline__ void unit(char* lds, const MixPtrs& P, int b, int h, int q0) {
    int tid_o = threadIdx.x; asm volatile("" : "+v"(tid_o));
    const int tid = tid_o, wid = __builtin_amdgcn_readfirstlane(tid >> 6), lane = tid & 63, r32 = lane & 31, hi = lane >> 5;
    constexpr int NQ = MODE == 0 ? 8 : 4;
    const int wq = MODE == 0 ? wid : (wid & 3), map = MODE == 0 ? 0 : (wid >> 2);
    const int qlo = q0 + 32 * wq, tq = qlo + r32;
    const size_t tok0 = (size_t)b * 2048;
    char* V_lds = lds + OFF_V; char* K_lds = lds + OFF_K;
    float* wsf = (float*)(lds + OFF_WS) + wid * 64; float* li_l = wsf; float* al_l = wsf + 32;
    float* A2 = (float*)(lds + OFF_A2); float* M2 = (float*)(lds + OFF_M2); float* MT = (float*)(lds + OFF_MT); float* SC = (float*)(lds + OFF_SC);
    const int NT = (q0 + (MODE == 0 ? 256 : 128)) / KVB;
    float M2row = 0.f, mtrow = 0.f;
    if (MODE == 0) {
        const int n = q0 + 256; const float* G = P.GATE + tok0 * 8;
        float lf[4], iv[4];
#pragma unroll
        for (int j = 0; j < 4; ++j) { const int t = 4 * tid + j; float f = 0.f, i = 0.f; if (t < n) { f = G[(size_t)t * 8 + 4 + h]; i = G[(size_t)t * 8 + h]; }
            lf[j] = fminf(f, 0.f) - 0.6931471805599453f * __builtin_amdgcn_logf(1.f + __builtin_amdgcn_exp2f(-kLog2e * fabsf(f))); iv[j] = i; }
        float s1 = lf[0], s2 = s1 + lf[1], s3 = s2 + lf[2], s4 = s3 + lf[3];
        float incl = s4;
#pragma unroll
        for (int o = 1; o < 64; o <<= 1) { const float t = __shfl_up(incl, o); if (lane >= o) incl += t; }
        if (lane == 63) SC[wid] = incl;
        __syncthreads();
        float wbase = 0.f;
#pragma unroll
        for (int w = 0; w < 8; ++w) { const float t = SC[w]; if (w < wid) wbase += t; }
        const float excl = wbase + incl - s4;
        const float B0 = excl + s1, B1 = excl + s2, B2 = excl + s3, B3 = excl + s4;
        const float a0 = iv[0] - B0, a1 = iv[1] - B1, a2 = iv[2] - B2, a3 = iv[3] - B3;
        const bool v0 = 4 * tid < n;
        const float NEG = -3.0e38f;
        const float m1 = v0 ? a0 : NEG, m2 = fmaxf(m1, v0 ? a1 : NEG), m3 = fmaxf(m2, v0 ? a2 : NEG), m4 = fmaxf(m3, v0 ? a3 : NEG);
        float mincl = m4;
#pragma unroll
        for (int o = 1; o < 64; o <<= 1) { const float t = __shfl_up(mincl, o); if (lane >= o) mincl = fmaxf(mincl, t); }
        float mprev = __shfl_up(mincl, 1); if (lane == 0) mprev = NEG;
        if (lane == 63) SC[8 + wid] = mincl;
        __syncthreads();
        float mbase = 0.f;
#pragma unroll
        for (int w = 0; w < 8; ++w) { const float t = SC[8 + w]; if (w < wid) mbase = fmaxf(mbase, t); }
        const float mex = fmaxf(mbase, mprev);
        const float x0 = fmaxf(mex, m1), x1 = fmaxf(mex, m2), x2 = fmaxf(mex, m3), x3 = fmaxf(mex, m4);
        if (v0) { *(f32x4*)(A2 + 4 * tid) = (f32x4){a0 * kLog2e, a1 * kLog2e, a2 * kLog2e, a3 * kLog2e};
                  *(f32x4*)(M2 + 4 * tid) = (f32x4){x0 * kLog2e, x1 * kLog2e, x2 * kLog2e, x3 * kLog2e};
                  *(f32x4*)(MT + 4 * tid) = (f32x4){B0 + x0, B1 + x1, B2 + x2, B3 + x3}; }
        __syncthreads();
        M2row = M2[tq]; mtrow = MT[tq];
    }
    bf16x8 qr[NQ];
    { const bf16_t* Qw = (MODE == 0 ? P.MQ : P.AQ) + (tok0 + tq) * 512 + h * 128 + map * 64 + hi * 8;
#pragma unroll
      for (int d0 = 0; d0 < NQ; ++d0) qr[d0] = *reinterpret_cast<const bf16x8*>(Qw + d0 * 16); }
    const bf16_t* Kg = (MODE == 0 ? P.MK : P.AK) + tok0 * 512 + h * 128;
    const bf16_t* Vg = P.PROJ + tok0 * 7168 + (MODE == 0 ? 1024 : 3072) + h * 128;
    const int sr = tid >> 4, sc = (tid & 15) * 8, vst0 = v_st(sr, sc), vst1 = v_st(32 + sr, sc);
    const int vb0 = (int)(uintptr_t)V_lds + v_rd_base(lane);
    bf16x8 vsA0, vsA1, ksA0, ksA1;
#define MIX_SLOAD(S, k0) do { vs##S##0 = *reinterpret_cast<const bf16x8*>(Vg + (size_t)((k0) + sr) * 7168 + sc); vs##S##1 = *reinterpret_cast<const bf16x8*>(Vg + (size_t)((k0) + 32 + sr) * 7168 + sc); \
    ks##S##0 = *reinterpret_cast<const bf16x8*>(Kg + (size_t)((k0) + sr) * 512 + sc); ks##S##1 = *reinterpret_cast<const bf16x8*>(Kg + (size_t)((k0) + 32 + sr) * 512 + sc); } while (0)
#define MIX_SWRITE(S, bb) do { *(bf16x8*)(V_lds + (bb) * SHM_T + vst0) = vs##S##0; *(bf16x8*)(V_lds + (bb) * SHM_T + vst1) = vs##S##1; \
    *(bf16x8*)(K_lds + (bb) * SHM_T + KSWZ(sr, sc * 2)) = ks##S##0; *(bf16x8*)(K_lds + (bb) * SHM_T + KSWZ(32 + sr, sc * 2)) = ks##S##1; } while (0)
#define MIX_BAR() do { asm volatile("s_waitcnt lgkmcnt(0)" ::: "memory"); __builtin_amdgcn_s_barrier(); asm volatile("" ::: "memory"); } while (0)
    f32x16 o[4];
#pragma unroll
    for (int d = 0; d < 4; ++d)
#pragma unroll
        for (int r = 0; r < 16; ++r) o[d][r] = 0.f;
    float m_run = -1e30f, l_run = 0.f;
    const float sl2 = MODE == 1 ? __builtin_amdgcn_exp2f(-2.f * (float)(h + 1)) * kLog2e : 0.f;
    auto mix_compute = [&](int j, int k0) __attribute__((always_inline)) {
        if (k0 <= qlo + 31) {
            const char* Kt = K_lds + (j & 1) * SHM_T;
            f32x16 p0, p1;
            if (MODE == 1) { const float base = sl2 * (float)(k0 - tq);
#pragma unroll
                for (int r = 0; r < 16; ++r) { p0[r] = fmaf(sl2, (float)crow(r, hi), base); p1[r] = fmaf(sl2, (float)(32 + crow(r, hi)), base); } }
            else {
#pragma unroll
                for (int r = 0; r < 16; ++r) { p0[r] = 0.f; p1[r] = 0.f; } }
            bf16x8 kb0[NQ], kb1[NQ];
#define MIX_KLD(D0) do { const int cb_ = (map * 64 + (D0) * 16 + hi * 8) * 2; kb0[D0] = *reinterpret_cast<const bf16x8*>(Kt + KSWZ(r32, cb_)); kb1[D0] = *reinterpret_cast<const bf16x8*>(Kt + KSWZ(32 + r32, cb_)); } while (0)
            MIX_KLD(0); MIX_KLD(1); SBAR();
#pragma unroll
            for (int d0 = 0; d0 < NQ; ++d0) {
                if (d0 + 2 < NQ) MIX_KLD(d0 + 2);
                p0 = __builtin_amdgcn_mfma_f32_32x32x16_bf16(kb0[d0], qr[d0], p0, 0, 0, 0);
                p1 = __builtin_amdgcn_mfma_f32_32x32x16_bf16(kb1[d0], qr[d0], p1, 0, 0, 0); SBAR(); }
#undef MIX_KLD
            const bool diag = k0 + 63 > qlo;
            if (MODE == 1) {
                if (diag) {
                    int tqm = tq; asm volatile("" : "+v"(tqm));
#pragma unroll
                    for (int r = 0; r < 16; ++r) { if (k0 + crow(r, hi) > tqm) p0[r] = -1e30f; if (k0 + 32 + crow(r, hi) > tqm) p1[r] = -1e30f; } }
                float pmax = p0[0];
#pragma unroll
                for (int r = 1; r < 16; ++r) pmax = fmaxf(pmax, p0[r]);
#pragma unroll
                for (int r = 0; r < 16; ++r) pmax = fmaxf(pmax, p1[r]);
                pmax = swap_max(pmax);
                float mn = m_run, alpha = 1.f;
                if (!__all(pmax - m_run <= 8.f)) { mn = fmaxf(m_run, pmax); alpha = __builtin_amdgcn_exp2f(m_run - mn); m_run = mn; }
                float ps = 0.f;
#pragma unroll
                for (int r = 0; r < 16; ++r) { p0[r] = __builtin_amdgcn_exp2f(p0[r] - mn); p1[r] = __builtin_amdgcn_exp2f(p1[r] - mn); ps += p0[r] + p1[r]; }
                ps = swap_sum(ps); l_run = l_run * alpha + ps;
                if (__any(alpha < 1.f)) { if (hi == 0) al_l[r32] = alpha; asm volatile("s_waitcnt lgkmcnt(0)" ::: "memory");
#pragma unroll
                    for (int r = 0; r < 16; ++r) { const float a = al_l[crow(r, hi)];
#pragma unroll
                        for (int d = 0; d < 4; ++d) o[d][r] *= a; } }
            } else {
                float ps = 0.f;
                if (diag) {
#pragma unroll
                    for (int i = 0; i < 4; ++i) { const f32x4 aa = *(const f32x4*)(A2 + k0 + 8 * i + 4 * hi), ab = *(const f32x4*)(A2 + k0 + 32 + 8 * i + 4 * hi);
#pragma unroll
                        for (int q = 0; q < 4; ++q) { const int r = 4 * i + q;
                            float w0 = __builtin_amdgcn_exp2f(fminf(aa[q] - M2row, 0.f)), w1 = __builtin_amdgcn_exp2f(fminf(ab[q] - M2row, 0.f));
                            if (k0 + crow(r, hi) > tq) w0 = 0.f; if (k0 + 32 + crow(r, hi) > tq) w1 = 0.f;
                            p0[r] *= w0; p1[r] *= w1; ps += p0[r] + p1[r]; } }
                    asm volatile("" : "+v"(ps));
                } else {
#pragma unroll
                    for (int i = 0; i < 4; ++i) { const f32x4 aa = *(const f32x4*)(A2 + k0 + 8 * i + 4 * hi), ab = *(const f32x4*)(A2 + k0 + 32 + 8 * i + 4 * hi);
#pragma unroll
                        for (int q = 0; q < 4; ++q) { const int r = 4 * i + q;
                            p0[r] *= __builtin_amdgcn_exp2f(aa[q] - M2row); p1[r] *= __builtin_amdgcn_exp2f(ab[q] - M2row); ps += p0[r] + p1[r]; } }
                }
                ps = swap_sum(ps); l_run += ps;
            }
            bf16x8 pa0, pa1, pa2, pa3; p_to_frags(p0, p1, pa0, pa1, pa2, pa3);
            pv_d0(o, vb0 + (j & 1) * SHM_T, pa0, pa1, pa2, pa3);
        }
    };
    MIX_SLOAD(A, 0); MIX_SWRITE(A, 0);
#define MIX_TILE(SL, SW, JJ) do { const int j = (JJ); \
        MIX_BAR(); \
        const int k0 = j * KVB; \
        if (j + 1 < NT) MIX_SLOAD(SL, k0 + KVB); \
        mix_compute(j, k0); \
        if (j + 1 < NT) MIX_SWRITE(SW, (j + 1) & 1); } while (0)
    for (int jj = 0; jj < NT; ++jj) { MIX_TILE(A, A, jj); }
#undef MIX_TILE
    __syncthreads();
#undef MIX_SLOAD
#undef MIX_SWRITE
#undef MIX_BAR
    int lane_e = lane; asm volatile("" : "+v"(lane_e));
    const int r32e = lane_e & 31, hie = lane_e >> 5;
    float rowscale;
    if (MODE == 1) rowscale = 1.f / l_run; else rowscale = 1.f / fmaxf(fabsf(l_run), __expf(-mtrow));
    if (hie == 0) li_l[r32e] = rowscale;
    asm volatile("s_waitcnt lgkmcnt(0)" ::: "memory");
    float rs[16];
#pragma unroll
    for (int r = 0; r < 16; ++r) rs[r] = li_l[crow(r, hie)];
#pragma unroll
    for (int d = 0; d < 4; ++d)
#pragma unroll
        for (int r = 0; r < 16; ++r) o[d][r] *= rs[r];
    if (MODE == 1) {
        __syncthreads();
        float* EX = (float*)lds + (size_t)wq * 4096 + lane_e;
        if (map == 1) {
#pragma unroll
            for (int d = 0; d < 4; ++d)
#pragma unroll
                for (int r = 0; r < 16; ++r) EX[(d * 16 + r) * 64] = o[d][r]; }
        __syncthreads();
        if (map == 0) { const float lam_l = P.lamv[0];
#pragma unroll
            for (int d = 0; d < 4; ++d)
#pragma unroll
                for (int r = 0; r < 16; ++r) o[d][r] -= lam_l * EX[(d * 16 + r) * 64]; }
    }
    if (MODE == 0 || map == 0) {
        float rn[16];
#pragma unroll
        for (int r = 0; r < 16; ++r) { float s = 0.f;
#pragma unroll
            for (int d = 0; d < 4; ++d) s += o[d][r] * o[d][r];
            s = half_sum32(s); rn[r] = __builtin_amdgcn_rsqf(s * (1.f / 128.f) + 1e-6f); }
        const float* hg = (MODE == 0 ? P.m_hgain : P.a_hgain) + h * 128;
        bf16_t* Ob = (MODE == 0 ? P.HM : P.HA) + (tok0 + qlo) * 512 + h * 128;
        unsigned short og[4][16];
        if (MODE == 0) {
#pragma unroll
            for (int d = 0; d < 4; ++d)
#pragma unroll
                for (int r = 0; r < 16; ++r) og[d][r] = P.PROJ[(tok0 + qlo + crow(r, hie)) * 7168 + 1536 + h * 128 + 32 * d + r32e]; }
#pragma unroll
        for (int d = 0; d < 4; ++d) { const int col = 32 * d + r32e; const float g = hg[col] * (MODE == 1 ? P.lamv[1] : 1.f);
#pragma unroll
            for (int r = 0; r < 16; ++r) { const int row = crow(r, hie); float v = o[d][r] * rn[r] * g;
                if (MODE == 0) v *= bf2f(og[d][r]);
                Ob[(size_t)row * 512 + col] = (bf16_t)(cvtpk(v, v) & 0xffffu); } }
    }
    __syncthreads();
}
template <bool DO_M, bool DO_A> __device__ __forceinline__ void mix_phase(char* lds, const MixPtrs& P, unsigned* queue) {
    volatile int* qw = (volatile int*)(lds + OFF_Q);
    if (DO_M) for (;;) {
        if (threadIdx.x == 0) *qw = (int)__hip_atomic_fetch_add(queue, 1u, __ATOMIC_RELAXED, __HIP_MEMORY_SCOPE_AGENT);
        __syncthreads();
        const int item = __builtin_amdgcn_readfirstlane(*qw);
        __syncthreads();
        if (item >= 256) break;
        unit<0>(lds, P, (item & 31) >> 2, item & 3, 256 * (7 - (item >> 5)));
    }
    if (DO_A) for (;;) {
        if (threadIdx.x == 0) *qw = (int)__hip_atomic_fetch_add(queue + 32, 1u, __ATOMIC_RELAXED, __HIP_MEMORY_SCOPE_AGENT);
        __syncthreads();
        const int item = __builtin_amdgcn_readfirstlane(*qw);
        __syncthreads();
        if (item >= 512) break;
        unit<1>(lds, P, (item & 31) >> 2, item & 3, 128 * (15 - (item >> 5)));
    }
}
}
namespace thin {
using pg8::bf16_t; using pg8::f32x4; using pg8::u32x4; using pg8::bf16x8;
typedef __attribute__((address_space(3))) float lds_f32;
__device__ __forceinline__ unsigned f2bf(float f) { unsigned u = __builtin_bit_cast(unsigned, f); return (u + 0x7fffu + ((u >> 16) & 1u)) >> 16; }
__device__ __forceinline__ unsigned pk2(float lo, float hi) { return f2bf(lo) | (f2bf(hi) << 16); }
__device__ __forceinline__ float wave_sum(float v) {
#pragma unroll
    for (int o = 1; o < 64; o <<= 1) v += __shfl_xor(v, o);
    return v;
}
__device__ __forceinline__ unsigned pack4_i8(float a, float b, float c, float d) {
    const int ia = (int)__builtin_rintf(a), ib = (int)__builtin_rintf(b), ic = (int)__builtin_rintf(c), id = (int)__builtin_rintf(d);
    return (unsigned)(ia & 0xff) | ((unsigned)(ib & 0xff) << 8) | ((unsigned)(ic & 0xff) << 16) | ((unsigned)(id & 0xff) << 24);
}
__device__ __forceinline__ float wave_max(float v) {
#pragma unroll
    for (int o = 1; o < 64; o <<= 1) v = fmaxf(v, __shfl_xor(v, o));
    return v;
}
__device__ __forceinline__ u32x4 quant16(const f32x4& a0, const f32x4& a1, const f32x4& a2, const f32x4& a3, float inv) {
    u32x4 w; w.x = pack4_i8(a0[0] * inv, a0[1] * inv, a0[2] * inv, a0[3] * inv); w.y = pack4_i8(a1[0] * inv, a1[1] * inv, a1[2] * inv, a1[3] * inv);
    w.z = pack4_i8(a2[0] * inv, a2[1] * inv, a2[2] * inv, a2[3] * inv); w.w = pack4_i8(a3[0] * inv, a3[1] * inv, a3[2] * inv, a3[3] * inv); return w;
}
__device__ __forceinline__ float absmax16(const f32x4& a0, const f32x4& a1, const f32x4& a2, const f32x4& a3) {
    float m = 0.f;
#pragma unroll
    for (int j = 0; j < 4; ++j) m = fmaxf(fmaxf(m, fmaxf(fabsf(a0[j]), fabsf(a1[j]))), fmaxf(fabsf(a2[j]), fabsf(a3[j])));
    return m;
}
__device__ __forceinline__ float row_rstd_wave(const float* ssq, int row, int lane, int vz) {
    float v = lane < 16 ? ssq[(size_t)(row + vz) * 16 + lane] : 0.f;
#pragma unroll
    for (int o = 1; o < 16; o <<= 1) v += __shfl_xor(v, o);
    v = __shfl(v, 0);
    return __builtin_amdgcn_rsqf(v * (1.f / 1024.f) + 1e-6f);
}
struct TrItem { const float* W; const float* gain; bf16_t* WT; int ldw, K, F, map, n0, k0; };
__device__ __forceinline__ void tr_load(const TrItem& I, float (&v)[16][4], int lane, int wave) {
    int so[4];
#pragma unroll
    for (int j = 0; j < 4; ++j) { const int n = I.n0 + lane + 64 * j; so[j] = I.map == 0 ? n : I.map == 1 ? (n < 2048 ? n : n + 8) : ((n & 255) >> 7) * I.F + (n >> 8) * 128 + (n & 127); }
    const float* Wk = I.W + (size_t)(I.k0 + wave * 16) * I.ldw;
#pragma unroll
    for (int r = 0; r < 16; ++r)
#pragma unroll
        for (int j = 0; j < 4; ++j) v[r][j] = Wk[(size_t)r * I.ldw + so[j]];
}
__device__ __forceinline__ void tr_store(const TrItem& I, const float (&v)[16][4], char* lds, int lane, int wave) {
    unsigned short* img = (unsigned short*)lds;
#pragma unroll
    for (int r = 0; r < 16; r += 2) { float g0 = 1.f, g1 = 1.f; if (I.gain) { g0 = I.gain[I.k0 + wave * 16 + r]; g1 = I.gain[I.k0 + wave * 16 + r + 1]; }
#pragma unroll
        for (int j = 0; j < 4; ++j) *(unsigned*)(img + (lane + 64 * j) * 130 + wave * 16 + r) = pk2(v[r][j] * g0, v[r + 1][j] * g1); }
    __syncthreads();
#pragma unroll 8
    for (int i = 0; i < 32; ++i) { const int n = wave * 32 + i; const unsigned w = *(const unsigned*)(img + n * 130 + 2 * lane);
        *(unsigned*)(I.WT + (size_t)(I.n0 + n) * I.K + I.k0 + 2 * lane) = w; }
    __syncthreads();
}
struct Q8Item { const float* W; const float* gain; unsigned char* W8; float* SB; int ldw, F, map, n0; };
__device__ __forceinline__ void q8_item(const Q8Item& I, char* lds, int lane, int wave) {
    unsigned* img = (unsigned*)lds;
    const int n = I.n0 + lane;
    int so1 = n < 2048 ? n : n + 8;
    if (n >= 2048 && n < 3072) { const int w = n & 255, bj = w >> 7, wc = (w >> 5) & 3, j = w & 31; so1 = 2056 + ((n - 2048) & ~255) + wc * 64 + bj * 32 + j; }
    const int so = I.map == 0 ? n : I.map == 1 ? so1 : ((n & 255) >> 7) * I.F + (n >> 8) * 128 + (n & 127);
    const float* Wk = I.W + (size_t)(wave * 128) * I.ldw + so;
    float va[32], vb[32];
#define Q8_LOAD(V, B) do { _Pragma("unroll") for (int r = 0; r < 32; ++r) V[r] = Wk[(size_t)((B) * 32 + r) * I.ldw]; } while (0)
#define Q8_PUT(V, B) do { _Pragma("unroll") for (int r = 0; r < 32; r += 2) { const int k = wave * 128 + (B) * 32 + r; \
        img[lane * 514 + (k >> 1)] = pk2(V[r] * I.gain[k], V[r + 1] * I.gain[k + 1]); } } while (0)
    Q8_LOAD(va, 0); Q8_LOAD(vb, 1); Q8_PUT(va, 0); Q8_LOAD(va, 2); Q8_PUT(vb, 1); Q8_LOAD(vb, 3); Q8_PUT(va, 2); Q8_PUT(vb, 3);
#undef Q8_LOAD
#undef Q8_PUT
    __syncthreads();
#pragma unroll 2
    for (int i = 0; i < 8; ++i) { const int nr = wave * 8 + i; const unsigned long long* rp = (const unsigned long long*)(img + nr * 514) + lane * 4;
        const unsigned long long d0 = rp[0], d1 = rp[1], d2 = rp[2], d3 = rp[3];
        u32x4 w0 = {(unsigned)d0, (unsigned)(d0 >> 32), (unsigned)d1, (unsigned)(d1 >> 32)}, w1 = {(unsigned)d2, (unsigned)(d2 >> 32), (unsigned)d3, (unsigned)(d3 >> 32)};
        f32x4 a0, a1, a2, a3; pg8::unpack8(w0, a0, a1); pg8::unpack8(w1, a2, a3);
        const float mx = wave_max(absmax16(a0, a1, a2, a3)), step = mx > 0.f ? mx * (1.f / 127.f) : 1.f;
        *((u32x4*)(I.W8 + (size_t)(I.n0 + nr) * 1024) + lane) = quant16(a0, a1, a2, a3, 1.f / step);
        if (lane == 0) I.SB[I.n0 + nr] = step; }
    __syncthreads();
}
struct ProIn {
    const float *x, *p, *attn_norm, *w_in, *pool_w, *pool_scale, *w_branch, *w_out, *ffn_norm, *dense_w_gu, *dense_w_down, *router_w, *moe_w_gu, *moe_w_down, *ple_norm, *ple_w_gate, *ple_w_proj;
    bf16_t *W_IN, *W_BR, *W_OUT, *W_GU0, *W_DN0, *W_GU1, *W_DN1, *W_PG, *W_PP, *XB, *PB; float *X, *SSQ, *WG, *WR; unsigned char* X8; float* RS1; unsigned char *W8_IN, *W8_GU0, *W8_GU1; float *SB_IN, *SB_GU0, *SB_GU1; float* GATE; const float* gate_bias;
};
__device__ __forceinline__ void prologue(const ProIn& a, char* lds, int vcu, int G) {
    int tid_o = threadIdx.x; asm volatile("" : "+v"(tid_o)); const int tid = tid_o, lane = tid & 63, wave = __builtin_amdgcn_readfirstlane(tid >> 6);
    const int gw = vcu * 8 + wave, NGW = G * 8;
    { constexpr int Q_GU1 = 8 * 112, Q_IN = 2 * 112, Q_GU0 = 88, NQ = Q_GU1 + Q_IN + Q_GU0;
#pragma unroll 1
      for (int it = vcu; it < NQ; it += G) { Q8Item I; int r = it;
          if (r < Q_GU1) { const int e = r / 112; r -= e * 112; I.W = a.moe_w_gu + (size_t)e * 1024 * 7168; I.ldw = 7168; I.gain = a.ffn_norm + 1024; I.F = 3584; I.map = 2; I.W8 = a.W8_GU1 + (size_t)e * 7168 * 1024; I.SB = a.SB_GU1 + e * 7168; }
          else if ((r -= Q_GU1) < Q_IN) { const int L = r / 112; r -= L * 112; I.W = a.w_in + (size_t)L * 1024 * 7176; I.ldw = 7176; I.gain = a.attn_norm + L * 1024; I.F = 0; I.map = 1; I.W8 = a.W8_IN + (size_t)L * 7168 * 1024; I.SB = a.SB_IN + L * 7168; }
          else { r -= Q_IN; I.W = a.dense_w_gu; I.ldw = 5632; I.gain = a.ffn_norm; I.F = 2816; I.map = 2; I.W8 = a.W8_GU0; I.SB = a.SB_GU0; }
          I.n0 = r * 64; q8_item(I, lds, lane, wave); } }
    constexpr int I_BR = 4 * 4, I_OUT = 8 * 4, I_DN0 = 22 * 4, I_DN1 = 28 * 4, I_PG = 8 * 4, I_PP = 2 * 4;
    constexpr int NITEMS = 4 * I_BR + 2 * I_OUT + I_DN0 + 8 * I_DN1 + 2 * I_PG + 2 * I_PP;
    auto decode = [&](int it, TrItem& I) {
        int r = it, N; I.gain = nullptr; I.F = 0; I.map = 0;
        if (r < 8 * I_DN1) { const int e = r / I_DN1; r -= e * I_DN1; I.W = a.moe_w_down + (size_t)e * 3584 * 1024; I.ldw = 1024; I.K = 3584; N = 1024; I.WT = a.W_DN1 + (size_t)e * 1024 * 3584; }
        else if ((r -= 8 * I_DN1) < I_DN0) { I.W = a.dense_w_down; I.ldw = 1024; I.K = 2816; N = 1024; I.WT = a.W_DN0; }
        else if ((r -= I_DN0) < 4 * I_BR) { const int q = r / I_BR, L = q >> 1, br = q & 1; r -= q * I_BR; I.W = a.w_branch + ((size_t)L * 3 + br) * 512 * 1024; I.ldw = 1024; I.K = 512; N = 1024; I.WT = a.W_BR + ((size_t)L * 3 + br) * 1024 * 512; }
        else if ((r -= 4 * I_BR) < 2 * I_OUT) { const int L = r / I_OUT; r -= L * I_OUT; I.W = a.w_out + (size_t)L * 1024 * 1024; I.ldw = 1024; I.K = 1024; N = 1024; I.WT = a.W_OUT + (size_t)L * 1024 * 1024; }
        else if ((r -= 2 * I_OUT) < 2 * I_PG) { const int L = r / I_PG; r -= L * I_PG; I.W = a.ple_w_gate + (size_t)L * 1024 * 1024; I.ldw = 1024; I.gain = a.ple_norm + L * 1024; I.K = 1024; N = 1024; I.WT = a.W_PG + (size_t)L * 1024 * 1024; }
        else { r -= 2 * I_PG; const int L = r / I_PP; r -= L * I_PP; I.W = a.ple_w_proj + (size_t)L * 256 * 1024; I.ldw = 1024; I.K = 256; N = 1024; I.WT = a.W_PP + (size_t)L * 1024 * 256; }
        const int nblk = N / 256; I.k0 = (r / nblk) * 128; I.n0 = (r % nblk) * 256;
    };
    { TrItem IA, IB; float va[16][4], vb[16][4]; int it = G - 1 - vcu;
      if (it < NITEMS) { decode(it, IA); tr_load(IA, va, lane, wave);
#pragma unroll 1
        for (;;) {
            const bool hb = it + G < NITEMS; if (hb) { decode(it + G, IB); tr_load(IB, vb, lane, wave); }
            tr_store(IA, va, lds, lane, wave);
            if (!hb) break;
            it += 2 * G; const bool ha = it < NITEMS; if (ha) { decode(it, IA); tr_load(IA, va, lane, wave); }
            tr_store(IB, vb, lds, lane, wave);
            if (!ha) break;
        } } }
    float wgx[4][4][8];
#pragma unroll
    for (int j = 0; j < 4; ++j)
#pragma unroll
        for (int i = 0; i < 4; ++i) { const int k = 4 * lane + 256 * j + i; const float gk = a.attn_norm[k]; const f32x4 w0 = *(const f32x4*)(a.w_in + (size_t)k * 7176 + 2048), w1 = *(const f32x4*)(a.w_in + (size_t)k * 7176 + 2052);
#pragma unroll
            for (int c = 0; c < 4; ++c) { wgx[j][i][c] = gk * w0[c]; wgx[j][i][4 + c] = gk * w1[c]; } }
    for (int m0 = gw * 2; m0 < 16384; m0 += NGW * 2) {
        f32x4 v[2][4];
#pragma unroll
        for (int q = 0; q < 2; ++q) { const f32x4* xr = (const f32x4*)(a.x + (size_t)(m0 + q) * 1024) + lane;
#pragma unroll
            for (int j = 0; j < 4; ++j) v[q][j] = xr[64 * j]; }
#pragma unroll
        for (int q = 0; q < 2; ++q) { const int m = m0 + q; unsigned long long* o8 = (unsigned long long*)(a.XB + (size_t)m * 1024) + lane; float s = 0.f;
#pragma unroll
            for (int j = 0; j < 4; ++j) { const f32x4 w = v[q][j]; s += (w[0] * w[0] + w[1] * w[1]) + (w[2] * w[2] + w[3] * w[3]);
                o8[64 * j] = (unsigned long long)pk2(w[0], w[1]) | ((unsigned long long)pk2(w[2], w[3]) << 32); }
            s = wave_sum(s);
            if (lane < 16) a.SSQ[(size_t)m * 16 + lane] = lane == 0 ? s : 0.f;
            float mx = 0.f;
#pragma unroll
            for (int j = 0; j < 4; ++j) mx = fmaxf(mx, fmaxf(fmaxf(fabsf(v[q][j][0]), fabsf(v[q][j][1])), fmaxf(fabsf(v[q][j][2]), fabsf(v[q][j][3]))));
            mx = wave_max(mx); const float step = mx > 0.f ? mx * (1.f / 127.f) : 1.f, inv = 1.f / step;
            unsigned* x8 = (unsigned*)(a.X8 + (size_t)m * 1024) + lane;
#pragma unroll
            for (int j = 0; j < 4; ++j) x8[64 * j] = pack4_i8(v[q][j][0] * inv, v[q][j][1] * inv, v[q][j][2] * inv, v[q][j][3] * inv);
            const float rstd = __builtin_amdgcn_rsqf(s * (1.f / 1024.f) + 1e-6f);
            if (lane == 0) a.RS1[m] = rstd * step;
            float d[8] = {0.f, 0.f, 0.f, 0.f, 0.f, 0.f, 0.f, 0.f};
#pragma unroll
            for (int j = 0; j < 4; ++j)
#pragma unroll
                for (int i = 0; i < 4; ++i)
#pragma unroll
                    for (int c = 0; c < 8; ++c) d[c] = fmaf(v[q][j][i], wgx[j][i][c], d[c]);
#pragma unroll
            for (int c = 0; c < 8; ++c) d[c] = wave_sum(d[c]);
            if (lane < 8) { float dv = d[0];
#pragma unroll
                for (int c = 1; c < 8; ++c) if (lane == c) dv = d[c];
                a.GATE[(size_t)m * 8 + lane] = dv * rstd + a.gate_bias[lane]; } }
    }
    { const size_t n8 = (size_t)2 * 16384 * 256 / 8; const size_t gt = (size_t)(vcu * 512 + tid), NT = (size_t)G * 512;
      for (size_t i0 = gt; i0 < n8; i0 += 4 * NT) { f32x4 v0[4], v1[4];
#pragma unroll
          for (int q = 0; q < 4; ++q) { const size_t i = i0 + q * NT; if (i < n8) { v0[q] = *(const f32x4*)(a.p + i * 8); v1[q] = *(const f32x4*)(a.p + i * 8 + 4); } }
#pragma unroll
          for (int q = 0; q < 4; ++q) { const size_t i = i0 + q * NT; if (i < n8) { u32x4 w; w.x = pk2(v0[q][0], v0[q][1]); w.y = pk2(v0[q][2], v0[q][3]); w.z = pk2(v1[q][0], v1[q][1]); w.w = pk2(v1[q][2], v1[q][3]); *(u32x4*)(a.PB + i * 8) = w; } } }
      for (size_t i = gt; i < 2 * 8192 + 8192; i += NT) {
          if (i < 2 * 8192) { const int L = (int)(i / 8192), k = (int)(i % 8192) / 8, j = (int)(i & 7); a.WG[i] = a.attn_norm[L * 1024 + k] * a.w_in[((size_t)L * 1024 + k) * 7176 + 2048 + j]; }
          else { const int q = (int)(i - 2 * 8192), k = q / 8; a.WR[q] = a.ffn_norm[1024 + k] * a.router_w[q]; } }
    }
    for (int task = vcu; task < 64; task += G) {
        const int L = task >> 5, g = (task >> 3) & 3, nb = task & 7;
        float* AsT = (float*)lds; float* Bs = AsT + 128 * 128;
        __syncthreads();
        const float* pw = a.pool_w + ((size_t)L * 4 + g) * 128 * 128; const float* ps = a.pool_scale + L * 512 + g * 128;
        const float* wb = a.w_branch + (((size_t)L * 3 + 2) * 512 + g * 128) * 1024 + nb * 128;
        for (int i = tid; i < 128 * 32; i += 512) { const int c = i >> 5, d4 = (i & 31) * 4; const f32x4 w = *(const f32x4*)(pw + c * 128 + d4), s = *(const f32x4*)(ps + d4);
            AsT[(d4 + 0) * 128 + c] = w[0] * s[0]; AsT[(d4 + 1) * 128 + c] = w[1] * s[1]; AsT[(d4 + 2) * 128 + c] = w[2] * s[2]; AsT[(d4 + 3) * 128 + c] = w[3] * s[3]; }
        for (int i = tid; i < 128 * 32; i += 512) { const int d = i >> 5, n4 = (i & 31) * 4; *(f32x4*)(Bs + d * 128 + n4) = *(const f32x4*)(wb + (size_t)d * 1024 + n4); }
        __syncthreads();
        const int nq = (tid & 31) * 4, cq = (tid >> 5) * 8;
        float acc[4][8];
#pragma unroll
        for (int i = 0; i < 4; ++i)
#pragma unroll
            for (int j = 0; j < 8; ++j) acc[i][j] = 0.f;
#pragma unroll 4
        for (int d = 0; d < 128; ++d) { const f32x4 bv = *(const f32x4*)(Bs + d * 128 + nq), a0 = *(const f32x4*)(AsT + d * 128 + cq), a1 = *(const f32x4*)(AsT + d * 128 + cq + 4);
#pragma unroll
            for (int i = 0; i < 4; ++i) {
#pragma unroll
                for (int j = 0; j < 4; ++j) { acc[i][j] = fmaf(bv[i], a0[j], acc[i][j]); acc[i][4 + j] = fmaf(bv[i], a1[j], acc[i][4 + j]); } } }
#pragma unroll
        for (int i = 0; i < 4; ++i) { u32x4 w; w.x = pk2(acc[i][0], acc[i][1]); w.y = pk2(acc[i][2], acc[i][3]); w.z = pk2(acc[i][4], acc[i][5]); w.w = pk2(acc[i][6], acc[i][7]);
            *(u32x4*)(a.W_BR + ((size_t)L * 3 + 2) * 1024 * 512 + (size_t)(nb * 128 + nq + i) * 512 + g * 128 + cq) = w; }
    }
    __syncthreads();
}
template <bool GATES> __device__ __forceinline__ void quant_act(const bf16_t* XB, const float* SSQ, unsigned char* X8, float* RS1, const float* WGt, const float* gate_bias, float* GATE, int vcu, int G) {
    int tid_o = threadIdx.x; asm volatile("" : "+v"(tid_o)); const int tid = tid_o, lane = tid & 63, wave = __builtin_amdgcn_readfirstlane(tid >> 6), gw = vcu * 8 + wave, NGW = G * 8;
    int vz = 0; asm volatile("" : "+v"(vz));
    float wgq[GATES ? 16 : 1][8];
    if (GATES) {
#pragma unroll
        for (int i = 0; i < 16; ++i) { const f32x4 w0 = *(const f32x4*)(WGt + (size_t)(16 * lane + i) * 8), w1 = *(const f32x4*)(WGt + (size_t)(16 * lane + i) * 8 + 4);
#pragma unroll
            for (int c = 0; c < 4; ++c) { wgq[i][c] = w0[c]; wgq[i][4 + c] = w1[c]; } } }
    constexpr int NR = GATES ? 2 : 8;
    for (int r0 = gw * NR; r0 < 16384; r0 += NGW * NR) {
        u32x4 v[NR][2]; float rs[NR];
#pragma unroll
        for (int q = 0; q < NR; ++q) { const u32x4* p = (const u32x4*)(XB + (size_t)(r0 + q) * 1024) + lane * 2; v[q][0] = p[0]; v[q][1] = p[1]; rs[q] = row_rstd_wave(SSQ, r0 + q, lane, vz); }
#pragma unroll
        for (int q = 0; q < NR; ++q) { f32x4 a0, a1, a2, a3; pg8::unpack8(v[q][0], a0, a1); pg8::unpack8(v[q][1], a2, a3);
            const float mx = wave_max(absmax16(a0, a1, a2, a3)), step = mx > 0.f ? mx * (1.f / 127.f) : 1.f;
            *((u32x4*)(X8 + (size_t)(r0 + q) * 1024) + lane) = quant16(a0, a1, a2, a3, 1.f / step);
            if (lane == 0) RS1[r0 + q] = rs[q] * step;
            if (GATES) { const float xv[16] = {a0[0], a0[1], a0[2], a0[3], a1[0], a1[1], a1[2], a1[3], a2[0], a2[1], a2[2], a2[3], a3[0], a3[1], a3[2], a3[3]};
                float d[8] = {0.f, 0.f, 0.f, 0.f, 0.f, 0.f, 0.f, 0.f};
#pragma unroll
                for (int i = 0; i < 16; ++i)
#pragma unroll
                    for (int c = 0; c < 8; ++c) d[c] = fmaf(xv[i], wgq[i][c], d[c]);
#pragma unroll
                for (int c = 0; c < 8; ++c) d[c] = wave_sum(d[c]);
                if (lane < 8) { float dv = d[0];
#pragma unroll
                    for (int c = 1; c < 8; ++c) if (lane == c) dv = d[c];
                    GATE[(size_t)(r0 + q) * 8 + lane] = dv * rs[q] + gate_bias[lane]; } } }
    }
}
struct PrepIn { const bf16_t *PROJ, *XB; const float *SSQ, *WG, *conv_w, *conv_b, *gate_bias, *q_gain, *k_gain; bf16_t *MQ, *MK, *AQ, *AK, *HP; float* GATE; };
__device__ __forceinline__ void prep(const PrepIn& a, char* lds, int vcu, int G) {
    int tid_o = threadIdx.x; asm volatile("" : "+v"(tid_o)); const int tid = tid_o, lane = tid & 63, wave = __builtin_amdgcn_readfirstlane(tid >> 6);
    float* cwl = (float*)lds;
    for (int i = tid; i < 4096 / 4; i += 512) ((f32x4*)cwl)[i] = ((const f32x4*)a.conv_w)[i];
    for (int i = tid; i < 1024 / 4; i += 512) ((f32x4*)(cwl + 4096))[i] = ((const f32x4*)a.conv_b)[i];
    __syncthreads();
    const int gw = vcu * 8 + wave, NGW = G * 8;
    const int c0 = lane * 16;
    int vz = 0; asm volatile("" : "+v"(vz));
    const int qg0 = (lane & 3) * 16;
    const float* qkg = (lane < 32 ? a.q_gain : a.k_gain) + qg0;
    const float qkscale = lane < 32 ? 0.125f * 1.4426950408889634f : 1.f;
    const int pc = lane * 8, pw = 2 << (lane >> 4);
    for (int chunk = gw; chunk < 16384 / 8; chunk += NGW) {
        const int row0 = chunk * 8, t0 = row0 & 2047;
        const bf16_t* pr0 = a.PROJ + (size_t)row0 * 7168;
        { u32x4 cv[11][2];
#pragma unroll
          for (int i = 0; i < 11; ++i) { const int d = i - 3, de = (d < 0 && t0 + d < 0) ? 0 : d; const bf16_t* p = pr0 + (long)de * 7168 + c0; cv[i][0] = *(const u32x4*)p; cv[i][1] = *(const u32x4*)(p + 8); }
          f32x4 wt[4][4], bs[4];
#pragma unroll
          for (int i = 0; i < 4; ++i) { bs[i] = *(const f32x4*)(cwl + 4096 + c0 + 4 * i);
#pragma unroll
              for (int j = 0; j < 4; ++j) wt[j][i] = *(const f32x4*)(cwl + j * 1024 + c0 + 4 * i); }
          const float ks = lane < 32 ? 1.f : 0.08838834764831845f;
#pragma unroll
          for (int r = 0; r < 8; ++r) { f32x4 y[4] = {bs[0], bs[1], bs[2], bs[3]};
#pragma unroll
              for (int j = 0; j < 4; ++j) { const float on = (t0 + r - 3 + j) >= 0 ? 1.f : 0.f; f32x4 x0, x1, x2, x3; pg8::unpack8(cv[r + j][0], x0, x1); pg8::unpack8(cv[r + j][1], x2, x3);
                  y[0] = y[0] + wt[j][0] * x0 * on; y[1] = y[1] + wt[j][1] * x1 * on; y[2] = y[2] + wt[j][2] * x2 * on; y[3] = y[3] + wt[j][3] * x3 * on; }
#pragma unroll
              for (int i = 0; i < 4; ++i)
#pragma unroll
                  for (int c = 0; c < 4; ++c) y[i][c] = y[i][c] * pg8::fsigmoid(y[i][c]) * ks;
              bf16_t* dst = (lane < 32 ? a.MQ : a.MK) + (size_t)(row0 + r) * 512 + (c0 & 511);
              *(u32x4*)dst = pg8::pack8(y[0], y[1]); *(u32x4*)(dst + 8) = pg8::pack8(y[2], y[3]); } }
        { u32x4 pv[23];
#pragma unroll
          for (int i = 0; i < 23; ++i) { const int d = i - 15, de = (d < 0 && t0 + d < 0) ? 0 : d; pv[i] = *(const u32x4*)(pr0 + (long)de * 7168 + 3584 + pc); }
#pragma unroll
          for (int r = 0; r < 8; ++r) { const int t = t0 + r, cnt = t + 1 < pw ? t + 1 : pw;
              f32x4 u0, u1; pg8::unpack8(pv[15 + r], u0, u1); f32x4 s0 = u0, s1 = u1;
#pragma unroll
              for (int j = 1; j < 16; ++j) { const float on = j < cnt ? 1.f : 0.f; f32x4 b0, b1; pg8::unpack8(pv[15 + r - j], b0, b1); s0 = s0 + b0 * on; s1 = s1 + b1 * on; }
              const float ic = 1.f / (float)cnt; s0 = s0 * ic - u0; s1 = s1 * ic - u1;
              *(u32x4*)(a.HP + (size_t)(row0 + r) * 512 + pc) = pg8::pack8(s0, s1); } }
    }
    __syncthreads();
}
struct RouteIn { const float *X, *SSQ, *WR, *router_b; const bf16_t* XB; bf16_t* XG; float* RSG; unsigned* cnt; int* TOKI; float* TOKG; };
__device__ __forceinline__ void route(const RouteIn& a, char* lds, int vcu, int G) {
    int tid_o = threadIdx.x; asm volatile("" : "+v"(tid_o)); const int tid = tid_o, lane = tid & 63, wave = __builtin_amdgcn_readfirstlane(tid >> 6);
    int vz = 0; asm volatile("" : "+v"(vz));
    int* lcnt = (int*)lds; int* lbase = lcnt + 8; int* lsel = lbase + 8;
    float* lgate = (float*)(lsel + 256);
    float* wrt = (float*)(lds + 8192);
    for (int i = tid; i < 8192; i += 512) wrt[(i & 7) * 1024 + (i >> 3)] = a.WR[i];
    for (int chunk = vcu; chunk < 16384 / 64; chunk += G) {
        if (tid < 8) lcnt[tid] = 0;
        __syncthreads();
        u32x4 xq[8][2]; float rsd[8];
#pragma unroll
        for (int rr = 0; rr < 8; ++rr) { const int row = chunk * 64 + wave * 8 + rr; const u32x4* src = (const u32x4*)(a.XB + (size_t)row * 1024) + lane * 2; xq[rr][0] = src[0]; xq[rr][1] = src[1];
            rsd[rr] = row_rstd_wave(a.SSQ, row, lane, vz); }
#pragma unroll
        for (int rr = 0; rr < 8; ++rr) { const int lrow = wave * 8 + rr;
            f32x4 a0, a1, a2, a3; pg8::unpack8(xq[rr][0], a0, a1); pg8::unpack8(xq[rr][1], a2, a3);
            const float xv[16] = {a0[0], a0[1], a0[2], a0[3], a1[0], a1[1], a1[2], a1[3], a2[0], a2[1], a2[2], a2[3], a3[0], a3[1], a3[2], a3[3]};
            float d[8];
#pragma unroll
            for (int c = 0; c < 8; ++c) { const f32x4* wp = (const f32x4*)(wrt + c * 1024 + 16 * lane); const f32x4 w0 = wp[0], w1 = wp[1], w2 = wp[2], w3 = wp[3];
                d[c] = ((xv[0] * w0[0] + xv[1] * w0[1]) + (xv[2] * w0[2] + xv[3] * w0[3])) + ((xv[4] * w1[0] + xv[5] * w1[1]) + (xv[6] * w1[2] + xv[7] * w1[3]))
                     + ((xv[8] * w2[0] + xv[9] * w2[1]) + (xv[10] * w2[2] + xv[11] * w2[3])) + ((xv[12] * w3[0] + xv[13] * w3[1]) + (xv[14] * w3[2] + xv[15] * w3[3])); }
            const float r = rsd[rr];
#pragma unroll
            for (int j = 0; j < 8; ++j) d[j] = wave_sum(d[j]) * r + a.router_b[j];
            int i0 = 0; float v0 = d[0];
#pragma unroll
            for (int j = 1; j < 8; ++j) if (d[j] > v0) { v0 = d[j]; i0 = j; }
            int i1 = -1; float v1 = -3.0e38f;
#pragma unroll
            for (int j = 0; j < 8; ++j) if (j != i0 && d[j] > v1) { v1 = d[j]; i1 = j; }
            if (lane == 0) { const float e1 = __expf(v1 - v0); const float g0 = 1.f / (1.f + e1);
                lsel[lrow * 4 + 0] = i0; lsel[lrow * 4 + 1] = atomicAdd(&lcnt[i0], 1); lsel[lrow * 4 + 2] = i1; lsel[lrow * 4 + 3] = atomicAdd(&lcnt[i1], 1);
                lgate[lrow * 2] = g0; lgate[lrow * 2 + 1] = e1 * g0; lgate[128 + lrow] = r; } }
        __syncthreads();
        if (tid < 8) lbase[tid] = (int)__hip_atomic_fetch_add(a.cnt + tid, (unsigned)lcnt[tid], __ATOMIC_RELAXED, __HIP_MEMORY_SCOPE_AGENT);
        __syncthreads();
        u32x4 xr[8][2];
#pragma unroll
        for (int rr = 0; rr < 8; ++rr) { const u32x4* src = (const u32x4*)(a.XB + (size_t)(chunk * 64 + wave * 8 + rr) * 1024) + lane * 2; xr[rr][0] = src[0]; xr[rr][1] = src[1]; }
#pragma unroll
        for (int rr = 0; rr < 8; ++rr) {
            const int lrow = wave * 8 + rr, row = chunk * 64 + lrow;
            const int e0 = lsel[lrow * 4], p0 = lbase[e0] + lsel[lrow * 4 + 1], e1 = lsel[lrow * 4 + 2], p1 = lbase[e1] + lsel[lrow * 4 + 3];
            f32x4 a0, a1, a2, a3; pg8::unpack8(xr[rr][0], a0, a1); pg8::unpack8(xr[rr][1], a2, a3);
            const float mx = wave_max(absmax16(a0, a1, a2, a3)), step = mx > 0.f ? mx * (1.f / 127.f) : 1.f; const u32x4 qq = quant16(a0, a1, a2, a3, 1.f / step);
            *((u32x4*)((unsigned char*)a.XG + ((size_t)e0 * 16384 + p0) * 1024) + lane) = qq;
            *((u32x4*)((unsigned char*)a.XG + ((size_t)e1 * 16384 + p1) * 1024) + lane) = qq;
            if (lane == 0) { const float r = lgate[128 + lrow] * step; a.RSG[(size_t)e0 * 16384 + p0] = r; a.RSG[(size_t)e1 * 16384 + p1] = r;
                a.TOKI[row * 4 + 0] = e0; a.TOKI[row * 4 + 1] = p0; a.TOKI[row * 4 + 2] = e1; a.TOKI[row * 4 + 3] = p1; a.TOKG[row * 2] = lgate[lrow * 2]; a.TOKG[row * 2 + 1] = lgate[lrow * 2 + 1]; }
        }
        __syncthreads();
    }
}
struct CombIn { float* X; bf16_t* XB; float* SSQ; const bf16_t* Y; const int* TOKI; const float* TOKG; int ts[8]; };
__device__ __forceinline__ void combine(const CombIn& a, int vcu, int G) {
    int tid_o = threadIdx.x; asm volatile("" : "+v"(tid_o)); const int tid = tid_o, lane = tid & 63, wave = __builtin_amdgcn_readfirstlane(tid >> 6), gw = vcu * 8 + wave, NGW = G * 8;
    int vz = 0; asm volatile("" : "+v"(vz));
    for (int r0 = gw * 4; r0 < 16384; r0 += NGW * 4) {
        int ti[4][4]; float tg[4][2];
#pragma unroll
        for (int q = 0; q < 4; ++q) { const int rv = r0 + q + vz;
#pragma unroll
            for (int i = 0; i < 4; ++i) ti[q][i] = a.TOKI[rv * 4 + i];
            tg[q][0] = a.TOKG[rv * 2]; tg[q][1] = a.TOKG[rv * 2 + 1]; }
        u32x4 y0[4][2], y1[4][2]; f32x4 xv[4][4]; int yr0[4], yr1[4];
#pragma unroll
        for (int q = 0; q < 4; ++q) { int t0 = 0, t1 = 0;
#pragma unroll
            for (int j = 0; j < 8; ++j) { if (j == ti[q][0]) t0 = a.ts[j]; if (j == ti[q][2]) t1 = a.ts[j]; }
            yr0[q] = t0 * 256 + ti[q][1]; yr1[q] = t1 * 256 + ti[q][3];
            const u32x4* p0 = (const u32x4*)(a.Y + (size_t)yr0[q] * 1024) + lane * 2; const u32x4* p1 = (const u32x4*)(a.Y + (size_t)yr1[q] * 1024) + lane * 2;
            y0[q][0] = p0[0]; y0[q][1] = p0[1]; y1[q][0] = p1[0]; y1[q][1] = p1[1];
            const u32x4* xp = (const u32x4*)(a.XB + (size_t)(r0 + q) * 1024) + lane * 2; pg8::unpack8(xp[0], xv[q][0], xv[q][1]); pg8::unpack8(xp[1], xv[q][2], xv[q][3]); }
#pragma unroll
        for (int q = 0; q < 4; ++q) { const int row = r0 + q; const float g0 = tg[q][0], g1 = tg[q][1]; f32x4 v[4]; float s = 0.f;
#pragma unroll
            for (int hh = 0; hh < 2; ++hh) { f32x4 a0, a1, b0, b1; pg8::unpack8(y0[q][hh], a0, a1); pg8::unpack8(y1[q][hh], b0, b1);
                v[2 * hh] = xv[q][2 * hh] + a0 * g0 + b0 * g1; v[2 * hh + 1] = xv[q][2 * hh + 1] + a1 * g0 + b1 * g1; }
            if (yr0[q] >= 32768) {
#pragma unroll
                for (int sl = 0; sl < 3; ++sl) { const u32x4* p2 = (const u32x4*)(a.Y + ((size_t)34816 + sl * 2048 + (yr0[q] - 32768)) * 1024) + lane * 2;
#pragma unroll
                    for (int hh = 0; hh < 2; ++hh) { f32x4 c0, c1; pg8::unpack8(p2[hh], c0, c1); v[2 * hh] = v[2 * hh] + c0 * g0; v[2 * hh + 1] = v[2 * hh + 1] + c1 * g0; } } }
            if (yr1[q] >= 32768) {
#pragma unroll
                for (int sl = 0; sl < 3; ++sl) { const u32x4* p3 = (const u32x4*)(a.Y + ((size_t)34816 + sl * 2048 + (yr1[q] - 32768)) * 1024) + lane * 2;
#pragma unroll
                    for (int hh = 0; hh < 2; ++hh) { f32x4 d0, d1; pg8::unpack8(p3[hh], d0, d1); v[2 * hh] = v[2 * hh] + d0 * g1; v[2 * hh + 1] = v[2 * hh + 1] + d1 * g1; } } }
#pragma unroll
            for (int i = 0; i < 4; ++i) s += (v[i][0] * v[i][0] + v[i][1] * v[i][1]) + (v[i][2] * v[i][2] + v[i][3] * v[i][3]);
            u32x4* xb = (u32x4*)(a.XB + (size_t)row * 1024) + lane * 2; xb[0] = pg8::pack8(v[0], v[1]); xb[1] = pg8::pack8(v[2], v[3]);
            s = wave_sum(s);
            if (lane < 16) a.SSQ[(size_t)row * 16 + lane] = lane == 0 ? s : 0.f; }
    }
}
}
#define LAS __attribute__((address_space(3)))
typedef unsigned short bf16_t;
constexpr int M = 16384, NWAVES = 8;
constexpr size_t MiB = 1u << 20;
constexpr size_t WS_CTL = 0, CTL_ZERO_BYTES = 1 * MiB;
constexpr size_t WS_SMALL = 1 * MiB;
constexpr size_t WS_TOKI = 2 * MiB, WS_TOKG = WS_TOKI + (size_t)M * 16;
constexpr size_t WS_SSQA = 3 * MiB, WS_SSQB = 4 * MiB, WS_GATE = 5 * MiB;
constexpr size_t WS_RSG = 6 * MiB;
constexpr size_t WS_W = 8 * MiB;
constexpr size_t WS_W_IN = WS_W, WS_W_BR = WS_W_IN + (size_t)2 * 7168 * 1024 * 2, WS_W_OUT = WS_W_BR + (size_t)6 * 1024 * 512 * 2, WS_W_GU0 = WS_W_OUT + (size_t)2 * 1024 * 1024 * 2,
                 WS_W_DN0 = WS_W_GU0 + (size_t)5632 * 1024 * 2, WS_W_GU1 = WS_W_DN0 + (size_t)1024 * 2816 * 2, WS_W_DN1 = WS_W_GU1 + (size_t)8 * 7168 * 1024 * 2,
                 WS_W_PG = WS_W_DN1 + (size_t)8 * 1024 * 3584 * 2, WS_W_PP = WS_W_PG + (size_t)2 * 1024 * 1024 * 2, WS_W_END = WS_W_PP + (size_t)2 * 1024 * 256 * 2;
constexpr size_t WS_XB = (WS_W_END + MiB - 1) / MiB * MiB, WS_PP = WS_XB + (size_t)M * 1024 * 2, WS_PB = WS_PP + (size_t)2 * M * 1024 * 2, WS_X8 = WS_PB + (size_t)2 * M * 256 * 2, WS_RS1 = WS_X8 + (size_t)M * 1024, WS_AREA = WS_RS1 + MiB;
constexpr size_t WS_PROJ = WS_AREA, WS_MQ = WS_PROJ + (size_t)M * 7168 * 2, WS_MK = WS_MQ + (size_t)M * 512 * 2, WS_AQ = WS_MK + (size_t)M * 512 * 2, WS_AK = WS_AQ + (size_t)M * 512 * 2,
                 WS_HM = WS_AK + (size_t)M * 512 * 2, WS_HA = WS_HM + (size_t)M * 512 * 2, WS_HP = WS_HA + (size_t)M * 512 * 2, WS_ZF = WS_HP + (size_t)M * 512 * 2, WS_ZB = WS_ZF + (size_t)M * 1024 * 4,
                 WS_G8 = WS_ZB + (size_t)M * 1024 * 2, WS_LAYER_END = WS_G8 + (size_t)M * 3072;
constexpr size_t WS_XG = WS_AREA, WS_Y = WS_AREA, WS_ACT = WS_XG + (size_t)8 * 16384 * 1024 * 2, WS_END = WS_ACT + (size_t)34816 * 3584 * 2;
static_assert(WS_LAYER_END <= WS_END && WS_ACT >= WS_MQ, "AREA views");
constexpr int CW_BAR = 4096, CW_QUEUE = 16384, CW_ECNT = 16384 + 256;

#define XB_TMO      128
#define XB_XCNT(j)  (256  + 64 * (j))
#define XB_XSUB(j)  (1280 + 64 * (j))
#define XB_XGEN(j)  (2304 + 64 * (j))
#define XB_TOP      3328
#define XB_TOPGEN   3392
#define XCD_BAR_WORDS 3456
#define XB_SPIN_CAP (1u << 18)

__device__ __forceinline__ unsigned xb_ld(unsigned* p)              { return __hip_atomic_load(p, __ATOMIC_RELAXED, __HIP_MEMORY_SCOPE_AGENT); }
__device__ __forceinline__ unsigned xb_add(unsigned* p, unsigned v) { return __hip_atomic_fetch_add(p, v, __ATOMIC_RELAXED, __HIP_MEMORY_SCOPE_AGENT); }
__device__ __forceinline__ unsigned xb_xcc_id() { return (unsigned)__builtin_amdgcn_s_getreg((3 << 11) | 20) & 0xFu; }
#define XB_SPIN(cond, bar) do { unsigned _sp = 0; while (cond) { __builtin_amdgcn_s_sleep(1); \
    if ((++_sp & 255u) == 0u) { if (xb_ld(&(bar)[XB_TMO])) break; if (_sp > XB_SPIN_CAP) { atomicAdd(&(bar)[XB_TMO], 1u); break; } } } } while (0)

struct XcdBarrier {
    unsigned* bar; unsigned x;
    volatile LAS unsigned* st;
};

__device__ __forceinline__ XcdBarrier xcd_barrier_post(unsigned* bar, volatile LAS unsigned* st) {
    XcdBarrier b; b.bar = bar; b.x = xb_xcc_id(); b.st = st;
    if (threadIdx.x == 0) (void)xb_add(&bar[XB_XCNT(b.x)], 1u);
    return b;
}
__device__ __forceinline__ void xcd_barrier_complete(unsigned* bar, unsigned x, unsigned& nloc, unsigned& nx) {
    const unsigned G = gridDim.x * gridDim.y * gridDim.z;
    unsigned sum, cnt, mine, sp = 0u;
    for (;;) {
        sum = 0u; cnt = 0u; mine = 0u;
#pragma unroll
        for (unsigned j = 0; j < 16; ++j) { const unsigned c = xb_ld(&bar[XB_XCNT(j)]); sum += c; cnt += (c > 0u) ? 1u : 0u; mine = (j == x) ? c : mine; }
        if (sum == G) break;
        __builtin_amdgcn_s_sleep(1);
        if ((++sp & 255u) == 0u) { if (xb_ld(&bar[XB_TMO])) break; if (sp > XB_SPIN_CAP) { atomicAdd(&bar[XB_TMO], 1u); break; } }
    }
    nloc = mine > 0u ? mine : 1u; nx = cnt > 0u ? cnt : 1u;
}

__device__ __forceinline__ void xcd_barrier(const XcdBarrier& b) {
    asm volatile("s_waitcnt vmcnt(0)" ::: "memory");
    __syncthreads();
    if (threadIdx.x == 0) {
        unsigned* bar = b.bar;
        __builtin_amdgcn_s_waitcnt(0);
        unsigned nloc = b.st[0], nx = b.st[1];
        if (nloc == 0u) { xcd_barrier_complete(bar, b.x, nloc, nx); b.st[0] = nloc; b.st[1] = nx; }
        const unsigned old = xb_add(&bar[XB_XSUB(b.x)], 1u);
        const unsigned gen = old / nloc;
        if (old + 1u == (gen + 1u) * nloc) {
            __builtin_amdgcn_fence(__ATOMIC_RELEASE, "agent");
            asm volatile("s_waitcnt vmcnt(0)" ::: "memory");
            const unsigned og = xb_add(&bar[XB_TOP], 1u);
            const unsigned tg = og / nx;
            if (og + 1u == (tg + 1u) * nx) xb_add(&bar[XB_TOPGEN], 1u);
            else XB_SPIN(xb_ld(&bar[XB_TOPGEN]) == tg, bar);
            __builtin_amdgcn_fence(__ATOMIC_ACQUIRE, "agent");
            xb_add(&bar[XB_XGEN(b.x)], 1u);
            asm volatile("s_waitcnt vmcnt(0)" ::: "memory");
        } else {
            XB_SPIN(xb_ld(&bar[XB_XGEN(b.x)]) == gen, bar);
            __builtin_amdgcn_fence(__ATOMIC_ACQUIRE, "agent");
            asm volatile("s_waitcnt vmcnt(0)" ::: "memory");
        }
    }
    __syncthreads();
}


struct Args { const float* in[26]; float* out; unsigned char* ws; int ph_lo, ph_hi; };
static_assert(sizeof(Args) == 26 * 8 + 8 + 8 + 8, "Args has no padding");

constexpr int LDS_BYTES = 147456, MISC_OFF = 131072 + 8192;

__global__ void __launch_bounds__(NWAVES * 64, 2) fwd_kernel(Args args) {
    extern __shared__ __attribute__((aligned(16))) unsigned char lds[];
    const int tid = threadIdx.x;
    const int G = gridDim.x; int vcu; { const int bx = blockIdx.x; vcu = (G % 8 == 0) ? (bx % 8) * (G / 8) + bx / 8 : bx; }
    volatile LAS unsigned* MISC = (volatile LAS unsigned*)((LAS unsigned char*)lds + MISC_OFF);
    if (tid < 32) MISC[tid] = 0u;
    __syncthreads();
    unsigned char* ws = args.ws;
    unsigned* ctl = (unsigned*)(ws + WS_CTL);
    const int lo = args.ph_lo, hi = args.ph_hi;
    const bool one_launch = (hi - lo) > 1;
    XcdBarrier bar; bar.bar = ctl + CW_BAR; bar.x = 0; bar.st = nullptr;
    if (one_launch) bar = xcd_barrier_post(ctl + CW_BAR, MISC + 8);
#ifndef EPI_ALIGN8
#define EPI_ALIGN8 true
#endif
#ifndef SITE_MASK
#define SITE_MASK 0xffff
#endif
#define EN(s) ((SITE_MASK >> (s)) & 1)
#define IN(k) (lo <= (k) && (k) < hi)
#define SEAM(k) do { if (IN(k) && IN((k) + 1)) xcd_barrier(bar); } while (0)
    LAS unsigned char* ring = (LAS unsigned char*)lds;
    const float* const* in = args.in;
    float* X = args.out;
#define SITE_WS size_t wso_ = 0; asm volatile("" : "+s"(wso_)); unsigned char* wsl = ws + wso_;
#define p_XB ((bf16_t*)(wsl + WS_XB))
#define p_PB ((bf16_t*)(wsl + WS_PB))
#define p_PPb ((bf16_t*)(wsl + WS_PP))
#define p_SSQA ((float*)(wsl + WS_SSQA))
#define p_SSQB ((float*)(wsl + WS_SSQB))
#define p_GATE ((float*)(wsl + WS_GATE))
#define p_RSG ((float*)(wsl + WS_RSG))
#define p_WG ((float*)(wsl + WS_SMALL))
#define p_WR (((float*)(wsl + WS_SMALL) + 2 * 8192))
#define p_PROJ ((bf16_t*)(wsl + WS_PROJ))
#define p_MQ ((bf16_t*)(wsl + WS_MQ))
#define p_MK ((bf16_t*)(wsl + WS_MK))
#define p_AQ ((bf16_t*)(wsl + WS_AQ))
#define p_AK ((bf16_t*)(wsl + WS_AK))
#define p_HM ((bf16_t*)(wsl + WS_HM))
#define p_HA ((bf16_t*)(wsl + WS_HA))
#define p_HP ((bf16_t*)(wsl + WS_HP))
#define p_ZB ((bf16_t*)(wsl + WS_ZB))
#define p_XG ((bf16_t*)(wsl + WS_XG))
#define p_Yb ((bf16_t*)(wsl + WS_Y))
#define p_ACT ((bf16_t*)(wsl + WS_ACT))
#define p_TOKI ((int*)(wsl + WS_TOKI))
#define p_TOKG ((float*)(wsl + WS_TOKG))
#define p_W_IN ((bf16_t*)(wsl + WS_W_IN))
#define p_W_BR ((bf16_t*)(wsl + WS_W_BR))
#define p_W_OUT ((bf16_t*)(wsl + WS_W_OUT))
#define p_W_GU0 ((bf16_t*)(wsl + WS_W_GU0))
#define p_W_DN0 ((bf16_t*)(wsl + WS_W_DN0))
#define p_W_GU1 ((bf16_t*)(wsl + WS_W_GU1))
#define p_W_DN1 ((bf16_t*)(wsl + WS_W_DN1))
#define p_W_PG ((bf16_t*)(wsl + WS_W_PG))
#define p_W_PP ((bf16_t*)(wsl + WS_W_PP))
    if (EN(0) && IN(0)) {
        SITE_WS
        thin::ProIn a; a.x = in[0]; a.p = in[1]; a.attn_norm = in[2]; a.w_in = in[3]; a.pool_w = in[12]; a.pool_scale = in[13]; a.w_branch = in[14]; a.w_out = in[15]; a.ffn_norm = in[16];
        a.dense_w_gu = in[17]; a.dense_w_down = in[18]; a.router_w = in[19]; a.moe_w_gu = in[21]; a.moe_w_down = in[22]; a.ple_norm = in[23]; a.ple_w_gate = in[24]; a.ple_w_proj = in[25];
        a.W_IN = p_W_IN; a.W_BR = p_W_BR; a.W_OUT = p_W_OUT; a.W_GU0 = p_W_GU0; a.W_DN0 = p_W_DN0; a.W_GU1 = p_W_GU1; a.W_DN1 = p_W_DN1; a.W_PG = p_W_PG; a.W_PP = p_W_PP; a.XB = p_XB; a.PB = p_PB; a.X = X; a.SSQ = p_SSQA; a.WG = p_WG; a.WR = p_WR; a.X8 = (unsigned char*)(wsl + WS_X8); a.RS1 = (float*)(wsl + WS_RS1);
        a.W8_IN = (unsigned char*)(wsl + WS_W_IN); a.SB_IN = (float*)(wsl + WS_W_IN + (size_t)14 * MiB); a.W8_GU0 = (unsigned char*)(wsl + WS_W_GU0); a.SB_GU0 = (float*)(wsl + WS_W_GU0 + (size_t)6 * MiB);
        a.W8_GU1 = (unsigned char*)(wsl + WS_W_GU1); a.SB_GU1 = (float*)(wsl + WS_W_GU1 + (size_t)56 * MiB); a.GATE = p_GATE; a.gate_bias = in[6];
        thin::prologue(a, (char*)lds, vcu, G);
    }
    SEAM(0);
#pragma unroll 1
    for (int L = 0; L < 2; ++L) {
        const int pb = 2 + 11 * L;
        if (EN(2) && IN(pb)) {
            SITE_WS
            pg8::Gemm g{(const bf16_t*)(wsl + WS_X8), (const bf16_t*)(wsl + WS_W_IN + (size_t)L * 7168 * 1024), M, 7168, 512, 512}; pg8::StaticOrder S; S.init(M, 7168, G, (int)blockIdx.x);
            pg8::EpiProj8 E{p_PROJ, (const float*)(wsl + WS_RS1), (const float*)(wsl + WS_W_IN + (size_t)14 * MiB) + L * 7168, p_AQ, p_AK, in[8] + L * 64, in[9] + L * 64, (unsigned char*)(wsl + WS_G8)};
            pg8::gemm_phase<pg8::EpiProj8, pg8::StaticOrder, EPI_ALIGN8, true>(ring, g, S, E);
        }
        SEAM(pb);
        if (EN(3) && IN(pb + 1)) {
            SITE_WS
            thin::PrepIn a; a.PROJ = p_PROJ; a.XB = p_XB; a.SSQ = p_SSQA; a.WG = p_WG + L * 8192; a.conv_w = in[4] + L * 4096; a.conv_b = in[5] + L * 1024; a.gate_bias = in[6] + L * 8;
            a.q_gain = in[8] + L * 64; a.k_gain = in[9] + L * 64; a.MQ = p_MQ; a.MK = p_MK; a.AQ = p_AQ; a.AK = p_AK; a.HP = p_HP; a.GATE = p_GATE;
            thin::prep(a, (char*)lds, vcu, G);
        }
        SEAM(pb + 1);
        if (EN(4) && IN(pb + 2)) {
            SITE_WS
            mix::MixPtrs P; P.PROJ = p_PROJ; P.MQ = p_MQ; P.MK = p_MK; P.AQ = p_AQ; P.AK = p_AK; P.GATE = p_GATE; P.HM = p_HM; P.HA = p_HA; P.m_hgain = in[7] + L * 512; P.a_hgain = in[11] + L * 512;
            { const float* lp = in[10] + L * 256; float d01 = 0.f, d23 = 0.f; for (int i = 0; i < 64; ++i) { d01 = fmaf(lp[i], lp[64 + i], d01); d23 = fmaf(lp[128 + i], lp[192 + i], d23); }
              const float lam_init = 0.8f - 0.6f * __expf(-0.3f * (float)L);
              float* lamv = (float*)((char*)lds + MISC_OFF + 64); if (tid == 0) { lamv[0] = __expf(d01) - __expf(d23) + lam_init; lamv[1] = 1.f - lam_init; } __syncthreads(); P.lamv = lamv; }
            mix::mix_phase<true, true>((char*)lds, P, ctl + CW_QUEUE + 64 * L);
        }
        SEAM(pb + 2);
        if (EN(5) && IN(pb + 3)) {
            SITE_WS
            pg8::MergeOrder S; S.S.init(M, 1024, G, (int)blockIdx.x);
            pg8::Gemm g{p_HM, p_W_BR + (size_t)L * 3 * 1024 * 512, 3 * M, 1024, 512, 512}; pg8::EpiZs E{p_ZB, (const unsigned char*)(wsl + WS_G8)};
            pg8::gemm_phase<pg8::EpiZs, pg8::MergeOrder, true, true>(ring, g, S, E);
        }
        SEAM(pb + 3);
        if (EN(6) && IN(pb + 4)) {
            SITE_WS
            pg8::Gemm g{p_ZB, p_W_OUT + (size_t)L * 1024 * 1024, M, 1024, 1024, 1024}; pg8::StaticOrder S; S.init(M, 1024, G, (int)blockIdx.x);
            pg8::EpiRes E{p_XB, p_SSQB};
            pg8::gemm_phase<pg8::EpiRes, pg8::StaticOrder, true, true>(ring, g, S, E);
        }
        SEAM(pb + 4);
        if (L == 0) {
            if (EN(7) && IN(pb + 5)) {
                SITE_WS
                thin::quant_act<false>(p_XB, p_SSQB, (unsigned char*)(wsl + WS_X8), (float*)(wsl + WS_RS1), nullptr, nullptr, nullptr, vcu, G);
                pg8::Gemm g{p_PB, p_W_PP, 2 * M, 1024, 256, 256};
                pg8::PpOrder S; S.S.init(2 * M, 1024, G, (int)blockIdx.x);
                pg8::EpiPP E{p_PPb};
                pg8::gemm_phase<pg8::EpiPP, pg8::PpOrder, true, true>(ring, g, S, E);
            }
            SEAM(pb + 5);
            if (EN(8) && IN(pb + 6)) {
                SITE_WS
                pg8::Gemm g{(const bf16_t*)(wsl + WS_X8), (const bf16_t*)(wsl + WS_W_GU0), M, 5632, 512, 512}; pg8::StaticOrder S; S.init(M, 5632, G, (int)blockIdx.x);
                pg8::EpiUp8d E{p_ACT, (const float*)(wsl + WS_RS1), (const float*)(wsl + WS_W_GU0 + (size_t)6 * MiB)};
                pg8::gemm_phase<pg8::EpiUp8d, pg8::StaticOrder, true, true>(ring, g, S, E);
            }
            SEAM(pb + 6);
            if (EN(9) && IN(pb + 7)) {
                SITE_WS
                pg8::Gemm g{p_ACT, p_W_DN0, M, 1024, 2816, 2816}; pg8::StaticOrder S; S.init(M, 1024, G, (int)blockIdx.x);
                pg8::EpiRes E{p_XB, p_SSQB};
                pg8::gemm_phase<pg8::EpiRes, pg8::StaticOrder, true, true>(ring, g, S, E);
            }
            SEAM(pb + 7);
        } else {
            if (EN(7) && IN(pb + 5)) {
                SITE_WS
                thin::RouteIn a; a.X = X; a.SSQ = p_SSQB; a.WR = p_WR; a.router_b = in[20]; a.XB = p_XB; a.XG = p_XG; a.RSG = p_RSG; a.cnt = ctl + CW_ECNT; a.TOKI = p_TOKI; a.TOKG = p_TOKG;
                thin::route(a, (char*)lds, vcu, G);
            }
            SEAM(pb + 5);
            int ts[9]; ts[0] = 0;
#pragma unroll
            for (int e = 0; e < 8; ++e) { const unsigned c = __hip_atomic_load(ctl + CW_ECNT + e, __ATOMIC_RELAXED, __HIP_MEMORY_SCOPE_AGENT); ts[e + 1] = ts[e] + (int)((c + 255u) >> 8); }
            if (EN(10) && IN(pb + 6)) {
                SITE_WS
                pg8::Gemm g{p_XG, p_W_GU1, 0, 0, 512, 512};
                pg8::MoeOrder<true> S{ts[8], 28, ts[8] * 28, G, (int)blockIdx.x, ts[0], ts[1], ts[2], ts[3], ts[4], ts[5], ts[6], ts[7], 0};
                pg8::EpiUp8 E{p_ACT, p_RSG, (const float*)(wsl + WS_W_GU1 + (size_t)56 * MiB), ts[0], ts[1], ts[2], ts[3], ts[4], ts[5], ts[6], ts[7]};
                pg8::gemm_phase<pg8::EpiUp8, pg8::MoeOrder<true>, EPI_ALIGN8, true>(ring, g, S, E);
            }
            SEAM(pb + 6);
            if (EN(11) && IN(pb + 7)) {
                SITE_WS
                const int RA = ts[8] < 128 ? ts[8] : 128, RB = ts[8] - RA;
                { pg8::Gemm g{p_ACT, p_W_DN1, 0, 0, 3584, 3584};
                  pg8::MoeOrder<false> S{RA, 4, RA * 4, G, (int)blockIdx.x, ts[0], ts[1], ts[2], ts[3], ts[4], ts[5], ts[6], ts[7], 0};
                  pg8::EpiDownMoe E{p_Yb, p_Yb, 3584};
                  pg8::gemm_phase<pg8::EpiDownMoe, pg8::MoeOrder<false>, true, true>(ring, g, S, E); }
                if (RB > 0) { pg8::Gemm g{p_ACT, p_W_DN1, 0, 0, 896, 3584};
                  pg8::MoeOrder<false, 4, 896> S{RB, 4, RB * 4 * 4, G, (int)(G - 1 - blockIdx.x), ts[0], ts[1], ts[2], ts[3], ts[4], ts[5], ts[6], ts[7], 128};
                  pg8::EpiDownMoe E{p_Yb, p_Yb + (size_t)34816 * 1024, 896};
                  pg8::gemm_phase<pg8::EpiDownMoe, pg8::MoeOrder<false, 4, 896>, true, true>(ring, g, S, E); }
            }
            SEAM(pb + 7);
            if (EN(12) && IN(pb + 8)) {
                SITE_WS
                thin::CombIn a; a.X = X; a.XB = p_XB; a.SSQ = p_SSQB; a.Y = p_Yb; a.TOKI = p_TOKI; a.TOKG = p_TOKG;
#pragma unroll
                for (int e = 0; e < 8; ++e) a.ts[e] = ts[e];
                thin::combine(a, vcu, G);
            }
            SEAM(pb + 8);
        }
        if (EN(13) && IN(pb + 9)) {
            SITE_WS
            pg8::Gemm g{p_XB, p_W_PG + (size_t)L * 1024 * 1024, M, 1024, 1024, 1024}; pg8::StaticOrder S; S.init(M, 1024, G, (int)blockIdx.x);
            if (L == 0) { pg8::EpiPle<false> E{X, p_XB, p_SSQB, p_SSQA, p_PPb}; pg8::gemm_phase<pg8::EpiPle<false>, pg8::StaticOrder, true, true>(ring, g, S, E); }
            else { pg8::EpiPle<true> E{X, p_XB, p_SSQB, p_SSQA, p_PPb + (size_t)M * 1024}; pg8::gemm_phase<pg8::EpiPle<true>, pg8::StaticOrder, true, true>(ring, g, S, E); }
        }
        if (L == 0) {
            SEAM(pb + 9);
            if (EN(7) && IN(pb + 10)) {
                SITE_WS
                thin::quant_act<true>(p_XB, p_SSQA, (unsigned char*)(wsl + WS_X8), (float*)(wsl + WS_RS1), p_WG + 8192, in[6] + 8, p_GATE, vcu, G);
            }
            SEAM(pb + 10);
        }
    }
#undef IN
#undef SEAM
#undef EN
#undef SITE_WS
#undef p_XB
#undef p_PB
#undef p_PPb
#undef p_SSQA
#undef p_SSQB
#undef p_GATE
#undef p_RSG
#undef p_WG
#undef p_WR
#undef p_PROJ
#undef p_MQ
#undef p_MK
#undef p_AQ
#undef p_AK
#undef p_HM
#undef p_HA
#undef p_HP
#undef p_ZB
#undef p_XG
#undef p_Yb
#undef p_ACT
#undef p_TOKI
#undef p_TOKG
#undef p_W_IN
#undef p_W_BR
#undef p_W_OUT
#undef p_W_GU0
#undef p_W_DN0
#undef p_W_GU1
#undef p_W_DN1
#undef p_W_PG
#undef p_W_PP

}

constexpr int N_PHASES = 24;
extern "C" void kernel_launch(void* const* d_in, const int* in_sizes, int n_in, void* d_out, int out_size, void* d_ws, size_t ws_size, hipStream_t stream) {
    static int grid = 0;
    if (grid == 0) {
        if (n_in != 26 || out_size != M * 1024 || ws_size < WS_END) { fprintf(stderr, "kernel_launch: unexpected shapes (n_in %d out %d ws %zu need %zu)\n", n_in, out_size, ws_size, (size_t)WS_END); grid = -1; return; }
        int dev = 0, cus = 0, per_cu = 0;
        if (hipGetDevice(&dev) != hipSuccess || hipDeviceGetAttribute(&cus, hipDeviceAttributeMultiprocessorCount, dev) != hipSuccess) { grid = -1; return; }
        if (hipFuncSetAttribute((const void*)fwd_kernel, hipFuncAttributeMaxDynamicSharedMemorySize, LDS_BYTES) != hipSuccess) { fprintf(stderr, "kernel_launch: hipFuncSetAttribute failed\n"); grid = -1; return; }
        if (hipOccupancyMaxActiveBlocksPerMultiprocessor(&per_cu, (const void*)fwd_kernel, NWAVES * 64, LDS_BYTES) != hipSuccess || per_cu < 1) { fprintf(stderr, "kernel_launch: occupancy query says %d blocks per CU\n", per_cu); }
        (void)hipGetLastError();
        grid = cus;
    }
    if (grid < 0) return;
    if (hipMemsetAsync((char*)d_ws + WS_CTL, 0, CTL_ZERO_BYTES, stream) != hipSuccess) return;
    Args a{};
    for (int i = 0; i < 26; ++i) a.in[i] = (const float*)d_in[i];
    a.out = (float*)d_out; a.ws = (unsigned char*)d_ws;
#if N_LAUNCH_PER_PHASE
    for (int ph = 0; ph < N_PHASES; ++ph) { if (ph == 1 || ph == 10 || ph == 23) continue;
        a.ph_lo = ph; a.ph_hi = ph + 1; hipLaunchKernelGGL(fwd_kernel, dim3(grid), dim3(NWAVES * 64), LDS_BYTES, stream, a); }
#else
    a.ph_lo = 0; a.ph_hi = N_PHASES;
    hipLaunchKernelGGL(fwd_kernel, dim3(grid), dim3(NWAVES * 64), LDS_BYTES, stream, a);
#endif
    const hipError_t le = hipPeekAtLastError();
    if (le != hipSuccess) fprintf(stderr, "kernel_launch: launch failed: %s\n", hipGetErrorName(le));
}
```

```cpp
#include <hip/hip_runtime.h>
#include <cstdio>
#include <cstdint>
#include <cmath>
#define N_LAUNCH_PER_PHASE 0
namespace pg8 {
#define PG8_LAS __attribute__((address_space(3)))
typedef unsigned short bf16_t;
typedef short bf16x8 __attribute__((ext_vector_type(8)));
typedef float f32x4 __attribute__((ext_vector_type(4)));
typedef unsigned u32x4 __attribute__((ext_vector_type(4)));
constexpr int BM = 256, BK = 64, HALF = 128, HTB = HALF * BK * 2  , STAGE_BYTES = 8 * HTB, NXCD = 8, WGM = 8;

__host__ __device__ __forceinline__ int lds_byte(int r, int c) { const int st = (r >> 4) * 2 + (c >> 5), rr = r & 15, cc = c & 31, ob = rr * 64 + cc * 2; return st * 1024 + (ob ^ (((ob >> 9) & 1) << 5)); }
__host__ __device__ __forceinline__ void stage_rc(int b, int& R, int& C) { const int st = b / 1024, sb = b % 1024, swz = sb ^ (((sb >> 9) & 1) << 5); R = (st >> 1) * 16 + swz / 64; C = (st & 1) * 32 + (swz % 64) / 2; }
__host__ __device__ __forceinline__ int perm32(int rho) { const int n = rho >> 4, i = rho & 15; return 8 * (i >> 2) + 4 * n + (i & 3); }

struct Unit { int pm, pn, ko; };
struct Gemm { const bf16_t* A; const bf16_t* Bt; int M, N, K, ld; };

struct StaticOrder {
    int nM, nN, nwg, G, c;
    __host__ __device__ void init(int M, int N, int G_, int c_) { nM = M / BM; nN = N / BM; nwg = nM * nN; G = G_; c = c_; }
    __host__ __device__ bool next(int i, Unit& u) const {
        const long L = (long)i * G + c; if (L >= nwg) return false;
        int wgid = (int)L; { const int q = nwg / NXCD, r = nwg % NXCD, xcd = wgid % NXCD, off = wgid / NXCD; wgid = (xcd < r ? xcd * (q + 1) : r * (q + 1) + (xcd - r) * q) + off; }
        const int nig = WGM * nN, gid = wgid / nig, fm = gid * WGM, gsz = (nM - fm) < WGM ? (nM - fm) : WGM;
        u.pm = fm + ((wgid % nig) % gsz); u.pn = (wgid % nig) / gsz; u.ko = 0; return true;
    }
    __device__ __forceinline__ void a_ready(const Unit&) const {}
    __device__ __forceinline__ void done(const Unit&) const {}
};
__device__ __forceinline__ unsigned cvt_pk_bf16(float lo, float hi) { unsigned r; asm volatile("v_cvt_pk_bf16_f32 %0, %1, %2" : "=v"(r) : "v"(lo), "v"(hi)); return r; }
typedef float f32x2 __attribute__((ext_vector_type(2)));
typedef int i32x4 __attribute__((ext_vector_type(4)));
template <class E> struct EpiTraits { static constexpr bool CHAIN = false, F8 = false; };
template <bool I8> struct AccOf { typedef f32x4 type; };
template <> struct AccOf<true> { typedef i32x4 type; };
__device__ __forceinline__ f32x4 mma16(bf16x8 a, bf16x8 b, f32x4 c) { return __builtin_amdgcn_mfma_f32_16x16x32_bf16(a, b, c, 0, 0, 0); }
typedef int i32x8 __attribute__((ext_vector_type(8)));
__device__ __forceinline__ f32x4 mma16f8(i32x8 a, i32x8 b, f32x4 c) {
    asm volatile("v_mfma_scale_f32_16x16x128_f8f6f4 %0, %1, %2, %0, %3, %3 op_sel_hi:[0,0,0]" : "+v"(c) : "v"(a), "v"(b), "v"(0x7f7f7f7f));
    return c; }
__device__ __forceinline__ i32x8 ld_f8(const __attribute__((address_space(3))) unsigned char* p) {
    const i32x4 lo = *(const __attribute__((address_space(3))) i32x4*)p, hi = *(const __attribute__((address_space(3))) i32x4*)(p + 1024);
    return __builtin_shufflevector(lo, hi, 0, 1, 2, 3, 4, 5, 6, 7); }
__device__ __forceinline__ i32x4 mma16(bf16x8 a, bf16x8 b, i32x4 c) { return __builtin_amdgcn_mfma_i32_16x16x64_i8(__builtin_bit_cast(i32x4, a), __builtin_bit_cast(i32x4, b), c, 0, 0, 0); }
template <class Epi, class Sched, bool ALIGN_EPI = false, bool SP2 = false>
__device__ __forceinline__ void gemm_phase(PG8_LAS unsigned char* lds, const Gemm g, const Sched& S, const Epi& E) {
    int tid_o = threadIdx.x; asm volatile("" : "+v"(tid_o));
    const int tid = tid_o, wid = __builtin_amdgcn_readfirstlane(tid >> 6), lane = tid & 63, wr = wid >> 2, wc = wid & 3, fr = lane & 15, fq = lane >> 4;
    const int K = g.ld, nt = g.K / BK;
    unsigned voffA[2], voffB[2];
#pragma unroll
    for (int i = 0; i < 2; ++i) { int R, C; stage_rc(tid * 16 + i * 8192, R, C); const int Rb = Epi::PERM ? ((R & ~31) + perm32(R & 31)) : R;
        voffA[i] = (unsigned)(R * K + C) * 2u; voffB[i] = (unsigned)(Rb * K + C) * 2u; }
    const size_t kstep = (size_t)(BK * 2);
    const size_t hstep = (size_t)HALF * K * 2;
    const size_t tstep = 2 * hstep;
    const unsigned ldsw = (unsigned)wid * 1024u;
    const int aoff = lds_byte(wr * 64 + fr, fq * 8), boff = lds_byte(wc * 32 + fr, fq * 8);
#define PG8_SA(b, h) (((b) * 2 + (h)) * HTB)
#define PG8_SB(b, h) ((4 + (b) * 2 + (h)) * HTB)
#define PG8_STAGE(bufoff, gbase, voff) do { _Pragma("unroll") for (int _i = 0; _i < 2; ++_i) \
        __builtin_amdgcn_global_load_lds((const unsigned*)((const char*)(gbase) + (voff)[_i]), (PG8_LAS unsigned*)(lds + (bufoff) + ldsw + _i * 8192), 16, 0, 0); } while (0)
#define PG8_LDA(dst, b, h) do { _Pragma("unroll") for (int m = 0; m < 4; ++m) { if constexpr (EpiTraits<Epi>::F8) dst##8[m] = ld_f8(lds + PG8_SA(b, h) + aoff + m * 2048); \
        else { _Pragma("unroll") for (int k = 0; k < 2; ++k) dst[m][k] = *(const PG8_LAS bf16x8*)(lds + PG8_SA(b, h) + aoff + m * 2048 + k * 1024); } } } while (0)
#define PG8_LDB(dst, b, h) do { _Pragma("unroll") for (int n = 0; n < 2; ++n) { if constexpr (EpiTraits<Epi>::F8) dst##8[n] = ld_f8(lds + PG8_SB(b, h) + boff + n * 2048); \
        else { _Pragma("unroll") for (int k = 0; k < 2; ++k) dst[n][k] = *(const PG8_LAS bf16x8*)(lds + PG8_SB(b, h) + boff + n * 2048 + k * 1024); } } } while (0)
#define PG8_MMA(ai, bj, At, Bt) do { __builtin_amdgcn_s_setprio(1); _Pragma("unroll") for (int m = 0; m < 4; ++m) _Pragma("unroll") for (int n = 0; n < 2; ++n) { \
        if constexpr (EpiTraits<Epi>::F8) acc[ai][bj][m][n] = mma16f8(Bt##8[n], At##8[m], acc[ai][bj][m][n]); \
        else { _Pragma("unroll") for (int k = 0; k < 2; ++k) acc[ai][bj][m][n] = mma16(Bt[n][k], At[m][k], acc[ai][bj][m][n]); } } __builtin_amdgcn_s_setprio(0); } while (0)
#define PG8_WAIT_V(n) asm volatile("s_waitcnt vmcnt(" #n ")" ::: "memory")
#define PG8_WAIT_L(n) asm volatile("s_waitcnt lgkmcnt(" #n ")" ::: "memory")
#define PG8_BAR __builtin_amdgcn_s_barrier()
#define PG8_SCHED __builtin_amdgcn_sched_barrier(0)
    Unit cur, nxt; int ui = 0;
    if (!S.next(0, cur)) return;
    typedef typename AccOf<Epi::I8>::type acc_t;
    acc_t acc[2][2][4][2];
#pragma unroll
    for (int a = 0; a < 2; ++a)
#pragma unroll
        for (int b = 0; b < 2; ++b)
#pragma unroll
            for (int m = 0; m < 4; ++m)
#pragma unroll
                for (int n = 0; n < 2; ++n) acc[a][b][m][n] = (acc_t){0, 0, 0, 0};
    bf16x8 At[4][2], B0[2][2], B1[2][2];
    i32x8 At8[4], B08[2], B18[2];
    const char* cA = (const char*)g.A + (size_t)cur.pm * tstep + (size_t)cur.ko * 2; const char* cB = (const char*)g.Bt + (size_t)cur.pn * tstep + (size_t)cur.ko * 2;
    S.a_ready(cur);
    if constexpr (SP2) {
        PG8_STAGE(PG8_SB(0, 0), cB, voffB); PG8_STAGE(PG8_SB(0, 1), cB + hstep, voffB); PG8_STAGE(PG8_SA(0, 0), cA, voffA); PG8_STAGE(PG8_SA(0, 1), cA + hstep, voffA);
        if (wr == 1) PG8_BAR;
        PG8_WAIT_V(2); PG8_BAR;
        PG8_STAGE(PG8_SB(1, 0), cB + kstep, voffB); PG8_STAGE(PG8_SA(1, 0), cA + kstep, voffA); PG8_STAGE(PG8_SB(1, 1), cB + hstep + kstep, voffB);
        PG8_WAIT_V(6); PG8_BAR;
    } else {
        PG8_STAGE(PG8_SB(0, 0), cB, voffB); PG8_STAGE(PG8_SA(0, 0), cA, voffA); PG8_STAGE(PG8_SB(0, 1), cB + hstep, voffB); PG8_STAGE(PG8_SA(0, 1), cA + hstep, voffA);
        if (wr == 1) PG8_BAR;
        PG8_WAIT_V(4); PG8_BAR;
        PG8_STAGE(PG8_SB(1, 0), cB + kstep, voffB); PG8_STAGE(PG8_SA(1, 0), cA + kstep, voffA); PG8_STAGE(PG8_SB(1, 1), cB + hstep + kstep, voffB);
        PG8_WAIT_V(6); PG8_BAR;
    }
    for (;;) {
        const bool has_next = S.next(ui + 1, nxt);
        const char* nA = has_next ? (const char*)g.A + (size_t)nxt.pm * tstep + (size_t)nxt.ko * 2 : cA; const char* nB = has_next ? (const char*)g.Bt + (size_t)nxt.pn * tstep + (size_t)nxt.ko * 2 : cB;
#pragma unroll 1
        for (int t = 0; t < nt; t += 2) {
            const bool last = (t == nt - 2);
            const char* a1 = cA + (size_t)(t + 1) * kstep;
            const char* a2 = last ? nA : cA + (size_t)(t + 2) * kstep; const char* b2 = last ? nB : cB + (size_t)(t + 2) * kstep;
            const char* a3 = a2 + kstep; const char* b3 = b2 + kstep;
            if (last && has_next) S.a_ready(nxt);
            if constexpr (SP2) {
            PG8_LDB(B0, 0, 0); PG8_LDB(B1, 0, 1); PG8_SCHED; PG8_LDA(At, 0, 0); PG8_STAGE(PG8_SA(1, 1), a1 + hstep, voffA);
            PG8_WAIT_V(8); PG8_WAIT_L(0); PG8_BAR; PG8_MMA(0, 0, At, B0); PG8_MMA(0, 1, At, B1); PG8_BAR; PG8_SCHED;
            PG8_LDA(At, 0, 1); PG8_STAGE(PG8_SB(0, 0), b2, voffB); PG8_STAGE(PG8_SB(0, 1), b2 + hstep, voffB); PG8_STAGE(PG8_SA(0, 0), a2, voffA);
            PG8_WAIT_V(8); PG8_WAIT_L(0); PG8_BAR; PG8_MMA(1, 0, At, B0); PG8_MMA(1, 1, At, B1); PG8_BAR; PG8_SCHED;
            PG8_LDB(B0, 1, 0); PG8_LDB(B1, 1, 1); PG8_SCHED; PG8_LDA(At, 1, 0); PG8_STAGE(PG8_SA(0, 1), a2 + hstep, voffA);
            PG8_WAIT_V(8); PG8_WAIT_L(0); PG8_BAR; PG8_MMA(0, 0, At, B0); PG8_MMA(0, 1, At, B1); PG8_BAR; PG8_SCHED;
            PG8_LDA(At, 1, 1); PG8_STAGE(PG8_SB(1, 0), b3, voffB); PG8_STAGE(PG8_SB(1, 1), b3 + hstep, voffB); PG8_STAGE(PG8_SA(1, 0), a3, voffA);
            PG8_WAIT_V(8); PG8_WAIT_L(0); PG8_BAR; PG8_MMA(1, 0, At, B0); PG8_MMA(1, 1, At, B1); PG8_BAR; PG8_SCHED;
            } else {
            PG8_LDB(B0, 0, 0); PG8_SCHED; PG8_LDA(At, 0, 0); PG8_STAGE(PG8_SA(1, 1), a1 + hstep, voffA);
            PG8_WAIT_L(8); PG8_BAR; PG8_WAIT_L(0); PG8_MMA(0, 0, At, B0); PG8_BAR; PG8_SCHED;
            PG8_LDB(B1, 0, 1); PG8_STAGE(PG8_SB(0, 0), b2, voffB);
            PG8_BAR; PG8_WAIT_L(0); PG8_MMA(0, 1, At, B1); PG8_BAR;
            PG8_LDA(At, 0, 1); PG8_STAGE(PG8_SA(0, 0), a2, voffA);
            PG8_BAR; PG8_WAIT_L(0); PG8_MMA(1, 0, At, B0); PG8_BAR; PG8_SCHED;
            PG8_STAGE(PG8_SB(0, 1), b2 + hstep, voffB);
            PG8_WAIT_V(6); PG8_BAR; PG8_MMA(1, 1, At, B1); PG8_BAR;
            PG8_LDB(B0, 1, 0); PG8_SCHED; PG8_LDA(At, 1, 0); PG8_STAGE(PG8_SA(0, 1), a2 + hstep, voffA);
            PG8_WAIT_L(8); PG8_BAR; PG8_WAIT_L(0); PG8_MMA(0, 0, At, B0); PG8_BAR; PG8_SCHED;
            PG8_LDB(B1, 1, 1); PG8_STAGE(PG8_SB(1, 0), b3, voffB);
            PG8_BAR; PG8_WAIT_L(0); PG8_MMA(0, 1, At, B1); PG8_BAR;
            PG8_LDA(At, 1, 1); PG8_STAGE(PG8_SA(1, 0), a3, voffA);
            PG8_BAR; PG8_WAIT_L(0); PG8_MMA(1, 0, At, B0); PG8_BAR; PG8_SCHED;
            PG8_STAGE(PG8_SB(1, 1), b3 + hstep, voffB);
            PG8_WAIT_V(6); PG8_BAR; PG8_MMA(1, 1, At, B1); PG8_BAR;
            }
        }
        if constexpr (ALIGN_EPI) { if (wr == 0) PG8_BAR; }
        if constexpr (EpiTraits<Epi>::CHAIN) { E.chain(acc, cur, wr, wc, fr, fq); S.done(cur); } else
        if constexpr (!Epi::AFTER_DRAIN) { E(acc, cur, wr, wc, fr, fq); S.done(cur); }
        if (!has_next) break;
        bool zero_acc = true; if constexpr (EpiTraits<Epi>::CHAIN) zero_acc = E.last(cur);
        if (zero_acc) {
#pragma unroll
        for (int a = 0; a < 2; ++a)
#pragma unroll
            for (int b = 0; b < 2; ++b)
#pragma unroll
                for (int m = 0; m < 4; ++m)
#pragma unroll
                    for (int n = 0; n < 2; ++n) acc[a][b][m][n] = (acc_t){0, 0, 0, 0};
        }
        cur = nxt; cA = nA; cB = nB; ++ui;
        if constexpr (ALIGN_EPI) { if (wr == 1) PG8_BAR; }
    }
    PG8_WAIT_V(0);
    if constexpr (!ALIGN_EPI) { if (wr == 0) PG8_BAR; }
    PG8_BAR;
    if constexpr (Epi::AFTER_DRAIN) { E.fused(acc, cur, wr, wc, fr, fq, lds, wid, lane); S.done(cur); }
#undef PG8_SA
#undef PG8_SB
#undef PG8_STAGE
#undef PG8_LDA
#undef PG8_LDB
#undef PG8_MMA
#undef PG8_WAIT_V
#undef PG8_WAIT_L
#undef PG8_BAR
#undef PG8_SCHED
}
}
namespace pg8 {
constexpr float kLog2e = 1.4426950408889634f;
__device__ __forceinline__ float fsigmoid(float x) { return __builtin_amdgcn_rcpf(1.f + __builtin_amdgcn_exp2f(-kLog2e * x)); }
__device__ __forceinline__ u32x4 pack8(const f32x4& a, const f32x4& b) { u32x4 w; w.x = cvt_pk_bf16(a[0], a[1]); w.y = cvt_pk_bf16(a[2], a[3]); w.z = cvt_pk_bf16(b[0], b[1]); w.w = cvt_pk_bf16(b[2], b[3]); return w; }
constexpr float kActScale = 8.f;
__device__ __forceinline__ unsigned cvt4_f8(float a, float b, float c, float d) {
    a = fminf(fmaxf(a, -448.f), 448.f); b = fminf(fmaxf(b, -448.f), 448.f); c = fminf(fmaxf(c, -448.f), 448.f); d = fminf(fmaxf(d, -448.f), 448.f);
    unsigned w = 0; w = __builtin_amdgcn_cvt_pk_fp8_f32(a, b, w, false); w = __builtin_amdgcn_cvt_pk_fp8_f32(c, d, w, true); return w; }
__device__ __forceinline__ void unpack8(const u32x4& w, f32x4& a, f32x4& b) {
    a[0] = __builtin_bit_cast(float, w.x << 16); a[1] = __builtin_bit_cast(float, w.x & 0xffff0000u); a[2] = __builtin_bit_cast(float, w.y << 16); a[3] = __builtin_bit_cast(float, w.y & 0xffff0000u);
    b[0] = __builtin_bit_cast(float, w.z << 16); b[1] = __builtin_bit_cast(float, w.z & 0xffff0000u); b[2] = __builtin_bit_cast(float, w.w << 16); b[3] = __builtin_bit_cast(float, w.w & 0xffff0000u);
}
__device__ __forceinline__ float row_rstd(const float* ssq, int row) {
    const f32x4* p = (const f32x4*)(ssq + (size_t)row * 16); const f32x4 a = p[0], b = p[1], c = p[2], d = p[3];
    const float s = ((a[0] + a[1]) + (a[2] + a[3])) + ((b[0] + b[1]) + (b[2] + b[3])) + ((c[0] + c[1]) + (c[2] + c[3])) + ((d[0] + d[1]) + (d[2] + d[3]));
    return __builtin_amdgcn_rsqf(s * (1.f / 1024.f) + 1e-6f);
}
__device__ __forceinline__ float sumsq8(const f32x4& a, const f32x4& b) { return (a[0] * a[0] + a[1] * a[1]) + (a[2] * a[2] + a[3] * a[3]) + (b[0] * b[0] + b[1] * b[1]) + (b[2] * b[2] + b[3] * b[3]); }
__device__ __forceinline__ float quad_sum_fq(float s) { s += __shfl_xor(s, 16); s += __shfl_xor(s, 32); return s; }

struct EpiProj {
    static constexpr bool PERM = true, AFTER_DRAIN = false, I8 = false;
    bf16_t* O; const float* ssq;
    __device__ __forceinline__ void operator()(const f32x4 (&acc)[2][2][4][2], const Unit& u, int wr, int wc, int fr, int fq) const {
        const bool sg = (u.pn == 6) || (u.pn == 7) || (u.pn >= 16);
        const int row0 = u.pm * BM + wr * 64 + fr, col0 = u.pn * BM + wc * 32 + 8 * fq;
#pragma unroll
        for (int ai = 0; ai < 2; ++ai)
#pragma unroll
            for (int m = 0; m < 4; ++m) { const int row = row0 + ai * HALF + m * 16; const float r = row_rstd(ssq, row); bf16_t* rowp = O + (size_t)row * 7168 + col0;
#pragma unroll
                for (int bj = 0; bj < 2; ++bj) { f32x4 v0 = acc[ai][bj][m][0] * r, v1 = acc[ai][bj][m][1] * r;
                    if (sg) {
#pragma unroll
                        for (int j = 0; j < 4; ++j) { v0[j] = fsigmoid(v0[j]); v1[j] = fsigmoid(v1[j]); } }
                    *(u32x4*)(rowp + bj * HALF) = pack8(v0, v1); } }
    }
};
struct EpiPlain {
    static constexpr bool PERM = true, AFTER_DRAIN = false, I8 = false;
    bf16_t* O;
    __device__ __forceinline__ void operator()(const f32x4 (&acc)[2][2][4][2], const Unit& u, int wr, int wc, int fr, int fq) const {
        const int row0 = u.pm * BM + wr * 64 + fr, col0 = u.pn * BM + wc * 32 + 8 * fq;
#pragma unroll
        for (int ai = 0; ai < 2; ++ai)
#pragma unroll
            for (int m = 0; m < 4; ++m) { bf16_t* rowp = O + (size_t)(row0 + ai * HALF + m * 16) * 1024 + col0;
#pragma unroll
                for (int bj = 0; bj < 2; ++bj) *(u32x4*)(rowp + bj * HALF) = pack8(acc[ai][bj][m][0], acc[ai][bj][m][1]); }
    }
};
template <int R> struct EpiZ {
    static constexpr bool PERM = true, AFTER_DRAIN = false, I8 = false;
    float* ZF; bf16_t* ZB; const bf16_t* PROJ;
    __device__ __forceinline__ void operator()(const f32x4 (&acc)[2][2][4][2], const Unit& u, int wr, int wc, int fr, int fq) const {
        const int row0 = u.pm * BM + wr * 64 + fr, col0 = u.pn * BM + wc * 32 + 8 * fq;
#pragma unroll
        for (int ai = 0; ai < 2; ++ai)
#pragma unroll
            for (int m = 0; m < 4; ++m) { const size_t row = (size_t)(row0 + ai * HALF + m * 16);
#pragma unroll
                for (int bj = 0; bj < 2; ++bj) { const int col = col0 + bj * HALF;
                    f32x4 g0, g1; unpack8(*(const u32x4*)(PROJ + row * 7168 + 4096 + R * 1024 + col), g0, g1);
                    f32x4 v0 = acc[ai][bj][m][0] * g0, v1 = acc[ai][bj][m][1] * g1; float* zp = ZF + row * 1024 + col;
                    if (R > 0) { v0 = v0 + *(const f32x4*)zp; v1 = v1 + *(const f32x4*)(zp + 4); }
                    if (R < 2) { *(f32x4*)zp = v0; *(f32x4*)(zp + 4) = v1; } else *(u32x4*)(ZB + row * 1024 + col) = pack8(v0, v1); } }
    }
};
struct EpiRes {
    static constexpr bool PERM = true, AFTER_DRAIN = false, I8 = false;
    bf16_t* XB; float* ssq;
    __device__ __forceinline__ void operator()(const f32x4 (&acc)[2][2][4][2], const Unit& u, int wr, int wc, int fr, int fq) const {
        const int row0 = u.pm * BM + wr * 64 + fr, col0 = u.pn * BM + wc * 32 + 8 * fq;
        bf16_t* const xb0 = XB + (size_t)row0 * 1024 + col0;
        u32x4 xin[2][4][2];
#pragma unroll
        for (int ai = 0; ai < 2; ++ai)
#pragma unroll
            for (int m = 0; m < 4; ++m)
#pragma unroll
                for (int bj = 0; bj < 2; ++bj) xin[ai][m][bj] = *(const u32x4*)(xb0 + (size_t)(ai * HALF + m * 16) * 1024 + bj * HALF);
#pragma unroll
        for (int ai = 0; ai < 2; ++ai)
#pragma unroll
            for (int m = 0; m < 4; ++m) { const size_t row = (size_t)(row0 + ai * HALF + m * 16); float s = 0.f;
#pragma unroll
                for (int bj = 0; bj < 2; ++bj) { f32x4 x0, x1; unpack8(xin[ai][m][bj], x0, x1);
                    const f32x4 v0 = x0 + acc[ai][bj][m][0], v1 = x1 + acc[ai][bj][m][1];
                    *(u32x4*)(xb0 + (size_t)(ai * HALF + m * 16) * 1024 + bj * HALF) = pack8(v0, v1); s += sumsq8(v0, v1); }
                s = quad_sum_fq(s); if (fq == 0) ssq[row * 16 + u.pn * 4 + wc] = s; }
    }
};
struct EpiResF8 {
    static constexpr bool PERM = true, AFTER_DRAIN = false, I8 = false;
    bf16_t* XB; float* ssq; const float* dq;
    __device__ __forceinline__ void operator()(const f32x4 (&acc)[2][2][4][2], const Unit& u, int wr, int wc, int fr, int fq) const {
        const int row0 = u.pm * BM + wr * 64 + fr, col0 = u.pn * BM + wc * 32 + 8 * fq;
        bf16_t* const xb0 = XB + (size_t)row0 * 1024 + col0; const float qs = dq[0];
        u32x4 xin[2][4][2];
#pragma unroll
        for (int ai = 0; ai < 2; ++ai)
#pragma unroll
            for (int m = 0; m < 4; ++m)
#pragma unroll
                for (int bj = 0; bj < 2; ++bj) xin[ai][m][bj] = *(const u32x4*)(xb0 + (size_t)(ai * HALF + m * 16) * 1024 + bj * HALF);
#pragma unroll
        for (int ai = 0; ai < 2; ++ai)
#pragma unroll
            for (int m = 0; m < 4; ++m) { const size_t row = (size_t)(row0 + ai * HALF + m * 16); float s = 0.f;
#pragma unroll
                for (int bj = 0; bj < 2; ++bj) { f32x4 x0, x1; unpack8(xin[ai][m][bj], x0, x1);
                    const f32x4 v0 = x0 + acc[ai][bj][m][0] * qs, v1 = x1 + acc[ai][bj][m][1] * qs;
                    *(u32x4*)(xb0 + (size_t)(ai * HALF + m * 16) * 1024 + bj * HALF) = pack8(v0, v1); s += sumsq8(v0, v1); }
                s = quad_sum_fq(s); if (fq == 0) ssq[row * 16 + u.pn * 4 + wc] = s; }
    }
};
template <> struct EpiTraits<EpiResF8> { static constexpr bool CHAIN = false, F8 = true; };
template <bool LAST> struct EpiPle {
    static constexpr bool PERM = true, AFTER_DRAIN = false, I8 = false;
    float* OUT; bf16_t* XB; const float* ssq_in; float* ssq_out; const bf16_t* PP;
    __device__ __forceinline__ void operator()(const f32x4 (&acc)[2][2][4][2], const Unit& u, int wr, int wc, int fr, int fq) const {
        const int row0 = u.pm * BM + wr * 64 + fr, col0 = u.pn * BM + wc * 32 + 8 * fq;
        bf16_t* const xb0 = XB + (size_t)row0 * 1024 + col0; const bf16_t* const pp0 = PP + (size_t)row0 * 1024 + col0;
        float rs[2][4];
        { f32x4 sq[2][4];
#pragma unroll
          for (int ai = 0; ai < 2; ++ai)
#pragma unroll
              for (int m = 0; m < 4; ++m) sq[ai][m] = *(const f32x4*)(ssq_in + (size_t)(row0 + ai * HALF + m * 16) * 16 + 4 * fq);
#pragma unroll
          for (int ai = 0; ai < 2; ++ai)
#pragma unroll
              for (int m = 0; m < 4; ++m) rs[ai][m] = __builtin_amdgcn_rsqf(quad_sum_fq((sq[ai][m][0] + sq[ai][m][1]) + (sq[ai][m][2] + sq[ai][m][3])) * (1.f / 1024.f) + 1e-6f); }
        constexpr int MB = 2;
#pragma unroll
        for (int ai = 0; ai < 2; ++ai)
#pragma unroll
          for (int mb = 0; mb < 4; mb += MB) {
            u32x4 xin[MB][2], pin[MB][2];
#pragma unroll
            for (int mm = 0; mm < MB; ++mm)
#pragma unroll
                for (int bj = 0; bj < 2; ++bj) { xin[mm][bj] = *(const u32x4*)(xb0 + (size_t)(ai * HALF + (mb + mm) * 16) * 1024 + bj * HALF); pin[mm][bj] = *(const u32x4*)(pp0 + (size_t)(ai * HALF + (mb + mm) * 16) * 1024 + bj * HALF); }
#pragma unroll
            for (int mm = 0; mm < MB; ++mm) { const int m = mb + mm; const size_t row = (size_t)(row0 + ai * HALF + m * 16); const float r = rs[ai][m]; float s = 0.f;
#pragma unroll
                for (int bj = 0; bj < 2; ++bj) { f32x4 x0, x1; unpack8(xin[mm][bj], x0, x1);
                    f32x4 p0, p1; unpack8(pin[mm][bj], p0, p1);
                    f32x4 v0 = acc[ai][bj][m][0] * r, v1 = acc[ai][bj][m][1] * r;
#pragma unroll
                    for (int j = 0; j < 4; ++j) { v0[j] = fsigmoid(v0[j]) * p0[j]; v1[j] = fsigmoid(v1[j]) * p1[j]; }
                    v0 = v0 + x0; v1 = v1 + x1;
                    if (LAST) { float* op = OUT + row * 1024 + col0 + bj * HALF; *(f32x4*)op = v0; *(f32x4*)(op + 4) = v1; }
                    else { *(u32x4*)(xb0 + (size_t)(ai * HALF + m * 16) * 1024 + bj * HALF) = pack8(v0, v1); s += sumsq8(v0, v1); } }
                if (!LAST) { s = quad_sum_fq(s); if (fq == 0) ssq_out[row * 16 + u.pn * 4 + wc] = s; } }
          }
    }
};
template <bool MOE> struct EpiUp {
    static constexpr bool PERM = true, AFTER_DRAIN = false, I8 = false;
    bf16_t* ACT; int F; const float* rs; int ts0, ts1, ts2, ts3, ts4, ts5, ts6, ts7;
    __device__ __forceinline__ void operator()(const f32x4 (&acc)[2][2][4][2], const Unit& u, int wr, int wc, int fr, int fq) const {
        int pnl = u.pn, otile = u.pm;
        if (MOE) { const int e = u.pm >> 6, rt = u.pm & 63; pnl = u.pn - e * 28;
            const int tse = e == 0 ? ts0 : e == 1 ? ts1 : e == 2 ? ts2 : e == 3 ? ts3 : e == 4 ? ts4 : e == 5 ? ts5 : e == 6 ? ts6 : ts7; otile = tse + rt; }
        const int lrow0 = wr * 64 + fr, col0 = pnl * 128 + wc * 32 + 8 * fq;
#pragma unroll
        for (int ai = 0; ai < 2; ++ai)
#pragma unroll
            for (int m = 0; m < 4; ++m) { const int lrow = lrow0 + ai * HALF + m * 16;
                const float r = MOE ? rs[(size_t)u.pm * BM + lrow] : row_rstd(rs, u.pm * BM + lrow);
                f32x4 g0 = acc[ai][0][m][0] * r, g1 = acc[ai][0][m][1] * r, u0 = acc[ai][1][m][0] * r, u1 = acc[ai][1][m][1] * r;
#pragma unroll
                for (int j = 0; j < 4; ++j) { g0[j] = g0[j] * fsigmoid(g0[j]) * u0[j]; g1[j] = g1[j] * fsigmoid(g1[j]) * u1[j]; }
                *(u32x4*)(ACT + (size_t)(otile * BM + lrow) * F + col0) = pack8(g0, g1); }
    }
};
struct EpiDownMoe {
    static constexpr bool PERM = true, AFTER_DRAIN = false, I8 = false;
    bf16_t* Y; bf16_t* Yx; int klen; const float* dq;
    __device__ __forceinline__ void operator()(const f32x4 (&acc)[2][2][4][2], const Unit& u, int wr, int wc, int fr, int fq) const {
        bf16_t* Y = this->Y; if (u.ko) { const int s = u.ko / klen; Y = Yx + ((size_t)(s - 1) * 2048 - 32768) * 1024; }
        const int row0 = u.pm * BM + wr * 64 + fr, col0 = (u.pn & 3) * BM + wc * 32 + 8 * fq; const float qs = dq[u.pn >> 2];
#pragma unroll
        for (int ai = 0; ai < 2; ++ai)
#pragma unroll
            for (int m = 0; m < 4; ++m) { bf16_t* rowp = Y + (size_t)(row0 + ai * HALF + m * 16) * 1024 + col0;
#pragma unroll
                for (int bj = 0; bj < 2; ++bj) *(u32x4*)(rowp + bj * HALF) = pack8(acc[ai][bj][m][0] * qs, acc[ai][bj][m][1] * qs); }
    }
};
template <> struct EpiTraits<EpiDownMoe> { static constexpr bool CHAIN = false, F8 = true; };
template <bool UP, int KSPLIT = 1, int KLEN = 0> struct MoeOrder {
    int R, nN, nwg, G, c; int ts0, ts1, ts2, ts3, ts4, ts5, ts6, ts7; int pm0;
    __device__ __forceinline__ bool next(int i, Unit& u) const {
        const long L = (long)i * G + c; if (L >= nwg) return false;
        const int ks = (int)(L % KSPLIT); u.ko = ks * KLEN;
        int wgid = (int)(L / KSPLIT); const int nwg = this->nwg / KSPLIT; { const int q = nwg / NXCD, r = nwg % NXCD, xcd = wgid % NXCD, off = wgid / NXCD; wgid = (xcd < r ? xcd * (q + 1) : r * (q + 1) + (xcd - r) * q) + off; }
        const int nig = WGM * nN, gid = wgid / nig, fm = gid * WGM, gsz = (R - fm) < WGM ? (R - fm) : WGM;
        const int pmc = pm0 + fm + ((wgid % nig) % gsz), pnl = (wgid % nig) / gsz;
        const int e = (pmc >= ts1) + (pmc >= ts2) + (pmc >= ts3) + (pmc >= ts4) + (pmc >= ts5) + (pmc >= ts6) + (pmc >= ts7);
        const int tse = e == 0 ? ts0 : e == 1 ? ts1 : e == 2 ? ts2 : e == 3 ? ts3 : e == 4 ? ts4 : e == 5 ? ts5 : e == 6 ? ts6 : ts7;
        if (UP) { u.pm = e * 64 + (pmc - tse); u.pn = e * 28 + pnl; } else { u.pm = pmc; u.pn = e * 4 + pnl; }
        return true;
    }
    __device__ __forceinline__ void a_ready(const Unit&) const {}
    __device__ __forceinline__ void done(const Unit&) const {}
};
struct EpiZs {
    static constexpr bool PERM = true, AFTER_DRAIN = false, I8 = false;
    bf16_t* ZB; const unsigned char* G8;
    __device__ __forceinline__ bool last(const Unit& u) const { return (u.pm >> 6) == 2; }
    __device__ __forceinline__ void operator()(const f32x4 (&acc)[2][2][4][2], const Unit& u, int wr, int wc, int fr, int fq) const {}
    __device__ __forceinline__ void chain(f32x4 (&acc)[2][2][4][2], const Unit& u, int wr, int wc, int fr, int fq) const {
        typedef unsigned u32x2 __attribute__((ext_vector_type(2)));
        const int r = u.pm >> 6, pm = u.pm & 63, pn = u.pn & 3;
        const int row0 = pm * BM + wr * 64 + fr, col0 = pn * BM + wc * 32 + 8 * fq;
        const unsigned char* const g0p = G8 + (size_t)row0 * 3072 + r * 1024 + col0;
        if (r < 2) {
#pragma unroll
            for (int ai = 0; ai < 2; ++ai) {
                u32x2 ga[4][2], gb[4][2];
#pragma unroll
                for (int m = 0; m < 4; ++m)
#pragma unroll
                    for (int bj = 0; bj < 2; ++bj) { const unsigned char* p = g0p + (size_t)(ai * HALF + m * 16) * 3072 + bj * HALF; ga[m][bj] = *(const u32x2*)p; gb[m][bj] = *(const u32x2*)(p + 1024); }
#pragma unroll
                for (int m = 0; m < 4; ++m)
#pragma unroll
                    for (int bj = 0; bj < 2; ++bj)
#pragma unroll
                        for (int j = 0; j < 4; ++j) {
                            acc[ai][bj][m][0][j] *= (float)((ga[m][bj].x >> (8 * j)) & 0xffu) * __builtin_amdgcn_rcpf((float)((gb[m][bj].x >> (8 * j)) & 0xffu));
                            acc[ai][bj][m][1][j] *= (float)((ga[m][bj].y >> (8 * j)) & 0xffu) * __builtin_amdgcn_rcpf((float)((gb[m][bj].y >> (8 * j)) & 0xffu)); }
            }
        } else {
            bf16_t* const zb0 = ZB + (size_t)row0 * 1024 + col0;
            u32x2 gw[2][4][2];
#pragma unroll
            for (int ai = 0; ai < 2; ++ai)
#pragma unroll
                for (int m = 0; m < 4; ++m)
#pragma unroll
                    for (int bj = 0; bj < 2; ++bj) gw[ai][m][bj] = *(const u32x2*)(g0p + (size_t)(ai * HALF + m * 16) * 3072 + bj * HALF);
#pragma unroll
            for (int ai = 0; ai < 2; ++ai)
#pragma unroll
                for (int m = 0; m < 4; ++m)
#pragma unroll
                    for (int bj = 0; bj < 2; ++bj) { const u32x2 g = gw[ai][m][bj]; f32x4 g0, g1;
#pragma unroll
                        for (int j = 0; j < 4; ++j) { g0[j] = (float)((g.x >> (8 * j)) & 0xffu) * (1.f / 255.f); g1[j] = (float)((g.y >> (8 * j)) & 0xffu) * (1.f / 255.f); }
                        *(u32x4*)(zb0 + (size_t)(ai * HALF + m * 16) * 1024 + bj * HALF) = pack8(acc[ai][bj][m][0] * g0, acc[ai][bj][m][1] * g1); }
        }
    }
};
template <> struct EpiTraits<EpiZs> { static constexpr bool CHAIN = true, F8 = false; };
struct MergeOrder {
    StaticOrder S;
    __device__ __forceinline__ bool next(int i, Unit& u) const { const int t = i / 3, r = i - 3 * t; if (!S.next(t, u)) return false; u.pm += r * 64; u.pn += r * 4; return true; }
    __device__ __forceinline__ void a_ready(const Unit&) const {}
    __device__ __forceinline__ void done(const Unit&) const {}
};
struct PpOrder {
    StaticOrder S;
    __device__ __forceinline__ bool next(int i, Unit& u) const { if (!S.next(i, u)) return false; u.pn += (u.pm >> 6) * 4; return true; }
    __device__ __forceinline__ void a_ready(const Unit&) const {}
    __device__ __forceinline__ void done(const Unit&) const {}
};
struct EpiPP {
    static constexpr bool PERM = true, AFTER_DRAIN = false, I8 = false;
    bf16_t* Y;
    __device__ __forceinline__ void operator()(const f32x4 (&acc)[2][2][4][2], const Unit& u, int wr, int wc, int fr, int fq) const {
        const int row0 = u.pm * BM + wr * 64 + fr, col0 = (u.pn & 3) * BM + wc * 32 + 8 * fq;
#pragma unroll
        for (int ai = 0; ai < 2; ++ai)
#pragma unroll
            for (int m = 0; m < 4; ++m) { bf16_t* rowp = Y + (size_t)(row0 + ai * HALF + m * 16) * 1024 + col0;
#pragma unroll
                for (int bj = 0; bj < 2; ++bj) *(u32x4*)(rowp + bj * HALF) = pack8(acc[ai][bj][m][0], acc[ai][bj][m][1]); }
    }
};
struct EpiUp8 {
    static constexpr bool PERM = true, AFTER_DRAIN = false, I8 = true;
    unsigned char* ACT; const float* rs; const float* sb; int ts0, ts1, ts2, ts3, ts4, ts5, ts6, ts7;
    __device__ __forceinline__ void operator()(const i32x4 (&acc)[2][2][4][2], const Unit& u, int wr, int wc, int fr, int fq) const {
        typedef unsigned u32x2 __attribute__((ext_vector_type(2)));
        const int e = u.pm >> 6, rt = u.pm & 63, pnl = u.pn - e * 28;
        const int tse = e == 0 ? ts0 : e == 1 ? ts1 : e == 2 ? ts2 : e == 3 ? ts3 : e == 4 ? ts4 : e == 5 ? ts5 : e == 6 ? ts6 : ts7, otile = tse + rt;
        const int lrow0 = wr * 64 + fr, col0 = pnl * 128 + wc * 32 + 8 * fq;
        const float* sbp = sb + (size_t)u.pn * 256 + wc * 32 + 8 * fq;
        const f32x4 sg0 = *(const f32x4*)sbp, sg1 = *(const f32x4*)(sbp + 4), su0 = *(const f32x4*)(sbp + 128), su1 = *(const f32x4*)(sbp + 132);
        float rr[2][4];
#pragma unroll
        for (int ai = 0; ai < 2; ++ai)
#pragma unroll
            for (int m = 0; m < 4; ++m) rr[ai][m] = rs[(size_t)u.pm * BM + lrow0 + ai * HALF + m * 16];
#pragma unroll
        for (int ai = 0; ai < 2; ++ai)
#pragma unroll
            for (int m = 0; m < 4; ++m) { const int lrow = lrow0 + ai * HALF + m * 16;
                const float r = rr[ai][m];
                const f32x4 rg0 = sg0 * r, rg1 = sg1 * r, ru0 = su0 * r, ru1 = su1 * r; f32x4 g0, g1, u0, u1;
#pragma unroll
                for (int j = 0; j < 4; ++j) { g0[j] = (float)acc[ai][0][m][0][j] * rg0[j]; g1[j] = (float)acc[ai][0][m][1][j] * rg1[j]; u0[j] = (float)acc[ai][1][m][0][j] * ru0[j]; u1[j] = (float)acc[ai][1][m][1][j] * ru1[j]; }
#pragma unroll
                for (int j = 0; j < 4; ++j) { g0[j] = g0[j] * fsigmoid(g0[j]) * u0[j] * kActScale; g1[j] = g1[j] * fsigmoid(g1[j]) * u1[j] * kActScale; }
                *(u32x2*)(ACT + (size_t)(otile * BM + lrow) * 3584 + col0) = (u32x2){cvt4_f8(g0[0], g0[1], g0[2], g0[3]), cvt4_f8(g1[0], g1[1], g1[2], g1[3])}; }
    }
};
struct EpiProj8 {
    static constexpr bool PERM = true, AFTER_DRAIN = false, I8 = true;
    bf16_t* O; const float* rs1; const float* sb; bf16_t* AQ; bf16_t* AK; const float* q_gain; const float* k_gain; unsigned char* G8;
    __device__ __forceinline__ void operator()(const i32x4 (&acc)[2][2][4][2], const Unit& u, int wr, int wc, int fr, int fq) const {
        const bool sg = (u.pn == 6) || (u.pn == 7);
        const bool mg = u.pn >= 16;
        const bool qk = (u.pn >= 8) && (u.pn < 12);
        const int row0 = u.pm * BM + wr * 64 + fr, col0 = u.pn * BM + wc * 32 + 8 * fq;
        f32x4 s0[2], s1[2];
#pragma unroll
        for (int bj = 0; bj < 2; ++bj) { s0[bj] = *(const f32x4*)(sb + col0 + bj * HALF); s1[bj] = *(const f32x4*)(sb + col0 + bj * HALF + 4); }
        float rr[2][4];
#pragma unroll
        for (int ai = 0; ai < 2; ++ai)
#pragma unroll
            for (int m = 0; m < 4; ++m) rr[ai][m] = rs1[row0 + ai * HALF + m * 16];
        if (qk) {
            const bool isk = u.pn >= 10; const int gidx = (u.pn - (isk ? 10 : 8)) * 4 + wc;
            const float* gp = (isk ? k_gain : q_gain) + 8 * fq; const float qs = isk ? 1.f : 0.125f * kLog2e;
            f32x4 gn[2][2];
#pragma unroll
            for (int bj = 0; bj < 2; ++bj) { gn[bj][0] = *(const f32x4*)(gp + bj * 32) * qs; gn[bj][1] = *(const f32x4*)(gp + bj * 32 + 4) * qs; }
            bf16_t* Ob = (isk ? AK : AQ) + gidx * 64 + 8 * fq;
#pragma unroll
            for (int ai = 0; ai < 2; ++ai)
#pragma unroll
                for (int m = 0; m < 4; ++m) { const int row = row0 + ai * HALF + m * 16; const float r = rr[ai][m]; const f32x4 r0[2] = {s0[0] * r, s0[1] * r}, r1[2] = {s1[0] * r, s1[1] * r}; f32x4 v[2][2]; float ss = 0.f;
#pragma unroll
                    for (int bj = 0; bj < 2; ++bj) {
#pragma unroll
                        for (int j = 0; j < 4; ++j) { v[bj][0][j] = (float)acc[ai][bj][m][0][j] * (r0[bj][j]); v[bj][1][j] = (float)acc[ai][bj][m][1][j] * (r1[bj][j]); }
                        ss += sumsq8(v[bj][0], v[bj][1]); }
                    ss = quad_sum_fq(ss); const float rn = __builtin_amdgcn_rsqf(ss * (1.f / 64.f) + 1e-6f);
#pragma unroll
                    for (int bj = 0; bj < 2; ++bj) *(u32x4*)(Ob + (size_t)row * 512 + bj * 32) = pack8(v[bj][0] * gn[bj][0] * rn, v[bj][1] * gn[bj][1] * rn); }
            return;
        }
        if (mg) {
            typedef unsigned u32x2 __attribute__((ext_vector_type(2)));
#pragma unroll
            for (int ai = 0; ai < 2; ++ai)
#pragma unroll
                for (int m = 0; m < 4; ++m) { const int row = row0 + ai * HALF + m * 16; const float r = rr[ai][m]; unsigned char* gp = G8 + (size_t)row * 3072 + (col0 - 4096);
#pragma unroll
                    for (int bj = 0; bj < 2; ++bj) { unsigned w[2];
#pragma unroll
                        for (int n = 0; n < 2; ++n) { const f32x4 s = (n ? s1[bj] : s0[bj]) * r; unsigned pk = 0;
#pragma unroll
                            for (int j = 0; j < 4; ++j) { const float g = fsigmoid((float)acc[ai][bj][m][n][j] * s[j]); pk |= (unsigned)fmaxf(__builtin_rintf(g * 255.f), 1.f) << (8 * j); }
                            w[n] = pk; }
                        *(u32x2*)(gp + bj * HALF) = (u32x2){w[0], w[1]}; } }
            return;
        }
#pragma unroll
        for (int ai = 0; ai < 2; ++ai)
#pragma unroll
            for (int m = 0; m < 4; ++m) { const int row = row0 + ai * HALF + m * 16; const float r = rr[ai][m]; bf16_t* rowp = O + (size_t)row * 7168 + col0;
#pragma unroll
                for (int bj = 0; bj < 2; ++bj) { f32x4 v0, v1; const f32x4 q0 = s0[bj] * r, q1 = s1[bj] * r;
#pragma unroll
                    for (int j = 0; j < 4; ++j) { v0[j] = (float)acc[ai][bj][m][0][j] * q0[j]; v1[j] = (float)acc[ai][bj][m][1][j] * q1[j]; }
                    if (sg) {
#pragma unroll
                        for (int j = 0; j < 4; ++j) { v0[j] = fsigmoid(v0[j]); v1[j] = fsigmoid(v1[j]); } }
                    *(u32x4*)(rowp + bj * HALF) = pack8(v0, v1); } }
    }
};
struct EpiUp8d {
    static constexpr bool PERM = true, AFTER_DRAIN = false, I8 = true;
    unsigned char* ACT; const float* rs1; const float* sb;
    __device__ __forceinline__ void operator()(const i32x4 (&acc)[2][2][4][2], const Unit& u, int wr, int wc, int fr, int fq) const {
        typedef unsigned u32x2 __attribute__((ext_vector_type(2)));
        const int row0 = u.pm * BM + wr * 64 + fr, col0 = u.pn * 128 + wc * 32 + 8 * fq;
        const float* sbp = sb + (size_t)u.pn * 256 + wc * 32 + 8 * fq;
        const f32x4 sg0 = *(const f32x4*)sbp, sg1 = *(const f32x4*)(sbp + 4), su0 = *(const f32x4*)(sbp + 128), su1 = *(const f32x4*)(sbp + 132);
        float rr[2][4];
#pragma unroll
        for (int ai = 0; ai < 2; ++ai)
#pragma unroll
            for (int m = 0; m < 4; ++m) rr[ai][m] = rs1[row0 + ai * HALF + m * 16];
#pragma unroll
        for (int ai = 0; ai < 2; ++ai)
#pragma unroll
            for (int m = 0; m < 4; ++m) { const int row = row0 + ai * HALF + m * 16; const float r = rr[ai][m];
                const f32x4 rg0 = sg0 * r, rg1 = sg1 * r, ru0 = su0 * r, ru1 = su1 * r; f32x4 g0, g1, u0, u1;
#pragma unroll
                for (int j = 0; j < 4; ++j) { g0[j] = (float)acc[ai][0][m][0][j] * rg0[j]; g1[j] = (float)acc[ai][0][m][1][j] * rg1[j]; u0[j] = (float)acc[ai][1][m][0][j] * ru0[j]; u1[j] = (float)acc[ai][1][m][1][j] * ru1[j]; }
#pragma unroll
                for (int j = 0; j < 4; ++j) { g0[j] = g0[j] * fsigmoid(g0[j]) * u0[j] * kActScale; g1[j] = g1[j] * fsigmoid(g1[j]) * u1[j] * kActScale; }
                *(u32x2*)(ACT + (size_t)row * 2816 + col0) = (u32x2){cvt4_f8(g0[0], g0[1], g0[2], g0[3]), cvt4_f8(g1[0], g1[1], g1[2], g1[3])}; }
    }
};
}
namespace mix {
using bf16x8 = __attribute__((ext_vector_type(8))) short;
using s16x4  = __attribute__((ext_vector_type(4))) short;
using f32x16 = __attribute__((ext_vector_type(16))) float;
using f32x4  = __attribute__((ext_vector_type(4))) float;
using u32x4  = __attribute__((ext_vector_type(4))) unsigned;
typedef unsigned short bf16_t;
constexpr int KVB = 64, SHM_T = KVB * 128 * 2;
constexpr int OFF_V = 0, OFF_K = 2 * SHM_T, OFF_WS = 4 * SHM_T, OFF_A2 = OFF_WS + 8 * 256, OFF_M2 = OFF_A2 + 8192, OFF_MT = OFF_M2 + 8192, OFF_SC = OFF_MT + 8192, OFF_Q = OFF_SC + 256, MIX_LDS = OFF_Q + 64;
constexpr float kLog2e = 1.4426950408889634f;
#define KSWZ(row, colB) ((row) * 256 + ((colB) ^ (((row) & 7) << 4)))
#define SBAR() __builtin_amdgcn_sched_barrier(0)
__device__ __forceinline__ int crow(int r, int hi) { return (r & 3) + 8 * (r >> 2) + 4 * hi; }
__device__ __forceinline__ unsigned cvtpk(float lo, float hi) { unsigned r; asm volatile("v_cvt_pk_bf16_f32 %0, %1, %2" : "=v"(r) : "v"(lo), "v"(hi)); return r; }
__device__ __forceinline__ float bf2f(unsigned short h) { return __builtin_bit_cast(float, (unsigned)h << 16); }
__device__ __forceinline__ int v_st(int k, int c) { const int kk = (k & ~0xC) | ((k & 4) << 1) | ((k & 8) >> 1); return ((kk >> 3) * 4 + (c >> 5)) * 512 + ((kk & 7) * 32 + (c & 31)) * 2; }
__device__ __forceinline__ int v_rd_base(int lane) { return ((lane & 3) << 3) | (((lane >> 2) & 3) << 6) | (((lane >> 4) & 1) << 5) | (((lane >> 5) & 1) << 8); }
constexpr int v_rd_off(int d0, int ks, int half) { return d0 * 512 + ks * 4096 + half * 2048; }
template <int OFF> __device__ __forceinline__ s16x4 tr_read(int vb) { s16x4 r; asm volatile("ds_read_b64_tr_b16 %0, %1 offset:%2" : "=&v"(r) : "v"(vb), "i"(OFF) : "memory"); return r; }
template <int D0> __device__ __forceinline__ void pv_one(f32x16& od, int vb, bf16x8 pa0, bf16x8 pa1, bf16x8 pa2, bf16x8 pa3) {
    const s16x4 l0 = tr_read<v_rd_off(D0, 0, 0)>(vb), h0 = tr_read<v_rd_off(D0, 0, 1)>(vb), l1 = tr_read<v_rd_off(D0, 1, 0)>(vb), h1 = tr_read<v_rd_off(D0, 1, 1)>(vb);
    const s16x4 l2 = tr_read<v_rd_off(D0, 2, 0)>(vb), h2 = tr_read<v_rd_off(D0, 2, 1)>(vb), l3 = tr_read<v_rd_off(D0, 3, 0)>(vb), h3 = tr_read<v_rd_off(D0, 3, 1)>(vb);
    asm volatile("s_waitcnt lgkmcnt(0)" ::: "memory"); SBAR();
#define MIX_PK(L, H) (bf16x8){L[0], L[1], L[2], L[3], H[0], H[1], H[2], H[3]}
    od = __builtin_amdgcn_mfma_f32_32x32x16_bf16(pa0, MIX_PK(l0, h0), od, 0, 0, 0);
    od = __builtin_amdgcn_mfma_f32_32x32x16_bf16(pa1, MIX_PK(l1, h1), od, 0, 0, 0);
    od = __builtin_amdgcn_mfma_f32_32x32x16_bf16(pa2, MIX_PK(l2, h2), od, 0, 0, 0);
    od = __builtin_amdgcn_mfma_f32_32x32x16_bf16(pa3, MIX_PK(l3, h3), od, 0, 0, 0);
#undef MIX_PK
}
__device__ __forceinline__ void pv_d0(f32x16* o, int vb, bf16x8 pa0, bf16x8 pa1, bf16x8 pa2, bf16x8 pa3) {
    pv_one<0>(o[0], vb, pa0, pa1, pa2, pa3); pv_one<1>(o[1], vb, pa0, pa1, pa2, pa3); pv_one<2>(o[2], vb, pa0, pa1, pa2, pa3); pv_one<3>(o[3], vb, pa0, pa1, pa2, pa3);
}
__device__ __forceinline__ float swap_max(float v) { auto rr = __builtin_amdgcn_permlane32_swap(__float_as_uint(v), __float_as_uint(v), false, false); return fmaxf(__uint_as_float(rr[0]), __uint_as_float(rr[1])); }
__device__ __forceinline__ float swap_sum(float v) { auto rr = __builtin_amdgcn_permlane32_swap(__float_as_uint(v), __float_as_uint(v), false, false); return __uint_as_float(rr[0]) + __uint_as_float(rr[1]); }
__device__ __forceinline__ void p_to_frags(const f32x16& p0, const f32x16& p1, bf16x8& pa0, bf16x8& pa1, bf16x8& pa2, bf16x8& pa3) {
#define MIX_PK4(P, BASE, OUT) do { unsigned a0 = cvtpk(P[BASE + 0], P[BASE + 1]), a1 = cvtpk(P[BASE + 2], P[BASE + 3]);   \
    unsigned b0 = cvtpk(P[BASE + 4], P[BASE + 5]), b1 = cvtpk(P[BASE + 6], P[BASE + 7]);                              \
    auto r0 = __builtin_amdgcn_permlane32_swap(a0, b0, false, false); auto r1 = __builtin_amdgcn_permlane32_swap(a1, b1, false, false); \
    u32x4 w = {r0[0], r1[0], r0[1], r1[1]}; OUT = *reinterpret_cast<bf16x8*>(&w); } while (0)
    MIX_PK4(p0, 0, pa0); MIX_PK4(p0, 8, pa1); MIX_PK4(p1, 0, pa2); MIX_PK4(p1, 8, pa3);
#undef MIX_PK4
}
__device__ __forceinline__ float half_sum32(float v) {
#pragma unroll
    for (int o = 1; o < 32; o <<= 1) v += __shfl_xor(v, o);
    return v;
}
struct MixPtrs {
    const bf16_t* PROJ;
    const bf16_t *MQ, *MK, *AQ, *AK;
    const float* GATE;
    bf16_t *HM, *HA;
    const float *m_hgain, *a_hgain;
    const float* lamv;
};
template <int MODE>
__device__ __forceinline__ void unit(char* lds, const MixPtrs& P, int b, int h, int q0) {
    int tid_o = threadIdx.x; asm volatile("" : "+v"(tid_o));
    const int tid = tid_o, wid = __builtin_amdgcn_readfirstlane(tid >> 6), lane = tid & 63, r32 = lane & 31, hi = lane >> 5;
    constexpr int NQ = MODE == 0 ? 8 : 4;
    const int wq = MODE == 0 ? wid : (wid & 3), map = MODE == 0 ? 0 : (wid >> 2);
    const int qlo = q0 + 32 * wq, tq = qlo + r32;
    const size_t tok0 = (size_t)b * 2048;
    char* V_lds = lds + OFF_V; char* K_lds = lds + OFF_K;
    float* wsf = (float*)(lds + OFF_WS) + wid * 64; float* li_l = wsf; float* al_l = wsf + 32;
    float* A2 = (float*)(lds + OFF_A2); float* M2 = (float*)(lds + OFF_M2); float* MT = (float*)(lds + OFF_MT); float* SC = (float*)(lds + OFF_SC);
    const int NT = (q0 + (MODE == 0 ? 256 : 128)) / KVB;
    float M2row = 0.f, mtrow = 0.f;
    if (MODE == 0) {
        const int n = q0 + 256; const float* G = P.GATE + tok0 * 8;
        float lf[4], iv[4];
#pragma unroll
        for (int j = 0; j < 4; ++j) { const int t = 4 * tid + j; float f = 0.f, i = 0.f; if (t < n) { f = G[(size_t)t * 8 + 4 + h]; i = G[(size_t)t * 8 + h]; }
            lf[j] = fminf(f, 0.f) - 0.6931471805599453f * __builtin_amdgcn_logf(1.f + __builtin_amdgcn_exp2f(-kLog2e * fabsf(f))); iv[j] = i; }
        float s1 = lf[0], s2 = s1 + lf[1], s3 = s2 + lf[2], s4 = s3 + lf[3];
        float incl = s4;
#pragma unroll
        for (int o = 1; o < 64; o <<= 1) { const float t = __shfl_up(incl, o); if (lane >= o) incl += t; }
        if (lane == 63) SC[wid] = incl;
        __syncthreads();
        float wbase = 0.f;
#pragma unroll
        for (int w = 0; w < 8; ++w) { const float t = SC[w]; if (w < wid) wbase += t; }
        const float excl = wbase + incl - s4;
        const float B0 = excl + s1, B1 = excl + s2, B2 = excl + s3, B3 = excl + s4;
        const float a0 = iv[0] - B0, a1 = iv[1] - B1, a2 = iv[2] - B2, a3 = iv[3] - B3;
        const bool v0 = 4 * tid < n;
        const float NEG = -3.0e38f;
        const float m1 = v0 ? a0 : NEG, m2 = fmaxf(m1, v0 ? a1 : NEG), m3 = fmaxf(m2, v0 ? a2 : NEG), m4 = fmaxf(m3, v0 ? a3 : NEG);
        float mincl = m4;
#pragma unroll
        for (int o = 1; o < 64; o <<= 1) { const float t = __shfl_up(mincl, o); if (lane >= o) mincl = fmaxf(mincl, t); }
        float mprev = __shfl_up(mincl, 1); if (lane == 0) mprev = NEG;
        if (lane == 63) SC[8 + wid] = mincl;
        __syncthreads();
        float mbase = 0.f;
#pragma unroll
        for (int w = 0; w < 8; ++w) { const float t = SC[8 + w]; if (w < wid) mbase = fmaxf(mbase, t); }
        const float mex = fmaxf(mbase, mprev);
        const float x0 = fmaxf(mex, m1), x1 = fmaxf(mex, m2), x2 = fmaxf(mex, m3), x3 = fmaxf(mex, m4);
        if (v0) { *(f32x4*)(A2 + 4 * tid) = (f32x4){a0 * kLog2e, a1 * kLog2e, a2 * kLog2e, a3 * kLog2e};
                  *(f32x4*)(M2 + 4 * tid) = (f32x4){x0 * kLog2e, x1 * kLog2e, x2 * kLog2e, x3 * kLog2e};
                  *(f32x4*)(MT + 4 * tid) = (f32x4){B0 + x0, B1 + x1, B2 + x2, B3 + x3}; }
        __syncthreads();
        M2row = M2[tq]; mtrow = MT[tq];
    }
    bf16x8 qr[NQ];
    { const bf16_t* Qw = (MODE == 0 ? P.MQ : P.AQ) + (tok0 + tq) * 512 + h * 128 + map * 64 + hi * 8;
#pragma unroll
      for (int d0 = 0; d0 < NQ; ++d0) qr[d0] = *reinterpret_cast<const bf16x8*>(Qw + d0 * 16); }
    const bf16_t* Kg = (MODE == 0 ? P.MK : P.AK) + tok0 * 512 + h * 128;
    const bf16_t* Vg = P.PROJ + tok0 * 7168 + (MODE == 0 ? 1024 : 3072) + h * 128;
    const int sr = tid >> 4, sc = (tid & 15) * 8, vst0 = v_st(sr, sc), vst1 = v_st(32 + sr, sc);
    const int vb0 = (int)(uintptr_t)V_lds + v_rd_base(lane);
    bf16x8 vsA0, vsA1, ksA0, ksA1;
#define MIX_SLOAD(S, k0) do { vs##S##0 = *reinterpret_cast<const bf16x8*>(Vg + (size_t)((k0) + sr) * 7168 + sc); vs##S##1 = *reinterpret_cast<const bf16x8*>(Vg + (size_t)((k0) + 32 + sr) * 7168 + sc); \
    ks##S##0 = *reinterpret_cast<const bf16x8*>(Kg + (size_t)((k0) + sr) * 512 + sc); ks##S##1 = *reinterpret_cast<const bf16x8*>(Kg + (size_t)((k0) + 32 + sr) * 512 + sc); } while (0)
#define MIX_SWRITE(S, bb) do { *(bf16x8*)(V_lds + (bb) * SHM_T + vst0) = vs##S##0; *(bf16x8*)(V_lds + (bb) * SHM_T + vst1) = vs##S##1; \
    *(bf16x8*)(K_lds + (bb) * SHM_T + KSWZ(sr, sc * 2)) = ks##S##0; *(bf16x8*)(K_lds + (bb) * SHM_T + KSWZ(32 + sr, sc * 2)) = ks##S##1; } while (0)
#define MIX_BAR() do { asm volatile("s_waitcnt lgkmcnt(0)" ::: "memory"); __builtin_amdgcn_s_barrier(); asm volatile("" ::: "memory"); } while (0)
    f32x16 o[4];
#pragma unroll
    for (int d = 0; d < 4; ++d)
#pragma unroll
        for (int r = 0; r < 16; ++r) o[d][r] = 0.f;
    float m_run = -1e30f, l_run = 0.f;
    const float sl2 = MODE == 1 ? __builtin_amdgcn_exp2f(-2.f * (float)(h + 1)) * kLog2e : 0.f;
    auto mix_compute = [&](int j, int k0) __attribute__((always_inline)) {
        if (k0 <= qlo + 31) {
            const char* Kt = K_lds + (j & 1) * SHM_T;
            f32x16 p0, p1;
            if (MODE == 1) { const float base = sl2 * (float)(k0 - tq);
#pragma unroll
                for (int r = 0; r < 16; ++r) { p0[r] = fmaf(sl2, (float)crow(r, hi), base); p1[r] = fmaf(sl2, (float)(32 + crow(r, hi)), base); } }
            else {
#pragma unroll
                for (int r = 0; r < 16; ++r) { p0[r] = 0.f; p1[r] = 0.f; } }
            bf16x8 kb0[NQ], kb1[NQ];
#define MIX_KLD(D0) do { const int cb_ = (map * 64 + (D0) * 16 + hi * 8) * 2; kb0[D0] = *reinterpret_cast<const bf16x8*>(Kt + KSWZ(r32, cb_)); kb1[D0] = *reinterpret_cast<const bf16x8*>(Kt + KSWZ(32 + r32, cb_)); } while (0)
            MIX_KLD(0); MIX_KLD(1); SBAR();
#pragma unroll
            for (int d0 = 0; d0 < NQ; ++d0) {
                if (d0 + 2 < NQ) MIX_KLD(d0 + 2);
                p0 = __builtin_amdgcn_mfma_f32_32x32x16_bf16(kb0[d0], qr[d0], p0, 0, 0, 0);
                p1 = __builtin_amdgcn_mfma_f32_32x32x16_bf16(kb1[d0], qr[d0], p1, 0, 0, 0); SBAR(); }
#undef MIX_KLD
            const bool diag = k0 + 63 > qlo;
            if (MODE == 1) {
                if (diag) {
                    int tqm = tq; asm volatile("" : "+v"(tqm));
#pragma unroll
                    for (int r = 0; r < 16; ++r) { if (k0 + crow(r, hi) > tqm) p0[r] = -1e30f; if (k0 + 32 + crow(r, hi) > tqm) p1[r] = -1e30f; } }
                float pmax = p0[0];
#pragma unroll
                for (int r = 1; r < 16; ++r) pmax = fmaxf(pmax, p0[r]);
#pragma unroll
                for (int r = 0; r < 16; ++r) pmax = fmaxf(pmax, p1[r]);
                pmax = swap_max(pmax);
                float mn = m_run, alpha = 1.f;
                if (!__all(pmax - m_run <= 8.f)) { mn = fmaxf(m_run, pmax); alpha = __builtin_amdgcn_exp2f(m_run - mn); m_run = mn; }
                float ps = 0.f;
#pragma unroll
                for (int r = 0; r < 16; ++r) { p0[r] = __builtin_amdgcn_exp2f(p0[r] - mn); p1[r] = __builtin_amdgcn_exp2f(p1[r] - mn); ps += p0[r] + p1[r]; }
                ps = swap_sum(ps); l_run = l_run * alpha + ps;
                if (__any(alpha < 1.f)) { if (hi == 0) al_l[r32] = alpha; asm volatile("s_waitcnt lgkmcnt(0)" ::: "memory");
#pragma unroll
                    for (int r = 0; r < 16; ++r) { const float a = al_l[crow(r, hi)];
#pragma unroll
                        for (int d = 0; d < 4; ++d) o[d][r] *= a; } }
            } else {
                float ps = 0.f;
                if (diag) {
#pragma unroll
                    for (int i = 0; i < 4; ++i) { const f32x4 aa = *(const f32x4*)(A2 + k0 + 8 * i + 4 * hi), ab = *(const f32x4*)(A2 + k0 + 32 + 8 * i + 4 * hi);
#pragma unroll
                        for (int q = 0; q < 4; ++q) { const int r = 4 * i + q;
                            float w0 = __builtin_amdgcn_exp2f(fminf(aa[q] - M2row, 0.f)), w1 = __builtin_amdgcn_exp2f(fminf(ab[q] - M2row, 0.f));
                            if (k0 + crow(r, hi) > tq) w0 = 0.f; if (k0 + 32 + crow(r, hi) > tq) w1 = 0.f;
                            p0[r] *= w0; p1[r] *= w1; ps += p0[r] + p1[r]; } }
                    asm volatile("" : "+v"(ps));
                } else {
#pragma unroll
                    for (int i = 0; i < 4; ++i) { const f32x4 aa = *(const f32x4*)(A2 + k0 + 8 * i + 4 * hi), ab = *(const f32x4*)(A2 + k0 + 32 + 8 * i + 4 * hi);
#pragma unroll
                        for (int q = 0; q < 4; ++q) { const int r = 4 * i + q;
                            p0[r] *= __builtin_amdgcn_exp2f(aa[q] - M2row); p1[r] *= __builtin_amdgcn_exp2f(ab[q] - M2row); ps += p0[r] + p1[r]; } }
                }
                ps = swap_sum(ps); l_run += ps;
            }
            bf16x8 pa0, pa1, pa2, pa3; p_to_frags(p0, p1, pa0, pa1, pa2, pa3);
            pv_d0(o, vb0 + (j & 1) * SHM_T, pa0, pa1, pa2, pa3);
        }
    };
    MIX_SLOAD(A, 0); MIX_SWRITE(A, 0);
#define MIX_TILE(SL, SW, JJ) do { const int j = (JJ); \
        MIX_BAR(); \
        const int k0 = j * KVB; \
        if (j + 1 < NT) MIX_SLOAD(SL, k0 + KVB); \
        mix_compute(j, k0); \
        if (j + 1 < NT) MIX_SWRITE(SW, (j + 1) & 1); } while (0)
    for (int jj = 0; jj < NT; ++jj) { MIX_TILE(A, A, jj); }
#undef MIX_TILE
    __syncthreads();
#undef MIX_SLOAD
#undef MIX_SWRITE
#undef MIX_BAR
    int lane_e = lane; asm volatile("" : "+v"(lane_e));
    const int r32e = lane_e & 31, hie = lane_e >> 5;
    float rowscale;
    if (MODE == 1) rowscale = 1.f / l_run; else rowscale = 1.f / fmaxf(fabsf(l_run), __expf(-mtrow));
    if (hie == 0) li_l[r32e] = rowscale;
    asm volatile("s_waitcnt lgkmcnt(0)" ::: "memory");
    float rs[16];
#pragma unroll
    for (int r = 0; r < 16; ++r) rs[r] = li_l[crow(r, hie)];
#pragma unroll
    for (int d = 0; d < 4; ++d)
#pragma unroll
        for (int r = 0; r < 16; ++r) o[d][r] *= rs[r];
    if (MODE == 1) {
        __syncthreads();
        float* EX = (float*)lds + (size_t)wq * 4096 + lane_e;
        if (map == 1) {
#pragma unroll
            for (int d = 0; d < 4; ++d)
#pragma unroll
                for (int r = 0; r < 16; ++r) EX[(d * 16 + r) * 64] = o[d][r]; }
        __syncthreads();
        if (map == 0) { const float lam_l = P.lamv[0];
#pragma unroll
            for (int d = 0; d < 4; ++d)
#pragma unroll
                for (int r = 0; r < 16; ++r) o[d][r] -= lam_l * EX[(d * 16 + r) * 64]; }
    }
    if (MODE == 0 || map == 0) {
        float rn[16];
#pragma unroll
        for (int r = 0; r < 16; ++r) { float s = 0.f;
#pragma unroll
            for (int d = 0; d < 4; ++d) s += o[d][r] * o[d][r];
            s = half_sum32(s); rn[r] = __builtin_amdgcn_rsqf(s * (1.f / 128.f) + 1e-6f); }
        const float* hg = (MODE == 0 ? P.m_hgain : P.a_hgain) + h * 128;
        bf16_t* Ob = (MODE == 0 ? P.HM : P.HA) + (tok0 + qlo) * 512 + h * 128;
        unsigned short og[4][16];
        if (MODE == 0) {
#pragma unroll
            for (int d = 0; d < 4; ++d)
#pragma unroll
                for (int r = 0; r < 16; ++r) og[d][r] = P.PROJ[(tok0 + qlo + crow(r, hie)) * 7168 + 1536 + h * 128 + 32 * d + r32e]; }
#pragma unroll
        for (int d = 0; d < 4; ++d) { const int col = 32 * d + r32e; const float g = hg[col] * (MODE == 1 ? P.lamv[1] : 1.f);
#pragma unroll
            for (int r = 0; r < 16; ++r) { const int row = crow(r, hie); float v = o[d][r] * rn[r] * g;
                if (MODE == 0) v *= bf2f(og[d][r]);
                Ob[(size_t)row * 512 + col] = (bf16_t)(cvtpk(v, v) & 0xffffu); } }
    }
    __syncthreads();
}
template <bool DO_M, bool DO_A> __device__ __forceinline__ void mix_phase(char* lds, const MixPtrs& P, unsigned* queue) {
    volatile int* qw = (volatile int*)(lds + OFF_Q);
    if (DO_M) for (;;) {
        if (threadIdx.x == 0) *qw = (int)__hip_atomic_fetch_add(queue, 1u, __ATOMIC_RELAXED, __HIP_MEMORY_SCOPE_AGENT);
        __syncthreads();
        const int item = __builtin_amdgcn_readfirstlane(*qw);
        __syncthreads();
        if (item >= 256) break;
        unit<0>(lds, P, (item & 31) >> 2, item & 3, 256 * (7 - (item >> 5)));
    }
    if (DO_A) for (;;) {
        if (threadIdx.x == 0) *qw = (int)__hip_atomic_fetch_add(queue + 32, 1u, __ATOMIC_RELAXED, __HIP_MEMORY_SCOPE_AGENT);
        __syncthreads();
        const int item = __builtin_amdgcn_readfirstlane(*qw);
        __syncthreads();
        if (item >= 512) break;
        unit<1>(lds, P, (item & 31) >> 2, item & 3, 128 * (15 - (item >> 5)));
    }
}
}
namespace thin {
using pg8::bf16_t; using pg8::f32x4; using pg8::u32x4; using pg8::bf16x8;
typedef __attribute__((address_space(3))) float lds_f32;
__device__ __forceinline__ unsigned f2bf(float f) { unsigned u = __builtin_bit_cast(unsigned, f); return (u + 0x7fffu + ((u >> 16) & 1u)) >> 16; }
__device__ __forceinline__ unsigned pk2(float lo, float hi) { return f2bf(lo) | (f2bf(hi) << 16); }
__device__ __forceinline__ float wave_sum(float v) {
#pragma unroll
    for (int o = 1; o < 64; o <<= 1) v += __shfl_xor(v, o);
    return v;
}
__device__ __forceinline__ unsigned pack4_i8(float a, float b, float c, float d) {
    const int ia = (int)__builtin_rintf(a), ib = (int)__builtin_rintf(b), ic = (int)__builtin_rintf(c), id = (int)__builtin_rintf(d);
    return (unsigned)(ia & 0xff) | ((unsigned)(ib & 0xff) << 8) | ((unsigned)(ic & 0xff) << 16) | ((unsigned)(id & 0xff) << 24);
}
__device__ __forceinline__ float wave_max(float v) {
#pragma unroll
    for (int o = 1; o < 64; o <<= 1) v = fmaxf(v, __shfl_xor(v, o));
    return v;
}
__device__ __forceinline__ u32x4 quant16(const f32x4& a0, const f32x4& a1, const f32x4& a2, const f32x4& a3, float inv) {
    u32x4 w; w.x = pack4_i8(a0[0] * inv, a0[1] * inv, a0[2] * inv, a0[3] * inv); w.y = pack4_i8(a1[0] * inv, a1[1] * inv, a1[2] * inv, a1[3] * inv);
    w.z = pack4_i8(a2[0] * inv, a2[1] * inv, a2[2] * inv, a2[3] * inv); w.w = pack4_i8(a3[0] * inv, a3[1] * inv, a3[2] * inv, a3[3] * inv); return w;
}
__device__ __forceinline__ float absmax16(const f32x4& a0, const f32x4& a1, const f32x4& a2, const f32x4& a3) {
    float m = 0.f;
#pragma unroll
    for (int j = 0; j < 4; ++j) m = fmaxf(fmaxf(m, fmaxf(fabsf(a0[j]), fabsf(a1[j]))), fmaxf(fabsf(a2[j]), fabsf(a3[j])));
    return m;
}
__device__ __forceinline__ float row_rstd_wave(const float* ssq, int row, int lane, int vz) {
    float v = lane < 16 ? ssq[(size_t)(row + vz) * 16 + lane] : 0.f;
#pragma unroll
    for (int o = 1; o < 16; o <<= 1) v += __shfl_xor(v, o);
    v = __shfl(v, 0);
    return __builtin_amdgcn_rsqf(v * (1.f / 1024.f) + 1e-6f);
}
struct TrItem { const float* W; const float* gain; bf16_t* WT; int ldw, K, F, map, n0, k0; int f8; float sc; };
__device__ __forceinline__ void tr_load(const TrItem& I, float (&v)[16][4], int lane, int wave) {
    int so[4];
#pragma unroll
    for (int j = 0; j < 4; ++j) { const int n = I.n0 + lane + 64 * j; so[j] = I.map == 0 ? n : I.map == 1 ? (n < 2048 ? n : n + 8) : ((n & 255) >> 7) * I.F + (n >> 8) * 128 + (n & 127); }
    const float* Wk = I.W + (size_t)(I.k0 + wave * 16) * I.ldw;
#pragma unroll
    for (int r = 0; r < 16; ++r)
#pragma unroll
        for (int j = 0; j < 4; ++j) v[r][j] = Wk[(size_t)r * I.ldw + so[j]];
}
__device__ __forceinline__ void tr_store(const TrItem& I, const float (&v)[16][4], char* lds, int lane, int wave) {
    if (I.f8) {
        unsigned char* img8 = (unsigned char*)lds; const float sc = I.sc;
#pragma unroll
        for (int r = 0; r < 16; r += 4)
#pragma unroll
            for (int j = 0; j < 4; ++j) *(unsigned*)(img8 + (lane + 64 * j) * 132 + wave * 16 + r) = pg8::cvt4_f8(v[r][j] * sc, v[r + 1][j] * sc, v[r + 2][j] * sc, v[r + 3][j] * sc);
        __syncthreads();
        unsigned char* WT8 = (unsigned char*)I.WT;
#pragma unroll 8
        for (int i = 0; i < 16; ++i) { const int n = wave * 32 + 2 * i + (lane >> 5); const unsigned w = *(const unsigned*)(img8 + n * 132 + 4 * (lane & 31));
            *(unsigned*)(WT8 + (size_t)(I.n0 + n) * I.K + I.k0 + 4 * (lane & 31)) = w; }
        __syncthreads();
        return;
    }
    unsigned short* img = (unsigned short*)lds;
#pragma unroll
    for (int r = 0; r < 16; r += 2) { float g0 = 1.f, g1 = 1.f; if (I.gain) { g0 = I.gain[I.k0 + wave * 16 + r]; g1 = I.gain[I.k0 + wave * 16 + r + 1]; }
#pragma unroll
        for (int j = 0; j < 4; ++j) *(unsigned*)(img + (lane + 64 * j) * 130 + wave * 16 + r) = pk2(v[r][j] * g0, v[r + 1][j] * g1); }
    __syncthreads();
#pragma unroll 8
    for (int i = 0; i < 32; ++i) { const int n = wave * 32 + i; const unsigned w = *(const unsigned*)(img + n * 130 + 2 * lane);
        *(unsigned*)(I.WT + (size_t)(I.n0 + n) * I.K + I.k0 + 2 * lane) = w; }
    __syncthreads();
}
struct Q8Item { const float* W; const float* gain; unsigned char* W8; float* SB; int ldw, F, map, n0; };
__device__ __forceinline__ void q8_item(const Q8Item& I, char* lds, int lane, int wave) {
    unsigned* img = (unsigned*)lds;
    const int n = I.n0 + lane;
    int so1 = n < 2048 ? n : n + 8;
    if (n >= 2048 && n < 3072) { const int w = n & 255, bj = w >> 7, wc = (w >> 5) & 3, j = w & 31; so1 = 2056 + ((n - 2048) & ~255) + wc * 64 + bj * 32 + j; }
    const int so = I.map == 0 ? n : I.map == 1 ? so1 : ((n & 255) >> 7) * I.F + (n >> 8) * 128 + (n & 127);
    const float* Wk = I.W + (size_t)(wave * 128) * I.ldw + so;
    float va[32], vb[32];
#define Q8_LOAD(V, B) do { _Pragma("unroll") for (int r = 0; r < 32; ++r) V[r] = Wk[(size_t)((B) * 32 + r) * I.ldw]; } while (0)
#define Q8_PUT(V, B) do { _Pragma("unroll") for (int r = 0; r < 32; r += 2) { const int k = wave * 128 + (B) * 32 + r; \
        img[lane * 514 + (k >> 1)] = pk2(V[r] * I.gain[k], V[r + 1] * I.gain[k + 1]); } } while (0)
    Q8_LOAD(va, 0); Q8_LOAD(vb, 1); Q8_PUT(va, 0); Q8_LOAD(va, 2); Q8_PUT(vb, 1); Q8_LOAD(vb, 3); Q8_PUT(va, 2); Q8_PUT(vb, 3);
#undef Q8_LOAD
#undef Q8_PUT
    __syncthreads();
#pragma unroll 2
    for (int i = 0; i < 8; ++i) { const int nr = wave * 8 + i; const unsigned long long* rp = (const unsigned long long*)(img + nr * 514) + lane * 4;
        const unsigned long long d0 = rp[0], d1 = rp[1], d2 = rp[2], d3 = rp[3];
        u32x4 w0 = {(unsigned)d0, (unsigned)(d0 >> 32), (unsigned)d1, (unsigned)(d1 >> 32)}, w1 = {(unsigned)d2, (unsigned)(d2 >> 32), (unsigned)d3, (unsigned)(d3 >> 32)};
        f32x4 a0, a1, a2, a3; pg8::unpack8(w0, a0, a1); pg8::unpack8(w1, a2, a3);
        const float mx = wave_max(absmax16(a0, a1, a2, a3)), step = mx > 0.f ? mx * (1.f / 127.f) : 1.f;
        *((u32x4*)(I.W8 + (size_t)(I.n0 + nr) * 1024) + lane) = quant16(a0, a1, a2, a3, 1.f / step);
        if (lane == 0) I.SB[I.n0 + nr] = step; }
    __syncthreads();
}
struct ProIn {
    const float *x, *p, *attn_norm, *w_in, *pool_w, *pool_scale, *w_branch, *w_out, *ffn_norm, *dense_w_gu, *dense_w_down, *router_w, *moe_w_gu, *moe_w_down, *ple_norm, *ple_w_gate, *ple_w_proj;
    bf16_t *W_IN, *W_BR, *W_OUT, *W_GU0, *W_DN0, *W_GU1, *W_DN1, *W_PG, *W_PP, *XB, *PB; float *X, *SSQ, *WG, *WR; unsigned char* X8; float* RS1; unsigned char *W8_IN, *W8_GU0, *W8_GU1; float *SB_IN, *SB_GU0, *SB_GU1; float* GATE; const float* gate_bias; float* DQ;
};
__device__ __forceinline__ void prologue(const ProIn& a, char* lds, int vcu, int G) {
    int tid_o = threadIdx.x; asm volatile("" : "+v"(tid_o)); const int tid = tid_o, lane = tid & 63, wave = __builtin_amdgcn_readfirstlane(tid >> 6);
    const int gw = vcu * 8 + wave, NGW = G * 8;
    float* wsc = (float*)(lds + 135168);
    { float mx[9];
#pragma unroll
      for (int s = 0; s < 9; ++s) { const f32x4* sp = (const f32x4*)(s == 0 ? a.dense_w_down : a.moe_w_down + (size_t)(s - 1) * 3584 * 1024) + tid * 2; const f32x4 u0 = sp[0], u1 = sp[1];
          mx[s] = fmaxf(fmaxf(fmaxf(fabsf(u0[0]), fabsf(u0[1])), fmaxf(fabsf(u0[2]), fabsf(u0[3]))), fmaxf(fmaxf(fabsf(u1[0]), fabsf(u1[1])), fmaxf(fabsf(u1[2]), fabsf(u1[3])))); }
#pragma unroll
      for (int s = 0; s < 9; ++s) { const float m = wave_max(mx[s]); if (lane == 0) wsc[16 + wave * 9 + s] = m; }
      __syncthreads();
      if (tid < 9) { float m = 0.f; for (int w = 0; w < 8; ++w) m = fmaxf(m, wsc[16 + w * 9 + tid]); const float sc = exp2f(floorf(log2f(160.f / fmaxf(m, 1e-30f)))); wsc[tid] = sc;
          if (vcu == 0) a.DQ[tid] = 1.f / (sc * pg8::kActScale); }
      __syncthreads(); }
    { constexpr int Q_GU1 = 8 * 112, Q_IN = 2 * 112, Q_GU0 = 88, NQ = Q_GU1 + Q_IN + Q_GU0;
#pragma unroll 1
      for (int it = vcu; it < NQ; it += G) { Q8Item I; int r = it;
          if (r < Q_GU1) { const int e = r / 112; r -= e * 112; I.W = a.moe_w_gu + (size_t)e * 1024 * 7168; I.ldw = 7168; I.gain = a.ffn_norm + 1024; I.F = 3584; I.map = 2; I.W8 = a.W8_GU1 + (size_t)e * 7168 * 1024; I.SB = a.SB_GU1 + e * 7168; }
          else if ((r -= Q_GU1) < Q_IN) { const int L = r / 112; r -= L * 112; I.W = a.w_in + (size_t)L * 1024 * 7176; I.ldw = 7176; I.gain = a.attn_norm + L * 1024; I.F = 0; I.map = 1; I.W8 = a.W8_IN + (size_t)L * 7168 * 1024; I.SB = a.SB_IN + L * 7168; }
          else { r -= Q_IN; I.W = a.dense_w_gu; I.ldw = 5632; I.gain = a.ffn_norm; I.F = 2816; I.map = 2; I.W8 = a.W8_GU0; I.SB = a.SB_GU0; }
          I.n0 = r * 64; q8_item(I, lds, lane, wave); } }
    constexpr int I_BR = 4 * 4, I_OUT = 8 * 4, I_DN0 = 22 * 4, I_DN1 = 28 * 4, I_PG = 8 * 4, I_PP = 2 * 4;
    constexpr int NITEMS = 4 * I_BR + 2 * I_OUT + I_DN0 + 8 * I_DN1 + 2 * I_PG + 2 * I_PP;
    auto decode = [&](int it, TrItem& I) {
        int r = it, N; I.gain = nullptr; I.F = 0; I.map = 0; I.f8 = 0; I.sc = 1.f;
        if (r < 8 * I_DN1) { const int e = r / I_DN1; r -= e * I_DN1; I.W = a.moe_w_down + (size_t)e * 3584 * 1024; I.ldw = 1024; I.K = 3584; N = 1024; I.WT = (bf16_t*)((unsigned char*)a.W_DN1 + (size_t)e * 1024 * 3584); I.f8 = 1; I.sc = wsc[1 + e]; }
        else if ((r -= 8 * I_DN1) < I_DN0) { I.W = a.dense_w_down; I.ldw = 1024; I.K = 2816; N = 1024; I.WT = a.W_DN0; I.f8 = 1; I.sc = wsc[0]; }
        else if ((r -= I_DN0) < 4 * I_BR) { const int q = r / I_BR, L = q >> 1, br = q & 1; r -= q * I_BR; I.W = a.w_branch + ((size_t)L * 3 + br) * 512 * 1024; I.ldw = 1024; I.K = 512; N = 1024; I.WT = a.W_BR + ((size_t)L * 3 + br) * 1024 * 512; }
        else if ((r -= 4 * I_BR) < 2 * I_OUT) { const int L = r / I_OUT; r -= L * I_OUT; I.W = a.w_out + (size_t)L * 1024 * 1024; I.ldw = 1024; I.K = 1024; N = 1024; I.WT = a.W_OUT + (size_t)L * 1024 * 1024; }
        else if ((r -= 2 * I_OUT) < 2 * I_PG) { const int L = r / I_PG; r -= L * I_PG; I.W = a.ple_w_gate + (size_t)L * 1024 * 1024; I.ldw = 1024; I.gain = a.ple_norm + L * 1024; I.K = 1024; N = 1024; I.WT = a.W_PG + (size_t)L * 1024 * 1024; }
        else { r -= 2 * I_PG; const int L = r / I_PP; r -= L * I_PP; I.W = a.ple_w_proj + (size_t)L * 256 * 1024; I.ldw = 1024; I.K = 256; N = 1024; I.WT = a.W_PP + (size_t)L * 1024 * 256; }
        const int nblk = N / 256; I.k0 = (r / nblk) * 128; I.n0 = (r % nblk) * 256;
    };
    { TrItem IA, IB; float va[16][4], vb[16][4]; int it = G - 1 - vcu;
      if (it < NITEMS) { decode(it, IA); tr_load(IA, va, lane, wave);
#pragma unroll 1
        for (;;) {
            const bool hb = it + G < NITEMS; if (hb) { decode(it + G, IB); tr_load(IB, vb, lane, wave); }
            tr_store(IA, va, lds, lane, wave);
            if (!hb) break;
            it += 2 * G; const bool ha = it < NITEMS; if (ha) { decode(it, IA); tr_load(IA, va, lane, wave); }
            tr_store(IB, vb, lds, lane, wave);
            if (!ha) break;
        } } }
    float wgx[4][4][8];
#pragma unroll
    for (int j = 0; j < 4; ++j)
#pragma unroll
        for (int i = 0; i < 4; ++i) { const int k = 4 * lane + 256 * j + i; const float gk = a.attn_norm[k]; const f32x4 w0 = *(const f32x4*)(a.w_in + (size_t)k * 7176 + 2048), w1 = *(const f32x4*)(a.w_in + (size_t)k * 7176 + 2052);
#pragma unroll
            for (int c = 0; c < 4; ++c) { wgx[j][i][c] = gk * w0[c]; wgx[j][i][4 + c] = gk * w1[c]; } }
    for (int m0 = gw * 2; m0 < 16384; m0 += NGW * 2) {
        f32x4 v[2][4];
#pragma unroll
        for (int q = 0; q < 2; ++q) { const f32x4* xr = (const f32x4*)(a.x + (size_t)(m0 + q) * 1024) + lane;
#pragma unroll
            for (int j = 0; j < 4; ++j) v[q][j] = xr[64 * j]; }
#pragma unroll
        for (int q = 0; q < 2; ++q) { const int m = m0 + q; unsigned long long* o8 = (unsigned long long*)(a.XB + (size_t)m * 1024) + lane; float s = 0.f;
#pragma unroll
            for (int j = 0; j < 4; ++j) { const f32x4 w = v[q][j]; s += (w[0] * w[0] + w[1] * w[1]) + (w[2] * w[2] + w[3] * w[3]);
                o8[64 * j] = (unsigned long long)pk2(w[0], w[1]) | ((unsigned long long)pk2(w[2], w[3]) << 32); }
            s = wave_sum(s);
            if (lane < 16) a.SSQ[(size_t)m * 16 + lane] = lane == 0 ? s : 0.f;
            float mx = 0.f;
#pragma unroll
            for (int j = 0; j < 4; ++j) mx = fmaxf(mx, fmaxf(fmaxf(fabsf(v[q][j][0]), fabsf(v[q][j][1])), fmaxf(fabsf(v[q][j][2]), fabsf(v[q][j][3]))));
            mx = wave_max(mx); const float step = mx > 0.f ? mx * (1.f / 127.f) : 1.f, inv = 1.f / step;
            unsigned* x8 = (unsigned*)(a.X8 + (size_t)m * 1024) + lane;
#pragma unroll
            for (int j = 0; j < 4; ++j) x8[64 * j] = pack4_i8(v[q][j][0] * inv, v[q][j][1] * inv, v[q][j][2] * inv, v[q][j][3] * inv);
            const float rstd = __builtin_amdgcn_rsqf(s * (1.f / 1024.f) + 1e-6f);
            if (lane == 0) a.RS1[m] = rstd * step;
            float d[8] = {0.f, 0.f, 0.f, 0.f, 0.f, 0.f, 0.f, 0.f};
#pragma unroll
            for (int j = 0; j < 4; ++j)
#pragma unroll
                for (int i = 0; i < 4; ++i)
#pragma unroll
                    for (int c = 0; c < 8; ++c) d[c] = fmaf(v[q][j][i], wgx[j][i][c], d[c]);
#pragma unroll
            for (int c = 0; c < 8; ++c) d[c] = wave_sum(d[c]);
            if (lane < 8) { float dv = d[0];
#pragma unroll
                for (int c = 1; c < 8; ++c) if (lane == c) dv = d[c];
                a.GATE[(size_t)m * 8 + lane] = dv * rstd + a.gate_bias[lane]; } }
    }
    { const size_t n8 = (size_t)2 * 16384 * 256 / 8; const size_t gt = (size_t)(vcu * 512 + tid), NT = (size_t)G * 512;
      for (size_t i0 = gt; i0 < n8; i0 += 4 * NT) { f32x4 v0[4], v1[4];
#pragma unroll
          for (int q = 0; q < 4; ++q) { const size_t i = i0 + q * NT; if (i < n8) { v0[q] = *(const f32x4*)(a.p + i * 8); v1[q] = *(const f32x4*)(a.p + i * 8 + 4); } }
#pragma unroll
          for (int q = 0; q < 4; ++q) { const size_t i = i0 + q * NT; if (i < n8) { u32x4 w; w.x = pk2(v0[q][0], v0[q][1]); w.y = pk2(v0[q][2], v0[q][3]); w.z = pk2(v1[q][0], v1[q][1]); w.w = pk2(v1[q][2], v1[q][3]); *(u32x4*)(a.PB + i * 8) = w; } } }
      for (size_t i = gt; i < 2 * 8192 + 8192; i += NT) {
          if (i < 2 * 8192) { const int L = (int)(i / 8192), k = (int)(i % 8192) / 8, j = (int)(i & 7); a.WG[i] = a.attn_norm[L * 1024 + k] * a.w_in[((size_t)L * 1024 + k) * 7176 + 2048 + j]; }
          else { const int q = (int)(i - 2 * 8192), k = q / 8; a.WR[q] = a.ffn_norm[1024 + k] * a.router_w[q]; } }
    }
    for (int task = vcu; task < 64; task += G) {
        const int L = task >> 5, g = (task >> 3) & 3, nb = task & 7;
        float* AsT = (float*)lds; float* Bs = AsT + 128 * 128;
        __syncthreads();
        const float* pw = a.pool_w + ((size_t)L * 4 + g) * 128 * 128; const float* ps = a.pool_scale + L * 512 + g * 128;
        const float* wb = a.w_branch + (((size_t)L * 3 + 2) * 512 + g * 128) * 1024 + nb * 128;
        for (int i = tid; i < 128 * 32; i += 512) { const int c = i >> 5, d4 = (i & 31) * 4; const f32x4 w = *(const f32x4*)(pw + c * 128 + d4), s = *(const f32x4*)(ps + d4);
            AsT[(d4 + 0) * 128 + c] = w[0] * s[0]; AsT[(d4 + 1) * 128 + c] = w[1] * s[1]; AsT[(d4 + 2) * 128 + c] = w[2] * s[2]; AsT[(d4 + 3) * 128 + c] = w[3] * s[3]; }
        for (int i = tid; i < 128 * 32; i += 512) { const int d = i >> 5, n4 = (i & 31) * 4; *(f32x4*)(Bs + d * 128 + n4) = *(const f32x4*)(wb + (size_t)d * 1024 + n4); }
        __syncthreads();
        const int nq = (tid & 31) * 4, cq = (tid >> 5) * 8;
        float acc[4][8];
#pragma unroll
        for (int i = 0; i < 4; ++i)
#pragma unroll
            for (int j = 0; j < 8; ++j) acc[i][j] = 0.f;
#pragma unroll 4
        for (int d = 0; d < 128; ++d) { const f32x4 bv = *(const f32x4*)(Bs + d * 128 + nq), a0 = *(const f32x4*)(AsT + d * 128 + cq), a1 = *(const f32x4*)(AsT + d * 128 + cq + 4);
#pragma unroll
            for (int i = 0; i < 4; ++i) {
#pragma unroll
                for (int j = 0; j < 4; ++j) { acc[i][j] = fmaf(bv[i], a0[j], acc[i][j]); acc[i][4 + j] = fmaf(bv[i], a1[j], acc[i][4 + j]); } } }
#pragma unroll
        for (int i = 0; i < 4; ++i) { u32x4 w; w.x = pk2(acc[i][0], acc[i][1]); w.y = pk2(acc[i][2], acc[i][3]); w.z = pk2(acc[i][4], acc[i][5]); w.w = pk2(acc[i][6], acc[i][7]);
            *(u32x4*)(a.W_BR + ((size_t)L * 3 + 2) * 1024 * 512 + (size_t)(nb * 128 + nq + i) * 512 + g * 128 + cq) = w; }
    }
    __syncthreads();
}
template <bool GATES> __device__ __forceinline__ void quant_act(const bf16_t* XB, const float* SSQ, unsigned char* X8, float* RS1, const float* WGt, const float* gate_bias, float* GATE, int vcu, int G) {
    int tid_o = threadIdx.x; asm volatile("" : "+v"(tid_o)); const int tid = tid_o, lane = tid & 63, wave = __builtin_amdgcn_readfirstlane(tid >> 6), gw = vcu * 8 + wave, NGW = G * 8;
    int vz = 0; asm volatile("" : "+v"(vz));
    float wgq[GATES ? 16 : 1][8];
    if (GATES) {
#pragma unroll
        for (int i = 0; i < 16; ++i) { const f32x4 w0 = *(const f32x4*)(WGt + (size_t)(16 * lane + i) * 8), w1 = *(const f32x4*)(WGt + (size_t)(16 * lane + i) * 8 + 4);
#pragma unroll
            for (int c = 0; c < 4; ++c) { wgq[i][c] = w0[c]; wgq[i][4 + c] = w1[c]; } } }
    constexpr int NR = GATES ? 2 : 8;
    for (int r0 = gw * NR; r0 < 16384; r0 += NGW * NR) {
        u32x4 v[NR][2]; float rs[NR];
#pragma unroll
        for (int q = 0; q < NR; ++q) { const u32x4* p = (const u32x4*)(XB + (size_t)(r0 + q) * 1024) + lane * 2; v[q][0] = p[0]; v[q][1] = p[1]; rs[q] = row_rstd_wave(SSQ, r0 + q, lane, vz); }
#pragma unroll
        for (int q = 0; q < NR; ++q) { f32x4 a0, a1, a2, a3; pg8::unpack8(v[q][0], a0, a1); pg8::unpack8(v[q][1], a2, a3);
            const float mx = wave_max(absmax16(a0, a1, a2, a3)), step = mx > 0.f ? mx * (1.f / 127.f) : 1.f;
            *((u32x4*)(X8 + (size_t)(r0 + q) * 1024) + lane) = quant16(a0, a1, a2, a3, 1.f / step);
            if (lane == 0) RS1[r0 + q] = rs[q] * step;
            if (GATES) { const float xv[16] = {a0[0], a0[1], a0[2], a0[3], a1[0], a1[1], a1[2], a1[3], a2[0], a2[1], a2[2], a2[3], a3[0], a3[1], a3[2], a3[3]};
                float d[8] = {0.f, 0.f, 0.f, 0.f, 0.f, 0.f, 0.f, 0.f};
#pragma unroll
                for (int i = 0; i < 16; ++i)
#pragma unroll
                    for (int c = 0; c < 8; ++c) d[c] = fmaf(xv[i], wgq[i][c], d[c]);
#pragma unroll
                for (int c = 0; c < 8; ++c) d[c] = wave_sum(d[c]);
                if (lane < 8) { float dv = d[0];
#pragma unroll
                    for (int c = 1; c < 8; ++c) if (lane == c) dv = d[c];
                    GATE[(size_t)(r0 + q) * 8 + lane] = dv * rs[q] + gate_bias[lane]; } } }
    }
}
struct PrepIn { const bf16_t *PROJ, *XB; const float *SSQ, *WG, *conv_w, *conv_b, *gate_bias, *q_gain, *k_gain; bf16_t *MQ, *MK, *AQ, *AK, *HP; float* GATE; };
__device__ __forceinline__ void prep(const PrepIn& a, char* lds, int vcu, int G) {
    int tid_o = threadIdx.x; asm volatile("" : "+v"(tid_o)); const int tid = tid_o, lane = tid & 63, wave = __builtin_amdgcn_readfirstlane(tid >> 6);
    float* cwl = (float*)lds;
    for (int i = tid; i < 4096 / 4; i += 512) ((f32x4*)cwl)[i] = ((const f32x4*)a.conv_w)[i];
    for (int i = tid; i < 1024 / 4; i += 512) ((f32x4*)(cwl + 4096))[i] = ((const f32x4*)a.conv_b)[i];
    __syncthreads();
    const int gw = vcu * 8 + wave, NGW = G * 8;
    const int c0 = lane * 16;
    int vz = 0; asm volatile("" : "+v"(vz));
    const int qg0 = (lane & 3) * 16;
    const float* qkg = (lane < 32 ? a.q_gain : a.k_gain) + qg0;
    const float qkscale = lane < 32 ? 0.125f * 1.4426950408889634f : 1.f;
    const int pc = lane * 8, pw = 2 << (lane >> 4);
    for (int chunk = gw; chunk < 16384 / 8; chunk += NGW) {
        const int row0 = chunk * 8, t0 = row0 & 2047;
        const bf16_t* pr0 = a.PROJ + (size_t)row0 * 7168;
        { u32x4 cv[11][2];
#pragma unroll
          for (int i = 0; i < 11; ++i) { const int d = i - 3, de = (d < 0 && t0 + d < 0) ? 0 : d; const bf16_t* p = pr0 + (long)de * 7168 + c0; cv[i][0] = *(const u32x4*)p; cv[i][1] = *(const u32x4*)(p + 8); }
          f32x4 wt[4][4], bs[4];
#pragma unroll
          for (int i = 0; i < 4; ++i) { bs[i] = *(const f32x4*)(cwl + 4096 + c0 + 4 * i);
#pragma unroll
              for (int j = 0; j < 4; ++j) wt[j][i] = *(const f32x4*)(cwl + j * 1024 + c0 + 4 * i); }
          const float ks = lane < 32 ? 1.f : 0.08838834764831845f;
#pragma unroll
          for (int r = 0; r < 8; ++r) { f32x4 y[4] = {bs[0], bs[1], bs[2], bs[3]};
#pragma unroll
              for (int j = 0; j < 4; ++j) { const float on = (t0 + r - 3 + j) >= 0 ? 1.f : 0.f; f32x4 x0, x1, x2, x3; pg8::unpack8(cv[r + j][0], x0, x1); pg8::unpack8(cv[r + j][1], x2, x3);
                  y[0] = y[0] + wt[j][0] * x0 * on; y[1] = y[1] + wt[j][1] * x1 * on; y[2] = y[2] + wt[j][2] * x2 * on; y[3] = y[3] + wt[j][3] * x3 * on; }
#pragma unroll
              for (int i = 0; i < 4; ++i)
#pragma unroll
                  for (int c = 0; c < 4; ++c) y[i][c] = y[i][c] * pg8::fsigmoid(y[i][c]) * ks;
              bf16_t* dst = (lane < 32 ? a.MQ : a.MK) + (size_t)(row0 + r) * 512 + (c0 & 511);
              *(u32x4*)dst = pg8::pack8(y[0], y[1]); *(u32x4*)(dst + 8) = pg8::pack8(y[2], y[3]); } }
        { u32x4 pv[23];
#pragma unroll
          for (int i = 0; i < 23; ++i) { const int d = i - 15, de = (d < 0 && t0 + d < 0) ? 0 : d; pv[i] = *(const u32x4*)(pr0 + (long)de * 7168 + 3584 + pc); }
#pragma unroll
          for (int r = 0; r < 8; ++r) { const int t = t0 + r, cnt = t + 1 < pw ? t + 1 : pw;
              f32x4 u0, u1; pg8::unpack8(pv[15 + r], u0, u1); f32x4 s0 = u0, s1 = u1;
#pragma unroll
              for (int j = 1; j < 16; ++j) { const float on = j < cnt ? 1.f : 0.f; f32x4 b0, b1; pg8::unpack8(pv[15 + r - j], b0, b1); s0 = s0 + b0 * on; s1 = s1 + b1 * on; }
              const float ic = 1.f / (float)cnt; s0 = s0 * ic - u0; s1 = s1 * ic - u1;
              *(u32x4*)(a.HP + (size_t)(row0 + r) * 512 + pc) = pg8::pack8(s0, s1); } }
    }
    __syncthreads();
}
struct RouteIn { const float *X, *SSQ, *WR, *router_b; const bf16_t* XB; bf16_t* XG; float* RSG; unsigned* cnt; int* TOKI; float* TOKG; };
__device__ __forceinline__ void route(const RouteIn& a, char* lds, int vcu, int G) {
    int tid_o = threadIdx.x; asm volatile("" : "+v"(tid_o)); const int tid = tid_o, lane = tid & 63, wave = __builtin_amdgcn_readfirstlane(tid >> 6);
    int vz = 0; asm volatile("" : "+v"(vz));
    int* lcnt = (int*)lds; int* lbase = lcnt + 8; int* lsel = lbase + 8;
    float* lgate = (float*)(lsel + 256);
    float* wrt = (float*)(lds + 8192);
    for (int i = tid; i < 8192; i += 512) wrt[(i & 7) * 1024 + (i >> 3)] = a.WR[i];
    for (int chunk = vcu; chunk < 16384 / 64; chunk += G) {
        if (tid < 8) lcnt[tid] = 0;
        __syncthreads();
        u32x4 xq[8][2]; float rsd[8];
#pragma unroll
        for (int rr = 0; rr < 8; ++rr) { const int row = chunk * 64 + wave * 8 + rr; const u32x4* src = (const u32x4*)(a.XB + (size_t)row * 1024) + lane * 2; xq[rr][0] = src[0]; xq[rr][1] = src[1];
            rsd[rr] = row_rstd_wave(a.SSQ, row, lane, vz); }
#pragma unroll
        for (int rr = 0; rr < 8; ++rr) { const int lrow = wave * 8 + rr;
            f32x4 a0, a1, a2, a3; pg8::unpack8(xq[rr][0], a0, a1); pg8::unpack8(xq[rr][1], a2, a3);
            const float xv[16] = {a0[0], a0[1], a0[2], a0[3], a1[0], a1[1], a1[2], a1[3], a2[0], a2[1], a2[2], a2[3], a3[0], a3[1], a3[2], a3[3]};
            float d[8];
#pragma unroll
            for (int c = 0; c < 8; ++c) { const f32x4* wp = (const f32x4*)(wrt + c * 1024 + 16 * lane); const f32x4 w0 = wp[0], w1 = wp[1], w2 = wp[2], w3 = wp[3];
                d[c] = ((xv[0] * w0[0] + xv[1] * w0[1]) + (xv[2] * w0[2] + xv[3] * w0[3])) + ((xv[4] * w1[0] + xv[5] * w1[1]) + (xv[6] * w1[2] + xv[7] * w1[3]))
                     + ((xv[8] * w2[0] + xv[9] * w2[1]) + (xv[10] * w2[2] + xv[11] * w2[3])) + ((xv[12] * w3[0] + xv[13] * w3[1]) + (xv[14] * w3[2] + xv[15] * w3[3])); }
            const float r = rsd[rr];
#pragma unroll
            for (int j = 0; j < 8; ++j) d[j] = wave_sum(d[j]) * r + a.router_b[j];
            int i0 = 0; float v0 = d[0];
#pragma unroll
            for (int j = 1; j < 8; ++j) if (d[j] > v0) { v0 = d[j]; i0 = j; }
            int i1 = -1; float v1 = -3.0e38f;
#pragma unroll
            for (int j = 0; j < 8; ++j) if (j != i0 && d[j] > v1) { v1 = d[j]; i1 = j; }
            if (lane == 0) { const float e1 = __expf(v1 - v0); const float g0 = 1.f / (1.f + e1);
                lsel[lrow * 4 + 0] = i0; lsel[lrow * 4 + 1] = atomicAdd(&lcnt[i0], 1); lsel[lrow * 4 + 2] = i1; lsel[lrow * 4 + 3] = atomicAdd(&lcnt[i1], 1);
                lgate[lrow * 2] = g0; lgate[lrow * 2 + 1] = e1 * g0; lgate[128 + lrow] = r; } }
        __syncthreads();
        if (tid < 8) lbase[tid] = (int)__hip_atomic_fetch_add(a.cnt + tid, (unsigned)lcnt[tid], __ATOMIC_RELAXED, __HIP_MEMORY_SCOPE_AGENT);
        __syncthreads();
        u32x4 xr[8][2];
#pragma unroll
        for (int rr = 0; rr < 8; ++rr) { const u32x4* src = (const u32x4*)(a.XB + (size_t)(chunk * 64 + wave * 8 + rr) * 1024) + lane * 2; xr[rr][0] = src[0]; xr[rr][1] = src[1]; }
#pragma unroll
        for (int rr = 0; rr < 8; ++rr) {
            const int lrow = wave * 8 + rr, row = chunk * 64 + lrow;
            const int e0 = lsel[lrow * 4], p0 = lbase[e0] + lsel[lrow * 4 + 1], e1 = lsel[lrow * 4 + 2], p1 = lbase[e1] + lsel[lrow * 4 + 3];
            f32x4 a0, a1, a2, a3; pg8::unpack8(xr[rr][0], a0, a1); pg8::unpack8(xr[rr][1], a2, a3);
            const float mx = wave_max(absmax16(a0, a1, a2, a3)), step = mx > 0.f ? mx * (1.f / 127.f) : 1.f; const u32x4 qq = quant16(a0, a1, a2, a3, 1.f / step);
            *((u32x4*)((unsigned char*)a.XG + ((size_t)e0 * 16384 + p0) * 1024) + lane) = qq;
            *((u32x4*)((unsigned char*)a.XG + ((size_t)e1 * 16384 + p1) * 1024) + lane) = qq;
            if (lane == 0) { const float r = lgate[128 + lrow] * step; a.RSG[(size_t)e0 * 16384 + p0] = r; a.RSG[(size_t)e1 * 16384 + p1] = r;
                a.TOKI[row * 4 + 0] = e0; a.TOKI[row * 4 + 1] = p0; a.TOKI[row * 4 + 2] = e1; a.TOKI[row * 4 + 3] = p1; a.TOKG[row * 2] = lgate[lrow * 2]; a.TOKG[row * 2 + 1] = lgate[lrow * 2 + 1]; }
        }
        __syncthreads();
    }
}
struct CombIn { float* X; bf16_t* XB; float* SSQ; const bf16_t* Y; const int* TOKI; const float* TOKG; int ts[8]; };
__device__ __forceinline__ void combine(const CombIn& a, int vcu, int G) {
    int tid_o = threadIdx.x; asm volatile("" : "+v"(tid_o)); const int tid = tid_o, lane = tid & 63, wave = __builtin_amdgcn_readfirstlane(tid >> 6), gw = vcu * 8 + wave, NGW = G * 8;
    int vz = 0; asm volatile("" : "+v"(vz));
    for (int r0 = gw * 4; r0 < 16384; r0 += NGW * 4) {
        int ti[4][4]; float tg[4][2];
#pragma unroll
        for (int q = 0; q < 4; ++q) { const int rv = r0 + q + vz;
#pragma unroll
            for (int i = 0; i < 4; ++i) ti[q][i] = a.TOKI[rv * 4 + i];
            tg[q][0] = a.TOKG[rv * 2]; tg[q][1] = a.TOKG[rv * 2 + 1]; }
        u32x4 y0[4][2], y1[4][2]; f32x4 xv[4][4]; int yr0[4], yr1[4];
#pragma unroll
        for (int q = 0; q < 4; ++q) { int t0 = 0, t1 = 0;
#pragma unroll
            for (int j = 0; j < 8; ++j) { if (j == ti[q][0]) t0 = a.ts[j]; if (j == ti[q][2]) t1 = a.ts[j]; }
            yr0[q] = t0 * 256 + ti[q][1]; yr1[q] = t1 * 256 + ti[q][3];
            const u32x4* p0 = (const u32x4*)(a.Y + (size_t)yr0[q] * 1024) + lane * 2; const u32x4* p1 = (const u32x4*)(a.Y + (size_t)yr1[q] * 1024) + lane * 2;
            y0[q][0] = p0[0]; y0[q][1] = p0[1]; y1[q][0] = p1[0]; y1[q][1] = p1[1];
            const u32x4* xp = (const u32x4*)(a.XB + (size_t)(r0 + q) * 1024) + lane * 2; pg8::unpack8(xp[0], xv[q][0], xv[q][1]); pg8::unpack8(xp[1], xv[q][2], xv[q][3]); }
#pragma unroll
        for (int q = 0; q < 4; ++q) { const int row = r0 + q; const float g0 = tg[q][0], g1 = tg[q][1]; f32x4 v[4]; float s = 0.f;
#pragma unroll
            for (int hh = 0; hh < 2; ++hh) { f32x4 a0, a1, b0, b1; pg8::unpack8(y0[q][hh], a0, a1); pg8::unpack8(y1[q][hh], b0, b1);
                v[2 * hh] = xv[q][2 * hh] + a0 * g0 + b0 * g1; v[2 * hh + 1] = xv[q][2 * hh + 1] + a1 * g0 + b1 * g1; }
            if (yr0[q] >= 32768) {
#pragma unroll
                for (int sl = 0; sl < 1; ++sl) { const u32x4* p2 = (const u32x4*)(a.Y + ((size_t)34816 + sl * 2048 + (yr0[q] - 32768)) * 1024) + lane * 2;
#pragma unroll
                    for (int hh = 0; hh < 2; ++hh) { f32x4 c0, c1; pg8::unpack8(p2[hh], c0, c1); v[2 * hh] = v[2 * hh] + c0 * g0; v[2 * hh + 1] = v[2 * hh + 1] + c1 * g0; } } }
            if (yr1[q] >= 32768) {
#pragma unroll
                for (int sl = 0; sl < 1; ++sl) { const u32x4* p3 = (const u32x4*)(a.Y + ((size_t)34816 + sl * 2048 + (yr1[q] - 32768)) * 1024) + lane * 2;
#pragma unroll
                    for (int hh = 0; hh < 2; ++hh) { f32x4 d0, d1; pg8::unpack8(p3[hh], d0, d1); v[2 * hh] = v[2 * hh] + d0 * g1; v[2 * hh + 1] = v[2 * hh + 1] + d1 * g1; } } }
#pragma unroll
            for (int i = 0; i < 4; ++i) s += (v[i][0] * v[i][0] + v[i][1] * v[i][1]) + (v[i][2] * v[i][2] + v[i][3] * v[i][3]);
            u32x4* xb = (u32x4*)(a.XB + (size_t)row * 1024) + lane * 2; xb[0] = pg8::pack8(v[0], v[1]); xb[1] = pg8::pack8(v[2], v[3]);
            s = wave_sum(s);
            if (lane < 16) a.SSQ[(size_t)row * 16 + lane] = lane == 0 ? s : 0.f; }
    }
}
}
#define LAS __attribute__((address_space(3)))
typedef unsigned short bf16_t;
constexpr int M = 16384, NWAVES = 8;
constexpr size_t MiB = 1u << 20;
constexpr size_t WS_CTL = 0, CTL_ZERO_BYTES = 1 * MiB;
constexpr size_t WS_SMALL = 1 * MiB;
constexpr size_t WS_TOKI = 2 * MiB, WS_TOKG = WS_TOKI + (size_t)M * 16;
constexpr size_t WS_SSQA = 3 * MiB, WS_SSQB = 4 * MiB, WS_GATE = 5 * MiB;
constexpr size_t WS_RSG = 6 * MiB;
constexpr size_t WS_W = 8 * MiB;
constexpr size_t WS_W_IN = WS_W, WS_W_BR = WS_W_IN + (size_t)2 * 7168 * 1024 * 2, WS_W_OUT = WS_W_BR + (size_t)6 * 1024 * 512 * 2, WS_W_GU0 = WS_W_OUT + (size_t)2 * 1024 * 1024 * 2,
                 WS_W_DN0 = WS_W_GU0 + (size_t)5632 * 1024 * 2, WS_W_GU1 = WS_W_DN0 + (size_t)1024 * 2816 * 2, WS_W_DN1 = WS_W_GU1 + (size_t)8 * 7168 * 1024 * 2,
                 WS_W_PG = WS_W_DN1 + (size_t)8 * 1024 * 3584 * 2, WS_W_PP = WS_W_PG + (size_t)2 * 1024 * 1024 * 2, WS_W_END = WS_W_PP + (size_t)2 * 1024 * 256 * 2;
constexpr size_t WS_XB = (WS_W_END + MiB - 1) / MiB * MiB, WS_PP = WS_XB + (size_t)M * 1024 * 2, WS_PB = WS_PP + (size_t)2 * M * 1024 * 2, WS_X8 = WS_PB + (size_t)2 * M * 256 * 2, WS_RS1 = WS_X8 + (size_t)M * 1024, WS_AREA = WS_RS1 + MiB;
constexpr size_t WS_PROJ = WS_AREA, WS_MQ = WS_PROJ + (size_t)M * 7168 * 2, WS_MK = WS_MQ + (size_t)M * 512 * 2, WS_AQ = WS_MK + (size_t)M * 512 * 2, WS_AK = WS_AQ + (size_t)M * 512 * 2,
                 WS_HM = WS_AK + (size_t)M * 512 * 2, WS_HA = WS_HM + (size_t)M * 512 * 2, WS_HP = WS_HA + (size_t)M * 512 * 2, WS_ZF = WS_HP + (size_t)M * 512 * 2, WS_ZB = WS_ZF + (size_t)M * 1024 * 4,
                 WS_G8 = WS_ZB + (size_t)M * 1024 * 2, WS_LAYER_END = WS_G8 + (size_t)M * 3072;
constexpr size_t WS_XG = WS_AREA, WS_Y = WS_AREA, WS_ACT = WS_XG + (size_t)8 * 16384 * 1024 * 2, WS_END = WS_ACT + (size_t)34816 * 3584 * 2;
static_assert(WS_LAYER_END <= WS_END && WS_ACT >= WS_MQ, "AREA views");
constexpr int CW_BAR = 4096, CW_QUEUE = 16384, CW_ECNT = 16384 + 256;

#define XB_TMO      128
#define XB_XCNT(j)  (256  + 64 * (j))
#define XB_XSUB(j)  (1280 + 64 * (j))
#define XB_XGEN(j)  (2304 + 64 * (j))
#define XB_TOP      3328
#define XB_TOPGEN   3392
#define XCD_BAR_WORDS 3456
#define XB_SPIN_CAP (1u << 18)

__device__ __forceinline__ unsigned xb_ld(unsigned* p)              { return __hip_atomic_load(p, __ATOMIC_RELAXED, __HIP_MEMORY_SCOPE_AGENT); }
__device__ __forceinline__ unsigned xb_add(unsigned* p, unsigned v) { return __hip_atomic_fetch_add(p, v, __ATOMIC_RELAXED, __HIP_MEMORY_SCOPE_AGENT); }
__device__ __forceinline__ unsigned xb_xcc_id() { return (unsigned)__builtin_amdgcn_s_getreg((3 << 11) | 20) & 0xFu; }
#define XB_SPIN(cond, bar) do { unsigned _sp = 0; while (cond) { __builtin_amdgcn_s_sleep(1); \
    if ((++_sp & 255u) == 0u) { if (xb_ld(&(bar)[XB_TMO])) break; if (_sp > XB_SPIN_CAP) { atomicAdd(&(bar)[XB_TMO], 1u); break; } } } } while (0)

struct XcdBarrier {
    unsigned* bar; unsigned x;
    volatile LAS unsigned* st;
};

__device__ __forceinline__ XcdBarrier xcd_barrier_post(unsigned* bar, volatile LAS unsigned* st) {
    XcdBarrier b; b.bar = bar; b.x = xb_xcc_id(); b.st = st;
    if (threadIdx.x == 0) (void)xb_add(&bar[XB_XCNT(b.x)], 1u);
    return b;
}
__device__ __forceinline__ void xcd_barrier_complete(unsigned* bar, unsigned x, unsigned& nloc, unsigned& nx) {
    const unsigned G = gridDim.x * gridDim.y * gridDim.z;
    unsigned sum, cnt, mine, sp = 0u;
    for (;;) {
        sum = 0u; cnt = 0u; mine = 0u;
#pragma unroll
        for (unsigned j = 0; j < 16; ++j) { const unsigned c = xb_ld(&bar[XB_XCNT(j)]); sum += c; cnt += (c > 0u) ? 1u : 0u; mine = (j == x) ? c : mine; }
        if (sum == G) break;
        __builtin_amdgcn_s_sleep(1);
        if ((++sp & 255u) == 0u) { if (xb_ld(&bar[XB_TMO])) break; if (sp > XB_SPIN_CAP) { atomicAdd(&bar[XB_TMO], 1u); break; } }
    }
    nloc = mine > 0u ? mine : 1u; nx = cnt > 0u ? cnt : 1u;
}

__device__ __forceinline__ void xcd_barrier(const XcdBarrier& b) {
    asm volatile("s_waitcnt vmcnt(0)" ::: "memory");
    __syncthreads();
    if (threadIdx.x == 0) {
        unsigned* bar = b.bar;
        __builtin_amdgcn_s_waitcnt(0);
        unsigned nloc = b.st[0], nx = b.st[1];
        if (nloc == 0u) { xcd_barrier_complete(bar, b.x, nloc, nx); b.st[0] = nloc; b.st[1] = nx; }
        const unsigned old = xb_add(&bar[XB_XSUB(b.x)], 1u);
        const unsigned gen = old / nloc;
        if (old + 1u == (gen + 1u) * nloc) {
            __builtin_amdgcn_fence(__ATOMIC_RELEASE, "agent");
            asm volatile("s_waitcnt vmcnt(0)" ::: "memory");
            const unsigned og = xb_add(&bar[XB_TOP], 1u);
            const unsigned tg = og / nx;
            if (og + 1u == (tg + 1u) * nx) xb_add(&bar[XB_TOPGEN], 1u);
            else XB_SPIN(xb_ld(&bar[XB_TOPGEN]) == tg, bar);
            __builtin_amdgcn_fence(__ATOMIC_ACQUIRE, "agent");
            xb_add(&bar[XB_XGEN(b.x)], 1u);
            asm volatile("s_waitcnt vmcnt(0)" ::: "memory");
        } else {
            XB_SPIN(xb_ld(&bar[XB_XGEN(b.x)]) == gen, bar);
            __builtin_amdgcn_fence(__ATOMIC_ACQUIRE, "agent");
            asm volatile("s_waitcnt vmcnt(0)" ::: "memory");
        }
    }
    __syncthreads();
}


struct Args { const float* in[26]; float* out; unsigned char* ws; int ph_lo, ph_hi; };
static_assert(sizeof(Args) == 26 * 8 + 8 + 8 + 8, "Args has no padding");

constexpr int LDS_BYTES = 147456, MISC_OFF = 131072 + 8192;

__global__ void __launch_bounds__(NWAVES * 64, 2) fwd_kernel(Args args) {
    extern __shared__ __attribute__((aligned(16))) unsigned char lds[];
    const int tid = threadIdx.x;
    const int G = gridDim.x; int vcu; { const int bx = blockIdx.x; vcu = (G % 8 == 0) ? (bx % 8) * (G / 8) + bx / 8 : bx; }
    volatile LAS unsigned* MISC = (volatile LAS unsigned*)((LAS unsigned char*)lds + MISC_OFF);
    if (tid < 32) MISC[tid] = 0u;
    __syncthreads();
    unsigned char* ws = args.ws;
    unsigned* ctl = (unsigned*)(ws + WS_CTL);
    const int lo = args.ph_lo, hi = args.ph_hi;
    const bool one_launch = (hi - lo) > 1;
    XcdBarrier bar; bar.bar = ctl + CW_BAR; bar.x = 0; bar.st = nullptr;
    if (one_launch) bar = xcd_barrier_post(ctl + CW_BAR, MISC + 8);
#ifndef EPI_ALIGN8
#define EPI_ALIGN8 true
#endif
#ifndef SITE_MASK
#define SITE_MASK 0xffff
#endif
#define EN(s) ((SITE_MASK >> (s)) & 1)
#define IN(k) (lo <= (k) && (k) < hi)
#define SEAM(k) do { if (IN(k) && IN((k) + 1)) xcd_barrier(bar); } while (0)
    LAS unsigned char* ring = (LAS unsigned char*)lds;
    const float* const* in = args.in;
    float* X = args.out;
#define SITE_WS size_t wso_ = 0; asm volatile("" : "+s"(wso_)); unsigned char* wsl = ws + wso_;
#define p_XB ((bf16_t*)(wsl + WS_XB))
#define p_PB ((bf16_t*)(wsl + WS_PB))
#define p_PPb ((bf16_t*)(wsl + WS_PP))
#define p_SSQA ((float*)(wsl + WS_SSQA))
#define p_SSQB ((float*)(wsl + WS_SSQB))
#define p_GATE ((float*)(wsl + WS_GATE))
#define p_RSG ((float*)(wsl + WS_RSG))
#define p_WG ((float*)(wsl + WS_SMALL))
#define p_WR (((float*)(wsl + WS_SMALL) + 2 * 8192))
#define p_DQ ((float*)(wsl + WS_SMALL + 131072))
#define p_PROJ ((bf16_t*)(wsl + WS_PROJ))
#define p_MQ ((bf16_t*)(wsl + WS_MQ))
#define p_MK ((bf16_t*)(wsl + WS_MK))
#define p_AQ ((bf16_t*)(wsl + WS_AQ))
#define p_AK ((bf16_t*)(wsl + WS_AK))
#define p_HM ((bf16_t*)(wsl + WS_HM))
#define p_HA ((bf16_t*)(wsl + WS_HA))
#define p_HP ((bf16_t*)(wsl + WS_HP))
#define p_ZB ((bf16_t*)(wsl + WS_ZB))
#define p_XG ((bf16_t*)(wsl + WS_XG))
#define p_Yb ((bf16_t*)(wsl + WS_Y))
#define p_ACT ((bf16_t*)(wsl + WS_ACT))
#define p_TOKI ((int*)(wsl + WS_TOKI))
#define p_TOKG ((float*)(wsl + WS_TOKG))
#define p_W_IN ((bf16_t*)(wsl + WS_W_IN))
#define p_W_BR ((bf16_t*)(wsl + WS_W_BR))
#define p_W_OUT ((bf16_t*)(wsl + WS_W_OUT))
#define p_W_GU0 ((bf16_t*)(wsl + WS_W_GU0))
#define p_W_DN0 ((bf16_t*)(wsl + WS_W_DN0))
#define p_W_GU1 ((bf16_t*)(wsl + WS_W_GU1))
#define p_W_DN1 ((bf16_t*)(wsl + WS_W_DN1))
#define p_W_PG ((bf16_t*)(wsl + WS_W_PG))
#define p_W_PP ((bf16_t*)(wsl + WS_W_PP))
    if (EN(0) && IN(0)) {
        SITE_WS
        thin::ProIn a; a.x = in[0]; a.p = in[1]; a.attn_norm = in[2]; a.w_in = in[3]; a.pool_w = in[12]; a.pool_scale = in[13]; a.w_branch = in[14]; a.w_out = in[15]; a.ffn_norm = in[16];
        a.dense_w_gu = in[17]; a.dense_w_down = in[18]; a.router_w = in[19]; a.moe_w_gu = in[21]; a.moe_w_down = in[22]; a.ple_norm = in[23]; a.ple_w_gate = in[24]; a.ple_w_proj = in[25];
        a.W_IN = p_W_IN; a.W_BR = p_W_BR; a.W_OUT = p_W_OUT; a.W_GU0 = p_W_GU0; a.W_DN0 = p_W_DN0; a.W_GU1 = p_W_GU1; a.W_DN1 = p_W_DN1; a.W_PG = p_W_PG; a.W_PP = p_W_PP; a.XB = p_XB; a.PB = p_PB; a.X = X; a.SSQ = p_SSQA; a.WG = p_WG; a.WR = p_WR; a.X8 = (unsigned char*)(wsl + WS_X8); a.RS1 = (float*)(wsl + WS_RS1);
        a.W8_IN = (unsigned char*)(wsl + WS_W_IN); a.SB_IN = (float*)(wsl + WS_W_IN + (size_t)14 * MiB); a.W8_GU0 = (unsigned char*)(wsl + WS_W_GU0); a.SB_GU0 = (float*)(wsl + WS_W_GU0 + (size_t)6 * MiB);
        a.W8_GU1 = (unsigned char*)(wsl + WS_W_GU1); a.SB_GU1 = (float*)(wsl + WS_W_GU1 + (size_t)56 * MiB); a.GATE = p_GATE; a.gate_bias = in[6]; a.DQ = p_DQ;
        thin::prologue(a, (char*)lds, vcu, G);
    }
    SEAM(0);
#pragma unroll 1
    for (int L = 0; L < 2; ++L) {
        const int pb = 2 + 11 * L;
        if (EN(2) && IN(pb)) {
            SITE_WS
            pg8::Gemm g{(const bf16_t*)(wsl + WS_X8), (const bf16_t*)(wsl + WS_W_IN + (size_t)L * 7168 * 1024), M, 7168, 512, 512}; pg8::StaticOrder S; S.init(M, 7168, G, (int)blockIdx.x);
            pg8::EpiProj8 E{p_PROJ, (const float*)(wsl + WS_RS1), (const float*)(wsl + WS_W_IN + (size_t)14 * MiB) + L * 7168, p_AQ, p_AK, in[8] + L * 64, in[9] + L * 64, (unsigned char*)(wsl + WS_G8)};
            pg8::gemm_phase<pg8::EpiProj8, pg8::StaticOrder, EPI_ALIGN8, true>(ring, g, S, E);
        }
        SEAM(pb);
        if (EN(3) && IN(pb + 1)) {
            SITE_WS
            thin::PrepIn a; a.PROJ = p_PROJ; a.XB = p_XB; a.SSQ = p_SSQA; a.WG = p_WG + L * 8192; a.conv_w = in[4] + L * 4096; a.conv_b = in[5] + L * 1024; a.gate_bias = in[6] + L * 8;
            a.q_gain = in[8] + L * 64; a.k_gain = in[9] + L * 64; a.MQ = p_MQ; a.MK = p_MK; a.AQ = p_AQ; a.AK = p_AK; a.HP = p_HP; a.GATE = p_GATE;
            thin::prep(a, (char*)lds, vcu, G);
        }
        SEAM(pb + 1);
        if (EN(4) && IN(pb + 2)) {
            SITE_WS
            mix::MixPtrs P; P.PROJ = p_PROJ; P.MQ = p_MQ; P.MK = p_MK; P.AQ = p_AQ; P.AK = p_AK; P.GATE = p_GATE; P.HM = p_HM; P.HA = p_HA; P.m_hgain = in[7] + L * 512; P.a_hgain = in[11] + L * 512;
            { const float* lp = in[10] + L * 256; float d01 = 0.f, d23 = 0.f; for (int i = 0; i < 64; ++i) { d01 = fmaf(lp[i], lp[64 + i], d01); d23 = fmaf(lp[128 + i], lp[192 + i], d23); }
              const float lam_init = 0.8f - 0.6f * __expf(-0.3f * (float)L);
              float* lamv = (float*)((char*)lds + MISC_OFF + 64); if (tid == 0) { lamv[0] = __expf(d01) - __expf(d23) + lam_init; lamv[1] = 1.f - lam_init; } __syncthreads(); P.lamv = lamv; }
            mix::mix_phase<true, true>((char*)lds, P, ctl + CW_QUEUE + 64 * L);
        }
        SEAM(pb + 2);
        if (EN(5) && IN(pb + 3)) {
            SITE_WS
            pg8::MergeOrder S; S.S.init(M, 1024, G, (int)blockIdx.x);
            pg8::Gemm g{p_HM, p_W_BR + (size_t)L * 3 * 1024 * 512, 3 * M, 1024, 512, 512}; pg8::EpiZs E{p_ZB, (const unsigned char*)(wsl + WS_G8)};
            pg8::gemm_phase<pg8::EpiZs, pg8::MergeOrder, true, true>(ring, g, S, E);
        }
        SEAM(pb + 3);
        if (EN(6) && IN(pb + 4)) {
            SITE_WS
            pg8::Gemm g{p_ZB, p_W_OUT + (size_t)L * 1024 * 1024, M, 1024, 1024, 1024}; pg8::StaticOrder S; S.init(M, 1024, G, (int)blockIdx.x);
            pg8::EpiRes E{p_XB, p_SSQB};
            pg8::gemm_phase<pg8::EpiRes, pg8::StaticOrder, true, true>(ring, g, S, E);
        }
        SEAM(pb + 4);
        if (L == 0) {
            if (EN(7) && IN(pb + 5)) {
                SITE_WS
                thin::quant_act<false>(p_XB, p_SSQB, (unsigned char*)(wsl + WS_X8), (float*)(wsl + WS_RS1), nullptr, nullptr, nullptr, vcu, G);
                pg8::Gemm g{p_PB, p_W_PP, 2 * M, 1024, 256, 256};
                pg8::PpOrder S; S.S.init(2 * M, 1024, G, (int)blockIdx.x);
                pg8::EpiPP E{p_PPb};
                pg8::gemm_phase<pg8::EpiPP, pg8::PpOrder, true, true>(ring, g, S, E);
            }
            SEAM(pb + 5);
            if (EN(8) && IN(pb + 6)) {
                SITE_WS
                pg8::Gemm g{(const bf16_t*)(wsl + WS_X8), (const bf16_t*)(wsl + WS_W_GU0), M, 5632, 512, 512}; pg8::StaticOrder S; S.init(M, 5632, G, (int)blockIdx.x);
                pg8::EpiUp8d E{(unsigned char*)p_ACT, (const float*)(wsl + WS_RS1), (const float*)(wsl + WS_W_GU0 + (size_t)6 * MiB)};
                pg8::gemm_phase<pg8::EpiUp8d, pg8::StaticOrder, true, true>(ring, g, S, E);
            }
            SEAM(pb + 6);
            if (EN(9) && IN(pb + 7)) {
                SITE_WS
                pg8::Gemm g{p_ACT, p_W_DN0, M, 1024, 1408, 1408}; pg8::StaticOrder S; S.init(M, 1024, G, (int)blockIdx.x);
                pg8::EpiResF8 E{p_XB, p_SSQB, p_DQ};
                pg8::gemm_phase<pg8::EpiResF8, pg8::StaticOrder, true, true>(ring, g, S, E);
            }
            SEAM(pb + 7);
        } else {
            if (EN(7) && IN(pb + 5)) {
                SITE_WS
                thin::RouteIn a; a.X = X; a.SSQ = p_SSQB; a.WR = p_WR; a.router_b = in[20]; a.XB = p_XB; a.XG = p_XG; a.RSG = p_RSG; a.cnt = ctl + CW_ECNT; a.TOKI = p_TOKI; a.TOKG = p_TOKG;
                thin::route(a, (char*)lds, vcu, G);
            }
            SEAM(pb + 5);
            int ts[9]; ts[0] = 0;
#pragma unroll
            for (int e = 0; e < 8; ++e) { const unsigned c = __hip_atomic_load(ctl + CW_ECNT + e, __ATOMIC_RELAXED, __HIP_MEMORY_SCOPE_AGENT); ts[e + 1] = ts[e] + (int)((c + 255u) >> 8); }
            if (EN(10) && IN(pb + 6)) {
                SITE_WS
                pg8::Gemm g{p_XG, p_W_GU1, 0, 0, 512, 512};
                pg8::MoeOrder<true> S{ts[8], 28, ts[8] * 28, G, (int)blockIdx.x, ts[0], ts[1], ts[2], ts[3], ts[4], ts[5], ts[6], ts[7], 0};
                pg8::EpiUp8 E{(unsigned char*)p_ACT, p_RSG, (const float*)(wsl + WS_W_GU1 + (size_t)56 * MiB), ts[0], ts[1], ts[2], ts[3], ts[4], ts[5], ts[6], ts[7]};
                pg8::gemm_phase<pg8::EpiUp8, pg8::MoeOrder<true>, EPI_ALIGN8, true>(ring, g, S, E);
            }
            SEAM(pb + 6);
            if (EN(11) && IN(pb + 7)) {
                SITE_WS
                const int RA = ts[8] < 128 ? ts[8] : 128, RB = ts[8] - RA;
                { pg8::Gemm g{p_ACT, p_W_DN1, 0, 0, 1792, 1792};
                  pg8::MoeOrder<false> S{RA, 4, RA * 4, G, (int)blockIdx.x, ts[0], ts[1], ts[2], ts[3], ts[4], ts[5], ts[6], ts[7], 0};
                  pg8::EpiDownMoe E{p_Yb, p_Yb, 1792, p_DQ + 1};
                  pg8::gemm_phase<pg8::EpiDownMoe, pg8::MoeOrder<false>, true, true>(ring, g, S, E); }
                if (RB > 0) { pg8::Gemm g{p_ACT, p_W_DN1, 0, 0, 896, 1792};
                  pg8::MoeOrder<false, 2, 896> S{RB, 4, RB * 4 * 2, G, (int)(G - 1 - blockIdx.x), ts[0], ts[1], ts[2], ts[3], ts[4], ts[5], ts[6], ts[7], 128};
                  pg8::EpiDownMoe E{p_Yb, p_Yb + (size_t)34816 * 1024, 896, p_DQ + 1};
                  pg8::gemm_phase<pg8::EpiDownMoe, pg8::MoeOrder<false, 2, 896>, true, true>(ring, g, S, E); }
            }
            SEAM(pb + 7);
            if (EN(12) && IN(pb + 8)) {
                SITE_WS
                thin::CombIn a; a.X = X; a.XB = p_XB; a.SSQ = p_SSQB; a.Y = p_Yb; a.TOKI = p_TOKI; a.TOKG = p_TOKG;
#pragma unroll
                for (int e = 0; e < 8; ++e) a.ts[e] = ts[e];
                thin::combine(a, vcu, G);
            }
            SEAM(pb + 8);
        }
        if (EN(13) && IN(pb + 9)) {
            SITE_WS
            pg8::Gemm g{p_XB, p_W_PG + (size_t)L * 1024 * 1024, M, 1024, 1024, 1024}; pg8::StaticOrder S; S.init(M, 1024, G, (int)blockIdx.x);
            if (L == 0) { pg8::EpiPle<false> E{X, p_XB, p_SSQB, p_SSQA, p_PPb}; pg8::gemm_phase<pg8::EpiPle<false>, pg8::StaticOrder, true, true>(ring, g, S, E); }
            else { pg8::EpiPle<true> E{X, p_XB, p_SSQB, p_SSQA, p_PPb + (size_t)M * 1024}; pg8::gemm_phase<pg8::EpiPle<true>, pg8::StaticOrder, true, true>(ring, g, S, E); }
        }
        if (L == 0) {
            SEAM(pb + 9);
            if (EN(7) && IN(pb + 10)) {
                SITE_WS
                thin::quant_act<true>(p_XB, p_SSQA, (unsigned char*)(wsl + WS_X8), (float*)(wsl + WS_RS1), p_WG + 8192, in[6] + 8, p_GATE, vcu, G);
            }
            SEAM(pb + 10);
        }
    }
#undef IN
#undef SEAM
#undef EN
#undef SITE_WS
#undef p_XB
#undef p_PB
#undef p_PPb
#undef p_SSQA
#undef p_SSQB
#undef p_GATE
#undef p_RSG
#undef p_WG
#undef p_WR
#undef p_DQ
#undef p_PROJ
#undef p_MQ
#undef p_MK
#undef p_AQ
#undef p_AK
#undef p_HM
#undef p_HA
#undef p_HP
#undef p_ZB
#undef p_XG
#undef p_Yb
#undef p_ACT
#undef p_TOKI
#undef p_TOKG
#undef p_W_IN
#undef p_W_BR
#undef p_W_OUT
#undef p_W_GU0
#undef p_W_DN0
#undef p_W_GU1
#undef p_W_DN1
#undef p_W_PG
#undef p_W_PP

}

constexpr int N_PHASES = 24;
extern "C" void kernel_launch(void* const* d_in, const int* in_sizes, int n_in, void* d_out, int out_size, void* d_ws, size_t ws_size, hipStream_t stream) {
    static int grid = 0;
    if (grid == 0) {
        if (n_in != 26 || out_size != M * 1024 || ws_size < WS_END) { fprintf(stderr, "kernel_launch: unexpected shapes (n_in %d out %d ws %zu need %zu)\n", n_in, out_size, ws_size, (size_t)WS_END); grid = -1; return; }
        int dev = 0, cus = 0, per_cu = 0;
        if (hipGetDevice(&dev) != hipSuccess || hipDeviceGetAttribute(&cus, hipDeviceAttributeMultiprocessorCount, dev) != hipSuccess) { grid = -1; return; }
        if (hipFuncSetAttribute((const void*)fwd_kernel, hipFuncAttributeMaxDynamicSharedMemorySize, LDS_BYTES) != hipSuccess) { fprintf(stderr, "kernel_launch: hipFuncSetAttribute failed\n"); grid = -1; return; }
        if (hipOccupancyMaxActiveBlocksPerMultiprocessor(&per_cu, (const void*)fwd_kernel, NWAVES * 64, LDS_BYTES) != hipSuccess || per_cu < 1) { fprintf(stderr, "kernel_launch: occupancy query says %d blocks per CU\n", per_cu); }
        (void)hipGetLastError();
        grid = cus;
    }
    if (grid < 0) return;
    if (hipMemsetAsync((char*)d_ws + WS_CTL, 0, CTL_ZERO_BYTES, stream) != hipSuccess) return;
    Args a{};
    for (int i = 0; i < 26; ++i) a.in[i] = (const float*)d_in[i];
    a.out = (float*)d_out; a.ws = (unsigned char*)d_ws;
#if N_LAUNCH_PER_PHASE
    for (int ph = 0; ph < N_PHASES; ++ph) { if (ph == 1 || ph == 10 || ph == 23) continue;
        a.ph_lo = ph; a.ph_hi = ph + 1; hipLaunchKernelGGL(fwd_kernel, dim3(grid), dim3(NWAVES * 64), LDS_BYTES, stream, a); }
#else
    a.ph_lo = 0; a.ph_hi = N_PHASES;
    hipLaunchKernelGGL(fwd_kernel, dim3(grid), dim3(NWAVES * 64), LDS_BYTES, stream, a);
#endif
    const hipError_t le = hipPeekAtLastError();
    if (le != hipSuccess) fprintf(stderr, "kernel_launch: launch failed: %s\n", hipGetErrorName(le));
}
```

```cpp
#include <hip/hip_runtime.h>
#include <cstdio>
#include <cstdint>
#include <cmath>
#define N_LAUNCH_PER_PHASE 0
namespace pg8 {
#define PG8_LAS __attribute__((address_space(3)))
typedef unsigned short bf16_t;
typedef short bf16x8 __attribute__((ext_vector_type(8)));
typedef float f32x4 __attribute__((ext_vector_type(4)));
typedef unsigned u32x4 __attribute__((ext_vector_type(4)));
constexpr int BM = 256, BK = 64, HALF = 128, HTB = HALF * BK * 2  , STAGE_BYTES = 8 * HTB, NXCD = 8, WGM = 8;

__host__ __device__ __forceinline__ int lds_byte(int r, int c) { const int st = (r >> 4) * 2 + (c >> 5), rr = r & 15, cc = c & 31, ob = rr * 64 + cc * 2; return st * 1024 + (ob ^ (((ob >> 9) & 1) << 5)); }
__host__ __device__ __forceinline__ void stage_rc(int b, int& R, int& C) { const int st = b / 1024, sb = b % 1024, swz = sb ^ (((sb >> 9) & 1) << 5); R = (st >> 1) * 16 + swz / 64; C = (st & 1) * 32 + (swz % 64) / 2; }
__host__ __device__ __forceinline__ int perm32(int rho) { const int n = rho >> 4, i = rho & 15; return 8 * (i >> 2) + 4 * n + (i & 3); }

struct Unit { int pm, pn, ko; };
struct Gemm { const bf16_t* A; const bf16_t* Bt; int M, N, K, ld; };

struct StaticOrder {
    int nM, nN, nwg, G, c;
    __host__ __device__ void init(int M, int N, int G_, int c_) { nM = M / BM; nN = N / BM; nwg = nM * nN; G = G_; c = c_; }
    __host__ __device__ bool next(int i, Unit& u) const {
        const long L = (long)i * G + c; if (L >= nwg) return false;
        int wgid = (int)L; { const int q = nwg / NXCD, r = nwg % NXCD, xcd = wgid % NXCD, off = wgid / NXCD; wgid = (xcd < r ? xcd * (q + 1) : r * (q + 1) + (xcd - r) * q) + off; }
        const int nig = WGM * nN, gid = wgid / nig, fm = gid * WGM, gsz = (nM - fm) < WGM ? (nM - fm) : WGM;
        u.pm = fm + ((wgid % nig) % gsz); u.pn = (wgid % nig) / gsz; u.ko = 0; return true;
    }
    __device__ __forceinline__ void a_ready(const Unit&) const {}
    __device__ __forceinline__ void done(const Unit&) const {}
};
__device__ __forceinline__ unsigned cvt_pk_bf16(float lo, float hi) { unsigned r; asm volatile("v_cvt_pk_bf16_f32 %0, %1, %2" : "=v"(r) : "v"(lo), "v"(hi)); return r; }
typedef float f32x2 __attribute__((ext_vector_type(2)));
typedef int i32x4 __attribute__((ext_vector_type(4)));
template <class E> struct EpiTraits { static constexpr bool CHAIN = false, F8 = false, PRE = false; };
template <bool I8> struct AccOf { typedef f32x4 type; };
template <> struct AccOf<true> { typedef i32x4 type; };
__device__ __forceinline__ f32x4 mma16(bf16x8 a, bf16x8 b, f32x4 c) { return __builtin_amdgcn_mfma_f32_16x16x32_bf16(a, b, c, 0, 0, 0); }
typedef int i32x8 __attribute__((ext_vector_type(8)));
__device__ __forceinline__ f32x4 mma16f8(i32x8 a, i32x8 b, f32x4 c) {
    asm volatile("v_mfma_scale_f32_16x16x128_f8f6f4 %0, %1, %2, %0, %3, %3 op_sel_hi:[0,0,0]" : "+v"(c) : "v"(a), "v"(b), "v"(0x7f7f7f7f));
    return c; }
__device__ __forceinline__ i32x8 ld_f8(const __attribute__((address_space(3))) unsigned char* p) {
    const i32x4 lo = *(const __attribute__((address_space(3))) i32x4*)p, hi = *(const __attribute__((address_space(3))) i32x4*)(p + 1024);
    return __builtin_shufflevector(lo, hi, 0, 1, 2, 3, 4, 5, 6, 7); }
__device__ __forceinline__ i32x4 mma16(bf16x8 a, bf16x8 b, i32x4 c) { return __builtin_amdgcn_mfma_i32_16x16x64_i8(__builtin_bit_cast(i32x4, a), __builtin_bit_cast(i32x4, b), c, 0, 0, 0); }
template <class Epi, class Sched, bool ALIGN_EPI = false, bool SP2 = false>
__device__ __forceinline__ void gemm_phase(PG8_LAS unsigned char* lds, const Gemm g, const Sched& S, const Epi& E) {
    int tid_o = threadIdx.x; asm volatile("" : "+v"(tid_o));
    const int tid = tid_o, wid = __builtin_amdgcn_readfirstlane(tid >> 6), lane = tid & 63, wr = wid >> 2, wc = wid & 3, fr = lane & 15, fq = lane >> 4;
    const int K = g.ld, nt = g.K / BK;
    unsigned voffA[2], voffB[2];
#pragma unroll
    for (int i = 0; i < 2; ++i) { int R, C; stage_rc(tid * 16 + i * 8192, R, C); const int Rb = Epi::PERM ? ((R & ~31) + perm32(R & 31)) : R;
        voffA[i] = (unsigned)(R * K + C) * 2u; voffB[i] = (unsigned)(Rb * K + C) * 2u; }
    const size_t kstep = (size_t)(BK * 2);
    const size_t hstep = (size_t)HALF * K * 2;
    const size_t tstep = 2 * hstep;
    const unsigned ldsw = (unsigned)wid * 1024u;
    const int aoff = lds_byte(wr * 64 + fr, fq * 8), boff = lds_byte(wc * 32 + fr, fq * 8);
#define PG8_SA(b, h) (((b) * 2 + (h)) * HTB)
#define PG8_SB(b, h) ((4 + (b) * 2 + (h)) * HTB)
#define PG8_STAGE(bufoff, gbase, voff) do { _Pragma("unroll") for (int _i = 0; _i < 2; ++_i) \
        __builtin_amdgcn_global_load_lds((const unsigned*)((const char*)(gbase) + (voff)[_i]), (PG8_LAS unsigned*)(lds + (bufoff) + ldsw + _i * 8192), 16, 0, 0); } while (0)
#define PG8_LDA(dst, b, h) do { _Pragma("unroll") for (int m = 0; m < 4; ++m) { if constexpr (EpiTraits<Epi>::F8) dst##8[m] = ld_f8(lds + PG8_SA(b, h) + aoff + m * 2048); \
        else { _Pragma("unroll") for (int k = 0; k < 2; ++k) dst[m][k] = *(const PG8_LAS bf16x8*)(lds + PG8_SA(b, h) + aoff + m * 2048 + k * 1024); } } } while (0)
#define PG8_LDB(dst, b, h) do { _Pragma("unroll") for (int n = 0; n < 2; ++n) { if constexpr (EpiTraits<Epi>::F8) dst##8[n] = ld_f8(lds + PG8_SB(b, h) + boff + n * 2048); \
        else { _Pragma("unroll") for (int k = 0; k < 2; ++k) dst[n][k] = *(const PG8_LAS bf16x8*)(lds + PG8_SB(b, h) + boff + n * 2048 + k * 1024); } } } while (0)
#define PG8_MMA(ai, bj, At, Bt) do { __builtin_amdgcn_s_setprio(1); _Pragma("unroll") for (int m = 0; m < 4; ++m) _Pragma("unroll") for (int n = 0; n < 2; ++n) { \
        if constexpr (EpiTraits<Epi>::F8) acc[ai][bj][m][n] = mma16f8(Bt##8[n], At##8[m], acc[ai][bj][m][n]); \
        else { _Pragma("unroll") for (int k = 0; k < 2; ++k) acc[ai][bj][m][n] = mma16(Bt[n][k], At[m][k], acc[ai][bj][m][n]); } } __builtin_amdgcn_s_setprio(0); } while (0)
#define PG8_WAIT_V(n) asm volatile("s_waitcnt vmcnt(" #n ")" ::: "memory")
#define PG8_WAIT_L(n) asm volatile("s_waitcnt lgkmcnt(" #n ")" ::: "memory")
#define PG8_BAR __builtin_amdgcn_s_barrier()
#define PG8_SCHED __builtin_amdgcn_sched_barrier(0)
    Unit cur, nxt; int ui = 0;
    if (!S.next(0, cur)) return;
    typedef typename AccOf<Epi::I8>::type acc_t;
    acc_t acc[2][2][4][2];
#pragma unroll
    for (int a = 0; a < 2; ++a)
#pragma unroll
        for (int b = 0; b < 2; ++b)
#pragma unroll
            for (int m = 0; m < 4; ++m)
#pragma unroll
                for (int n = 0; n < 2; ++n) acc[a][b][m][n] = (acc_t){0, 0, 0, 0};
    bf16x8 At[4][2], B0[2][2], B1[2][2];
    i32x8 At8[4], B08[2], B18[2];
    const char* cA = (const char*)g.A + (size_t)cur.pm * tstep + (size_t)cur.ko * 2; const char* cB = (const char*)g.Bt + (size_t)cur.pn * tstep + (size_t)cur.ko * 2;
    S.a_ready(cur);
    if constexpr (SP2) {
        PG8_STAGE(PG8_SB(0, 0), cB, voffB); PG8_STAGE(PG8_SB(0, 1), cB + hstep, voffB); PG8_STAGE(PG8_SA(0, 0), cA, voffA); PG8_STAGE(PG8_SA(0, 1), cA + hstep, voffA);
        if (wr == 1) PG8_BAR;
        PG8_WAIT_V(2); PG8_BAR;
        PG8_STAGE(PG8_SB(1, 0), cB + kstep, voffB); PG8_STAGE(PG8_SA(1, 0), cA + kstep, voffA); PG8_STAGE(PG8_SB(1, 1), cB + hstep + kstep, voffB);
        PG8_WAIT_V(6); PG8_BAR;
    } else {
        PG8_STAGE(PG8_SB(0, 0), cB, voffB); PG8_STAGE(PG8_SA(0, 0), cA, voffA); PG8_STAGE(PG8_SB(0, 1), cB + hstep, voffB); PG8_STAGE(PG8_SA(0, 1), cA + hstep, voffA);
        if (wr == 1) PG8_BAR;
        PG8_WAIT_V(4); PG8_BAR;
        PG8_STAGE(PG8_SB(1, 0), cB + kstep, voffB); PG8_STAGE(PG8_SA(1, 0), cA + kstep, voffA); PG8_STAGE(PG8_SB(1, 1), cB + hstep + kstep, voffB);
        PG8_WAIT_V(6); PG8_BAR;
    }
    for (;;) {
        const bool has_next = S.next(ui + 1, nxt);
        const char* nA = has_next ? (const char*)g.A + (size_t)nxt.pm * tstep + (size_t)nxt.ko * 2 : cA; const char* nB = has_next ? (const char*)g.Bt + (size_t)nxt.pn * tstep + (size_t)nxt.ko * 2 : cB;
#pragma unroll 1
        for (int t = 0; t < nt; t += 2) {
            const bool last = (t == nt - 2);
            const char* a1 = cA + (size_t)(t + 1) * kstep;
            const char* a2 = last ? nA : cA + (size_t)(t + 2) * kstep; const char* b2 = last ? nB : cB + (size_t)(t + 2) * kstep;
            const char* a3 = a2 + kstep; const char* b3 = b2 + kstep;
            if (last && has_next) S.a_ready(nxt);
            if constexpr (SP2) {
            bool pre = false; if constexpr (EpiTraits<Epi>::PRE) pre = last;
            PG8_LDB(B0, 0, 0); PG8_LDB(B1, 0, 1); PG8_SCHED; PG8_LDA(At, 0, 0); PG8_STAGE(PG8_SA(1, 1), a1 + hstep, voffA);
            if constexpr (EpiTraits<Epi>::PRE) { if (pre) __builtin_amdgcn_global_load_lds((const unsigned*)E.pre_ptr(cur, tid), (PG8_LAS unsigned*)(lds + STAGE_BYTES + wid * 256), 4, 0, 0); }
            if (pre) PG8_WAIT_V(9); else PG8_WAIT_V(8); PG8_WAIT_L(0); PG8_BAR; PG8_MMA(0, 0, At, B0); PG8_MMA(0, 1, At, B1); PG8_BAR; PG8_SCHED;
            PG8_LDA(At, 0, 1); PG8_STAGE(PG8_SB(0, 0), b2, voffB); PG8_STAGE(PG8_SB(0, 1), b2 + hstep, voffB); PG8_STAGE(PG8_SA(0, 0), a2, voffA);
            if (pre) PG8_WAIT_V(9); else PG8_WAIT_V(8); PG8_WAIT_L(0); PG8_BAR; PG8_MMA(1, 0, At, B0); PG8_MMA(1, 1, At, B1); PG8_BAR; PG8_SCHED;
            PG8_LDB(B0, 1, 0); PG8_LDB(B1, 1, 1); PG8_SCHED; PG8_LDA(At, 1, 0); PG8_STAGE(PG8_SA(0, 1), a2 + hstep, voffA);
            PG8_WAIT_V(8); PG8_WAIT_L(0); PG8_BAR; PG8_MMA(0, 0, At, B0); PG8_MMA(0, 1, At, B1); PG8_BAR; PG8_SCHED;
            PG8_LDA(At, 1, 1); PG8_STAGE(PG8_SB(1, 0), b3, voffB); PG8_STAGE(PG8_SB(1, 1), b3 + hstep, voffB); PG8_STAGE(PG8_SA(1, 0), a3, voffA);
            PG8_WAIT_V(8); PG8_WAIT_L(0); PG8_BAR; PG8_MMA(1, 0, At, B0); PG8_MMA(1, 1, At, B1); PG8_BAR; PG8_SCHED;
            } else {
            PG8_LDB(B0, 0, 0); PG8_SCHED; PG8_LDA(At, 0, 0); PG8_STAGE(PG8_SA(1, 1), a1 + hstep, voffA);
            PG8_WAIT_L(8); PG8_BAR; PG8_WAIT_L(0); PG8_MMA(0, 0, At, B0); PG8_BAR; PG8_SCHED;
            PG8_LDB(B1, 0, 1); PG8_STAGE(PG8_SB(0, 0), b2, voffB);
            PG8_BAR; PG8_WAIT_L(0); PG8_MMA(0, 1, At, B1); PG8_BAR;
            PG8_LDA(At, 0, 1); PG8_STAGE(PG8_SA(0, 0), a2, voffA);
            PG8_BAR; PG8_WAIT_L(0); PG8_MMA(1, 0, At, B0); PG8_BAR; PG8_SCHED;
            PG8_STAGE(PG8_SB(0, 1), b2 + hstep, voffB);
            PG8_WAIT_V(6); PG8_BAR; PG8_MMA(1, 1, At, B1); PG8_BAR;
            PG8_LDB(B0, 1, 0); PG8_SCHED; PG8_LDA(At, 1, 0); PG8_STAGE(PG8_SA(0, 1), a2 + hstep, voffA);
            PG8_WAIT_L(8); PG8_BAR; PG8_WAIT_L(0); PG8_MMA(0, 0, At, B0); PG8_BAR; PG8_SCHED;
            PG8_LDB(B1, 1, 1); PG8_STAGE(PG8_SB(1, 0), b3, voffB);
            PG8_BAR; PG8_WAIT_L(0); PG8_MMA(0, 1, At, B1); PG8_BAR;
            PG8_LDA(At, 1, 1); PG8_STAGE(PG8_SA(1, 0), a3, voffA);
            PG8_BAR; PG8_WAIT_L(0); PG8_MMA(1, 0, At, B0); PG8_BAR; PG8_SCHED;
            PG8_STAGE(PG8_SB(1, 1), b3 + hstep, voffB);
            PG8_WAIT_V(6); PG8_BAR; PG8_MMA(1, 1, At, B1); PG8_BAR;
            }
        }
        if constexpr (ALIGN_EPI) { if (wr == 0) PG8_BAR; }
        if constexpr (EpiTraits<Epi>::CHAIN) { E.chain(acc, cur, wr, wc, fr, fq); S.done(cur); } else
        if constexpr (!Epi::AFTER_DRAIN) { E(acc, cur, wr, wc, fr, fq); S.done(cur); }
        if (!has_next) break;
        bool zero_acc = true; if constexpr (EpiTraits<Epi>::CHAIN) zero_acc = E.last(cur);
        if (zero_acc) {
#pragma unroll
        for (int a = 0; a < 2; ++a)
#pragma unroll
            for (int b = 0; b < 2; ++b)
#pragma unroll
                for (int m = 0; m < 4; ++m)
#pragma unroll
                    for (int n = 0; n < 2; ++n) acc[a][b][m][n] = (acc_t){0, 0, 0, 0};
        }
        cur = nxt; cA = nA; cB = nB; ++ui;
        if constexpr (ALIGN_EPI) { if (wr == 1) PG8_BAR; }
    }
    PG8_WAIT_V(0);
    if constexpr (!ALIGN_EPI) { if (wr == 0) PG8_BAR; }
    PG8_BAR;
    if constexpr (Epi::AFTER_DRAIN) { E.fused(acc, cur, wr, wc, fr, fq, lds, wid, lane); S.done(cur); }
#undef PG8_SA
#undef PG8_SB
#undef PG8_STAGE
#undef PG8_LDA
#undef PG8_LDB
#undef PG8_MMA
#undef PG8_WAIT_V
#undef PG8_WAIT_L
#undef PG8_BAR
#undef PG8_SCHED
}
}
namespace pg8 {
constexpr float kLog2e = 1.4426950408889634f;
__device__ __forceinline__ float fsigmoid(float x) { return __builtin_amdgcn_rcpf(1.f + __builtin_amdgcn_exp2f(-kLog2e * x)); }
__device__ __forceinline__ u32x4 pack8(const f32x4& a, const f32x4& b) { u32x4 w; w.x = cvt_pk_bf16(a[0], a[1]); w.y = cvt_pk_bf16(a[2], a[3]); w.z = cvt_pk_bf16(b[0], b[1]); w.w = cvt_pk_bf16(b[2], b[3]); return w; }
constexpr float kActScale = 8.f;
__device__ __forceinline__ unsigned cvt4_f8(float a, float b, float c, float d) {
    a = fminf(fmaxf(a, -448.f), 448.f); b = fminf(fmaxf(b, -448.f), 448.f); c = fminf(fmaxf(c, -448.f), 448.f); d = fminf(fmaxf(d, -448.f), 448.f);
    unsigned w = 0; w = __builtin_amdgcn_cvt_pk_fp8_f32(a, b, w, false); w = __builtin_amdgcn_cvt_pk_fp8_f32(c, d, w, true); return w; }
__device__ __forceinline__ void unpack8(const u32x4& w, f32x4& a, f32x4& b) {
    a[0] = __builtin_bit_cast(float, w.x << 16); a[1] = __builtin_bit_cast(float, w.x & 0xffff0000u); a[2] = __builtin_bit_cast(float, w.y << 16); a[3] = __builtin_bit_cast(float, w.y & 0xffff0000u);
    b[0] = __builtin_bit_cast(float, w.z << 16); b[1] = __builtin_bit_cast(float, w.z & 0xffff0000u); b[2] = __builtin_bit_cast(float, w.w << 16); b[3] = __builtin_bit_cast(float, w.w & 0xffff0000u);
}
__device__ __forceinline__ float row_rstd(const float* ssq, int row) {
    const f32x4* p = (const f32x4*)(ssq + (size_t)row * 16); const f32x4 a = p[0], b = p[1], c = p[2], d = p[3];
    const float s = ((a[0] + a[1]) + (a[2] + a[3])) + ((b[0] + b[1]) + (b[2] + b[3])) + ((c[0] + c[1]) + (c[2] + c[3])) + ((d[0] + d[1]) + (d[2] + d[3]));
    return __builtin_amdgcn_rsqf(s * (1.f / 1024.f) + 1e-6f);
}
__device__ __forceinline__ float sumsq8(const f32x4& a, const f32x4& b) { return (a[0] * a[0] + a[1] * a[1]) + (a[2] * a[2] + a[3] * a[3]) + (b[0] * b[0] + b[1] * b[1]) + (b[2] * b[2] + b[3] * b[3]); }
__device__ __forceinline__ float quad_sum_fq(float s) { s += __shfl_xor(s, 16); s += __shfl_xor(s, 32); return s; }

struct EpiRes {
    static constexpr bool PERM = true, AFTER_DRAIN = false, I8 = false;
    bf16_t* XB; float* ssq;
    __device__ __forceinline__ void operator()(const f32x4 (&acc)[2][2][4][2], const Unit& u, int wr, int wc, int fr, int fq) const {
        const int row0 = u.pm * BM + wr * 64 + fr, col0 = u.pn * BM + wc * 32 + 8 * fq;
        bf16_t* const xb0 = XB + (size_t)row0 * 1024 + col0;
        u32x4 xin[2][4][2];
#pragma unroll
        for (int ai = 0; ai < 2; ++ai)
#pragma unroll
            for (int m = 0; m < 4; ++m)
#pragma unroll
                for (int bj = 0; bj < 2; ++bj) xin[ai][m][bj] = *(const u32x4*)(xb0 + (size_t)(ai * HALF + m * 16) * 1024 + bj * HALF);
#pragma unroll
        for (int ai = 0; ai < 2; ++ai)
#pragma unroll
            for (int m = 0; m < 4; ++m) { const size_t row = (size_t)(row0 + ai * HALF + m * 16); float s = 0.f;
#pragma unroll
                for (int bj = 0; bj < 2; ++bj) { f32x4 x0, x1; unpack8(xin[ai][m][bj], x0, x1);
                    const f32x4 v0 = x0 + acc[ai][bj][m][0], v1 = x1 + acc[ai][bj][m][1];
                    *(u32x4*)(xb0 + (size_t)(ai * HALF + m * 16) * 1024 + bj * HALF) = pack8(v0, v1); s += sumsq8(v0, v1); }
                s = quad_sum_fq(s); if (fq == 0) ssq[row * 16 + u.pn * 4 + wc] = s; }
    }
};
struct EpiResF8 {
    static constexpr bool PERM = true, AFTER_DRAIN = false, I8 = false;
    bf16_t* XB; float* ssq; float qs;
    __device__ __forceinline__ void operator()(const f32x4 (&acc)[2][2][4][2], const Unit& u, int wr, int wc, int fr, int fq) const {
        const int row0 = u.pm * BM + wr * 64 + fr, col0 = u.pn * BM + wc * 32 + 8 * fq;
        bf16_t* const xb0 = XB + (size_t)row0 * 1024 + col0;
        u32x4 xin[2][4][2];
#pragma unroll
        for (int ai = 0; ai < 2; ++ai)
#pragma unroll
            for (int m = 0; m < 4; ++m)
#pragma unroll
                for (int bj = 0; bj < 2; ++bj) xin[ai][m][bj] = *(const u32x4*)(xb0 + (size_t)(ai * HALF + m * 16) * 1024 + bj * HALF);
#pragma unroll
        for (int ai = 0; ai < 2; ++ai)
#pragma unroll
            for (int m = 0; m < 4; ++m) { const size_t row = (size_t)(row0 + ai * HALF + m * 16); float s = 0.f;
#pragma unroll
                for (int bj = 0; bj < 2; ++bj) { f32x4 x0, x1; unpack8(xin[ai][m][bj], x0, x1);
                    const f32x4 v0 = x0 + acc[ai][bj][m][0] * qs, v1 = x1 + acc[ai][bj][m][1] * qs;
                    *(u32x4*)(xb0 + (size_t)(ai * HALF + m * 16) * 1024 + bj * HALF) = pack8(v0, v1); s += sumsq8(v0, v1); }
                s = quad_sum_fq(s); if (fq == 0) ssq[row * 16 + u.pn * 4 + wc] = s; }
    }
};
template <> struct EpiTraits<EpiResF8> { static constexpr bool CHAIN = false, F8 = true, PRE = false; };
template <bool LAST> struct EpiPle {
    static constexpr bool PERM = true, AFTER_DRAIN = false, I8 = false;
    float* OUT; bf16_t* XB; const float* ssq_in; float* ssq_out; const bf16_t* PP;
    __device__ __forceinline__ void operator()(const f32x4 (&acc)[2][2][4][2], const Unit& u, int wr, int wc, int fr, int fq) const {
        const int row0 = u.pm * BM + wr * 64 + fr, col0 = u.pn * BM + wc * 32 + 8 * fq;
        bf16_t* const xb0 = XB + (size_t)row0 * 1024 + col0; const bf16_t* const pp0 = PP + (size_t)row0 * 1024 + col0;
        float rs[2][4];
        { f32x4 sq[2][4];
#pragma unroll
          for (int ai = 0; ai < 2; ++ai)
#pragma unroll
              for (int m = 0; m < 4; ++m) sq[ai][m] = *(const f32x4*)(ssq_in + (size_t)(row0 + ai * HALF + m * 16) * 16 + 4 * fq);
#pragma unroll
          for (int ai = 0; ai < 2; ++ai)
#pragma unroll
              for (int m = 0; m < 4; ++m) rs[ai][m] = __builtin_amdgcn_rsqf(quad_sum_fq((sq[ai][m][0] + sq[ai][m][1]) + (sq[ai][m][2] + sq[ai][m][3])) * (1.f / 1024.f) + 1e-6f); }
        constexpr int MB = 2;
#pragma unroll
        for (int ai = 0; ai < 2; ++ai)
#pragma unroll
          for (int mb = 0; mb < 4; mb += MB) {
            u32x4 xin[MB][2], pin[MB][2];
#pragma unroll
            for (int mm = 0; mm < MB; ++mm)
#pragma unroll
                for (int bj = 0; bj < 2; ++bj) { xin[mm][bj] = *(const u32x4*)(xb0 + (size_t)(ai * HALF + (mb + mm) * 16) * 1024 + bj * HALF); pin[mm][bj] = *(const u32x4*)(pp0 + (size_t)(ai * HALF + (mb + mm) * 16) * 1024 + bj * HALF); }
#pragma unroll
            for (int mm = 0; mm < MB; ++mm) { const int m = mb + mm; const size_t row = (size_t)(row0 + ai * HALF + m * 16); const float r = rs[ai][m]; float s = 0.f;
#pragma unroll
                for (int bj = 0; bj < 2; ++bj) { f32x4 x0, x1; unpack8(xin[mm][bj], x0, x1);
                    f32x4 p0, p1; unpack8(pin[mm][bj], p0, p1);
                    f32x4 v0 = acc[ai][bj][m][0] * r, v1 = acc[ai][bj][m][1] * r;
#pragma unroll
                    for (int j = 0; j < 4; ++j) { v0[j] = fsigmoid(v0[j]) * p0[j]; v1[j] = fsigmoid(v1[j]) * p1[j]; }
                    v0 = v0 + x0; v1 = v1 + x1;
                    if (LAST) { float* op = OUT + row * 1024 + col0 + bj * HALF; *(f32x4*)op = v0; *(f32x4*)(op + 4) = v1; }
                    else { *(u32x4*)(xb0 + (size_t)(ai * HALF + m * 16) * 1024 + bj * HALF) = pack8(v0, v1); s += sumsq8(v0, v1); } }
                if (!LAST) { s = quad_sum_fq(s); if (fq == 0) ssq_out[row * 16 + u.pn * 4 + wc] = s; } }
          }
    }
};
struct EpiDownMoe {
    static constexpr bool PERM = true, AFTER_DRAIN = false, I8 = false;
    bf16_t* Y; bf16_t* Yx; int klen; float dq0, dq1, dq2, dq3, dq4, dq5, dq6, dq7;
    __device__ __forceinline__ void operator()(const f32x4 (&acc)[2][2][4][2], const Unit& u, int wr, int wc, int fr, int fq) const {
        bf16_t* Y = this->Y; if (u.ko) { const int s = u.ko / klen; Y = Yx + ((size_t)(s - 1) * 2048 - 32768) * 1024; }
        const int row0 = u.pm * BM + wr * 64 + fr, col0 = (u.pn & 3) * BM + wc * 32 + 8 * fq; const int ex = u.pn >> 2; const float qs = ex == 0 ? dq0 : ex == 1 ? dq1 : ex == 2 ? dq2 : ex == 3 ? dq3 : ex == 4 ? dq4 : ex == 5 ? dq5 : ex == 6 ? dq6 : dq7;
#pragma unroll
        for (int ai = 0; ai < 2; ++ai)
#pragma unroll
            for (int m = 0; m < 4; ++m) { bf16_t* rowp = Y + (size_t)(row0 + ai * HALF + m * 16) * 1024 + col0;
#pragma unroll
                for (int bj = 0; bj < 2; ++bj) *(u32x4*)(rowp + bj * HALF) = pack8(acc[ai][bj][m][0] * qs, acc[ai][bj][m][1] * qs); }
    }
};
template <> struct EpiTraits<EpiDownMoe> { static constexpr bool CHAIN = false, F8 = true, PRE = false; };
template <bool UP, int KSPLIT = 1, int KLEN = 0> struct MoeOrder {
    int R, nN, nwg, G, c; int ts0, ts1, ts2, ts3, ts4, ts5, ts6, ts7; int pm0;
    __device__ __forceinline__ bool next(int i, Unit& u) const {
        const long L = (long)i * G + c; if (L >= nwg) return false;
        const int ks = (int)(L % KSPLIT); u.ko = ks * KLEN;
        int wgid = (int)(L / KSPLIT); const int nwg = this->nwg / KSPLIT; { const int q = nwg / NXCD, r = nwg % NXCD, xcd = wgid % NXCD, off = wgid / NXCD; wgid = (xcd < r ? xcd * (q + 1) : r * (q + 1) + (xcd - r) * q) + off; }
        const int nig = WGM * nN, gid = wgid / nig, fm = gid * WGM, gsz = (R - fm) < WGM ? (R - fm) : WGM;
        const int pmc = pm0 + fm + ((wgid % nig) % gsz), pnl = (wgid % nig) / gsz;
        const int e = (pmc >= ts1) + (pmc >= ts2) + (pmc >= ts3) + (pmc >= ts4) + (pmc >= ts5) + (pmc >= ts6) + (pmc >= ts7);
        const int tse = e == 0 ? ts0 : e == 1 ? ts1 : e == 2 ? ts2 : e == 3 ? ts3 : e == 4 ? ts4 : e == 5 ? ts5 : e == 6 ? ts6 : ts7;
        if (UP) { u.pm = e * 64 + (pmc - tse); u.pn = e * 28 + pnl; } else { u.pm = pmc; u.pn = e * 4 + pnl; }
        return true;
    }
    __device__ __forceinline__ void a_ready(const Unit&) const {}
    __device__ __forceinline__ void done(const Unit&) const {}
};
struct EpiZs {
    static constexpr bool PERM = true, AFTER_DRAIN = false, I8 = false;
    bf16_t* ZB; const unsigned char* G8;
    __device__ __forceinline__ bool last(const Unit& u) const { return (u.pm >> 6) == 2; }
    __device__ __forceinline__ void operator()(const f32x4 (&acc)[2][2][4][2], const Unit& u, int wr, int wc, int fr, int fq) const {}
    __device__ __forceinline__ void chain(f32x4 (&acc)[2][2][4][2], const Unit& u, int wr, int wc, int fr, int fq) const {
        typedef unsigned u32x2 __attribute__((ext_vector_type(2)));
        const int r = u.pm >> 6, pm = u.pm & 63, pn = u.pn & 3;
        const int row0 = pm * BM + wr * 64 + fr, col0 = pn * BM + wc * 32 + 8 * fq;
        const unsigned char* const g0p = G8 + (size_t)row0 * 3072 + r * 1024 + col0;
        if (r < 2) {
#pragma unroll
            for (int ai = 0; ai < 2; ++ai) {
                u32x2 ga[4][2], gb[4][2];
#pragma unroll
                for (int m = 0; m < 4; ++m)
#pragma unroll
                    for (int bj = 0; bj < 2; ++bj) { const unsigned char* p = g0p + (size_t)(ai * HALF + m * 16) * 3072 + bj * HALF; ga[m][bj] = *(const u32x2*)p; gb[m][bj] = *(const u32x2*)(p + 1024); }
#pragma unroll
                for (int m = 0; m < 4; ++m)
#pragma unroll
                    for (int bj = 0; bj < 2; ++bj)
#pragma unroll
                        for (int j = 0; j < 4; ++j) {
                            acc[ai][bj][m][0][j] *= (float)((ga[m][bj].x >> (8 * j)) & 0xffu) * __builtin_amdgcn_rcpf((float)((gb[m][bj].x >> (8 * j)) & 0xffu));
                            acc[ai][bj][m][1][j] *= (float)((ga[m][bj].y >> (8 * j)) & 0xffu) * __builtin_amdgcn_rcpf((float)((gb[m][bj].y >> (8 * j)) & 0xffu)); }
            }
        } else {
            bf16_t* const zb0 = ZB + (size_t)row0 * 1024 + col0;
            u32x2 gw[2][4][2];
#pragma unroll
            for (int ai = 0; ai < 2; ++ai)
#pragma unroll
                for (int m = 0; m < 4; ++m)
#pragma unroll
                    for (int bj = 0; bj < 2; ++bj) gw[ai][m][bj] = *(const u32x2*)(g0p + (size_t)(ai * HALF + m * 16) * 3072 + bj * HALF);
#pragma unroll
            for (int ai = 0; ai < 2; ++ai)
#pragma unroll
                for (int m = 0; m < 4; ++m)
#pragma unroll
                    for (int bj = 0; bj < 2; ++bj) { const u32x2 g = gw[ai][m][bj]; f32x4 g0, g1;
#pragma unroll
                        for (int j = 0; j < 4; ++j) { g0[j] = (float)((g.x >> (8 * j)) & 0xffu) * (1.f / 255.f); g1[j] = (float)((g.y >> (8 * j)) & 0xffu) * (1.f / 255.f); }
                        *(u32x4*)(zb0 + (size_t)(ai * HALF + m * 16) * 1024 + bj * HALF) = pack8(acc[ai][bj][m][0] * g0, acc[ai][bj][m][1] * g1); }
        }
    }
};
template <> struct EpiTraits<EpiZs> { static constexpr bool CHAIN = true, F8 = false, PRE = false; };
struct MergeOrder {
    StaticOrder S;
    __device__ __forceinline__ bool next(int i, Unit& u) const { const int t = i / 3, r = i - 3 * t; if (!S.next(t, u)) return false; u.pm += r * 64; u.pn += r * 4; return true; }
    __device__ __forceinline__ void a_ready(const Unit&) const {}
    __device__ __forceinline__ void done(const Unit&) const {}
};
struct PpOrder {
    int c, G;
    __device__ __forceinline__ bool next(int i, Unit& u) const {
        int idx;
        if (G != 256) { const long L = (long)i * G + c; if (L >= 512) return false; idx = (int)L; }
        else if (c >= 128) { if (i >= 3) return false; idx = i < 2 ? (c - 128) * 2 + i : 256 + c; }
        else { if (i >= 1) return false; idx = 256 + c; }
        u.pm = idx >> 2; u.pn = (idx & 3) + (u.pm >> 6) * 4; u.ko = 0; return true; }
    __device__ __forceinline__ void a_ready(const Unit&) const {}
    __device__ __forceinline__ void done(const Unit&) const {}
};
struct EpiPP {
    static constexpr bool PERM = true, AFTER_DRAIN = false, I8 = false;
    bf16_t* Y;
    __device__ __forceinline__ void operator()(const f32x4 (&acc)[2][2][4][2], const Unit& u, int wr, int wc, int fr, int fq) const {
        const int row0 = u.pm * BM + wr * 64 + fr, col0 = (u.pn & 3) * BM + wc * 32 + 8 * fq;
#pragma unroll
        for (int ai = 0; ai < 2; ++ai)
#pragma unroll
            for (int m = 0; m < 4; ++m) { bf16_t* rowp = Y + (size_t)(row0 + ai * HALF + m * 16) * 1024 + col0;
#pragma unroll
                for (int bj = 0; bj < 2; ++bj) *(u32x4*)(rowp + bj * HALF) = pack8(acc[ai][bj][m][0], acc[ai][bj][m][1]); }
    }
};
struct EpiUp8 {
    static constexpr bool PERM = true, AFTER_DRAIN = false, I8 = true;
    const PG8_LAS float* P; unsigned char* ACT; const float* rs; const float* sb; int ts0, ts1, ts2, ts3, ts4, ts5, ts6, ts7;
    __device__ __forceinline__ const float* pre_ptr(const Unit& u, int tid) const { return tid < 256 ? rs + (size_t)u.pm * BM + tid : sb + (size_t)u.pn * 256 + (tid - 256); }
    __device__ __forceinline__ void operator()(const i32x4 (&acc)[2][2][4][2], const Unit& u, int wr, int wc, int fr, int fq) const {
        typedef unsigned u32x2 __attribute__((ext_vector_type(2)));
        const int e = u.pm >> 6, rt = u.pm & 63, pnl = u.pn - e * 28;
        const int tse = e == 0 ? ts0 : e == 1 ? ts1 : e == 2 ? ts2 : e == 3 ? ts3 : e == 4 ? ts4 : e == 5 ? ts5 : e == 6 ? ts6 : ts7, otile = tse + rt;
        const int lrow0 = wr * 64 + fr, col0 = pnl * 128 + wc * 32 + 8 * fq;
        const PG8_LAS float* sbp = P + 256 + wc * 32 + 8 * fq;
        const f32x4 sg0 = *(const PG8_LAS f32x4*)sbp, sg1 = *(const PG8_LAS f32x4*)(sbp + 4), su0 = *(const PG8_LAS f32x4*)(sbp + 128), su1 = *(const PG8_LAS f32x4*)(sbp + 132);
        float rr[2][4];
#pragma unroll
        for (int ai = 0; ai < 2; ++ai)
#pragma unroll
            for (int m = 0; m < 4; ++m) rr[ai][m] = P[lrow0 + ai * HALF + m * 16];
#pragma unroll
        for (int ai = 0; ai < 2; ++ai)
#pragma unroll
            for (int m = 0; m < 4; ++m) { const int lrow = lrow0 + ai * HALF + m * 16;
                const float r = rr[ai][m];
                const f32x4 rg0 = sg0 * r, rg1 = sg1 * r, ru0 = su0 * r, ru1 = su1 * r; f32x4 g0, g1, u0, u1;
#pragma unroll
                for (int j = 0; j < 4; ++j) { g0[j] = (float)acc[ai][0][m][0][j] * rg0[j]; g1[j] = (float)acc[ai][0][m][1][j] * rg1[j]; u0[j] = (float)acc[ai][1][m][0][j] * ru0[j]; u1[j] = (float)acc[ai][1][m][1][j] * ru1[j]; }
#pragma unroll
                for (int j = 0; j < 4; ++j) { g0[j] = g0[j] * fsigmoid(g0[j]) * u0[j] * kActScale; g1[j] = g1[j] * fsigmoid(g1[j]) * u1[j] * kActScale; }
                *(u32x2*)(ACT + (size_t)(otile * BM + lrow) * 3584 + col0) = (u32x2){cvt4_f8(g0[0], g0[1], g0[2], g0[3]), cvt4_f8(g1[0], g1[1], g1[2], g1[3])}; }
    }
};
template <> struct EpiTraits<EpiUp8> { static constexpr bool CHAIN = false, F8 = false, PRE = true; };
struct EpiProj8 {
    static constexpr bool PERM = true, AFTER_DRAIN = false, I8 = true;
    const PG8_LAS float* P; bf16_t* O; const float* rs1; const float* sb; bf16_t* AQ; bf16_t* AK; const float* q_gain; const float* k_gain; unsigned char* G8;
    __device__ __forceinline__ const float* pre_ptr(const Unit& u, int tid) const { return tid < 256 ? rs1 + (size_t)u.pm * BM + tid : sb + (size_t)u.pn * 256 + (tid - 256); }
    __device__ __forceinline__ void operator()(const i32x4 (&acc)[2][2][4][2], const Unit& u, int wr, int wc, int fr, int fq) const {
        const bool sg = (u.pn == 6) || (u.pn == 7);
        const bool mg = u.pn >= 16;
        const bool qk = (u.pn >= 8) && (u.pn < 12);
        const int row0 = u.pm * BM + wr * 64 + fr, col0 = u.pn * BM + wc * 32 + 8 * fq;
        f32x4 s0[2], s1[2];
#pragma unroll
        for (int bj = 0; bj < 2; ++bj) { s0[bj] = *(const PG8_LAS f32x4*)(P + 256 + wc * 32 + 8 * fq + bj * HALF); s1[bj] = *(const PG8_LAS f32x4*)(P + 256 + wc * 32 + 8 * fq + bj * HALF + 4); }
        float rr[2][4];
#pragma unroll
        for (int ai = 0; ai < 2; ++ai)
#pragma unroll
            for (int m = 0; m < 4; ++m) rr[ai][m] = P[wr * 64 + fr + ai * HALF + m * 16];
        if (qk) {
            const bool isk = u.pn >= 10; const int gidx = (u.pn - (isk ? 10 : 8)) * 4 + wc;
            const float* gp = (isk ? k_gain : q_gain) + 8 * fq; const float qs = isk ? 1.f : 0.125f * kLog2e;
            f32x4 gn[2][2];
#pragma unroll
            for (int bj = 0; bj < 2; ++bj) { gn[bj][0] = *(const f32x4*)(gp + bj * 32) * qs; gn[bj][1] = *(const f32x4*)(gp + bj * 32 + 4) * qs; }
            bf16_t* Ob = (isk ? AK : AQ) + gidx * 64 + 8 * fq;
#pragma unroll
            for (int ai = 0; ai < 2; ++ai)
#pragma unroll
                for (int m = 0; m < 4; ++m) { const int row = row0 + ai * HALF + m * 16; const float r = rr[ai][m]; const f32x4 r0[2] = {s0[0] * r, s0[1] * r}, r1[2] = {s1[0] * r, s1[1] * r}; f32x4 v[2][2]; float ss = 0.f;
#pragma unroll
                    for (int bj = 0; bj < 2; ++bj) {
#pragma unroll
                        for (int j = 0; j < 4; ++j) { v[bj][0][j] = (float)acc[ai][bj][m][0][j] * (r0[bj][j]); v[bj][1][j] = (float)acc[ai][bj][m][1][j] * (r1[bj][j]); }
                        ss += sumsq8(v[bj][0], v[bj][1]); }
                    ss = quad_sum_fq(ss); const float rn = __builtin_amdgcn_rsqf(ss * (1.f / 64.f) + 1e-6f);
#pragma unroll
                    for (int bj = 0; bj < 2; ++bj) *(u32x4*)(Ob + (size_t)row * 512 + bj * 32) = pack8(v[bj][0] * gn[bj][0] * rn, v[bj][1] * gn[bj][1] * rn); }
            return;
        }
        if (mg) {
            typedef unsigned u32x2 __attribute__((ext_vector_type(2)));
#pragma unroll
            for (int ai = 0; ai < 2; ++ai)
#pragma unroll
                for (int m = 0; m < 4; ++m) { const int row = row0 + ai * HALF + m * 16; const float r = rr[ai][m]; unsigned char* gp = G8 + (size_t)row * 3072 + (col0 - 4096);
#pragma unroll
                    for (int bj = 0; bj < 2; ++bj) { unsigned w[2];
#pragma unroll
                        for (int n = 0; n < 2; ++n) { const f32x4 s = (n ? s1[bj] : s0[bj]) * r; unsigned pk = 0;
#pragma unroll
                            for (int j = 0; j < 4; ++j) { const float g = fsigmoid((float)acc[ai][bj][m][n][j] * s[j]); pk |= (unsigned)fmaxf(__builtin_rintf(g * 255.f), 1.f) << (8 * j); }
                            w[n] = pk; }
                        *(u32x2*)(gp + bj * HALF) = (u32x2){w[0], w[1]}; } }
            return;
        }
#pragma unroll
        for (int ai = 0; ai < 2; ++ai)
#pragma unroll
            for (int m = 0; m < 4; ++m) { const int row = row0 + ai * HALF + m * 16; const float r = rr[ai][m]; bf16_t* rowp = O + (size_t)row * 7168 + col0;
#pragma unroll
                for (int bj = 0; bj < 2; ++bj) { f32x4 v0, v1; const f32x4 q0 = s0[bj] * r, q1 = s1[bj] * r;
#pragma unroll
                    for (int j = 0; j < 4; ++j) { v0[j] = (float)acc[ai][bj][m][0][j] * q0[j]; v1[j] = (float)acc[ai][bj][m][1][j] * q1[j]; }
                    if (sg) {
#pragma unroll
                        for (int j = 0; j < 4; ++j) { v0[j] = fsigmoid(v0[j]); v1[j] = fsigmoid(v1[j]); } }
                    *(u32x4*)(rowp + bj * HALF) = pack8(v0, v1); } }
    }
};
template <> struct EpiTraits<EpiProj8> { static constexpr bool CHAIN = false, F8 = false, PRE = true; };
struct EpiUp8d {
    static constexpr bool PERM = true, AFTER_DRAIN = false, I8 = true;
    const PG8_LAS float* P; unsigned char* ACT; const float* rs1; const float* sb;
    __device__ __forceinline__ const float* pre_ptr(const Unit& u, int tid) const { return tid < 256 ? rs1 + (size_t)u.pm * BM + tid : sb + (size_t)u.pn * 256 + (tid - 256); }
    __device__ __forceinline__ void operator()(const i32x4 (&acc)[2][2][4][2], const Unit& u, int wr, int wc, int fr, int fq) const {
        typedef unsigned u32x2 __attribute__((ext_vector_type(2)));
        const int row0 = u.pm * BM + wr * 64 + fr, col0 = u.pn * 128 + wc * 32 + 8 * fq;
        const PG8_LAS float* sbp = P + 256 + wc * 32 + 8 * fq;
        const f32x4 sg0 = *(const PG8_LAS f32x4*)sbp, sg1 = *(const PG8_LAS f32x4*)(sbp + 4), su0 = *(const PG8_LAS f32x4*)(sbp + 128), su1 = *(const PG8_LAS f32x4*)(sbp + 132);
        float rr[2][4];
#pragma unroll
        for (int ai = 0; ai < 2; ++ai)
#pragma unroll
            for (int m = 0; m < 4; ++m) rr[ai][m] = P[wr * 64 + fr + ai * HALF + m * 16];
#pragma unroll
        for (int ai = 0; ai < 2; ++ai)
#pragma unroll
            for (int m = 0; m < 4; ++m) { const int row = row0 + ai * HALF + m * 16; const float r = rr[ai][m];
                const f32x4 rg0 = sg0 * r, rg1 = sg1 * r, ru0 = su0 * r, ru1 = su1 * r; f32x4 g0, g1, u0, u1;
#pragma unroll
                for (int j = 0; j < 4; ++j) { g0[j] = (float)acc[ai][0][m][0][j] * rg0[j]; g1[j] = (float)acc[ai][0][m][1][j] * rg1[j]; u0[j] = (float)acc[ai][1][m][0][j] * ru0[j]; u1[j] = (float)acc[ai][1][m][1][j] * ru1[j]; }
#pragma unroll
                for (int j = 0; j < 4; ++j) { g0[j] = g0[j] * fsigmoid(g0[j]) * u0[j] * kActScale; g1[j] = g1[j] * fsigmoid(g1[j]) * u1[j] * kActScale; }
                *(u32x2*)(ACT + (size_t)row * 2816 + col0) = (u32x2){cvt4_f8(g0[0], g0[1], g0[2], g0[3]), cvt4_f8(g1[0], g1[1], g1[2], g1[3])}; }
    }
};
template <> struct EpiTraits<EpiUp8d> { static constexpr bool CHAIN = false, F8 = false, PRE = true; };
}
namespace mix {
using bf16x8 = __attribute__((ext_vector_type(8))) short;
using s16x4  = __attribute__((ext_vector_type(4))) short;
using f32x16 = __attribute__((ext_vector_type(16))) float;
using f32x4  = __attribute__((ext_vector_type(4))) float;
using u32x4  = __attribute__((ext_vector_type(4))) unsigned;
typedef unsigned short bf16_t;
constexpr int KVB = 64, SHM_T = KVB * 128 * 2;
constexpr int OFF_V = 0, OFF_K = 2 * SHM_T, OFF_WS = 4 * SHM_T, OFF_A2 = OFF_WS + 8 * 256, OFF_M2 = OFF_A2 + 8192, OFF_MT = OFF_M2 + 8192, OFF_SC = OFF_MT + 8192, OFF_Q = OFF_SC + 256, MIX_LDS = OFF_Q + 64;
constexpr float kLog2e = 1.4426950408889634f;
#define KSWZ(row, colB) ((row) * 256 + ((colB) ^ (((row) & 7) << 4)))
#define SBAR() __builtin_amdgcn_sched_barrier(0)
__device__ __forceinline__ int crow(int r, int hi) { return (r & 3) + 8 * (r >> 2) + 4 * hi; }
__device__ __forceinline__ unsigned cvtpk(float lo, float hi) { unsigned r; asm volatile("v_cvt_pk_bf16_f32 %0, %1, %2" : "=v"(r) : "v"(lo), "v"(hi)); return r; }
__device__ __forceinline__ float bf2f(unsigned short h) { return __builtin_bit_cast(float, (unsigned)h << 16); }
__device__ __forceinline__ int v_st(int k, int c) { const int kk = (k & ~0xC) | ((k & 4) << 1) | ((k & 8) >> 1); return ((kk >> 3) * 4 + (c >> 5)) * 512 + ((kk & 7) * 32 + (c & 31)) * 2; }
__device__ __forceinline__ int v_rd_base(int lane) { return ((lane & 3) << 3) | (((lane >> 2) & 3) << 6) | (((lane >> 4) & 1) << 5) | (((lane >> 5) & 1) << 8); }
constexpr int v_rd_off(int d0, int ks, int half) { return d0 * 512 + ks * 4096 + half * 2048; }
template <int OFF> __device__ __forceinline__ s16x4 tr_read(int vb) { s16x4 r; asm volatile("ds_read_b64_tr_b16 %0, %1 offset:%2" : "=&v"(r) : "v"(vb), "i"(OFF) : "memory"); return r; }
template <int D0> __device__ __forceinline__ void pv_one(f32x16& od, int vb, bf16x8 pa0, bf16x8 pa1, bf16x8 pa2, bf16x8 pa3) {
    const s16x4 l0 = tr_read<v_rd_off(D0, 0, 0)>(vb), h0 = tr_read<v_rd_off(D0, 0, 1)>(vb), l1 = tr_read<v_rd_off(D0, 1, 0)>(vb), h1 = tr_read<v_rd_off(D0, 1, 1)>(vb);
    const s16x4 l2 = tr_read<v_rd_off(D0, 2, 0)>(vb), h2 = tr_read<v_rd_off(D0, 2, 1)>(vb), l3 = tr_read<v_rd_off(D0, 3, 0)>(vb), h3 = tr_read<v_rd_off(D0, 3, 1)>(vb);
    asm volatile("s_waitcnt lgkmcnt(0)" ::: "memory"); SBAR();
#define MIX_PK(L, H) (bf16x8){L[0], L[1], L[2], L[3], H[0], H[1], H[2], H[3]}
    od = __builtin_amdgcn_mfma_f32_32x32x16_bf16(pa0, MIX_PK(l0, h0), od, 0, 0, 0);
    od = __builtin_amdgcn_mfma_f32_32x32x16_bf16(pa1, MIX_PK(l1, h1), od, 0, 0, 0);
    od = __builtin_amdgcn_mfma_f32_32x32x16_bf16(pa2, MIX_PK(l2, h2), od, 0, 0, 0);
    od = __builtin_amdgcn_mfma_f32_32x32x16_bf16(pa3, MIX_PK(l3, h3), od, 0, 0, 0);
#undef MIX_PK
}
__device__ __forceinline__ void pv_d0(f32x16* o, int vb, bf16x8 pa0, bf16x8 pa1, bf16x8 pa2, bf16x8 pa3) {
    pv_one<0>(o[0], vb, pa0, pa1, pa2, pa3); pv_one<1>(o[1], vb, pa0, pa1, pa2, pa3); pv_one<2>(o[2], vb, pa0, pa1, pa2, pa3); pv_one<3>(o[3], vb, pa0, pa1, pa2, pa3);
}
__device__ __forceinline__ float swap_max(float v) { auto rr = __builtin_amdgcn_permlane32_swap(__float_as_uint(v), __float_as_uint(v), false, false); return fmaxf(__uint_as_float(rr[0]), __uint_as_float(rr[1])); }
__device__ __forceinline__ float swap_sum(float v) { auto rr = __builtin_amdgcn_permlane32_swap(__float_as_uint(v), __float_as_uint(v), false, false); return __uint_as_float(rr[0]) + __uint_as_float(rr[1]); }
__device__ __forceinline__ void p_to_frags(const f32x16& p0, const f32x16& p1, bf16x8& pa0, bf16x8& pa1, bf16x8& pa2, bf16x8& pa3) {
#define MIX_PK4(P, BASE, OUT) do { unsigned a0 = cvtpk(P[BASE + 0], P[BASE + 1]), a1 = cvtpk(P[BASE + 2], P[BASE + 3]);   \
    unsigned b0 = cvtpk(P[BASE + 4], P[BASE + 5]), b1 = cvtpk(P[BASE + 6], P[BASE + 7]);                              \
    auto r0 = __builtin_amdgcn_permlane32_swap(a0, b0, false, false); auto r1 = __builtin_amdgcn_permlane32_swap(a1, b1, false, false); \
    u32x4 w = {r0[0], r1[0], r0[1], r1[1]}; OUT = *reinterpret_cast<bf16x8*>(&w); } while (0)
    MIX_PK4(p0, 0, pa0); MIX_PK4(p0, 8, pa1); MIX_PK4(p1, 0, pa2); MIX_PK4(p1, 8, pa3);
#undef MIX_PK4
}
__device__ __forceinline__ float half_sum32(float v) {
#pragma unroll
    for (int o = 1; o < 32; o <<= 1) v += __shfl_xor(v, o);
    return v;
}
struct MixPtrs {
    const bf16_t* PROJ;
    const bf16_t *MQ, *MK, *AQ, *AK;
    const float* GATE;
    bf16_t *HM, *HA;
    const float *m_hgain, *a_hgain;
    const float* lamv;
};
template <int MODE>
__device__ __forceinline__ void unit(char* lds, const MixPtrs& P, int b, int h, int q0) {
    int tid_o = threadIdx.x; asm volatile("" : "+v"(tid_o));
    const int tid = tid_o, wid = __builtin_amdgcn_readfirstlane(tid >> 6), lane = tid & 63, r32 = lane & 31, hi = lane >> 5;
    constexpr int NQ = MODE == 0 ? 8 : 4;
    const int wq = MODE == 0 ? wid : (wid & 3), map = MODE == 0 ? 0 : (wid >> 2);
    const int qlo = q0 + 32 * wq, tq = qlo + r32;
    const size_t tok0 = (size_t)b * 2048;
    char* V_lds = lds + OFF_V; char* K_lds = lds + OFF_K;
    float* wsf = (float*)(lds + OFF_WS) + wid * 64; float* li_l = wsf; float* al_l = wsf + 32;
    float* A2 = (float*)(lds + OFF_A2); float* M2 = (float*)(lds + OFF_M2); float* MT = (float*)(lds + OFF_MT); float* SC = (float*)(lds + OFF_SC);
    const int NT = (q0 + (MODE == 0 ? 256 : 128)) / KVB;
    float M2row = 0.f, mtrow = 0.f;
    if (MODE == 0) {
        const int n = q0 + 256; const float* G = P.GATE + tok0 * 8;
        float lf[4], iv[4];
#pragma unroll
        for (int j = 0; j < 4; ++j) { const int t = 4 * tid + j; float f = 0.f, i = 0.f; if (t < n) { f = G[(size_t)t * 8 + 4 + h]; i = G[(size_t)t * 8 + h]; }
            lf[j] = fminf(f, 0.f) - 0.6931471805599453f * __builtin_amdgcn_logf(1.f + __builtin_amdgcn_exp2f(-kLog2e * fabsf(f))); iv[j] = i; }
        float s1 = lf[0], s2 = s1 + lf[1], s3 = s2 + lf[2], s4 = s3 + lf[3];
        float incl = s4;
#pragma unroll
        for (int o = 1; o < 64; o <<= 1) { const float t = __shfl_up(incl, o); if (lane >= o) incl += t; }
        if (lane == 63) SC[wid] = incl;
        __syncthreads();
        float wbase = 0.f;
#pragma unroll
        for (int w = 0; w < 8; ++w) { const float t = SC[w]; if (w < wid) wbase += t; }
        const float excl = wbase + incl - s4;
        const float B0 = excl + s1, B1 = excl + s2, B2 = excl + s3, B3 = excl + s4;
        const float a0 = iv[0] - B0, a1 = iv[1] - B1, a2 = iv[2] - B2, a3 = iv[3] - B3;
        const bool v0 = 4 * tid < n;
        const float NEG = -3.0e38f;
        const float m1 = v0 ? a0 : NEG, m2 = fmaxf(m1, v0 ? a1 : NEG), m3 = fmaxf(m2, v0 ? a2 : NEG), m4 = fmaxf(m3, v0 ? a3 : NEG);
        float mincl = m4;
#pragma unroll
        for (int o = 1; o < 64; o <<= 1) { const float t = __shfl_up(mincl, o); if (lane >= o) mincl = fmaxf(mincl, t); }
        float mprev = __shfl_up(mincl, 1); if (lane == 0) mprev = NEG;
        if (lane == 63) SC[8 + wid] = mincl;
        __syncthreads();
        float mbase = 0.f;
#pragma unroll
        for (int w = 0; w < 8; ++w) { const float t = SC[8 + w]; if (w < wid) mbase = fmaxf(mbase, t); }
        const float mex = fmaxf(mbase, mprev);
        const float x0 = fmaxf(mex, m1), x1 = fmaxf(mex, m2), x2 = fmaxf(mex, m3), x3 = fmaxf(mex, m4);
        if (v0) { *(f32x4*)(A2 + 4 * tid) = (f32x4){a0 * kLog2e, a1 * kLog2e, a2 * kLog2e, a3 * kLog2e};
                  *(f32x4*)(M2 + 4 * tid) = (f32x4){x0 * kLog2e, x1 * kLog2e, x2 * kLog2e, x3 * kLog2e};
                  *(f32x4*)(MT + 4 * tid) = (f32x4){B0 + x0, B1 + x1, B2 + x2, B3 + x3}; }
        __syncthreads();
        M2row = M2[tq]; mtrow = MT[tq];
    }
    bf16x8 qr[NQ];
    { const bf16_t* Qw = (MODE == 0 ? P.MQ : P.AQ) + (tok0 + tq) * 512 + h * 128 + map * 64 + hi * 8;
#pragma unroll
      for (int d0 = 0; d0 < NQ; ++d0) qr[d0] = *reinterpret_cast<const bf16x8*>(Qw + d0 * 16); }
    const bf16_t* Kg = (MODE == 0 ? P.MK : P.AK) + tok0 * 512 + h * 128;
    const bf16_t* Vg = P.PROJ + tok0 * 7168 + (MODE == 0 ? 1024 : 3072) + h * 128;
    const int sr = tid >> 4, sc = (tid & 15) * 8, vst0 = v_st(sr, sc), vst1 = v_st(32 + sr, sc);
    const int vb0 = (int)(uintptr_t)V_lds + v_rd_base(lane);
    bf16x8 vsA0, vsA1, ksA0, ksA1;
#define MIX_SLOAD(S, k0) do { vs##S##0 = *reinterpret_cast<const bf16x8*>(Vg + (size_t)((k0) + sr) * 7168 + sc); vs##S##1 = *reinterpret_cast<const bf16x8*>(Vg + (size_t)((k0) + 32 + sr) * 7168 + sc); \
    ks##S##0 = *reinterpret_cast<const bf16x8*>(Kg + (size_t)((k0) + sr) * 512 + sc); ks##S##1 = *reinterpret_cast<const bf16x8*>(Kg + (size_t)((k0) + 32 + sr) * 512 + sc); } while (0)
#define MIX_SWRITE(S, bb) do { *(bf16x8*)(V_lds + (bb) * SHM_T + vst0) = vs##S##0; *(bf16x8*)(V_lds + (bb) * SHM_T + vst1) = vs##S##1; \
    *(bf16x8*)(K_lds + (bb) * SHM_T + KSWZ(sr, sc * 2)) = ks##S##0; *(bf16x8*)(K_lds + (bb) * SHM_T + KSWZ(32 + sr, sc * 2)) = ks##S##1; } while (0)
#define MIX_BAR() do { asm volatile("s_waitcnt lgkmcnt(0)" ::: "memory"); __builtin_amdgcn_s_barrier(); asm volatile("" ::: "memory"); } while (0)
    f32x16 o[4];
#pragma unroll
    for (int d = 0; d < 4; ++d)
#pragma unroll
        for (int r = 0; r < 16; ++r) o[d][r] = 0.f;
    float m_run = -1e30f, l_run = 0.f;
    const float sl2 = MODE == 1 ? __builtin_amdgcn_exp2f(-2.f * (float)(h + 1)) * kLog2e : 0.f;
    auto mix_compute = [&](int j, int k0) __attribute__((always_inline)) {
        if (k0 <= qlo + 31) {
            const char* Kt = K_lds + (j & 1) * SHM_T;
            f32x16 p0, p1;
            if (MODE == 1) { const float base = sl2 * (float)(k0 - tq);
#pragma unroll
                for (int r = 0; r < 16; ++r) { p0[r] = fmaf(sl2, (float)crow(r, hi), base); p1[r] = fmaf(sl2, (float)(32 + crow(r, hi)), base); } }
            else {
#pragma unroll
                for (int r = 0; r < 16; ++r) { p0[r] = 0.f; p1[r] = 0.f; } }
            bf16x8 kb0[NQ], kb1[NQ];
#define MIX_KLD(D0) do { const int cb_ = (map * 64 + (D0) * 16 + hi * 8) * 2; kb0[D0] = *reinterpret_cast<const bf16x8*>(Kt + KSWZ(r32, cb_)); kb1[D0] = *reinterpret_cast<const bf16x8*>(Kt + KSWZ(32 + r32, cb_)); } while (0)
            MIX_KLD(0); MIX_KLD(1); SBAR();
#pragma unroll
            for (int d0 = 0; d0 < NQ; ++d0) {
                if (d0 + 2 < NQ) MIX_KLD(d0 + 2);
                p0 = __builtin_amdgcn_mfma_f32_32x32x16_bf16(kb0[d0], qr[d0], p0, 0, 0, 0);
                p1 = __builtin_amdgcn_mfma_f32_32x32x16_bf16(kb1[d0], qr[d0], p1, 0, 0, 0); SBAR(); }
#undef MIX_KLD
            const bool diag = k0 + 63 > qlo;
            if (MODE == 1) {
                if (diag) {
                    int tqm = tq; asm volatile("" : "+v"(tqm));
#pragma unroll
                    for (int r = 0; r < 16; ++r) { if (k0 + crow(r, hi) > tqm) p0[r] = -1e30f; if (k0 + 32 + crow(r, hi) > tqm) p1[r] = -1e30f; } }
                float pmax = p0[0];
#pragma unroll
                for (int r = 1; r < 16; ++r) pmax = fmaxf(pmax, p0[r]);
#pragma unroll
                for (int r = 0; r < 16; ++r) pmax = fmaxf(pmax, p1[r]);
                pmax = swap_max(pmax);
                float mn = m_run, alpha = 1.f;
                if (!__all(pmax - m_run <= 8.f)) { mn = fmaxf(m_run, pmax); alpha = __builtin_amdgcn_exp2f(m_run - mn); m_run = mn; }
                float ps = 0.f;
#pragma unroll
                for (int r = 0; r < 16; ++r) { p0[r] = __builtin_amdgcn_exp2f(p0[r] - mn); p1[r] = __builtin_amdgcn_exp2f(p1[r] - mn); ps += p0[r] + p1[r]; }
                ps = swap_sum(ps); l_run = l_run * alpha + ps;
                if (__any(alpha < 1.f)) { if (hi == 0) al_l[r32] = alpha; asm volatile("s_waitcnt lgkmcnt(0)" ::: "memory");
#pragma unroll
                    for (int r = 0; r < 16; ++r) { const float a = al_l[crow(r, hi)];
#pragma unroll
                        for (int d = 0; d < 4; ++d) o[d][r] *= a; } }
            } else {
                float ps = 0.f;
                if (diag) {
#pragma unroll
                    for (int i = 0; i < 4; ++i) { const f32x4 aa = *(const f32x4*)(A2 + k0 + 8 * i + 4 * hi), ab = *(const f32x4*)(A2 + k0 + 32 + 8 * i + 4 * hi);
#pragma unroll
                        for (int q = 0; q < 4; ++q) { const int r = 4 * i + q;
                            float w0 = __builtin_amdgcn_exp2f(fminf(aa[q] - M2row, 0.f)), w1 = __builtin_amdgcn_exp2f(fminf(ab[q] - M2row, 0.f));
                            if (k0 + crow(r, hi) > tq) w0 = 0.f; if (k0 + 32 + crow(r, hi) > tq) w1 = 0.f;
                            p0[r] *= w0; p1[r] *= w1; ps += p0[r] + p1[r]; } }
                    asm volatile("" : "+v"(ps));
                } else {
#pragma unroll
                    for (int i = 0; i < 4; ++i) { const f32x4 aa = *(const f32x4*)(A2 + k0 + 8 * i + 4 * hi), ab = *(const f32x4*)(A2 + k0 + 32 + 8 * i + 4 * hi);
#pragma unroll
                        for (int q = 0; q < 4; ++q) { const int r = 4 * i + q;
                            p0[r] *= __builtin_amdgcn_exp2f(aa[q] - M2row); p1[r] *= __builtin_amdgcn_exp2f(ab[q] - M2row); ps += p0[r] + p1[r]; } }
                }
                ps = swap_sum(ps); l_run += ps;
            }
            bf16x8 pa0, pa1, pa2, pa3; p_to_frags(p0, p1, pa0, pa1, pa2, pa3);
            pv_d0(o, vb0 + (j & 1) * SHM_T, pa0, pa1, pa2, pa3);
        }
    };
    MIX_SLOAD(A, 0); MIX_SWRITE(A, 0);
#define MIX_TILE(SL, SW, JJ) do { const int j = (JJ); \
        MIX_BAR(); \
        const int k0 = j * KVB; \
        if (j + 1 < NT) MIX_SLOAD(SL, k0 + KVB); \
        mix_compute(j, k0); \
        if (j + 1 < NT) MIX_SWRITE(SW, (j + 1) & 1); } while (0)
    for (int jj = 0; jj < NT; ++jj) { MIX_TILE(A, A, jj); }
#undef MIX_TILE
    __syncthreads();
#undef MIX_SLOAD
#undef MIX_SWRITE
#undef MIX_BAR
    int lane_e = lane; asm volatile("" : "+v"(lane_e));
    const int r32e = lane_e & 31, hie = lane_e >> 5;
    float rowscale;
    if (MODE == 1) rowscale = 1.f / l_run; else rowscale = 1.f / fmaxf(fabsf(l_run), __expf(-mtrow));
    if (hie == 0) li_l[r32e] = rowscale;
    asm volatile("s_waitcnt lgkmcnt(0)" ::: "memory");
    float rs[16];
#pragma unroll
    for (int r = 0; r < 16; ++r) rs[r] = li_l[crow(r, hie)];
#pragma unroll
    for (int d = 0; d < 4; ++d)
#pragma unroll
        for (int r = 0; r < 16; ++r) o[d][r] *= rs[r];
    if (MODE == 1) {
        __syncthreads();
        float* EX = (float*)lds + (size_t)wq * 4096 + lane_e;
        if (map == 1) {
#pragma unroll
            for (int d = 0; d < 4; ++d)
#pragma unroll
                for (int r = 0; r < 16; ++r) EX[(d * 16 + r) * 64] = o[d][r]; }
        __syncthreads();
        if (map == 0) { const float lam_l = P.lamv[0];
#pragma unroll
            for (int d = 0; d < 4; ++d)
#pragma unroll
                for (int r = 0; r < 16; ++r) o[d][r] -= lam_l * EX[(d * 16 + r) * 64]; }
    }
    if (MODE == 0 || map == 0) {
        float rn[16];
#pragma unroll
        for (int r = 0; r < 16; ++r) { float s = 0.f;
#pragma unroll
            for (int d = 0; d < 4; ++d) s += o[d][r] * o[d][r];
            s = half_sum32(s); rn[r] = __builtin_amdgcn_rsqf(s * (1.f / 128.f) + 1e-6f); }
        const float* hg = (MODE == 0 ? P.m_hgain : P.a_hgain) + h * 128;
        bf16_t* Ob = (MODE == 0 ? P.HM : P.HA) + (tok0 + qlo) * 512 + h * 128;
        unsigned short og[4][16];
        if (MODE == 0) {
#pragma unroll
            for (int d = 0; d < 4; ++d)
#pragma unroll
                for (int r = 0; r < 16; ++r) og[d][r] = P.PROJ[(tok0 + qlo + crow(r, hie)) * 7168 + 1536 + h * 128 + 32 * d + r32e]; }
#pragma unroll
        for (int d = 0; d < 4; ++d) { const int col = 32 * d + r32e; const float g = hg[col] * (MODE == 1 ? P.lamv[1] : 1.f);
#pragma unroll
            for (int r = 0; r < 16; ++r) { const int row = crow(r, hie); float v = o[d][r] * rn[r] * g;
                if (MODE == 0) v *= bf2f(og[d][r]);
                Ob[(size_t)row * 512 + col] = (bf16_t)(cvtpk(v, v) & 0xffffu); } }
    }
    __syncthreads();
}
template <bool DO_M, bool DO_A> __device__ __forceinline__ void mix_phase(char* lds, const MixPtrs& P, unsigned* queue) {
    volatile int* qw = (volatile int*)(lds + OFF_Q);
    if (DO_M) for (;;) {
        if (threadIdx.x == 0) *qw = (int)__hip_atomic_fetch_add(queue, 1u, __ATOMIC_RELAXED, __HIP_MEMORY_SCOPE_AGENT);
        __syncthreads();
        const int item = __builtin_amdgcn_readfirstlane(*qw);
        __syncthreads();
        if (item >= 256) break;
        unit<0>(lds, P, (item & 31) >> 2, item & 3, 256 * (7 - (item >> 5)));
    }
    if (DO_A) for (;;) {
        if (threadIdx.x == 0) *qw = (int)__hip_atomic_fetch_add(queue + 32, 1u, __ATOMIC_RELAXED, __HIP_MEMORY_SCOPE_AGENT);
        __syncthreads();
        const int item = __builtin_amdgcn_readfirstlane(*qw);
        __syncthreads();
        if (item >= 512) break;
        unit<1>(lds, P, (item & 31) >> 2, item & 3, 128 * (15 - (item >> 5)));
    }
}
}
namespace thin {
using pg8::bf16_t; using pg8::f32x4; using pg8::u32x4; using pg8::bf16x8;
typedef __attribute__((address_space(3))) float lds_f32;
__device__ __forceinline__ unsigned f2bf(float f) { unsigned u = __builtin_bit_cast(unsigned, f); return (u + 0x7fffu + ((u >> 16) & 1u)) >> 16; }
__device__ __forceinline__ unsigned pk2(float lo, float hi) { return f2bf(lo) | (f2bf(hi) << 16); }
__device__ __forceinline__ float wave_sum(float v) {
#pragma unroll
    for (int o = 1; o < 64; o <<= 1) v += __shfl_xor(v, o);
    return v;
}
__device__ __forceinline__ unsigned pack4_i8(float a, float b, float c, float d) {
    const int ia = (int)__builtin_rintf(a), ib = (int)__builtin_rintf(b), ic = (int)__builtin_rintf(c), id = (int)__builtin_rintf(d);
    return (unsigned)(ia & 0xff) | ((unsigned)(ib & 0xff) << 8) | ((unsigned)(ic & 0xff) << 16) | ((unsigned)(id & 0xff) << 24);
}
__device__ __forceinline__ float wave_max(float v) {
#pragma unroll
    for (int o = 1; o < 64; o <<= 1) v = fmaxf(v, __shfl_xor(v, o));
    return v;
}
__device__ __forceinline__ u32x4 quant16(const f32x4& a0, const f32x4& a1, const f32x4& a2, const f32x4& a3, float inv) {
    u32x4 w; w.x = pack4_i8(a0[0] * inv, a0[1] * inv, a0[2] * inv, a0[3] * inv); w.y = pack4_i8(a1[0] * inv, a1[1] * inv, a1[2] * inv, a1[3] * inv);
    w.z = pack4_i8(a2[0] * inv, a2[1] * inv, a2[2] * inv, a2[3] * inv); w.w = pack4_i8(a3[0] * inv, a3[1] * inv, a3[2] * inv, a3[3] * inv); return w;
}
__device__ __forceinline__ float absmax16(const f32x4& a0, const f32x4& a1, const f32x4& a2, const f32x4& a3) {
    float m = 0.f;
#pragma unroll
    for (int j = 0; j < 4; ++j) m = fmaxf(fmaxf(m, fmaxf(fabsf(a0[j]), fabsf(a1[j]))), fmaxf(fabsf(a2[j]), fabsf(a3[j])));
    return m;
}
__device__ __forceinline__ float row_rstd_wave(const float* ssq, int row, int lane, int vz) {
    float v = lane < 16 ? ssq[(size_t)(row + vz) * 16 + lane] : 0.f;
#pragma unroll
    for (int o = 1; o < 16; o <<= 1) v += __shfl_xor(v, o);
    v = __shfl(v, 0);
    return __builtin_amdgcn_rsqf(v * (1.f / 1024.f) + 1e-6f);
}
struct TrItem { const float* W; const float* gain; bf16_t* WT; int ldw, K, F, map, n0, k0; int f8; float sc; };
__device__ __forceinline__ void tr_load(const TrItem& I, float (&v)[16][4], int lane, int wave) {
    const float* Wk = I.W + (size_t)(I.k0 + wave * 16) * I.ldw + I.n0 + 4 * lane;
#pragma unroll
    for (int r = 0; r < 16; ++r) { const f32x4 t = *(const f32x4*)(Wk + (size_t)r * I.ldw); v[r][0] = t[0]; v[r][1] = t[1]; v[r][2] = t[2]; v[r][3] = t[3]; }
}
__device__ __forceinline__ void tr_store(const TrItem& I, const float (&v)[16][4], char* lds, int lane, int wave) {
    if (I.f8) {
        unsigned char* img8 = (unsigned char*)lds; const float sc = I.sc;
#pragma unroll
        for (int r = 0; r < 16; r += 4)
#pragma unroll
            for (int j = 0; j < 4; ++j) *(unsigned*)(img8 + (4 * lane + j) * 132 + wave * 16 + r) = pg8::cvt4_f8(v[r][j] * sc, v[r + 1][j] * sc, v[r + 2][j] * sc, v[r + 3][j] * sc);
        __syncthreads();
        unsigned char* WT8 = (unsigned char*)I.WT;
#pragma unroll 8
        for (int i = 0; i < 16; ++i) { const int n = wave * 32 + 2 * i + (lane >> 5); const unsigned w = *(const unsigned*)(img8 + n * 132 + 4 * (lane & 31));
            *(unsigned*)(WT8 + (size_t)(I.n0 + n) * I.K + I.k0 + 4 * (lane & 31)) = w; }
        __syncthreads();
        return;
    }
    unsigned short* img = (unsigned short*)lds;
#pragma unroll
    for (int r = 0; r < 16; r += 2) { float g0 = 1.f, g1 = 1.f; if (I.gain) { g0 = I.gain[I.k0 + wave * 16 + r]; g1 = I.gain[I.k0 + wave * 16 + r + 1]; }
#pragma unroll
        for (int j = 0; j < 4; ++j) *(unsigned*)(img + (4 * lane + j) * 130 + wave * 16 + r) = pk2(v[r][j] * g0, v[r + 1][j] * g1); }
    __syncthreads();
#pragma unroll 8
    for (int i = 0; i < 32; ++i) { const int n = wave * 32 + i; const unsigned w = *(const unsigned*)(img + n * 130 + 2 * lane);
        *(unsigned*)(I.WT + (size_t)(I.n0 + n) * I.K + I.k0 + 2 * lane) = w; }
    __syncthreads();
}
struct Q8Item { const float* W; const float* gain; unsigned char* W8; float* SB; int ldw, F, map, n0; };
__device__ __forceinline__ void q8_item(const Q8Item& I, char* lds, int lane, int wave) {
    unsigned* img = (unsigned*)lds;
    const int cg = lane & 15, rs = lane >> 4, n = I.n0 + 4 * cg;
    int so1 = n < 2048 ? n : n + 8;
    if (n >= 2048 && n < 3072) { const int w = n & 255, bj = w >> 7, wc = (w >> 5) & 3, j = w & 31; so1 = 2056 + ((n - 2048) & ~255) + wc * 64 + bj * 32 + j; }
    const int so = I.map == 0 ? n : I.map == 1 ? so1 : ((n & 255) >> 7) * I.F + (n >> 8) * 128 + (n & 127);
    const float* Wk = I.W + (size_t)(wave * 128 + 2 * rs) * I.ldw + so;
    f32x4 va[16], vb[16];
#pragma unroll
    for (int p = 0; p < 16; ++p) { va[p] = *(const f32x4*)(Wk + (size_t)(8 * p) * I.ldw); vb[p] = *(const f32x4*)(Wk + (size_t)(8 * p + 1) * I.ldw); }
#pragma unroll
    for (int p = 0; p < 16; ++p)
#pragma unroll
        for (int c = 0; c < 4; ++c) img[(4 * cg + c) * 514 + wave * 64 + 4 * p + rs] = pk2(va[p][c], vb[p][c]);
    const f32x4 gk0 = *(const f32x4*)(I.gain + lane * 16), gk1 = *(const f32x4*)(I.gain + lane * 16 + 4), gk2 = *(const f32x4*)(I.gain + lane * 16 + 8), gk3 = *(const f32x4*)(I.gain + lane * 16 + 12);
    __syncthreads();
#pragma unroll 2
    for (int i = 0; i < 8; ++i) { const int nr = wave * 8 + i; const unsigned long long* rp = (const unsigned long long*)(img + nr * 514) + lane * 4;
        const unsigned long long d0 = rp[0], d1 = rp[1], d2 = rp[2], d3 = rp[3];
        u32x4 w0 = {(unsigned)d0, (unsigned)(d0 >> 32), (unsigned)d1, (unsigned)(d1 >> 32)}, w1 = {(unsigned)d2, (unsigned)(d2 >> 32), (unsigned)d3, (unsigned)(d3 >> 32)};
        f32x4 a0, a1, a2, a3; pg8::unpack8(w0, a0, a1); pg8::unpack8(w1, a2, a3); a0 = a0 * gk0; a1 = a1 * gk1; a2 = a2 * gk2; a3 = a3 * gk3;
        const float mx = wave_max(absmax16(a0, a1, a2, a3)), step = mx > 0.f ? mx * (1.f / 127.f) : 1.f;
        *((u32x4*)(I.W8 + (size_t)(I.n0 + nr) * 1024) + lane) = quant16(a0, a1, a2, a3, 1.f / step);
        if (lane == 0) I.SB[I.n0 + nr] = step; }
    __syncthreads();
}
struct MoeCvIn { const float *moe_w_gu, *moe_w_down, *dense_w_gu, *dense_w_down, *ffn_norm, *p, *w_in, *attn_norm, *w_branch, *w_out, *ple_w_gate, *ple_norm, *ple_w_proj; bf16_t *PB, *W_BR, *W_OUT, *W_PG, *W_PP; unsigned char* W8_IN; float* SB_IN; unsigned char *W8_GU1, *W8_GU0; float *SB_GU1, *SB_GU0; bf16_t *W_DN1, *W_DN0; const float* DQ; };
template <typename D> __device__ __forceinline__ void tr_run(const D& decode, char* lds, int w, int NW, int NIT, int lane, int wave) {
    TrItem IA, IB; float va[16][4], vb[16][4]; int it = w;
    if (it < NIT) { decode(it, IA); tr_load(IA, va, lane, wave);
#pragma unroll 1
        for (;;) {
            const bool hb = it + NW < NIT; if (hb) { decode(it + NW, IB); tr_load(IB, vb, lane, wave); }
            tr_store(IA, va, lds, lane, wave);
            if (!hb) break;
            it += 2 * NW; const bool ha = it < NIT; if (ha) { decode(it, IA); tr_load(IA, va, lane, wave); }
            tr_store(IB, vb, lds, lane, wave);
            if (!ha) break;
        } }
}
template <int PART> __device__ __forceinline__ void moe_convert(const MoeCvIn& a, char* lds, int w, int NW) {
    int tid_o = threadIdx.x; asm volatile("" : "+v"(tid_o)); const int tid = tid_o, lane = tid & 63, wave = __builtin_amdgcn_readfirstlane(tid >> 6);
    if constexpr (PART == 0) {
        auto small0 = [&](int L, int it, TrItem& I) { int r = it, N = 1024; I.gain = nullptr; I.F = 0; I.map = 0; I.f8 = 0; I.sc = 1.f; I.ldw = 1024;
            if (r < 32) { const int br = r >> 4; r &= 15; I.W = a.w_branch + ((size_t)L * 3 + br) * 512 * 1024; I.K = 512; I.WT = a.W_BR + ((size_t)L * 3 + br) * 1024 * 512; }
            else if ((r -= 32) < 32) { I.W = a.w_out + (size_t)L * 1024 * 1024; I.K = 1024; I.WT = a.W_OUT + (size_t)L * 1024 * 1024; }
            else if ((r -= 32) < 32) { I.W = a.ple_w_gate + (size_t)L * 1024 * 1024; I.gain = a.ple_norm + L * 1024; I.K = 1024; I.WT = a.W_PG + (size_t)L * 1024 * 1024; }
            else { r -= 32; const int l2 = r >> 3; r &= 7; I.W = a.ple_w_proj + (size_t)l2 * 256 * 1024; I.K = 256; I.WT = a.W_PP + (size_t)l2 * 1024 * 256; }
            const int nblk = N / 256; I.k0 = (r / nblk) * 128; I.n0 = (r % nblk) * 256; };
#pragma unroll 1
        for (int it = w; it < 8 * 112 + 88 + 112; it += NW) { Q8Item I; int r = it;
            if (r < 8 * 112) { const int e = r / 112; r -= e * 112; I.W = a.moe_w_gu + (size_t)e * 1024 * 7168; I.ldw = 7168; I.gain = a.ffn_norm + 1024; I.F = 3584; I.map = 2; I.W8 = a.W8_GU1 + (size_t)e * 7168 * 1024; I.SB = a.SB_GU1 + e * 7168; }
            else if ((r -= 8 * 112) < 88) { I.W = a.dense_w_gu; I.ldw = 5632; I.gain = a.ffn_norm; I.F = 2816; I.map = 2; I.W8 = a.W8_GU0; I.SB = a.SB_GU0; }
            else { r -= 88; I.W = a.w_in + (size_t)1024 * 7176; I.ldw = 7176; I.gain = a.attn_norm + 1024; I.F = 0; I.map = 1; I.W8 = a.W8_IN + (size_t)7168 * 1024; I.SB = a.SB_IN + 7168; }
            I.n0 = r * 64; q8_item(I, lds, lane, wave); }
        const float sc0 = 1.f / (a.DQ[0] * 8.f);
        auto decode = [&](int it, TrItem& I) { if (it >= 88) { small0(0, it - 88, I); return; } I.gain = nullptr; I.F = 0; I.map = 0; I.W = a.dense_w_down; I.ldw = 1024; I.K = 2816; I.WT = a.W_DN0; I.f8 = 1; I.sc = sc0; I.k0 = (it >> 2) * 128; I.n0 = (it & 3) * 256; };
        tr_run(decode, lds, NW - 1 - w, NW, 88 + 112, lane, wave);
        { const size_t n8 = (size_t)2 * 16384 * 256 / 8; const size_t gt = (size_t)(w * 512 + tid), NT = (size_t)NW * 512;
          for (size_t i0 = gt; i0 < n8; i0 += 4 * NT) { f32x4 v0[4], v1[4];
#pragma unroll
              for (int q = 0; q < 4; ++q) { const size_t i = i0 + q * NT; if (i < n8) { v0[q] = *(const f32x4*)(a.p + i * 8); v1[q] = *(const f32x4*)(a.p + i * 8 + 4); } }
#pragma unroll
              for (int q = 0; q < 4; ++q) { const size_t i = i0 + q * NT; if (i < n8) { u32x4 w4; w4.x = pk2(v0[q][0], v0[q][1]); w4.y = pk2(v0[q][2], v0[q][3]); w4.z = pk2(v1[q][0], v1[q][1]); w4.w = pk2(v1[q][2], v1[q][3]); *(u32x4*)(a.PB + i * 8) = w4; } } } }
    } else {
        auto small1 = [&](int L, int it, TrItem& I) { int r = it, N = 1024; I.gain = nullptr; I.F = 0; I.map = 0; I.f8 = 0; I.sc = 1.f; I.ldw = 1024;
            if (r < 32) { const int br = r >> 4; r &= 15; I.W = a.w_branch + ((size_t)L * 3 + br) * 512 * 1024; I.K = 512; I.WT = a.W_BR + ((size_t)L * 3 + br) * 1024 * 512; }
            else if ((r -= 32) < 32) { I.W = a.w_out + (size_t)L * 1024 * 1024; I.K = 1024; I.WT = a.W_OUT + (size_t)L * 1024 * 1024; }
            else if ((r -= 32) < 32) { I.W = a.ple_w_gate + (size_t)L * 1024 * 1024; I.gain = a.ple_norm + L * 1024; I.K = 1024; I.WT = a.W_PG + (size_t)L * 1024 * 1024; }
            else { r -= 32; const int l2 = r >> 3; r &= 7; I.W = a.ple_w_proj + (size_t)l2 * 256 * 1024; I.K = 256; I.WT = a.W_PP + (size_t)l2 * 1024 * 256; }
            const int nblk = N / 256; I.k0 = (r / nblk) * 128; I.n0 = (r % nblk) * 256; };
        auto decode = [&](int it, TrItem& I) { if (it >= 896) { small1(1, it - 896, I); return; } const int e = it / 112, r = it - e * 112; I.gain = nullptr; I.F = 0; I.map = 0; I.W = a.moe_w_down + (size_t)e * 3584 * 1024; I.ldw = 1024; I.K = 3584;
            I.WT = (bf16_t*)((unsigned char*)a.W_DN1 + (size_t)e * 1024 * 3584); I.f8 = 1; I.sc = 1.f / (a.DQ[1 + e] * 8.f); I.k0 = (r >> 2) * 128; I.n0 = (r & 3) * 256; };
        tr_run(decode, lds, w, NW, 8 * 112 + 96, lane, wave);
    }
    __syncthreads();
}
struct ProIn {
    const float *x, *p, *attn_norm, *w_in, *pool_w, *pool_scale, *w_branch, *w_out, *ffn_norm, *dense_w_gu, *dense_w_down, *router_w, *moe_w_gu, *moe_w_down, *ple_norm, *ple_w_gate, *ple_w_proj;
    bf16_t *W_IN, *W_BR, *W_OUT, *W_GU0, *W_DN0, *W_GU1, *W_DN1, *W_PG, *W_PP, *XB, *PB; float *X, *SSQ; unsigned char* X8; float* RS1; unsigned char *W8_IN, *W8_GU0, *W8_GU1; float *SB_IN, *SB_GU0, *SB_GU1; float* GATE; const float* gate_bias; bf16_t* WH16; float* DQ;
};
__device__ __forceinline__ void prologue(const ProIn& a, char* lds, int vcu, int G) {
    int tid_o = threadIdx.x; asm volatile("" : "+v"(tid_o)); const int tid = tid_o, lane = tid & 63, wave = __builtin_amdgcn_readfirstlane(tid >> 6);
    const int gw = vcu * 8 + wave, NGW = G * 8;
    float* wsc = (float*)(lds + 135168);
    { float mx[9];
#pragma unroll
      for (int s = 0; s < 9; ++s) { const f32x4* sp = (const f32x4*)(s == 0 ? a.dense_w_down : a.moe_w_down + (size_t)(s - 1) * 3584 * 1024) + tid * 2; const f32x4 u0 = sp[0], u1 = sp[1];
          mx[s] = fmaxf(fmaxf(fmaxf(fabsf(u0[0]), fabsf(u0[1])), fmaxf(fabsf(u0[2]), fabsf(u0[3]))), fmaxf(fmaxf(fabsf(u1[0]), fabsf(u1[1])), fmaxf(fabsf(u1[2]), fabsf(u1[3])))); }
#pragma unroll
      for (int s = 0; s < 9; ++s) { const float m = wave_max(mx[s]); if (lane == 0) wsc[16 + wave * 9 + s] = m; }
      __syncthreads();
      if (tid < 9) { float m = 0.f; for (int w = 0; w < 8; ++w) m = fmaxf(m, wsc[16 + w * 9 + tid]); const float sc = exp2f(floorf(log2f(160.f / fmaxf(m, 1e-30f)))); wsc[tid] = sc;
          if (vcu == 0) a.DQ[tid] = 1.f / (sc * pg8::kActScale); }
      __syncthreads(); }
    { constexpr int Q_GU1 = 8 * 112, Q_IN = 2 * 112, Q_GU0 = 88, NQ = Q_GU1 + Q_IN + Q_GU0;
#pragma unroll 1
      for (int it = Q_GU1 + vcu; it < Q_GU1 + 112; it += G) { Q8Item I; int r = it;
          if (r < Q_GU1) { const int e = r / 112; r -= e * 112; I.W = a.moe_w_gu + (size_t)e * 1024 * 7168; I.ldw = 7168; I.gain = a.ffn_norm + 1024; I.F = 3584; I.map = 2; I.W8 = a.W8_GU1 + (size_t)e * 7168 * 1024; I.SB = a.SB_GU1 + e * 7168; }
          else if ((r -= Q_GU1) < Q_IN) { const int L = r / 112; r -= L * 112; I.W = a.w_in + (size_t)L * 1024 * 7176; I.ldw = 7176; I.gain = a.attn_norm + L * 1024; I.F = 0; I.map = 1; I.W8 = a.W8_IN + (size_t)L * 7168 * 1024; I.SB = a.SB_IN + L * 7168; }
          else { r -= Q_IN; I.W = a.dense_w_gu; I.ldw = 5632; I.gain = a.ffn_norm; I.F = 2816; I.map = 2; I.W8 = a.W8_GU0; I.SB = a.SB_GU0; }
          I.n0 = r * 64; q8_item(I, lds, lane, wave); } }
    constexpr int I_BR = 4 * 4, I_OUT = 8 * 4, I_DN0 = 22 * 4, I_DN1 = 28 * 4, I_PG = 8 * 4, I_PP = 2 * 4;
    constexpr int NITEMS = 4 * I_BR + 2 * I_OUT + I_DN0 + 8 * I_DN1 + 2 * I_PG + 2 * I_PP;
    auto decode = [&](int it, TrItem& I) {
        int r = it, N; I.gain = nullptr; I.F = 0; I.map = 0; I.f8 = 0; I.sc = 1.f;
        if (r < 8 * I_DN1) { const int e = r / I_DN1; r -= e * I_DN1; I.W = a.moe_w_down + (size_t)e * 3584 * 1024; I.ldw = 1024; I.K = 3584; N = 1024; I.WT = (bf16_t*)((unsigned char*)a.W_DN1 + (size_t)e * 1024 * 3584); I.f8 = 1; I.sc = wsc[1 + e]; }
        else if ((r -= 8 * I_DN1) < I_DN0) { I.W = a.dense_w_down; I.ldw = 1024; I.K = 2816; N = 1024; I.WT = a.W_DN0; I.f8 = 1; I.sc = wsc[0]; }
        else if ((r -= I_DN0) < 4 * I_BR) { const int q = r / I_BR, L = q >> 1, br = q & 1; r -= q * I_BR; I.W = a.w_branch + ((size_t)L * 3 + br) * 512 * 1024; I.ldw = 1024; I.K = 512; N = 1024; I.WT = a.W_BR + ((size_t)L * 3 + br) * 1024 * 512; }
        else if ((r -= 4 * I_BR) < 2 * I_OUT) { const int L = r / I_OUT; r -= L * I_OUT; I.W = a.w_out + (size_t)L * 1024 * 1024; I.ldw = 1024; I.K = 1024; N = 1024; I.WT = a.W_OUT + (size_t)L * 1024 * 1024; }
        else if ((r -= 2 * I_OUT) < 2 * I_PG) { const int L = r / I_PG; r -= L * I_PG; I.W = a.ple_w_gate + (size_t)L * 1024 * 1024; I.ldw = 1024; I.gain = a.ple_norm + L * 1024; I.K = 1024; N = 1024; I.WT = a.W_PG + (size_t)L * 1024 * 1024; }
        else { r -= 2 * I_PG; const int L = r / I_PP; r -= L * I_PP; I.W = a.ple_w_proj + (size_t)L * 256 * 1024; I.ldw = 1024; I.K = 256; N = 1024; I.WT = a.W_PP + (size_t)L * 1024 * 256; }
        const int nblk = N / 256; I.k0 = (r / nblk) * 128; I.n0 = (r % nblk) * 256;
    };
    { TrItem IA, IB; float va[16][4], vb[16][4]; int it = NITEMS + vcu;
      if (it < NITEMS) { decode(it, IA); tr_load(IA, va, lane, wave);
#pragma unroll 1
        for (;;) {
            const bool hb = it + G < NITEMS; if (hb) { decode(it + G, IB); tr_load(IB, vb, lane, wave); }
            tr_store(IA, va, lds, lane, wave);
            if (!hb) break;
            it += 2 * G; const bool ha = it < NITEMS; if (ha) { decode(it, IA); tr_load(IA, va, lane, wave); }
            tr_store(IB, vb, lds, lane, wave);
            if (!ha) break;
        } } }
    float wgx[4][4][8];
#pragma unroll
    for (int j = 0; j < 4; ++j)
#pragma unroll
        for (int i = 0; i < 4; ++i) { const int k = 4 * lane + 256 * j + i; const float gk = a.attn_norm[k]; const f32x4 w0 = *(const f32x4*)(a.w_in + (size_t)k * 7176 + 2048), w1 = *(const f32x4*)(a.w_in + (size_t)k * 7176 + 2052);
#pragma unroll
            for (int c = 0; c < 4; ++c) { wgx[j][i][c] = gk * w0[c]; wgx[j][i][4 + c] = gk * w1[c]; } }
    const bool bal = (G == 256);
    for (int i = 0; i < (bal ? 5 : 0x7fffffff); ++i) {
        int m0 = (gw + i * NGW) * 2;
        if (bal) { if (i == 3 && vcu < 112) continue;
                   if (i == 4) { if (gw < 896 || gw >= 1792) break; m0 = ((gw - 896) + 3 * NGW) * 2; } }
        else if (m0 >= 16384) break;
        f32x4 v[2][4];
#pragma unroll
        for (int q = 0; q < 2; ++q) { const f32x4* xr = (const f32x4*)(a.x + (size_t)(m0 + q) * 1024) + lane;
#pragma unroll
            for (int j = 0; j < 4; ++j) v[q][j] = xr[64 * j]; }
#pragma unroll
        for (int q = 0; q < 2; ++q) { const int m = m0 + q; unsigned long long* o8 = (unsigned long long*)(a.XB + (size_t)m * 1024) + lane; float s = 0.f;
#pragma unroll
            for (int j = 0; j < 4; ++j) { const f32x4 w = v[q][j]; s += (w[0] * w[0] + w[1] * w[1]) + (w[2] * w[2] + w[3] * w[3]);
                o8[64 * j] = (unsigned long long)pk2(w[0], w[1]) | ((unsigned long long)pk2(w[2], w[3]) << 32); }
            s = wave_sum(s);
            if (lane < 16) a.SSQ[(size_t)m * 16 + lane] = lane == 0 ? s : 0.f;
            float mx = 0.f;
#pragma unroll
            for (int j = 0; j < 4; ++j) mx = fmaxf(mx, fmaxf(fmaxf(fabsf(v[q][j][0]), fabsf(v[q][j][1])), fmaxf(fabsf(v[q][j][2]), fabsf(v[q][j][3]))));
            mx = wave_max(mx); const float step = mx > 0.f ? mx * (1.f / 127.f) : 1.f, inv = 1.f / step;
            unsigned* x8 = (unsigned*)(a.X8 + (size_t)m * 1024) + lane;
#pragma unroll
            for (int j = 0; j < 4; ++j) x8[64 * j] = pack4_i8(v[q][j][0] * inv, v[q][j][1] * inv, v[q][j][2] * inv, v[q][j][3] * inv);
            const float rstd = __builtin_amdgcn_rsqf(s * (1.f / 1024.f) + 1e-6f);
            if (lane == 0) a.RS1[m] = rstd * step;
            float d[8] = {0.f, 0.f, 0.f, 0.f, 0.f, 0.f, 0.f, 0.f};
#pragma unroll
            for (int j = 0; j < 4; ++j)
#pragma unroll
                for (int i = 0; i < 4; ++i)
#pragma unroll
                    for (int c = 0; c < 8; ++c) d[c] = fmaf(v[q][j][i], wgx[j][i][c], d[c]);
#pragma unroll
            for (int c = 0; c < 8; ++c) d[c] = wave_sum(d[c]);
            if (lane < 8) { float dv = d[0];
#pragma unroll
                for (int c = 1; c < 8; ++c) if (lane == c) dv = d[c];
                a.GATE[(size_t)m * 8 + lane] = dv * rstd + a.gate_bias[lane]; } }
    }
    { const size_t gt = (size_t)(vcu * 512 + tid), NT = (size_t)G * 512;
      for (size_t i = gt; i < 3 * 16384; i += NT) { const int tb = (int)(i >> 14), c = (int)(i >> 10) & 15, k = (int)i & 1023;
          const float w = tb < 2 ? a.attn_norm[tb * 1024 + k] * a.w_in[((size_t)tb * 1024 + k) * 7176 + 2048 + (c & 7)] : a.ffn_norm[1024 + k] * a.router_w[k * 8 + (c & 7)];
          const unsigned hi = f2bf(w); const float lo = w - __builtin_bit_cast(float, hi << 16);
          a.WH16[i] = (bf16_t)(c < 8 ? hi : f2bf(lo)); }
    }
    for (int task = vcu; task < 256; task += G) {
        const int L = task >> 7, g = (task >> 5) & 3, nb = task & 31;
        float* AsT = (float*)lds; float* Bs = AsT + 128 * 128;
        __syncthreads();
        const float* pw = a.pool_w + ((size_t)L * 4 + g) * 128 * 128; const float* ps = a.pool_scale + L * 512 + g * 128;
        const float* wb = a.w_branch + (((size_t)L * 3 + 2) * 512 + g * 128) * 1024 + nb * 32;
        f32x4 wv[8], bq[2]; const f32x4 sv = *(const f32x4*)(ps + (tid & 31) * 4);
#pragma unroll
        for (int q = 0; q < 8; ++q) { const int i = tid + 512 * q; wv[q] = *(const f32x4*)(pw + (i >> 5) * 128 + (i & 31) * 4); }
#pragma unroll
        for (int q = 0; q < 2; ++q) { const int i = tid + 512 * q; bq[q] = *(const f32x4*)(wb + (size_t)(i >> 3) * 1024 + (i & 7) * 4); }
#pragma unroll
        for (int q = 0; q < 8; ++q) { const int i = tid + 512 * q, c = i >> 5, d4 = (i & 31) * 4;
            AsT[(d4 + 0) * 128 + c] = wv[q][0] * sv[0]; AsT[(d4 + 1) * 128 + c] = wv[q][1] * sv[1]; AsT[(d4 + 2) * 128 + c] = wv[q][2] * sv[2]; AsT[(d4 + 3) * 128 + c] = wv[q][3] * sv[3]; }
#pragma unroll
        for (int q = 0; q < 2; ++q) { const int i = tid + 512 * q; *(f32x4*)(Bs + (i >> 3) * 32 + (i & 7) * 4) = bq[q]; }
        __syncthreads();
        const int nq = tid & 31, cq = (tid >> 5) * 8;
        float acc[8];
#pragma unroll
        for (int j = 0; j < 8; ++j) acc[j] = 0.f;
#pragma unroll 8
        for (int d = 0; d < 128; ++d) { const float bv = Bs[d * 32 + nq]; const f32x4 a0 = *(const f32x4*)(AsT + d * 128 + cq), a1 = *(const f32x4*)(AsT + d * 128 + cq + 4);
#pragma unroll
            for (int j = 0; j < 4; ++j) { acc[j] = fmaf(bv, a0[j], acc[j]); acc[4 + j] = fmaf(bv, a1[j], acc[4 + j]); } }
        u32x4 w; w.x = pk2(acc[0], acc[1]); w.y = pk2(acc[2], acc[3]); w.z = pk2(acc[4], acc[5]); w.w = pk2(acc[6], acc[7]);
        *(u32x4*)(a.W_BR + ((size_t)L * 3 + 2) * 1024 * 512 + (size_t)(nb * 32 + nq) * 512 + g * 128 + cq) = w;
    }
    __syncthreads();
}
struct RowPassIn { const bf16_t* XB; const float* SSQ; const bf16_t* WT16; const float* bias; unsigned char* X8; float* RS1; float* GATE; unsigned char* XG; float* RSG; unsigned* cnt; int* TOKI; float* TOKG; };
template <int MODE> __device__ __forceinline__ void row_pass(const RowPassIn& a, char* lds, int vcu, int G) {
    typedef unsigned u32x2 __attribute__((ext_vector_type(2)));
    int tid_o = threadIdx.x; asm volatile("" : "+v"(tid_o)); const int tid = tid_o, lane = tid & 63, wave = __builtin_amdgcn_readfirstlane(tid >> 6);
    const int rb = wave & 3, kh = wave >> 2, r = lane & 15, kq = lane >> 4, lrow = rb * 16 + r;
    float* part = (float*)lds;
    float* pmax = part + 2048;
    float* lrs = pmax + 128;
    int* lcnt = (int*)(lrs + 64); int* lbase = lcnt + 8; int* lsel = lbase + 8;
    float* lgate = (float*)(lsel + 256);
    for (int chunk = vcu; chunk < 16384 / 64; chunk += G) {
        const int row = chunk * 64 + lrow;
        const bf16_t* xp = a.XB + (size_t)row * 1024 + kh * 512 + kq * 8;
        bf16x8 av[16];
#pragma unroll
        for (int s = 0; s < 16; ++s) av[s] = *(const bf16x8*)(xp + 32 * s);
        const f32x4 sq = *(const f32x4*)(a.SSQ + (size_t)row * 16 + 4 * kq);
        f32x4 acc = {0.f, 0.f, 0.f, 0.f};
        if (MODE != 0) { const bf16_t* wp = a.WT16 + (size_t)r * 1024 + kh * 512 + kq * 8;
#pragma unroll
            for (int h = 0; h < 2; ++h) { bf16x8 bv[8];
#pragma unroll
                for (int s = 0; s < 8; ++s) bv[s] = *(const bf16x8*)(wp + 32 * (8 * h + s));
#pragma unroll
                for (int s = 0; s < 8; ++s) acc = __builtin_amdgcn_mfma_f32_16x16x32_bf16(av[8 * h + s], bv[s], acc, 0, 0, 0); } }
        if (MODE == 2 && tid < 8) lcnt[tid] = 0;
        float ssum = (sq[0] + sq[1]) + (sq[2] + sq[3]); ssum += __shfl_xor(ssum, 16); ssum += __shfl_xor(ssum, 32);
        const float rstd = __builtin_amdgcn_rsqf(ssum * (1.f / 1024.f) + 1e-6f);
        float mx = 0.f;
#pragma unroll
        for (int s = 0; s < 16; ++s) { const u32x4 w = __builtin_bit_cast(u32x4, av[s]);
#pragma unroll
            for (int j = 0; j < 4; ++j) mx = fmaxf(mx, fmaxf(fabsf(__builtin_bit_cast(float, w[j] << 16)), fabsf(__builtin_bit_cast(float, w[j] & 0xffff0000u)))); }
        mx = fmaxf(mx, __shfl_xor(mx, 16)); mx = fmaxf(mx, __shfl_xor(mx, 32));
        if (kq == 0) { pmax[kh * 64 + lrow] = mx; if (kh == 0) lrs[lrow] = rstd; }
        if (MODE != 0) {
#pragma unroll
            for (int i = 0; i < 4; ++i) part[(kh * 64 + rb * 16 + 4 * kq + i) * 16 + r] = acc[i]; }
        __syncthreads();
        const float rowmax = fmaxf(pmax[lrow], pmax[64 + lrow]), step = rowmax > 0.f ? rowmax * (1.f / 127.f) : 1.f, inv = 1.f / step;
        auto q8s = [&](int s) { const u32x4 w = __builtin_bit_cast(u32x4, av[s]); u32x2 q;
            q.x = pack4_i8(__builtin_bit_cast(float, w[0] << 16) * inv, __builtin_bit_cast(float, w[0] & 0xffff0000u) * inv, __builtin_bit_cast(float, w[1] << 16) * inv, __builtin_bit_cast(float, w[1] & 0xffff0000u) * inv);
            q.y = pack4_i8(__builtin_bit_cast(float, w[2] << 16) * inv, __builtin_bit_cast(float, w[2] & 0xffff0000u) * inv, __builtin_bit_cast(float, w[3] << 16) * inv, __builtin_bit_cast(float, w[3] & 0xffff0000u) * inv);
            return q; };
        if (MODE != 2) {
            unsigned char* dst = a.X8 + (size_t)row * 1024 + kh * 512 + kq * 8;
#pragma unroll
            for (int s = 0; s < 16; ++s) *(u32x2*)(dst + 32 * s) = q8s(s);
            if (kq == 0 && kh == 0) a.RS1[row] = rstd * step;
            if (MODE == 1) { const int lr2 = tid >> 3, cc = tid & 7;
                const float y = (part[lr2 * 16 + cc] + part[lr2 * 16 + cc + 8]) + (part[(64 + lr2) * 16 + cc] + part[(64 + lr2) * 16 + cc + 8]);
                a.GATE[(size_t)(chunk * 64 + lr2) * 8 + cc] = y * lrs[lr2] + a.bias[cc]; }
        } else {
            if (tid < 64) { float d[8]; const float rr = lrs[tid];
#pragma unroll
                for (int j = 0; j < 8; ++j) d[j] = ((part[tid * 16 + j] + part[tid * 16 + j + 8]) + (part[(64 + tid) * 16 + j] + part[(64 + tid) * 16 + j + 8])) * rr + a.bias[j];
                int i0 = 0; float v0 = d[0];
#pragma unroll
                for (int j = 1; j < 8; ++j) if (d[j] > v0) { v0 = d[j]; i0 = j; }
                int i1 = -1; float v1 = -3.0e38f;
#pragma unroll
                for (int j = 0; j < 8; ++j) if (j != i0 && d[j] > v1) { v1 = d[j]; i1 = j; }
                const float e1 = __expf(v1 - v0); const float g0 = 1.f / (1.f + e1);
                lsel[tid * 4 + 0] = i0; lsel[tid * 4 + 1] = atomicAdd(&lcnt[i0], 1); lsel[tid * 4 + 2] = i1; lsel[tid * 4 + 3] = atomicAdd(&lcnt[i1], 1);
                lgate[tid * 2] = g0; lgate[tid * 2 + 1] = e1 * g0; }
            __syncthreads();
            if (tid < 8) lbase[tid] = (int)__hip_atomic_fetch_add(a.cnt + tid, (unsigned)lcnt[tid], __ATOMIC_RELAXED, __HIP_MEMORY_SCOPE_AGENT);
            __syncthreads();
            const int e0 = lsel[lrow * 4], p0 = lbase[e0] + lsel[lrow * 4 + 1], e1 = lsel[lrow * 4 + 2], p1 = lbase[e1] + lsel[lrow * 4 + 3];
            unsigned char* d0 = a.XG + ((size_t)e0 * 16384 + p0) * 1024 + kh * 512 + kq * 8; unsigned char* d1 = a.XG + ((size_t)e1 * 16384 + p1) * 1024 + kh * 512 + kq * 8;
#pragma unroll
            for (int s = 0; s < 16; ++s) { const u32x2 q = q8s(s); *(u32x2*)(d0 + 32 * s) = q; *(u32x2*)(d1 + 32 * s) = q; }
            if (kq == 0 && kh == 0) { const float rsv = rstd * step; a.RSG[(size_t)e0 * 16384 + p0] = rsv; a.RSG[(size_t)e1 * 16384 + p1] = rsv;
                a.TOKI[row * 4 + 0] = e0; a.TOKI[row * 4 + 1] = p0; a.TOKI[row * 4 + 2] = e1; a.TOKI[row * 4 + 3] = p1; a.TOKG[row * 2] = lgate[lrow * 2]; a.TOKG[row * 2 + 1] = lgate[lrow * 2 + 1]; }
        }
        __syncthreads();
    }
}
struct PrepIn { const bf16_t *PROJ; const float *conv_w, *conv_b, *q_gain, *k_gain; bf16_t *MQ, *MK, *AQ, *AK, *HP; };
__device__ __forceinline__ void prep(const PrepIn& a, char* lds, int vcu, int G) {
    int tid_o = threadIdx.x; asm volatile("" : "+v"(tid_o)); const int tid = tid_o, lane = tid & 63, wave = __builtin_amdgcn_readfirstlane(tid >> 6);
    float* cwl = (float*)lds;
    for (int i = tid; i < 4096 / 4; i += 512) ((f32x4*)cwl)[i] = ((const f32x4*)a.conv_w)[i];
    for (int i = tid; i < 1024 / 4; i += 512) ((f32x4*)(cwl + 4096))[i] = ((const f32x4*)a.conv_b)[i];
    __syncthreads();
    const int gw = vcu * 8 + wave, NGW = G * 8;
    const int c0 = lane * 16;
    int vz = 0; asm volatile("" : "+v"(vz));
    const int qg0 = (lane & 3) * 16;
    const float* qkg = (lane < 32 ? a.q_gain : a.k_gain) + qg0;
    const float qkscale = lane < 32 ? 0.125f * 1.4426950408889634f : 1.f;
    const int pc = lane * 8, pw = 2 << (lane >> 4);
    for (int chunk = gw; chunk < 16384 / 8; chunk += NGW) {
        const int row0 = chunk * 8, t0 = row0 & 2047;
        const bf16_t* pr0 = a.PROJ + (size_t)row0 * 7168;
        { u32x4 cv[11][2];
#pragma unroll
          for (int i = 0; i < 11; ++i) { const int d = i - 3, de = (d < 0 && t0 + d < 0) ? 0 : d; const bf16_t* p = pr0 + (long)de * 7168 + c0; cv[i][0] = *(const u32x4*)p; cv[i][1] = *(const u32x4*)(p + 8); }
          f32x4 wt[4][4], bs[4];
#pragma unroll
          for (int i = 0; i < 4; ++i) { bs[i] = *(const f32x4*)(cwl + 4096 + c0 + 4 * i);
#pragma unroll
              for (int j = 0; j < 4; ++j) wt[j][i] = *(const f32x4*)(cwl + j * 1024 + c0 + 4 * i); }
          const float ks = lane < 32 ? 1.f : 0.08838834764831845f;
#pragma unroll
          for (int r = 0; r < 8; ++r) { f32x4 y[4] = {bs[0], bs[1], bs[2], bs[3]};
#pragma unroll
              for (int j = 0; j < 4; ++j) { const float on = (t0 + r - 3 + j) >= 0 ? 1.f : 0.f; f32x4 x0, x1, x2, x3; pg8::unpack8(cv[r + j][0], x0, x1); pg8::unpack8(cv[r + j][1], x2, x3);
                  y[0] = y[0] + wt[j][0] * x0 * on; y[1] = y[1] + wt[j][1] * x1 * on; y[2] = y[2] + wt[j][2] * x2 * on; y[3] = y[3] + wt[j][3] * x3 * on; }
#pragma unroll
              for (int i = 0; i < 4; ++i)
#pragma unroll
                  for (int c = 0; c < 4; ++c) y[i][c] = y[i][c] * pg8::fsigmoid(y[i][c]) * ks;
              bf16_t* dst = (lane < 32 ? a.MQ : a.MK) + (size_t)(row0 + r) * 512 + (c0 & 511);
              *(u32x4*)dst = pg8::pack8(y[0], y[1]); *(u32x4*)(dst + 8) = pg8::pack8(y[2], y[3]); } }
        { u32x4 pv[23];
#pragma unroll
          for (int i = 0; i < 23; ++i) { const int d = i - 15, de = (d < 0 && t0 + d < 0) ? 0 : d; pv[i] = *(const u32x4*)(pr0 + (long)de * 7168 + 3584 + pc); }
#pragma unroll
          for (int r = 0; r < 8; ++r) { const int t = t0 + r, cnt = t + 1 < pw ? t + 1 : pw;
              f32x4 u0, u1; pg8::unpack8(pv[15 + r], u0, u1); f32x4 s0 = u0, s1 = u1;
#pragma unroll
              for (int j = 1; j < 16; ++j) { const float on = j < cnt ? 1.f : 0.f; f32x4 b0, b1; pg8::unpack8(pv[15 + r - j], b0, b1); s0 = s0 + b0 * on; s1 = s1 + b1 * on; }
              const float ic = 1.f / (float)cnt; s0 = s0 * ic - u0; s1 = s1 * ic - u1;
              *(u32x4*)(a.HP + (size_t)(row0 + r) * 512 + pc) = pg8::pack8(s0, s1); } }
    }
    __syncthreads();
}
struct CombIn { float* X; bf16_t* XB; float* SSQ; const bf16_t* Y; const int* TOKI; const float* TOKG; int ts[8]; };
__device__ __forceinline__ void combine(const CombIn& a, int vcu, int G) {
    int tid_o = threadIdx.x; asm volatile("" : "+v"(tid_o)); const int tid = tid_o, lane = tid & 63, wave = __builtin_amdgcn_readfirstlane(tid >> 6), gw = vcu * 8 + wave, NGW = G * 8;
    int vz = 0; asm volatile("" : "+v"(vz));
    for (int r0 = gw * 4; r0 < 16384; r0 += NGW * 4) {
        int ti[4][4]; float tg[4][2];
#pragma unroll
        for (int q = 0; q < 4; ++q) { const int rv = r0 + q + vz;
#pragma unroll
            for (int i = 0; i < 4; ++i) ti[q][i] = a.TOKI[rv * 4 + i];
            tg[q][0] = a.TOKG[rv * 2]; tg[q][1] = a.TOKG[rv * 2 + 1]; }
        u32x4 y0[4][2], y1[4][2]; f32x4 xv[4][4]; int yr0[4], yr1[4];
#pragma unroll
        for (int q = 0; q < 4; ++q) { int t0 = 0, t1 = 0;
#pragma unroll
            for (int j = 0; j < 8; ++j) { if (j == ti[q][0]) t0 = a.ts[j]; if (j == ti[q][2]) t1 = a.ts[j]; }
            yr0[q] = t0 * 256 + ti[q][1]; yr1[q] = t1 * 256 + ti[q][3];
            const u32x4* p0 = (const u32x4*)(a.Y + (size_t)yr0[q] * 1024) + lane * 2; const u32x4* p1 = (const u32x4*)(a.Y + (size_t)yr1[q] * 1024) + lane * 2;
            y0[q][0] = p0[0]; y0[q][1] = p0[1]; y1[q][0] = p1[0]; y1[q][1] = p1[1];
            const u32x4* xp = (const u32x4*)(a.XB + (size_t)(r0 + q) * 1024) + lane * 2; pg8::unpack8(xp[0], xv[q][0], xv[q][1]); pg8::unpack8(xp[1], xv[q][2], xv[q][3]); }
#pragma unroll
        for (int q = 0; q < 4; ++q) { const int row = r0 + q; const float g0 = tg[q][0], g1 = tg[q][1]; f32x4 v[4]; float s = 0.f;
#pragma unroll
            for (int hh = 0; hh < 2; ++hh) { f32x4 a0, a1, b0, b1; pg8::unpack8(y0[q][hh], a0, a1); pg8::unpack8(y1[q][hh], b0, b1);
                v[2 * hh] = xv[q][2 * hh] + a0 * g0 + b0 * g1; v[2 * hh + 1] = xv[q][2 * hh + 1] + a1 * g0 + b1 * g1; }
            if (yr0[q] >= 32768) {
#pragma unroll
                for (int sl = 0; sl < 1; ++sl) { const u32x4* p2 = (const u32x4*)(a.Y + ((size_t)34816 + sl * 2048 + (yr0[q] - 32768)) * 1024) + lane * 2;
#pragma unroll
                    for (int hh = 0; hh < 2; ++hh) { f32x4 c0, c1; pg8::unpack8(p2[hh], c0, c1); v[2 * hh] = v[2 * hh] + c0 * g0; v[2 * hh + 1] = v[2 * hh + 1] + c1 * g0; } } }
            if (yr1[q] >= 32768) {
#pragma unroll
                for (int sl = 0; sl < 1; ++sl) { const u32x4* p3 = (const u32x4*)(a.Y + ((size_t)34816 + sl * 2048 + (yr1[q] - 32768)) * 1024) + lane * 2;
#pragma unroll
                    for (int hh = 0; hh < 2; ++hh) { f32x4 d0, d1; pg8::unpack8(p3[hh], d0, d1); v[2 * hh] = v[2 * hh] + d0 * g1; v[2 * hh + 1] = v[2 * hh + 1] + d1 * g1; } } }
#pragma unroll
            for (int i = 0; i < 4; ++i) s += (v[i][0] * v[i][0] + v[i][1] * v[i][1]) + (v[i][2] * v[i][2] + v[i][3] * v[i][3]);
            u32x4* xb = (u32x4*)(a.XB + (size_t)row * 1024) + lane * 2; xb[0] = pg8::pack8(v[0], v[1]); xb[1] = pg8::pack8(v[2], v[3]);
            s = wave_sum(s);
            if (lane < 16) a.SSQ[(size_t)row * 16 + lane] = lane == 0 ? s : 0.f; }
    }
}
}
#define LAS __attribute__((address_space(3)))
typedef unsigned short bf16_t;
constexpr int M = 16384, NWAVES = 8;
constexpr size_t MiB = 1u << 20;
constexpr size_t WS_CTL = 0, CTL_ZERO_BYTES = 1 * MiB;
constexpr size_t WS_SMALL = 1 * MiB;
constexpr size_t WS_TOKI = 2 * MiB, WS_TOKG = WS_TOKI + (size_t)M * 16;
constexpr size_t WS_SSQA = 3 * MiB, WS_SSQB = 4 * MiB, WS_GATE = 5 * MiB;
constexpr size_t WS_RSG = 6 * MiB;
constexpr size_t WS_W = 8 * MiB;
constexpr size_t WS_W_IN = WS_W, WS_W_BR = WS_W_IN + (size_t)2 * 7168 * 1024 * 2, WS_W_OUT = WS_W_BR + (size_t)6 * 1024 * 512 * 2, WS_W_GU0 = WS_W_OUT + (size_t)2 * 1024 * 1024 * 2,
                 WS_W_DN0 = WS_W_GU0 + (size_t)5632 * 1024 * 2, WS_W_GU1 = WS_W_DN0 + (size_t)1024 * 2816 * 2, WS_W_DN1 = WS_W_GU1 + (size_t)8 * 7168 * 1024 * 2,
                 WS_W_PG = WS_W_DN1 + (size_t)8 * 1024 * 3584 * 2, WS_W_PP = WS_W_PG + (size_t)2 * 1024 * 1024 * 2, WS_W_END = WS_W_PP + (size_t)2 * 1024 * 256 * 2;
constexpr size_t WS_XB = (WS_W_END + MiB - 1) / MiB * MiB, WS_PP = WS_XB + (size_t)M * 1024 * 2, WS_PB = WS_PP + (size_t)2 * M * 1024 * 2, WS_X8 = WS_PB + (size_t)2 * M * 256 * 2, WS_RS1 = WS_X8 + (size_t)M * 1024, WS_AREA = WS_RS1 + MiB;
constexpr size_t WS_PROJ = WS_AREA, WS_MQ = WS_PROJ + (size_t)M * 7168 * 2, WS_MK = WS_MQ + (size_t)M * 512 * 2, WS_AQ = WS_MK + (size_t)M * 512 * 2, WS_AK = WS_AQ + (size_t)M * 512 * 2,
                 WS_HM = WS_AK + (size_t)M * 512 * 2, WS_HA = WS_HM + (size_t)M * 512 * 2, WS_HP = WS_HA + (size_t)M * 512 * 2, WS_ZF = WS_HP + (size_t)M * 512 * 2, WS_ZB = WS_ZF + (size_t)M * 1024 * 4,
                 WS_G8 = WS_ZB + (size_t)M * 1024 * 2, WS_LAYER_END = WS_G8 + (size_t)M * 3072;
constexpr size_t WS_XG = WS_AREA, WS_Y = WS_AREA, WS_ACT = WS_XG + (size_t)8 * 16384 * 1024 * 2, WS_END = WS_ACT + (size_t)34816 * 3584 * 2;
static_assert(WS_LAYER_END <= WS_END && WS_ACT >= WS_MQ, "AREA views");
constexpr int CW_BAR = 4096, CW_QUEUE = 16384, CW_ECNT = 16384 + 256;

#define XB_TMO      128
#define XB_XCNT(j)  (256  + 64 * (j))
#define XB_XSUB(j)  (1280 + 64 * (j))
#define XB_XGEN(j)  (2304 + 64 * (j))
#define XB_TOP      3328
#define XB_TOPGEN   3392
#define XCD_BAR_WORDS 3456
#define XB_SPIN_CAP (1u << 18)

__device__ __forceinline__ unsigned xb_ld(unsigned* p)              { return __hip_atomic_load(p, __ATOMIC_RELAXED, __HIP_MEMORY_SCOPE_AGENT); }
__device__ __forceinline__ unsigned xb_add(unsigned* p, unsigned v) { return __hip_atomic_fetch_add(p, v, __ATOMIC_RELAXED, __HIP_MEMORY_SCOPE_AGENT); }
__device__ __forceinline__ unsigned xb_xcc_id() { return (unsigned)__builtin_amdgcn_s_getreg((3 << 11) | 20) & 0xFu; }
#define XB_SPIN(cond, bar) do { unsigned _sp = 0; while (cond) { __builtin_amdgcn_s_sleep(1); \
    if ((++_sp & 255u) == 0u) { if (xb_ld(&(bar)[XB_TMO])) break; if (_sp > XB_SPIN_CAP) { atomicAdd(&(bar)[XB_TMO], 1u); break; } } } } while (0)

struct XcdBarrier {
    unsigned* bar; unsigned x;
    volatile LAS unsigned* st;
};

__device__ __forceinline__ XcdBarrier xcd_barrier_post(unsigned* bar, volatile LAS unsigned* st) {
    XcdBarrier b; b.bar = bar; b.x = xb_xcc_id(); b.st = st;
    if (threadIdx.x == 0) (void)xb_add(&bar[XB_XCNT(b.x)], 1u);
    return b;
}
__device__ __forceinline__ void xcd_barrier_complete(unsigned* bar, unsigned x, unsigned& nloc, unsigned& nx) {
    const unsigned G = gridDim.x * gridDim.y * gridDim.z;
    unsigned sum, cnt, mine, sp = 0u;
    for (;;) {
        sum = 0u; cnt = 0u; mine = 0u;
#pragma unroll
        for (unsigned j = 0; j < 16; ++j) { const unsigned c = xb_ld(&bar[XB_XCNT(j)]); sum += c; cnt += (c > 0u) ? 1u : 0u; mine = (j == x) ? c : mine; }
        if (sum == G) break;
        __builtin_amdgcn_s_sleep(1);
        if ((++sp & 255u) == 0u) { if (xb_ld(&bar[XB_TMO])) break; if (sp > XB_SPIN_CAP) { atomicAdd(&bar[XB_TMO], 1u); break; } }
    }
    nloc = mine > 0u ? mine : 1u; nx = cnt > 0u ? cnt : 1u;
}

__device__ __forceinline__ void xcd_barrier(const XcdBarrier& b) {
    asm volatile("s_waitcnt vmcnt(0)" ::: "memory");
    __syncthreads();
    if (threadIdx.x == 0) {
        unsigned* bar = b.bar;
        __builtin_amdgcn_s_waitcnt(0);
        unsigned nloc = b.st[0], nx = b.st[1];
        if (nloc == 0u) { xcd_barrier_complete(bar, b.x, nloc, nx); b.st[0] = nloc; b.st[1] = nx; }
        const unsigned old = xb_add(&bar[XB_XSUB(b.x)], 1u);
        const unsigned gen = old / nloc;
        if (old + 1u == (gen + 1u) * nloc) {
            __builtin_amdgcn_fence(__ATOMIC_RELEASE, "agent");
            asm volatile("s_waitcnt vmcnt(0)" ::: "memory");
            const unsigned og = xb_add(&bar[XB_TOP], 1u);
            const unsigned tg = og / nx;
            if (og + 1u == (tg + 1u) * nx) xb_add(&bar[XB_TOPGEN], 1u);
            else XB_SPIN(xb_ld(&bar[XB_TOPGEN]) == tg, bar);
            __builtin_amdgcn_fence(__ATOMIC_ACQUIRE, "agent");
            xb_add(&bar[XB_XGEN(b.x)], 1u);
            asm volatile("s_waitcnt vmcnt(0)" ::: "memory");
        } else {
            XB_SPIN(xb_ld(&bar[XB_XGEN(b.x)]) == gen, bar);
            __builtin_amdgcn_fence(__ATOMIC_ACQUIRE, "agent");
            asm volatile("s_waitcnt vmcnt(0)" ::: "memory");
        }
    }
    __syncthreads();
}


struct Args { const float* in[26]; float* out; unsigned char* ws; int ph_lo, ph_hi; };
static_assert(sizeof(Args) == 26 * 8 + 8 + 8 + 8, "Args has no padding");

constexpr int LDS_BYTES = 147456, MISC_OFF = 131072 + 8192;

__global__ void __launch_bounds__(NWAVES * 64, 2) fwd_kernel(Args args) {
    extern __shared__ __attribute__((aligned(16))) unsigned char lds[];
    const int tid = threadIdx.x;
    const int G = gridDim.x; int vcu; { const int bx = blockIdx.x; vcu = (G % 8 == 0) ? (bx % 8) * (G / 8) + bx / 8 : bx; }
    volatile LAS unsigned* MISC = (volatile LAS unsigned*)((LAS unsigned char*)lds + MISC_OFF);
    if (tid < 32) MISC[tid] = 0u;
    __syncthreads();
    unsigned char* ws = args.ws;
    unsigned* ctl = (unsigned*)(ws + WS_CTL);
    const int lo = args.ph_lo, hi = args.ph_hi;
    const bool one_launch = (hi - lo) > 1;
    XcdBarrier bar; bar.bar = ctl + CW_BAR; bar.x = 0; bar.st = nullptr;
    if (one_launch) bar = xcd_barrier_post(ctl + CW_BAR, MISC + 8);
#ifndef EPI_ALIGN8
#define EPI_ALIGN8 true
#endif
#ifndef SITE_MASK
#define SITE_MASK 0xffff
#endif
#define EN(s) ((SITE_MASK >> (s)) & 1)
#define IN(k) (lo <= (k) && (k) < hi)
#define SEAM(k) do { if (IN(k) && IN((k) + 1)) xcd_barrier(bar); } while (0)
    LAS unsigned char* ring = (LAS unsigned char*)lds;
    const float* const* in = args.in;
    float* X = args.out;
#define SITE_WS size_t wso_ = 0; asm volatile("" : "+s"(wso_)); unsigned char* wsl = ws + wso_;
#define p_XB ((bf16_t*)(wsl + WS_XB))
#define p_PB ((bf16_t*)(wsl + WS_PB))
#define p_PPb ((bf16_t*)(wsl + WS_PP))
#define p_SSQA ((float*)(wsl + WS_SSQA))
#define p_SSQB ((float*)(wsl + WS_SSQB))
#define p_GATE ((float*)(wsl + WS_GATE))
#define p_RSG ((float*)(wsl + WS_RSG))
#define p_DQ ((float*)(wsl + WS_SMALL + 131072))
#define p_WH16 ((bf16_t*)(wsl + WS_SMALL + 262144))
#define p_PROJ ((bf16_t*)(wsl + WS_PROJ))
#define p_MQ ((bf16_t*)(wsl + WS_MQ))
#define p_MK ((bf16_t*)(wsl + WS_MK))
#define p_AQ ((bf16_t*)(wsl + WS_AQ))
#define p_AK ((bf16_t*)(wsl + WS_AK))
#define p_HM ((bf16_t*)(wsl + WS_HM))
#define p_HA ((bf16_t*)(wsl + WS_HA))
#define p_HP ((bf16_t*)(wsl + WS_HP))
#define p_ZB ((bf16_t*)(wsl + WS_ZB))
#define p_XG ((bf16_t*)(wsl + WS_XG))
#define p_Yb ((bf16_t*)(wsl + WS_Y))
#define p_ACT ((bf16_t*)(wsl + WS_ACT))
#define p_TOKI ((int*)(wsl + WS_TOKI))
#define p_TOKG ((float*)(wsl + WS_TOKG))
#define p_W_IN ((bf16_t*)(wsl + WS_W_IN))
#define p_W_BR ((bf16_t*)(wsl + WS_W_BR))
#define p_W_OUT ((bf16_t*)(wsl + WS_W_OUT))
#define p_W_GU0 ((bf16_t*)(wsl + WS_W_GU0))
#define p_W_DN0 ((bf16_t*)(wsl + WS_W_DN0))
#define p_W_GU1 ((bf16_t*)(wsl + WS_W_GU1))
#define p_W_DN1 ((bf16_t*)(wsl + WS_W_DN1))
#define p_W_PG ((bf16_t*)(wsl + WS_W_PG))
#define p_W_PP ((bf16_t*)(wsl + WS_W_PP))
    if (EN(0) && IN(0)) {
        SITE_WS
        thin::ProIn a; a.x = in[0]; a.p = in[1]; a.attn_norm = in[2]; a.w_in = in[3]; a.pool_w = in[12]; a.pool_scale = in[13]; a.w_branch = in[14]; a.w_out = in[15]; a.ffn_norm = in[16];
        a.dense_w_gu = in[17]; a.dense_w_down = in[18]; a.router_w = in[19]; a.moe_w_gu = in[21]; a.moe_w_down = in[22]; a.ple_norm = in[23]; a.ple_w_gate = in[24]; a.ple_w_proj = in[25];
        a.W_IN = p_W_IN; a.W_BR = p_W_BR; a.W_OUT = p_W_OUT; a.W_GU0 = p_W_GU0; a.W_DN0 = p_W_DN0; a.W_GU1 = p_W_GU1; a.W_DN1 = p_W_DN1; a.W_PG = p_W_PG; a.W_PP = p_W_PP; a.XB = p_XB; a.PB = p_PB; a.X = X; a.SSQ = p_SSQA; a.X8 = (unsigned char*)(wsl + WS_X8); a.RS1 = (float*)(wsl + WS_RS1);
        a.W8_IN = (unsigned char*)(wsl + WS_W_IN); a.SB_IN = (float*)(wsl + WS_W_IN + (size_t)14 * MiB); a.W8_GU0 = (unsigned char*)(wsl + WS_W_GU0); a.SB_GU0 = (float*)(wsl + WS_W_GU0 + (size_t)6 * MiB);
        a.W8_GU1 = (unsigned char*)(wsl + WS_W_GU1); a.SB_GU1 = (float*)(wsl + WS_W_GU1 + (size_t)56 * MiB); a.GATE = p_GATE; a.gate_bias = in[6]; a.DQ = p_DQ; a.WH16 = p_WH16;
        thin::prologue(a, (char*)lds, vcu, G);
    }
    SEAM(0);
#pragma unroll 1
    for (int L = 0; L < 2; ++L) {
        const int pb = 2 + 11 * L;
        if (EN(2) && IN(pb)) {
            SITE_WS
            pg8::Gemm g{(const bf16_t*)(wsl + WS_X8), (const bf16_t*)(wsl + WS_W_IN + (size_t)L * 7168 * 1024), M, 7168, 512, 512}; pg8::StaticOrder S; S.init(M, 7168, G, (int)blockIdx.x);
            pg8::EpiProj8 E{(const LAS float*)(ring + pg8::STAGE_BYTES), p_PROJ, (const float*)(wsl + WS_RS1), (const float*)(wsl + WS_W_IN + (size_t)14 * MiB) + L * 7168, p_AQ, p_AK, in[8] + L * 64, in[9] + L * 64, (unsigned char*)(wsl + WS_G8)};
            pg8::gemm_phase<pg8::EpiProj8, pg8::StaticOrder, EPI_ALIGN8, true>(ring, g, S, E);
        }
        SEAM(pb);
        if (EN(3) && IN(pb + 1)) {
            SITE_WS
            thin::PrepIn a; a.PROJ = p_PROJ; a.conv_w = in[4] + L * 4096; a.conv_b = in[5] + L * 1024;
            a.q_gain = in[8] + L * 64; a.k_gain = in[9] + L * 64; a.MQ = p_MQ; a.MK = p_MK; a.AQ = p_AQ; a.AK = p_AK; a.HP = p_HP;
            thin::prep(a, (char*)lds, vcu, G);
        }
        SEAM(pb + 1);
        if (EN(4) && IN(pb + 2)) {
            SITE_WS
            mix::MixPtrs P; P.PROJ = p_PROJ; P.MQ = p_MQ; P.MK = p_MK; P.AQ = p_AQ; P.AK = p_AK; P.GATE = p_GATE; P.HM = p_HM; P.HA = p_HA; P.m_hgain = in[7] + L * 512; P.a_hgain = in[11] + L * 512;
            { const float* lp = in[10] + L * 256; float d01 = 0.f, d23 = 0.f; for (int i = 0; i < 64; ++i) { d01 = fmaf(lp[i], lp[64 + i], d01); d23 = fmaf(lp[128 + i], lp[192 + i], d23); }
              const float lam_init = 0.8f - 0.6f * __expf(-0.3f * (float)L);
              float* lamv = (float*)((char*)lds + MISC_OFF + 64); if (tid == 0) { lamv[0] = __expf(d01) - __expf(d23) + lam_init; lamv[1] = 1.f - lam_init; } __syncthreads(); P.lamv = lamv; }
#ifndef MOE_CV_NW
#define MOE_CV_NW 128
#endif
            if ((int)blockIdx.x < MOE_CV_NW) {
                thin::MoeCvIn c; c.moe_w_gu = in[21]; c.moe_w_down = in[22]; c.p = in[1]; c.PB = p_PB; c.w_in = in[3]; c.attn_norm = in[2]; c.w_branch = in[14]; c.w_out = in[15]; c.ple_w_gate = in[24]; c.ple_norm = in[23]; c.ple_w_proj = in[25]; c.W_BR = p_W_BR; c.W_OUT = p_W_OUT; c.W_PG = p_W_PG; c.W_PP = p_W_PP; c.W8_IN = (unsigned char*)(wsl + WS_W_IN); c.SB_IN = (float*)(wsl + WS_W_IN + (size_t)14 * MiB); c.dense_w_gu = in[17]; c.dense_w_down = in[18]; c.ffn_norm = in[16]; c.W8_GU0 = (unsigned char*)(wsl + WS_W_GU0); c.SB_GU0 = (float*)(wsl + WS_W_GU0 + (size_t)6 * MiB); c.W_DN0 = p_W_DN0; c.W8_GU1 = (unsigned char*)(wsl + WS_W_GU1); c.SB_GU1 = (float*)(wsl + WS_W_GU1 + (size_t)56 * MiB); c.W_DN1 = p_W_DN1; c.DQ = p_DQ;
                if (L == 0) thin::moe_convert<0>(c, (char*)lds, (int)blockIdx.x, MOE_CV_NW); else thin::moe_convert<1>(c, (char*)lds, (int)blockIdx.x, MOE_CV_NW);
            }
            mix::mix_phase<true, true>((char*)lds, P, ctl + CW_QUEUE + 64 * L);
        }
        SEAM(pb + 2);
        if (EN(5) && IN(pb + 3)) {
            SITE_WS
            pg8::MergeOrder S; S.S.init(M, 1024, G, (int)blockIdx.x);
            pg8::Gemm g{p_HM, p_W_BR + (size_t)L * 3 * 1024 * 512, 3 * M, 1024, 512, 512}; pg8::EpiZs E{p_ZB, (const unsigned char*)(wsl + WS_G8)};
            pg8::gemm_phase<pg8::EpiZs, pg8::MergeOrder, true, true>(ring, g, S, E);
        }
        SEAM(pb + 3);
        if (EN(6) && IN(pb + 4)) {
            SITE_WS
            pg8::Gemm g{p_ZB, p_W_OUT + (size_t)L * 1024 * 1024, M, 1024, 1024, 1024}; pg8::StaticOrder S; S.init(M, 1024, G, (int)blockIdx.x);
            pg8::EpiRes E{p_XB, p_SSQB};
            pg8::gemm_phase<pg8::EpiRes, pg8::StaticOrder, true, true>(ring, g, S, E);
        }
        SEAM(pb + 4);
        if (L == 0) {
            if (EN(7) && IN(pb + 5)) {
                SITE_WS
                { thin::RowPassIn a{}; a.XB = p_XB; a.SSQ = p_SSQB; a.X8 = (unsigned char*)(wsl + WS_X8); a.RS1 = (float*)(wsl + WS_RS1); thin::row_pass<0>(a, (char*)lds, vcu, G); }
            }
            SEAM(pb + 5);
            if (EN(8) && IN(pb + 6)) {
                SITE_WS
                pg8::Gemm g{(const bf16_t*)(wsl + WS_X8), (const bf16_t*)(wsl + WS_W_GU0), M, 5632, 512, 512}; pg8::StaticOrder S; S.init(M, 5632, G, (int)blockIdx.x);
                pg8::EpiUp8d E{(const LAS float*)(ring + pg8::STAGE_BYTES), (unsigned char*)p_ACT, (const float*)(wsl + WS_RS1), (const float*)(wsl + WS_W_GU0 + (size_t)6 * MiB)};
                pg8::gemm_phase<pg8::EpiUp8d, pg8::StaticOrder, true, true>(ring, g, S, E);
                { pg8::Gemm g2{p_PB, p_W_PP, 2 * M, 1024, 256, 256};
                  pg8::PpOrder S2{(int)blockIdx.x, G};
                  pg8::EpiPP E2{p_PPb};
                  pg8::gemm_phase<pg8::EpiPP, pg8::PpOrder, true, true>(ring, g2, S2, E2); }
            }
            SEAM(pb + 6);
            if (EN(9) && IN(pb + 7)) {
                SITE_WS
                pg8::Gemm g{p_ACT, p_W_DN0, M, 1024, 1408, 1408}; pg8::StaticOrder S; S.init(M, 1024, G, (int)blockIdx.x);
                pg8::EpiResF8 E{p_XB, p_SSQB, __hip_atomic_load(p_DQ, __ATOMIC_RELAXED, __HIP_MEMORY_SCOPE_AGENT)};
                pg8::gemm_phase<pg8::EpiResF8, pg8::StaticOrder, true, true>(ring, g, S, E);
            }
            SEAM(pb + 7);
        } else {
            if (EN(7) && IN(pb + 5)) {
                SITE_WS
                thin::RowPassIn a{}; a.XB = p_XB; a.SSQ = p_SSQB; a.WT16 = p_WH16 + 2 * 16384; a.bias = in[20]; a.XG = (unsigned char*)p_XG; a.RSG = p_RSG; a.cnt = ctl + CW_ECNT; a.TOKI = p_TOKI; a.TOKG = p_TOKG;
                thin::row_pass<2>(a, (char*)lds, vcu, G);
            }
            SEAM(pb + 5);
            int ts[9]; ts[0] = 0;
#pragma unroll
            for (int e = 0; e < 8; ++e) { const unsigned c = __hip_atomic_load(ctl + CW_ECNT + e, __ATOMIC_RELAXED, __HIP_MEMORY_SCOPE_AGENT); ts[e + 1] = ts[e] + (int)((c + 255u) >> 8); }
            if (EN(10) && IN(pb + 6)) {
                SITE_WS
                pg8::Gemm g{p_XG, p_W_GU1, 0, 0, 512, 512};
                pg8::MoeOrder<true> S{ts[8], 28, ts[8] * 28, G, (int)blockIdx.x, ts[0], ts[1], ts[2], ts[3], ts[4], ts[5], ts[6], ts[7], 0};
                pg8::EpiUp8 E{(const LAS float*)(ring + pg8::STAGE_BYTES), (unsigned char*)p_ACT, p_RSG, (const float*)(wsl + WS_W_GU1 + (size_t)56 * MiB), ts[0], ts[1], ts[2], ts[3], ts[4], ts[5], ts[6], ts[7]};
                pg8::gemm_phase<pg8::EpiUp8, pg8::MoeOrder<true>, EPI_ALIGN8, true>(ring, g, S, E);
            }
            SEAM(pb + 6);
            if (EN(11) && IN(pb + 7)) {
                SITE_WS
                const int RA = ts[8] < 128 ? ts[8] : 128, RB = ts[8] - RA;
                float dqe[8];
#pragma unroll
                for (int e = 0; e < 8; ++e) dqe[e] = __hip_atomic_load(p_DQ + 1 + e, __ATOMIC_RELAXED, __HIP_MEMORY_SCOPE_AGENT);
                { pg8::Gemm g{p_ACT, p_W_DN1, 0, 0, 1792, 1792};
                  pg8::MoeOrder<false> S{RA, 4, RA * 4, G, (int)blockIdx.x, ts[0], ts[1], ts[2], ts[3], ts[4], ts[5], ts[6], ts[7], 0};
                  pg8::EpiDownMoe E{p_Yb, p_Yb, 1792, dqe[0], dqe[1], dqe[2], dqe[3], dqe[4], dqe[5], dqe[6], dqe[7]};
                  pg8::gemm_phase<pg8::EpiDownMoe, pg8::MoeOrder<false>, true, true>(ring, g, S, E); }
                if (RB > 0) { pg8::Gemm g{p_ACT, p_W_DN1, 0, 0, 896, 1792};
                  pg8::MoeOrder<false, 2, 896> S{RB, 4, RB * 4 * 2, G, (int)(G - 1 - blockIdx.x), ts[0], ts[1], ts[2], ts[3], ts[4], ts[5], ts[6], ts[7], 128};
                  pg8::EpiDownMoe E{p_Yb, p_Yb + (size_t)34816 * 1024, 896, dqe[0], dqe[1], dqe[2], dqe[3], dqe[4], dqe[5], dqe[6], dqe[7]};
                  pg8::gemm_phase<pg8::EpiDownMoe, pg8::MoeOrder<false, 2, 896>, true, true>(ring, g, S, E); }
            }
            SEAM(pb + 7);
            if (EN(12) && IN(pb + 8)) {
                SITE_WS
                thin::CombIn a; a.X = X; a.XB = p_XB; a.SSQ = p_SSQB; a.Y = p_Yb; a.TOKI = p_TOKI; a.TOKG = p_TOKG;
#pragma unroll
                for (int e = 0; e < 8; ++e) a.ts[e] = ts[e];
                thin::combine(a, vcu, G);
            }
            SEAM(pb + 8);
        }
        if (EN(13) && IN(pb + 9)) {
            SITE_WS
            pg8::Gemm g{p_XB, p_W_PG + (size_t)L * 1024 * 1024, M, 1024, 1024, 1024}; pg8::StaticOrder S; S.init(M, 1024, G, (int)blockIdx.x);
            if (L == 0) { pg8::EpiPle<false> E{X, p_XB, p_SSQB, p_SSQA, p_PPb}; pg8::gemm_phase<pg8::EpiPle<false>, pg8::StaticOrder, true, true>(ring, g, S, E); }
            else { pg8::EpiPle<true> E{X, p_XB, p_SSQB, p_SSQA, p_PPb + (size_t)M * 1024}; pg8::gemm_phase<pg8::EpiPle<true>, pg8::StaticOrder, true, true>(ring, g, S, E); }
        }
        if (L == 0) {
            SEAM(pb + 9);
            if (EN(7) && IN(pb + 10)) {
                SITE_WS
                thin::RowPassIn a{}; a.XB = p_XB; a.SSQ = p_SSQA; a.X8 = (unsigned char*)(wsl + WS_X8); a.RS1 = (float*)(wsl + WS_RS1); a.WT16 = p_WH16 + 16384; a.bias = in[6] + 8; a.GATE = p_GATE;
                thin::row_pass<1>(a, (char*)lds, vcu, G);
            }
            SEAM(pb + 10);
        }
    }
#undef IN
#undef SEAM
#undef EN
#undef SITE_WS
#undef p_XB
#undef p_PB
#undef p_PPb
#undef p_SSQA
#undef p_SSQB
#undef p_GATE
#undef p_RSG
#undef p_DQ
#undef p_WH16
#undef p_PROJ
#undef p_MQ
#undef p_MK
#undef p_AQ
#undef p_AK
#undef p_HM
#undef p_HA
#undef p_HP
#undef p_ZB
#undef p_XG
#undef p_Yb
#undef p_ACT
#undef p_TOKI
#undef p_TOKG
#undef p_W_IN
#undef p_W_BR
#undef p_W_OUT
#undef p_W_GU0
#undef p_W_DN0
#undef p_W_GU1
#undef p_W_DN1
#undef p_W_PG
#undef p_W_PP

}

constexpr int N_PHASES = 24;
extern "C" void kernel_launch(void* const* d_in, const int* in_sizes, int n_in, void* d_out, int out_size, void* d_ws, size_t ws_size, hipStream_t stream) {
    static int grid = 0;
    if (grid == 0) {
        if (n_in != 26 || out_size != M * 1024 || ws_size < WS_END) { fprintf(stderr, "kernel_launch: unexpected shapes (n_in %d out %d ws %zu need %zu)\n", n_in, out_size, ws_size, (size_t)WS_END); grid = -1; return; }
        int dev = 0, cus = 0, per_cu = 0;
        if (hipGetDevice(&dev) != hipSuccess || hipDeviceGetAttribute(&cus, hipDeviceAttributeMultiprocessorCount, dev) != hipSuccess) { grid = -1; return; }
        if (hipFuncSetAttribute((const void*)fwd_kernel, hipFuncAttributeMaxDynamicSharedMemorySize, LDS_BYTES) != hipSuccess) { fprintf(stderr, "kernel_launch: hipFuncSetAttribute failed\n"); grid = -1; return; }
        if (hipOccupancyMaxActiveBlocksPerMultiprocessor(&per_cu, (const void*)fwd_kernel, NWAVES * 64, LDS_BYTES) != hipSuccess || per_cu < 1) { fprintf(stderr, "kernel_launch: occupancy query says %d blocks per CU\n", per_cu); }
        (void)hipGetLastError();
        grid = cus;
    }
    if (grid < 0) return;
    if (hipMemsetAsync((char*)d_ws + WS_CTL, 0, CTL_ZERO_BYTES, stream) != hipSuccess) return;
    Args a{};
    for (int i = 0; i < 26; ++i) a.in[i] = (const float*)d_in[i];
    a.out = (float*)d_out; a.ws = (unsigned char*)d_ws;
#if N_LAUNCH_PER_PHASE
    for (int ph = 0; ph < N_PHASES; ++ph) { if (ph == 1 || ph == 10 || ph == 23) continue;
        a.ph_lo = ph; a.ph_hi = ph + 1; hipLaunchKernelGGL(fwd_kernel, dim3(grid), dim3(NWAVES * 64), LDS_BYTES, stream, a); }
#else
    a.ph_lo = 0; a.ph_hi = N_PHASES;
    hipLaunchKernelGGL(fwd_kernel, dim3(grid), dim3(NWAVES * 64), LDS_BYTES, stream, a);
#endif
    const hipError_t le = hipPeekAtLastError();
    if (le != hipSuccess) fprintf(stderr, "kernel_launch: launch failed: %s\n", hipGetErrorName(le));
}
```
